# Optimizing an MI355X kernel written in HIP

```python
import math
import jax, jax.numpy as jnp
from jax import lax
import numpy as np

D_MODEL = 1024
BATCH = 2
SEQ = 8192
DEPTH = 1

HEAD_DIM = 64
A_Q_HEADS = 8
A_KV_HEADS = 2
A_GROUP = A_Q_HEADS // A_KV_HEADS
WINDOW = 128
BLOCK = 128
B_HEADS = 4
B_VDIM = 2 * HEAD_DIM
A_WIDTH = A_Q_HEADS * HEAD_DIM
B_WIDTH = B_HEADS * B_VDIM
D_FF = 256 * ((8 * D_MODEL // 3 + 255) // 256)
ROPE_THETA = 10000.0
EPS = 1e-6
N_MOD = 9
NEG = -1e30

SPLIT_SIZES = (
    A_Q_HEADS * HEAD_DIM,
    A_KV_HEADS * HEAD_DIM,
    A_KV_HEADS * HEAD_DIM,
    B_HEADS * 2 * HEAD_DIM,
    B_HEADS * 2 * HEAD_DIM,
    B_HEADS * B_VDIM,
    D_MODEL,
    D_MODEL,
)
IN_COLS = sum(SPLIT_SIZES)
SPLIT_POINTS = tuple(int(v) for v in np.cumsum(SPLIT_SIZES)[:-1])

kernel_name = "hybrid_gated_window_diff_attn_macaron_adaln"


def rmsnorm(x, g):
    xf = x.astype(jnp.float32)
    y = xf * lax.rsqrt(jnp.mean(xf * xf, axis=-1, keepdims=True) + EPS)
    return (y * g.astype(jnp.float32)).astype(x.dtype)


def modulate(h, shift, scale):
    return h * (1 + scale[:, None, :]) + shift[:, None, :]


def swiglu(h, w_in, w_out):
    gate, up = jnp.split(h @ w_in, 2, axis=-1)
    return (jax.nn.silu(gate) * up) @ w_out


def rope_tables(positions):
    inv_freq = ROPE_THETA ** (-jnp.arange(0, HEAD_DIM, 2, dtype=jnp.float32) / HEAD_DIM)
    ang = positions.astype(jnp.float32)[..., None] * inv_freq
    ang = jnp.concatenate([ang, ang], axis=-1)
    return jnp.cos(ang), jnp.sin(ang)


def apply_rope(x, cos, sin):
    bshape = cos.shape[:2] + (1,) * (x.ndim - 3) + (HEAD_DIM,)
    cos, sin = cos.reshape(bshape), sin.reshape(bshape)
    xf = x.astype(jnp.float32)
    x1, x2 = jnp.split(xf, 2, axis=-1)
    rot = jnp.concatenate([-x2, x1], axis=-1)
    return (xf * cos + rot * sin).astype(x.dtype)


def window_gqa_sink(q, k, v, sink):
    B, S = q.shape[0], q.shape[1]
    nb = S // BLOCK
    qb = q.reshape(B, nb, BLOCK, A_KV_HEADS, A_GROUP, HEAD_DIM)
    pad = ((0, 0), (BLOCK, BLOCK), (0, 0), (0, 0))
    kp = jnp.pad(k, pad).reshape(B, nb + 2, BLOCK, A_KV_HEADS, HEAD_DIM)
    vp = jnp.pad(v, pad).reshape(B, nb + 2, BLOCK, A_KV_HEADS, HEAD_DIM)
    kw = jnp.concatenate([kp[:, :-2], kp[:, 1:-1], kp[:, 2:]], axis=2)
    vw = jnp.concatenate([vp[:, :-2], vp[:, 1:-1], vp[:, 2:]], axis=2)
    s = jnp.einsum('bnqhgd,bnkhd->bnhgqk', qb, kw,
                   preferred_element_type=jnp.float32) * (HEAD_DIM ** -0.5)
    blk = jnp.arange(nb)[:, None, None] * BLOCK
    qpos = blk + jnp.arange(BLOCK)[None, :, None]
    kpos = blk - BLOCK + jnp.arange(3 * BLOCK)[None, None, :]
    valid = (jnp.abs(qpos - kpos) <= WINDOW) & (kpos >= 0) & (kpos < S)
    s = jnp.where(valid[None, :, None, None], s, NEG)
    sk = sink.astype(jnp.float32).reshape(A_KV_HEADS, A_GROUP)[None, None, :, :, None, None]
    m = jnp.maximum(jnp.max(s, axis=-1, keepdims=True), sk)
    e = jnp.exp(s - m)
    p = e / (jnp.sum(e, axis=-1, keepdims=True) + jnp.exp(sk - m))
    o = jnp.einsum('bnhgqk,bnkhd->bnqhgd', p.astype(v.dtype), vw)
    return o.reshape(B, S, A_Q_HEADS * HEAD_DIM)


def diff_attention(q, k, v, lam):
    B, S = q.shape[0], q.shape[1]
    nb = S // BLOCK
    qb = q.reshape(B, nb, BLOCK, B_HEADS, 2, HEAD_DIM).transpose(1, 0, 2, 3, 4, 5)

    def one_block(qblk):
        s = jnp.einsum('bqhtd,bkhtd->bhtqk', qblk, k,
                       preferred_element_type=jnp.float32) * (HEAD_DIM ** -0.5)
        p = jax.nn.softmax(s, axis=-1)
        a = p[:, :, 0] - lam * p[:, :, 1]
        return jnp.einsum('bhqk,bkhe->bqhe', a.astype(v.dtype), v)

    o = lax.map(one_block, qb)
    return o.transpose(1, 0, 2, 3, 4).reshape(B, S, B_HEADS, B_VDIM)


def setup_inputs(seed: int = 0) -> dict:
    key = jax.random.key(seed)
    ks = iter(jax.random.split(key, 40))
    f32 = jnp.float32

    def nrm(shape, scale):
        return jax.random.normal(next(ks), shape, f32) * scale

    def gain(shape):
        return 1.0 + 0.02 * jax.random.normal(next(ks), shape, f32)

    L = DEPTH
    return {
        "x": nrm((BATCH, SEQ, D_MODEL), 1.0),
        "c": nrm((BATCH, D_MODEL), 1.0),
        "positions": jnp.broadcast_to(jnp.arange(SEQ, dtype=jnp.int32), (BATCH, SEQ)),
        "w_mod": nrm((L, D_MODEL, N_MOD * D_MODEL), 0.5 * D_MODEL ** -0.5),
        "b_mod": nrm((L, N_MOD * D_MODEL), 0.02),
        "norm_ffn1": gain((L, D_MODEL)),
        "w_ffn1_in": nrm((L, D_MODEL, 2 * D_FF), D_MODEL ** -0.5),
        "w_ffn1_out": nrm((L, D_FF, D_MODEL), D_FF ** -0.5),
        "norm_mix": gain((L, D_MODEL)),
        "w_in": nrm((L, D_MODEL, IN_COLS), D_MODEL ** -0.5),
        "qn_a": gain((L, HEAD_DIM)),
        "kn_a": gain((L, HEAD_DIM)),
        "sink_a": nrm((L, A_Q_HEADS), 1.0),
        "qn_b": gain((L, HEAD_DIM)),
        "kn_b": gain((L, HEAD_DIM)),
        "lam_q1": nrm((L, HEAD_DIM), 0.1),
        "lam_k1": nrm((L, HEAD_DIM), 0.1),
        "lam_q2": nrm((L, HEAD_DIM), 0.1),
        "lam_k2": nrm((L, HEAD_DIM), 0.1),
        "subln_b": gain((L, B_VDIM)),
        "w_branch_a": nrm((L, A_WIDTH, D_MODEL), A_WIDTH ** -0.5),
        "w_branch_b": nrm((L, B_WIDTH, D_MODEL), B_WIDTH ** -0.5),
        "w_out": nrm((L, D_MODEL, D_MODEL), D_MODEL ** -0.5),
        "norm_ffn2": gain((L, D_MODEL)),
        "w_ffn2_in": nrm((L, D_MODEL, 2 * D_FF), D_MODEL ** -0.5),
        "w_ffn2_out": nrm((L, D_FF, D_MODEL), D_FF ** -0.5),
    }


def reference(x, c, positions, w_mod, b_mod, norm_ffn1, w_ffn1_in, w_ffn1_out,
              norm_mix, w_in, qn_a, kn_a, sink_a, qn_b, kn_b,
              lam_q1, lam_k1, lam_q2, lam_k2, subln_b,
              w_branch_a, w_branch_b, w_out, norm_ffn2, w_ffn2_in, w_ffn2_out):
    B, S = x.shape[0], x.shape[1]
    cos, sin = rope_tables(positions)
    c_act = jax.nn.silu(c)
    for l in range(DEPTH):
        mod = c_act @ w_mod[l] + b_mod[l]
        (sh1, sc1, g1, sh2, sc2, g2, sh3, sc3, g3) = jnp.split(mod, N_MOD, axis=-1)

        h = modulate(rmsnorm(x, norm_ffn1[l]), sh1, sc1)
        x = x + 0.5 * g1[:, None, :] * swiglu(h, w_ffn1_in[l], w_ffn1_out[l])

        h = modulate(rmsnorm(x, norm_mix[l]), sh2, sc2)
        qa, ka, va, qb, kb, vb, ga, gb = jnp.split(h @ w_in[l], SPLIT_POINTS, axis=-1)

        qa = apply_rope(rmsnorm(qa.reshape(B, S, A_Q_HEADS, HEAD_DIM), qn_a[l]), cos, sin)
        ka = apply_rope(rmsnorm(ka.reshape(B, S, A_KV_HEADS, HEAD_DIM), kn_a[l]), cos, sin)
        va = va.reshape(B, S, A_KV_HEADS, HEAD_DIM)
        ya = window_gqa_sink(qa, ka, va, sink_a[l]) @ w_branch_a[l]

        qb = apply_rope(rmsnorm(qb.reshape(B, S, B_HEADS, 2, HEAD_DIM), qn_b[l]), cos, sin)
        kb = apply_rope(rmsnorm(kb.reshape(B, S, B_HEADS, 2, HEAD_DIM), kn_b[l]), cos, sin)
        vb = vb.reshape(B, S, B_HEADS, B_VDIM)
        lam_init = 0.8 - 0.6 * math.exp(-0.3 * l)
        f32 = jnp.float32
        lam = (jnp.exp(jnp.sum(lam_q1[l].astype(f32) * lam_k1[l].astype(f32)))
               - jnp.exp(jnp.sum(lam_q2[l].astype(f32) * lam_k2[l].astype(f32))) + lam_init)
        ob = diff_attention(qb, kb, vb, lam)
        ob = (rmsnorm(ob, subln_b[l]) * (1.0 - lam_init)).reshape(B, S, B_WIDTH)
        yb = ob @ w_branch_b[l]

        merged = jax.nn.sigmoid(ga) * ya + jax.nn.sigmoid(gb) * yb
        x = x + g2[:, None, :] * (merged @ w_out[l])

        h = modulate(rmsnorm(x, norm_ffn2[l]), sh3, sc3)
        x = x + 0.5 * g3[:, None, :] * swiglu(h, w_ffn2_in[l], w_ffn2_out[l])
    return x
```

```cpp
#include <hip/hip_runtime.h>
#include <cstdio>
#include <cstdint>
#include <cmath>
__device__ __forceinline__ int mk_lane_() { int l = (int)__builtin_amdgcn_mbcnt_hi(~0u, __builtin_amdgcn_mbcnt_lo(~0u, 0u)); asm volatile("" : "+v"(l)); return l; }
#define MK_LANE() mk_lane_()
namespace pg8 {
#define PG8_LAS __attribute__((address_space(3)))
typedef unsigned short bf16_t;
typedef short bf16x8 __attribute__((ext_vector_type(8)));
typedef float f32x4 __attribute__((ext_vector_type(4)));
typedef unsigned u32x4 __attribute__((ext_vector_type(4)));
constexpr int BM = 256, BK = 64, HALF = 128, HTB = HALF * BK * 2  , STAGE_BYTES = 8 * HTB, NXCD = 8, WGM = 8;

__host__ __device__ __forceinline__ int lds_byte(int r, int c) { const int st = (r >> 4) * 2 + (c >> 5), rr = r & 15, cc = c & 31, ob = rr * 64 + cc * 2; return st * 1024 + (ob ^ (((ob >> 9) & 1) << 5)); }
__host__ __device__ __forceinline__ void stage_rc(int b, int& R, int& C) { const int st = b / 1024, sb = b % 1024, swz = sb ^ (((sb >> 9) & 1) << 5); R = (st >> 1) * 16 + swz / 64; C = (st & 1) * 32 + (swz % 64) / 2; }
__host__ __device__ __forceinline__ int perm32(int rho) { const int n = rho >> 4, i = rho & 15; return 8 * (i >> 2) + 4 * n + (i & 3); }

struct Unit { int pm, pn; };
struct Gemm { const bf16_t* A; const bf16_t* Bt; int M, N, K; };

struct StaticOrder {
    int nM, nN, nwg, G, c;
    __host__ __device__ void init(int M, int N, int G_, int c_) { nM = M / BM; nN = N / BM; nwg = nM * nN; G = G_; c = c_; }
    __host__ __device__ bool next(int i, Unit& u) const {
        const long L = (long)i * G + c; if (L >= nwg) return false;
        int wgid = (int)L; { const int q = nwg / NXCD, r = nwg % NXCD, xcd = wgid % NXCD, off = wgid / NXCD; wgid = (xcd < r ? xcd * (q + 1) : r * (q + 1) + (xcd - r) * q) + off; }
        const int nig = WGM * nN, gid = wgid / nig, fm = gid * WGM, gsz = (nM - fm) < WGM ? (nM - fm) : WGM;
        u.pm = fm + ((wgid % nig) % gsz); u.pn = (wgid % nig) / gsz; return true;
    }
    __device__ __forceinline__ void a_ready(const Unit&) const {}
    __device__ __forceinline__ void done(const Unit&) const {}
};

__device__ __forceinline__ unsigned cvt_pk_bf16(float lo, float hi) { unsigned r; asm volatile("v_cvt_pk_bf16_f32 %0, %1, %2" : "=v"(r) : "v"(lo), "v"(hi)); return r; }
__device__ __forceinline__ float bf_lo(unsigned w) { return __uint_as_float(w << 16); }
__device__ __forceinline__ float bf_hi(unsigned w) { return __uint_as_float(w & 0xffff0000u); }
constexpr float RMS_EPS = 1e-6f, LOG2E = 1.4426950408889634f;
__device__ __forceinline__ float row_rinv(const float* rss, int row) { const f32x4 s = *(const f32x4*)(rss + (size_t)row * 4); return rsqrtf(((s[0] + s[1]) + (s[2] + s[3])) * (1.0f / 1024.0f) + RMS_EPS); }
__device__ __forceinline__ float fast_sigmoid(float v) { return __builtin_amdgcn_rcpf(1.0f + __builtin_amdgcn_exp2f(-v * LOG2E)); }

struct EpiSwiGLU {
    static constexpr bool PERM = true, AFTER_DRAIN = false;
    bf16_t* H; int ldh; const float* rss; const float* cb; int ncb;
    __device__ __forceinline__ void operator()(const f32x4 (&acc)[2][2][4][2], const Unit& u, int wr, int wc, int fr, int fq) const {
        const int b = u.pm >> 5, colb = u.pn * BM + wc * 32 + 8 * fq, outcol = u.pn * HALF + wc * 32 + 8 * fq;
        const float* cbb = cb + (size_t)b * ncb + colb;
        const f32x4 bg0 = *(const f32x4*)(cbb), bg1 = *(const f32x4*)(cbb + 4), bu0 = *(const f32x4*)(cbb + HALF), bu1 = *(const f32x4*)(cbb + HALF + 4);
#pragma unroll
        for (int ai = 0; ai < 2; ++ai)
#pragma unroll
            for (int m = 0; m < 4; ++m) {
                const int row = u.pm * BM + ai * HALF + wr * 64 + m * 16 + fr; const float ri = row_rinv(rss, row);
                const f32x4 g0 = acc[ai][0][m][0] * ri + bg0, g1 = acc[ai][0][m][1] * ri + bg1, u0 = acc[ai][1][m][0] * ri + bu0, u1 = acc[ai][1][m][1] * ri + bu1;
                float o[8];
#pragma unroll
                for (int j = 0; j < 4; ++j) { o[j] = g0[j] * fast_sigmoid(g0[j]) * u0[j]; o[4 + j] = g1[j] * fast_sigmoid(g1[j]) * u1[j]; }
                u32x4 w; w.x = cvt_pk_bf16(o[0], o[1]); w.y = cvt_pk_bf16(o[2], o[3]); w.z = cvt_pk_bf16(o[4], o[5]); w.w = cvt_pk_bf16(o[6], o[7]);
                *(u32x4*)(H + (size_t)row * ldh + outcol) = w; }
    }
};

struct EpiInProj {
    static constexpr bool PERM = true, AFTER_DRAIN = false;
    bf16_t *QA, *KA, *VA, *QB, *KB, *VB, *GA, *GB; const float* rss; const float* cb; const float* cost; const float* sint; const float *qn_a, *kn_a, *qn_b, *kn_b; float qscale;
    __device__ __forceinline__ void operator()(const f32x4 (&acc)[2][2][4][2], const Unit& u, int wr, int wc, int fr, int fq) const {
        const int pn = u.pn, b = u.pm >> 5;
        int mode; bf16_t* dst; int ld; const float* gain = qn_a; float scale = 1.f;
        if (pn < 2) { mode = 0; dst = QA + (4 * pn + wc) * 64; ld = 512; gain = qn_a; scale = qscale; }
        else if (pn == 2) { if (wc < 2) { mode = 0; dst = KA + wc * 64; ld = 128; gain = kn_a; } else { mode = 1; dst = VA + (wc - 2) * 64; ld = 128; } }
        else if (pn < 5) { mode = 0; dst = QB + (4 * (pn - 3) + wc) * 64; ld = 512; gain = qn_b; scale = qscale; }
        else if (pn < 7) { mode = 0; dst = KB + (4 * (pn - 5) + wc) * 64; ld = 512; gain = kn_b; }
        else if (pn < 9) { mode = 1; dst = VB + (4 * (pn - 7) + wc) * 64; ld = 512; }
        else if (pn < 13) { mode = 2; dst = GA + (pn - 9) * BM + wc * 32; ld = 1024; }
        else { mode = 2; dst = GB + (pn - 13) * BM + wc * 32; ld = 1024; }
        const int bjoff = (mode == 2) ? HALF : 32;
        const float* cbb = cb + (size_t)b * 4352 + pn * BM + wc * 32 + 8 * fq;
        f32x4 bv[2][2];
#pragma unroll
        for (int bj = 0; bj < 2; ++bj)
#pragma unroll
            for (int n = 0; n < 2; ++n) bv[bj][n] = *(const f32x4*)(cbb + bj * HALF + 4 * n);
        f32x4 gv[2][2];
#pragma unroll
        for (int bj = 0; bj < 2; ++bj)
#pragma unroll
            for (int n = 0; n < 2; ++n) gv[bj][n] = *(const f32x4*)(gain + bj * 32 + 8 * fq + 4 * n);
#pragma unroll
        for (int ai = 0; ai < 2; ++ai)
#pragma unroll
            for (int m = 0; m < 4; ++m) {
                const int row = u.pm * BM + ai * HALF + wr * 64 + m * 16 + fr; const float ri = row_rinv(rss, row);
                f32x4 v[2][2];
#pragma unroll
                for (int bj = 0; bj < 2; ++bj)
#pragma unroll
                    for (int n = 0; n < 2; ++n) v[bj][n] = acc[ai][bj][m][n] * ri + bv[bj][n];
                if (mode == 0) {
                    float ss = 0.f;
#pragma unroll
                    for (int bj = 0; bj < 2; ++bj)
#pragma unroll
                        for (int n = 0; n < 2; ++n) ss += (v[bj][n][0] * v[bj][n][0] + v[bj][n][1] * v[bj][n][1]) + (v[bj][n][2] * v[bj][n][2] + v[bj][n][3] * v[bj][n][3]);
                    ss += __shfl_xor(ss, 16); ss += __shfl_xor(ss, 32);
                    const float rn = rsqrtf(ss * (1.0f / 64.0f) + RMS_EPS);
#pragma unroll
                    for (int n = 0; n < 2; ++n) {
                        const f32x4 cs = *(const f32x4*)(cost + (size_t)row * 32 + 8 * fq + 4 * n), sn = *(const f32x4*)(sint + (size_t)row * 32 + 8 * fq + 4 * n);
                        const f32x4 lo = v[0][n] * rn * gv[0][n], hi = v[1][n] * rn * gv[1][n];
                        v[0][n] = (lo * cs - hi * sn) * scale; v[1][n] = (hi * cs + lo * sn) * scale; }
                } else if (mode == 2) {
#pragma unroll
                    for (int bj = 0; bj < 2; ++bj)
#pragma unroll
                        for (int n = 0; n < 2; ++n)
#pragma unroll
                            for (int j = 0; j < 4; ++j) v[bj][n][j] = fast_sigmoid(v[bj][n][j]);
                }
                bf16_t* rowp = dst + (size_t)row * ld + 8 * fq;
#pragma unroll
                for (int bj = 0; bj < 2; ++bj) { u32x4 w; w.x = cvt_pk_bf16(v[bj][0][0], v[bj][0][1]); w.y = cvt_pk_bf16(v[bj][0][2], v[bj][0][3]); w.z = cvt_pk_bf16(v[bj][1][0], v[bj][1][1]); w.w = cvt_pk_bf16(v[bj][1][2], v[bj][1][3]);
                    *(u32x4*)(rowp + bj * bjoff) = w; } }
    }
};

struct EpiBranch {
    static constexpr bool PERM = true, AFTER_DRAIN = false;
    const bf16_t* GA; const bf16_t* GB; bf16_t* MG;
    __device__ __forceinline__ void operator()(const f32x4 (&acc)[2][2][4][2], const Unit& u, int wr, int wc, int fr, int fq) const {
        const int col = u.pn * HALF + wc * 32 + 8 * fq;
#pragma unroll
        for (int ai = 0; ai < 2; ++ai)
#pragma unroll
            for (int m = 0; m < 4; ++m) {
                const int row = u.pm * BM + ai * HALF + wr * 64 + m * 16 + fr; const size_t off = (size_t)row * 1024 + col;
                const u32x4 ga = *(const u32x4*)(GA + off), gb = *(const u32x4*)(GB + off);
                const f32x4 ya0 = acc[ai][0][m][0], ya1 = acc[ai][0][m][1], yb0 = acc[ai][1][m][0], yb1 = acc[ai][1][m][1];
                u32x4 w;
                w.x = cvt_pk_bf16(bf_lo(ga.x) * ya0[0] + bf_lo(gb.x) * yb0[0], bf_hi(ga.x) * ya0[1] + bf_hi(gb.x) * yb0[1]);
                w.y = cvt_pk_bf16(bf_lo(ga.y) * ya0[2] + bf_lo(gb.y) * yb0[2], bf_hi(ga.y) * ya0[3] + bf_hi(gb.y) * yb0[3]);
                w.z = cvt_pk_bf16(bf_lo(ga.z) * ya1[0] + bf_lo(gb.z) * yb1[0], bf_hi(ga.z) * ya1[1] + bf_hi(gb.z) * yb1[1]);
                w.w = cvt_pk_bf16(bf_lo(ga.w) * ya1[2] + bf_lo(gb.w) * yb1[2], bf_hi(ga.w) * ya1[3] + bf_hi(gb.w) * yb1[3]);
                *(u32x4*)(MG + off) = w; }
    }
};

template <bool WRITE_A, int COEF2> struct EpiResid {
    static constexpr bool PERM = true, AFTER_DRAIN = true;
    static constexpr float coef = 0.5f * COEF2; static constexpr int modld = 9216;
    const float* xin; float* xout; const float* gate;
    bf16_t* Aout; const float* gnorm; const float* sc; float* rss_out;
    __device__ __forceinline__ void fused(f32x4 (&acc)[2][2][4][2], const Unit& u, int wr, int wc, int fr, int fq, PG8_LAS unsigned char* lds, int wid, int lane) const {
        const int b = u.pm >> 5, col0 = u.pn * BM + wc * 32 + 8 * fq;
        float ss[2][4];
#pragma unroll
        for (int ai = 0; ai < 2; ++ai)
#pragma unroll
            for (int m = 0; m < 4; ++m) ss[ai][m] = 0.f;
#pragma unroll
        for (int bj = 0; bj < 2; ++bj) {
            f32x4 gt[2], gvv[2];
#pragma unroll
            for (int n = 0; n < 2; ++n) { const int c = col0 + bj * HALF + 4 * n; gt[n] = *(const f32x4*)(gate + (size_t)b * modld + c) * coef;
                if (WRITE_A) gvv[n] = *(const f32x4*)(gnorm + c) * (*(const f32x4*)(sc + (size_t)b * modld + c) + 1.0f); }
#pragma unroll
            for (int ai = 0; ai < 2; ++ai)
#pragma unroll
                for (int m = 0; m < 4; ++m) {
                    const int row = u.pm * BM + ai * HALF + wr * 64 + m * 16 + fr; const size_t off = (size_t)row * 1024 + col0 + bj * HALF; float s = 0.f;
                    f32x4 xo[2];
#pragma unroll
                    for (int n = 0; n < 2; ++n) { const f32x4 xi = *(const f32x4*)(xin + off + 4 * n); xo[n] = xi + gt[n] * acc[ai][bj][m][n]; *(f32x4*)(xout + off + 4 * n) = xo[n];
                        if (WRITE_A) s += (xo[n][0] * xo[n][0] + xo[n][1] * xo[n][1]) + (xo[n][2] * xo[n][2] + xo[n][3] * xo[n][3]); }
                    if (WRITE_A) { const f32x4 a0 = xo[0] * gvv[0], a1 = xo[1] * gvv[1]; u32x4 w; w.x = cvt_pk_bf16(a0[0], a0[1]); w.y = cvt_pk_bf16(a0[2], a0[3]); w.z = cvt_pk_bf16(a1[0], a1[1]); w.w = cvt_pk_bf16(a1[2], a1[3]);
                        *(u32x4*)(Aout + off) = w; ss[ai][m] += s; }
                    if (m & 1) asm volatile("" ::: "memory"); }
        }
        if (WRITE_A) {
            PG8_LAS float* P = (PG8_LAS float*)lds;
#pragma unroll
            for (int ai = 0; ai < 2; ++ai)
#pragma unroll
                for (int m = 0; m < 4; ++m) { float s = ss[ai][m]; s += __shfl_xor(s, 16); s += __shfl_xor(s, 32); if (fq == 0) P[(ai * HALF + wr * 64 + m * 16 + fr) * 4 + wc] = s; }
            asm volatile("s_waitcnt lgkmcnt(0)" ::: "memory"); __builtin_amdgcn_s_barrier(); asm volatile("" ::: "memory");
            const int t = wid * 64 + lane;
            if (t < 256) { const PG8_LAS float* p = P + t * 4; rss_out[(size_t)(u.pm * BM + t) * 4 + u.pn] = (p[0] + p[1]) + (p[2] + p[3]); }
        }
    }
};

template <class Epi, class Sched, bool ALIGN_EPI = false, bool SP2 = false>
__device__ __forceinline__ void gemm_phase(PG8_LAS unsigned char* lds, const Gemm g, const Sched S, const Epi E, const int wid  ) {
    const int lane = MK_LANE(), tid = wid * 64 + lane, wr = wid >> 2, wc = wid & 3, fr = lane & 15, fq = lane >> 4;
    const int K = g.K, nt = K / BK;
    unsigned voffA[2], voffB[2];
#pragma unroll
    for (int i = 0; i < 2; ++i) { int R, C; stage_rc(tid * 16 + i * 8192, R, C); const int Rb = Epi::PERM ? ((R & ~31) + perm32(R & 31)) : R;
        voffA[i] = (unsigned)(R * K + C) * 2u; voffB[i] = (unsigned)(Rb * K + C) * 2u; }
    const size_t kstep = (size_t)(BK * 2);
    const size_t hstep = (size_t)HALF * K * 2;
    const size_t tstep = 2 * hstep;
    const unsigned ldsw = (unsigned)wid * 1024u;
    const int aoff = lds_byte(wr * 64 + fr, fq * 8), boff = lds_byte(wc * 32 + fr, fq * 8);
#define PG8_SA(b, h) (((b) * 2 + (h)) * HTB)
#define PG8_SB(b, h) ((4 + (b) * 2 + (h)) * HTB)
#define PG8_STAGE(bufoff, gbase, voff) do { _Pragma("unroll") for (int _i = 0; _i < 2; ++_i) \
        __builtin_amdgcn_global_load_lds((const unsigned*)((const char*)(gbase) + (voff)[_i]), (PG8_LAS unsigned*)(lds + (bufoff) + ldsw + _i * 8192), 16, 0, 0); } while (0)
#define PG8_LDA(dst, b, h) do { _Pragma("unroll") for (int m = 0; m < 4; ++m) _Pragma("unroll") for (int k = 0; k < 2; ++k) dst[m][k] = *(const PG8_LAS bf16x8*)(lds + PG8_SA(b, h) + aoff + m * 2048 + k * 1024); } while (0)
#define PG8_LDB(dst, b, h) do { _Pragma("unroll") for (int n = 0; n < 2; ++n) _Pragma("unroll") for (int k = 0; k < 2; ++k) dst[n][k] = *(const PG8_LAS bf16x8*)(lds + PG8_SB(b, h) + boff + n * 2048 + k * 1024); } while (0)
#define PG8_MMA(ai, bj, At, Bt) do { __builtin_amdgcn_s_setprio(1); _Pragma("unroll") for (int m = 0; m < 4; ++m) _Pragma("unroll") for (int n = 0; n < 2; ++n) _Pragma("unroll") for (int k = 0; k < 2; ++k) \
        acc[ai][bj][m][n] = __builtin_amdgcn_mfma_f32_16x16x32_bf16(Bt[n][k], At[m][k], acc[ai][bj][m][n], 0, 0, 0); __builtin_amdgcn_s_setprio(0); } while (0)
#define PG8_WAIT_V(n) asm volatile("s_waitcnt vmcnt(" #n ")" ::: "memory")
#define PG8_WAIT_L(n) asm volatile("s_waitcnt lgkmcnt(" #n ")" ::: "memory")
#define PG8_BAR __builtin_amdgcn_s_barrier()
#define PG8_SCHED __builtin_amdgcn_sched_barrier(0)
    Unit cur, nxt; int ui = 0;
    if (!S.next(0, cur)) return;
    f32x4 acc[2][2][4][2];
#pragma unroll
    for (int a = 0; a < 2; ++a)
#pragma unroll
        for (int b = 0; b < 2; ++b)
#pragma unroll
            for (int m = 0; m < 4; ++m)
#pragma unroll
                for (int n = 0; n < 2; ++n) acc[a][b][m][n] = (f32x4){0.f, 0.f, 0.f, 0.f};
    bf16x8 At[4][2], B0[2][2], B1[2][2];
    const char* cA = (const char*)g.A + (size_t)cur.pm * tstep; const char* cB = (const char*)g.Bt + (size_t)cur.pn * tstep;
    S.a_ready(cur);
    if constexpr (SP2) {
        PG8_STAGE(PG8_SB(0, 0), cB, voffB); PG8_STAGE(PG8_SB(0, 1), cB + hstep, voffB); PG8_STAGE(PG8_SA(0, 0), cA, voffA); PG8_STAGE(PG8_SA(0, 1), cA + hstep, voffA);
        if (wr == 1) PG8_BAR;
        PG8_WAIT_V(2); PG8_BAR;
        PG8_STAGE(PG8_SB(1, 0), cB + kstep, voffB); PG8_STAGE(PG8_SA(1, 0), cA + kstep, voffA); PG8_STAGE(PG8_SB(1, 1), cB + hstep + kstep, voffB);
        PG8_WAIT_V(6); PG8_BAR;
    } else {
        PG8_STAGE(PG8_SB(0, 0), cB, voffB); PG8_STAGE(PG8_SA(0, 0), cA, voffA); PG8_STAGE(PG8_SB(0, 1), cB + hstep, voffB); PG8_STAGE(PG8_SA(0, 1), cA + hstep, voffA);
        if (wr == 1) PG8_BAR;
        PG8_WAIT_V(4); PG8_BAR;
        PG8_STAGE(PG8_SB(1, 0), cB + kstep, voffB); PG8_STAGE(PG8_SA(1, 0), cA + kstep, voffA); PG8_STAGE(PG8_SB(1, 1), cB + hstep + kstep, voffB);
        PG8_WAIT_V(6); PG8_BAR;
    }
    for (;;) {
        const bool has_next = S.next(ui + 1, nxt);
        const char* nA = has_next ? (const char*)g.A + (size_t)nxt.pm * tstep : cA; const char* nB = has_next ? (const char*)g.Bt + (size_t)nxt.pn * tstep : cB;
        for (int t = 0; t < nt; t += 2) {
            const bool last = (t == nt - 2);
            const char* a1 = cA + (size_t)(t + 1) * kstep;
            const char* a2 = last ? nA : cA + (size_t)(t + 2) * kstep; const char* b2 = last ? nB : cB + (size_t)(t + 2) * kstep;
            const char* a3 = a2 + kstep; const char* b3 = b2 + kstep;
            if (last && has_next) S.a_ready(nxt);
            if constexpr (SP2) {
            PG8_LDB(B0, 0, 0); PG8_LDB(B1, 0, 1); PG8_SCHED; PG8_LDA(At, 0, 0); PG8_STAGE(PG8_SA(1, 1), a1 + hstep, voffA);
            PG8_WAIT_V(8); PG8_WAIT_L(0); PG8_BAR; PG8_MMA(0, 0, At, B0); PG8_MMA(0, 1, At, B1); PG8_BAR; PG8_SCHED;
            PG8_LDA(At, 0, 1); PG8_STAGE(PG8_SB(0, 0), b2, voffB); PG8_STAGE(PG8_SB(0, 1), b2 + hstep, voffB); PG8_STAGE(PG8_SA(0, 0), a2, voffA);
            PG8_WAIT_V(8); PG8_WAIT_L(0); PG8_BAR; PG8_MMA(1, 0, At, B0); PG8_MMA(1, 1, At, B1); PG8_BAR; PG8_SCHED;
            PG8_LDB(B0, 1, 0); PG8_LDB(B1, 1, 1); PG8_SCHED; PG8_LDA(At, 1, 0); PG8_STAGE(PG8_SA(0, 1), a2 + hstep, voffA);
            PG8_WAIT_V(8); PG8_WAIT_L(0); PG8_BAR; PG8_MMA(0, 0, At, B0); PG8_MMA(0, 1, At, B1); PG8_BAR; PG8_SCHED;
            PG8_LDA(At, 1, 1); PG8_STAGE(PG8_SB(1, 0), b3, voffB); PG8_STAGE(PG8_SB(1, 1), b3 + hstep, voffB); PG8_STAGE(PG8_SA(1, 0), a3, voffA);
            PG8_WAIT_V(8); PG8_WAIT_L(0); PG8_BAR; PG8_MMA(1, 0, At, B0); PG8_MMA(1, 1, At, B1); PG8_BAR; PG8_SCHED;
            } else {
            PG8_LDB(B0, 0, 0); PG8_SCHED; PG8_LDA(At, 0, 0); PG8_STAGE(PG8_SA(1, 1), a1 + hstep, voffA);
            PG8_WAIT_L(8); PG8_BAR; PG8_WAIT_L(0); PG8_MMA(0, 0, At, B0); PG8_BAR; PG8_SCHED;
            PG8_LDB(B1, 0, 1); PG8_STAGE(PG8_SB(0, 0), b2, voffB);
            PG8_BAR; PG8_WAIT_L(0); PG8_MMA(0, 1, At, B1); PG8_BAR;
            PG8_LDA(At, 0, 1); PG8_STAGE(PG8_SA(0, 0), a2, voffA);
            PG8_BAR; PG8_WAIT_L(0); PG8_MMA(1, 0, At, B0); PG8_BAR; PG8_SCHED;
            PG8_STAGE(PG8_SB(0, 1), b2 + hstep, voffB);
            PG8_WAIT_V(6); PG8_BAR; PG8_MMA(1, 1, At, B1); PG8_BAR;
            PG8_LDB(B0, 1, 0); PG8_SCHED; PG8_LDA(At, 1, 0); PG8_STAGE(PG8_SA(0, 1), a2 + hstep, voffA);
            PG8_WAIT_L(8); PG8_BAR; PG8_WAIT_L(0); PG8_MMA(0, 0, At, B0); PG8_BAR; PG8_SCHED;
            PG8_LDB(B1, 1, 1); PG8_STAGE(PG8_SB(1, 0), b3, voffB);
            PG8_BAR; PG8_WAIT_L(0); PG8_MMA(0, 1, At, B1); PG8_BAR;
            PG8_LDA(At, 1, 1); PG8_STAGE(PG8_SA(1, 0), a3, voffA);
            PG8_BAR; PG8_WAIT_L(0); PG8_MMA(1, 0, At, B0); PG8_BAR; PG8_SCHED;
            PG8_STAGE(PG8_SB(1, 1), b3 + hstep, voffB);
            PG8_WAIT_V(6); PG8_BAR; PG8_MMA(1, 1, At, B1); PG8_BAR;
            }
        }
        if constexpr (ALIGN_EPI) { if (wr == 0) PG8_BAR; }
        if constexpr (!Epi::AFTER_DRAIN) { E(acc, cur, wr, wc, fr, fq); S.done(cur); }
        if (!has_next) break;
#pragma unroll
        for (int a = 0; a < 2; ++a)
#pragma unroll
            for (int b = 0; b < 2; ++b)
#pragma unroll
                for (int m = 0; m < 4; ++m)
#pragma unroll
                    for (int n = 0; n < 2; ++n) acc[a][b][m][n] = (f32x4){0.f, 0.f, 0.f, 0.f};
        cur = nxt; cA = nA; cB = nB; ++ui;
        if constexpr (ALIGN_EPI) { if (wr == 1) PG8_BAR; }
    }
    PG8_WAIT_V(0);
    if constexpr (!ALIGN_EPI) { if (wr == 0) PG8_BAR; }
    PG8_BAR;
    if constexpr (Epi::AFTER_DRAIN) { E.fused(acc, cur, wr, wc, fr, fq, lds, wid, lane); S.done(cur); }
#undef PG8_SA
#undef PG8_SB
#undef PG8_STAGE
#undef PG8_LDA
#undef PG8_LDB
#undef PG8_MMA
#undef PG8_WAIT_V
#undef PG8_WAIT_L
#undef PG8_BAR
#undef PG8_SCHED
}
}

#ifndef PG8_SP2
#define PG8_SP2 true
#endif
#ifndef PG8_ALIGN
#define PG8_ALIGN true
#endif
namespace att {
using bf16x8 = __attribute__((ext_vector_type(8))) short;
using s16x4  = __attribute__((ext_vector_type(4))) short;
using f32x16 = __attribute__((ext_vector_type(16))) float;
using u32x4  = __attribute__((ext_vector_type(4))) unsigned;
typedef unsigned short bf16_t;
constexpr int NW = 8, QBLK = 32, KVBLK = 64;
#ifndef ATT_SDEPTH
#define ATT_SDEPTH 1
#endif
#define ATT_SBAR() __builtin_amdgcn_sched_barrier(0)
#define KSWZ64(row, colB) ((row) * 128 + ((colB) ^ ((((row) >> 1) & 7) << 4)))
__device__ __forceinline__ int crow(int r, int hi) { return (r & 3) + 8 * (r >> 2) + 4 * hi; }
__device__ __forceinline__ unsigned cvtpk(float lo, float hi) { unsigned r; asm volatile("v_cvt_pk_bf16_f32 %0, %1, %2" : "=v"(r) : "v"(lo), "v"(hi)); return r; }
__device__ __forceinline__ float bf2f(bf16_t h) { return __uint_as_float((unsigned)h << 16); }
template <int NCB> __device__ __forceinline__ int v_st(int k, int c) { const int kk = (k & ~0xC) | ((k & 4) << 1) | ((k & 8) >> 1); return ((kk >> 3) * NCB + (c >> 5)) * 512 + ((kk & 7) * 32 + (c & 31)) * 2; }
__device__ __forceinline__ int v_rd_base(int lane) { return ((lane & 3) << 3) | (((lane >> 2) & 3) << 6) | (((lane >> 4) & 1) << 5) | (((lane >> 5) & 1) << 8); }
template <int OFF> __device__ __forceinline__ s16x4 tr_read(int vb) { s16x4 r; asm volatile("ds_read_b64_tr_b16 %0, %1 offset:%2" : "=&v"(r) : "v"(vb), "i"(OFF) : "memory"); return r; }
template <int NCB, int D0> __device__ __forceinline__ void pv_one(f32x16& od, int vb, bf16x8 pa0, bf16x8 pa1, bf16x8 pa2, bf16x8 pa3) {
#define VOFF(ks, half) (D0 * 512 + (2 * (ks) + (half)) * (NCB * 512))
  const s16x4 l0 = tr_read<VOFF(0, 0)>(vb), h0 = tr_read<VOFF(0, 1)>(vb), l1 = tr_read<VOFF(1, 0)>(vb), h1 = tr_read<VOFF(1, 1)>(vb);
  const s16x4 l2 = tr_read<VOFF(2, 0)>(vb), h2 = tr_read<VOFF(2, 1)>(vb), l3 = tr_read<VOFF(3, 0)>(vb), h3 = tr_read<VOFF(3, 1)>(vb);
#undef VOFF
  asm volatile("s_waitcnt lgkmcnt(0)" ::: "memory"); ATT_SBAR();
#define PK(L, H) (bf16x8){L[0], L[1], L[2], L[3], H[0], H[1], H[2], H[3]}
  od = __builtin_amdgcn_mfma_f32_32x32x16_bf16(pa0, PK(l0, h0), od, 0, 0, 0);
  od = __builtin_amdgcn_mfma_f32_32x32x16_bf16(pa1, PK(l1, h1), od, 0, 0, 0);
  od = __builtin_amdgcn_mfma_f32_32x32x16_bf16(pa2, PK(l2, h2), od, 0, 0, 0);
  od = __builtin_amdgcn_mfma_f32_32x32x16_bf16(pa3, PK(l3, h3), od, 0, 0, 0);
#undef PK
}
__device__ __forceinline__ void qkt(f32x16& p0, f32x16& p1, const char* Ks, const bf16x8* qr, const f32x16& negm, int r32, int hi) {
#pragma unroll
  for (int d0 = 0; d0 < 4; ++d0) { const int cb = d0 * 32 + hi * 16;
    const bf16x8 b0 = *reinterpret_cast<const bf16x8*>(Ks + KSWZ64(r32, cb));
    const bf16x8 b1 = *reinterpret_cast<const bf16x8*>(Ks + KSWZ64(32 + r32, cb));
    if (d0 == 0) { p0 = __builtin_amdgcn_mfma_f32_32x32x16_bf16(b0, qr[0], negm, 0, 0, 0); p1 = __builtin_amdgcn_mfma_f32_32x32x16_bf16(b1, qr[0], negm, 0, 0, 0); }
    else { p0 = __builtin_amdgcn_mfma_f32_32x32x16_bf16(b0, qr[d0], p0, 0, 0, 0); p1 = __builtin_amdgcn_mfma_f32_32x32x16_bf16(b1, qr[d0], p1, 0, 0, 0); } }
}
template <bool WIN> __device__ __forceinline__ void wmask(f32x16& p0, f32x16& p1, int qpos, int kbase, int hi) {
  if constexpr (WIN) {
#pragma unroll
    for (int r = 0; r < 16; ++r) { const int k0 = kbase + crow(r, hi) - qpos; if (k0 > 128 || k0 < -128) p0[r] = -INFINITY; if (k0 + 32 > 128 || k0 + 32 < -128) p1[r] = -INFINITY; }
  }
}
__device__ __forceinline__ void exp_half(f32x16& p) {
#pragma unroll
  for (int r = 0; r < 16; ++r) p[r] = __builtin_amdgcn_exp2f(p[r]);
}
__device__ __forceinline__ void finish_sm(f32x16& p0, f32x16& p1, float& l_reg, bf16x8& pa0, bf16x8& pa1, bf16x8& pa2, bf16x8& pa3) {
  exp_half(p1);
  float ps = 0.f;
#pragma unroll
  for (int r = 0; r < 16; ++r) ps += p0[r];
#pragma unroll
  for (int r = 0; r < 16; ++r) ps += p1[r];
  l_reg += ps;
#define PK4(P, BASE, OUT) do { unsigned a0 = cvtpk(P[BASE + 0], P[BASE + 1]), a1 = cvtpk(P[BASE + 2], P[BASE + 3]);   \
    unsigned b0 = cvtpk(P[BASE + 4], P[BASE + 5]), b1 = cvtpk(P[BASE + 6], P[BASE + 7]);                              \
    auto r0 = __builtin_amdgcn_permlane32_swap(a0, b0, false, false); auto r1 = __builtin_amdgcn_permlane32_swap(a1, b1, false, false); \
    u32x4 w = {r0[0], r1[0], r0[1], r1[1]}; OUT = *reinterpret_cast<bf16x8*>(&w); } while (0)
  PK4(p0, 0, pa0); PK4(p0, 8, pa1); PK4(p1, 0, pa2); PK4(p1, 8, pa3);
#undef PK4
}
constexpr int LDS_V = 0, LDS_K = 2 * KVBLK * 128 * 2, LDS_WS = LDS_K + 2 * KVBLK * 64 * 2, LDS_STG = LDS_WS + NW * 64 * 4, ATT_LDS_BYTES = LDS_STG + NW * 8192;
template <int NCB, bool WIN>
__device__ __forceinline__ void attn_pass(__amdgpu_buffer_rsrc_t rs, unsigned Qb, unsigned ldq, unsigned Kh, unsigned ldk, unsigned Vh, unsigned ldv, int seq, int qpos0, int kpos0, float negm_s, char* lds, f32x16 (&o)[NCB], float& l_out, const int wid) {
  constexpr int DV = NCB * 32, SHM_V = KVBLK * DV * 2, SHM_K = KVBLK * 64 * 2, NVL = NCB / 2;
  const int lane = MK_LANE(), tid = wid * 64 + lane, r32 = lane & 31, hi = lane >> 5;
  char* V_lds = lds + LDS_V; char* K_lds = lds + LDS_K;
  bf16x8 qr[4];
  { const unsigned qoff = (unsigned)(wid * QBLK + r32) * ldq + hi * 16;
#pragma unroll
    for (int d0 = 0; d0 < 4; ++d0) { const u32x4 w = __builtin_amdgcn_raw_buffer_load_b128(rs, qoff + d0 * 32, Qb, 0); qr[d0] = __builtin_bit_cast(bf16x8, w); } }
  f32x16 negm; { float ns = negm_s; asm volatile("" : "+v"(ns));
#pragma unroll
  for (int r = 0; r < 16; ++r) negm[r] = ns; }
  asm volatile("" : "+v"(negm));
#pragma unroll
  for (int d = 0; d < NCB; ++d) o[d] = f32x16{};
  float l_reg = 0.f;
  const int ksr = tid >> 3, ksc = (tid & 7) * 8;
  const int vsr = (NCB == 4) ? (tid >> 4) : (tid >> 3), vsc = (NCB == 4) ? (tid & 15) * 8 : (tid & 7) * 8;
  const int kst = KSWZ64(ksr, ksc * 2), vst0 = v_st<NCB>(vsr, vsc), vst1 = v_st<NCB>(32 + vsr, vsc);
  const int vb0 = (int)(uintptr_t)V_lds + v_rd_base(lane);
  const int qpos = qpos0 + wid * QBLK + r32;
  constexpr int SDEPTH = ATT_SDEPTH;
  struct Slot { bf16x8 k, v0, v1; } sl[SDEPTH];
  const unsigned kgoff = (unsigned)ksr * ldk + ksc * 2, vgoff0 = (unsigned)vsr * ldv + vsc * 2, vgoff1 = vgoff0 + 32u * ldv;
#define SLOAD(i, k0) do { const unsigned Kt_ = Kh + (unsigned)(k0) * ldk, Vt_ = Vh + (unsigned)(k0) * ldv; sl[i].k = __builtin_bit_cast(bf16x8, __builtin_amdgcn_raw_buffer_load_b128(rs, kgoff, Kt_, 0)); \
    sl[i].v0 = __builtin_bit_cast(bf16x8, __builtin_amdgcn_raw_buffer_load_b128(rs, vgoff0, Vt_, 0)); if (NVL == 2) sl[i].v1 = __builtin_bit_cast(bf16x8, __builtin_amdgcn_raw_buffer_load_b128(rs, vgoff1, Vt_, 0)); } while (0)
#define SWRITE(b, i) do { *(bf16x8*)(K_lds + (b) * SHM_K + kst) = sl[i].k; *(bf16x8*)(V_lds + (b) * SHM_V + vst0) = sl[i].v0; if (NVL == 2) *(bf16x8*)(V_lds + (b) * SHM_V + vst1) = sl[i].v1; } while (0)
#define SWAIT() do { if (SDEPTH == 1) asm volatile("s_waitcnt vmcnt(0)" ::: "memory"); else if (NVL == 2) asm volatile("s_waitcnt vmcnt(3)" ::: "memory"); else asm volatile("s_waitcnt vmcnt(2)" ::: "memory"); } while (0)
#define PVALL(vb) do { pv_one<NCB, 0>(o[0], vb, pa0, pa1, pa2, pa3); pv_one<NCB, 1>(o[1], vb, pa0, pa1, pa2, pa3); if constexpr (NCB == 4) { pv_one<NCB, 2>(o[2], vb, pa0, pa1, pa2, pa3); pv_one<NCB, 3>(o[3], vb, pa0, pa1, pa2, pa3); } } while (0)
  f32x16 pA0, pA1, pB0, pB1; bf16x8 pa0, pa1, pa2, pa3; const int NT = seq / KVBLK;
  constexpr int SE = 0, SO = SDEPTH - 1;
  SLOAD(SE, 0); asm volatile("s_waitcnt vmcnt(0)" ::: "memory"); SWRITE(0, SE); __syncthreads();
  qkt(pA0, pA1, K_lds, qr, negm, r32, hi); wmask<WIN>(pA0, pA1, qpos, kpos0, hi); exp_half(pA0);
  SLOAD(SO, KVBLK); if constexpr (SDEPTH == 2) { if (2 < NT) SLOAD(SE, 2 * KVBLK); }
  SWAIT(); SWRITE(1, SO); __syncthreads();
  for (int j = 1; j + 1 < NT; j += 2) {
    ATT_SBAR(); qkt(pB0, pB1, K_lds + SHM_K, qr, negm, r32, hi); wmask<WIN>(pB0, pB1, qpos, kpos0 + j * KVBLK, hi);
    finish_sm(pA0, pA1, l_reg, pa0, pa1, pa2, pa3); ATT_SBAR();
    SLOAD(SO, (j + SDEPTH) * KVBLK); ATT_SBAR();
    PVALL(vb0); exp_half(pB0);
    __syncthreads(); SWAIT(); SWRITE(0, SE); __syncthreads();
    ATT_SBAR(); qkt(pA0, pA1, K_lds, qr, negm, r32, hi); wmask<WIN>(pA0, pA1, qpos, kpos0 + (j + 1) * KVBLK, hi);
    finish_sm(pB0, pB1, l_reg, pa0, pa1, pa2, pa3); ATT_SBAR();
    if (SDEPTH == 1 || j + 3 < NT) SLOAD(SE, (j + 1 + SDEPTH) * KVBLK); ATT_SBAR();
    PVALL(vb0 + SHM_V); exp_half(pA0);
    __syncthreads(); SWAIT(); SWRITE(1, SO); __syncthreads();
  }
  ATT_SBAR(); qkt(pB0, pB1, K_lds + SHM_K, qr, negm, r32, hi); wmask<WIN>(pB0, pB1, qpos, kpos0 + (NT - 1) * KVBLK, hi);
  finish_sm(pA0, pA1, l_reg, pa0, pa1, pa2, pa3); ATT_SBAR();
  PVALL(vb0); exp_half(pB0);
  finish_sm(pB0, pB1, l_reg, pa0, pa1, pa2, pa3); ATT_SBAR();
  PVALL(vb0 + SHM_V);
  { auto rr = __builtin_amdgcn_permlane32_swap(__float_as_uint(l_reg), __float_as_uint(l_reg), false, false); l_out = __uint_as_float(rr[0]) + __uint_as_float(rr[1]); }
  __syncthreads();
#undef SLOAD
#undef SWRITE
#undef SWAIT
#undef PVALL
}
__device__ __forceinline__ void row_recips(float l, float extra, float* wsf, int r32, int hi, float (&rli)[16]) {
  if (hi == 0) wsf[r32] = l + extra; asm volatile("s_waitcnt lgkmcnt(0)" ::: "memory");
#pragma unroll
  for (int r = 0; r < 16; ++r) rli[r] = __builtin_amdgcn_rcpf(wsf[crow(r, hi)]);
  asm volatile("s_waitcnt lgkmcnt(0)" ::: "memory");
}

__device__ __forceinline__ void win_unit(__amdgpu_buffer_rsrc_t rs, const char* wsb, int b, int hq, int qb, const bf16_t* QA, const bf16_t* KA, const bf16_t* VA, bf16_t* ACAT, const float* scal, char* lds, const int wid) {
  constexpr int S = 8192;
  const int lane0 = MK_LANE(), kvh = hq >> 2;
  const int q0 = qb * 256; int kbeg = q0 - 128, kend = q0 + 384; if (kbeg < 0) kbeg = 0; if (kend > S) kend = S;
  const size_t rowbase = (size_t)b * S;
  f32x16 o[2]; float l;
  attn_pass<2, true>(rs, (unsigned)((const char*)(QA + (rowbase + q0) * 512 + hq * 64) - wsb), 1024u, (unsigned)((const char*)(KA + (rowbase + kbeg) * 128 + kvh * 64) - wsb), 256u, (unsigned)((const char*)(VA + (rowbase + kbeg) * 128 + kvh * 64) - wsb), 256u, kend - kbeg, q0, kbeg, scal[8 + hq], lds, o, l, wid);
  int r32 = lane0 & 31, hi = lane0 >> 5, lane = lane0; asm volatile("" : "+v"(r32), "+v"(hi), "+v"(lane));
  float* wsf = (float*)(lds + LDS_WS) + wid * 64; float rli[16];
  row_recips(l, scal[16 + hq], wsf, r32, hi, rli);
  bf16_t* stg = (bf16_t*)(lds + LDS_STG) + wid * 4096;
#pragma unroll
  for (int r = 0; r < 16; ++r) { const int orow = crow(r, hi);
#pragma unroll
    for (int d0 = 0; d0 < 2; ++d0) stg[orow * 64 + d0 * 32 + r32] = (bf16_t)(cvtpk(o[d0][r] * rli[r], 0.f) & 0xffffu); }
  asm volatile("s_waitcnt lgkmcnt(0)" ::: "memory");
  const int widl = wid;
  bf16_t* Ow = ACAT + (rowbase + q0) * 1024 + hq * 64 + (unsigned)((widl * QBLK + (lane >> 3)) * 1024 + (lane & 7) * 8);
  const bf16_t* sp = stg + (lane >> 3) * 64 + (lane & 7) * 8;
#pragma unroll
  for (int i = 0; i < 4; ++i) { const u32x4 v = *(const u32x4*)(sp + i * 512); *(u32x4*)(Ow + (size_t)i * 8192) = v; }
  asm volatile("s_waitcnt lgkmcnt(0)" ::: "memory"); __syncthreads();
}

__device__ __forceinline__ void diff_unit(__amdgpu_buffer_rsrc_t rs, const char* wsb, int b, int h, int qb, const bf16_t* QB, const bf16_t* KB, const bf16_t* VB, bf16_t* ACAT, const float* scal, const float* subln, char* lds, const int wid) {
  constexpr int S = 8192;
  const int lane0 = MK_LANE();
  const size_t rowbase = (size_t)b * S; const int q0 = qb * 256;
  float* wsf = (float*)(lds + LDS_WS) + wid * 64; float rli[16];
  bf16_t* stg = (bf16_t*)(lds + LDS_STG) + wid * 4096;
  const float lam = scal[0], post = 1.0f - scal[1], negm_s = scal[2];
#pragma unroll 1
  for (int t = 0; t < 2; ++t) {
    f32x16 o[4]; float l;
    attn_pass<4, false>(rs, (unsigned)((const char*)(QB + (rowbase + q0) * 512 + (2 * h + t) * 64) - wsb), 1024u, (unsigned)((const char*)(KB + rowbase * 512 + (2 * h + t) * 64) - wsb), 1024u, (unsigned)((const char*)(VB + rowbase * 512 + h * 128) - wsb), 1024u, S, q0, 0, negm_s, lds, o, l, wid);
    int r32 = lane0 & 31, hi = lane0 >> 5, lane = lane0; asm volatile("" : "+v"(r32), "+v"(hi), "+v"(lane));
    row_recips(l, 0.f, wsf, r32, hi, rli);
    if (t == 0) {
#pragma unroll
      for (int r = 0; r < 16; ++r) { const int orow = crow(r, hi);
#pragma unroll
        for (int d0 = 0; d0 < 4; ++d0) stg[orow * 128 + d0 * 32 + r32] = (bf16_t)(cvtpk(o[d0][r] * rli[r], 0.f) & 0xffffu); }
    } else {
      float ss[16];
#pragma unroll
      for (int r = 0; r < 16; ++r) { const int orow = crow(r, hi); float s_ = 0.f;
#pragma unroll
        for (int d0 = 0; d0 < 4; ++d0) { const float v = bf2f(stg[orow * 128 + d0 * 32 + r32]) - lam * (o[d0][r] * rli[r]); o[d0][r] = v; s_ += v * v; }
        ss[r] = s_; }
#pragma unroll
      for (int r = 0; r < 16; ++r) { float s_ = ss[r]; s_ += __shfl_xor(s_, 1); s_ += __shfl_xor(s_, 2); s_ += __shfl_xor(s_, 4); s_ += __shfl_xor(s_, 8); s_ += __shfl_xor(s_, 16); ss[r] = rsqrtf(s_ * (1.0f / 128.0f) + 1e-6f) * post; }
      float sl[4];
#pragma unroll
      for (int d0 = 0; d0 < 4; ++d0) sl[d0] = subln[d0 * 32 + r32];
#pragma unroll
      for (int r = 0; r < 16; ++r) { const int orow = crow(r, hi);
#pragma unroll
        for (int d0 = 0; d0 < 4; ++d0) stg[orow * 128 + d0 * 32 + r32] = (bf16_t)(cvtpk(o[d0][r] * ss[r] * sl[d0], 0.f) & 0xffffu); }
      asm volatile("s_waitcnt lgkmcnt(0)" ::: "memory");
      const int widl = wid;
      bf16_t* Ow = ACAT + (rowbase + q0) * 1024 + 512 + h * 128 + (unsigned)((widl * QBLK + (lane >> 4)) * 1024 + (lane & 15) * 8);
      const bf16_t* sp = stg + (lane >> 4) * 128 + (lane & 15) * 8;
#pragma unroll
      for (int i = 0; i < 8; ++i) { const u32x4 v = *(const u32x4*)(sp + i * 512); *(u32x4*)(Ow + (size_t)i * 4096) = v; }
    }
  }
  asm volatile("s_waitcnt lgkmcnt(0)" ::: "memory"); __syncthreads();
}
#undef ATT_SBAR
#undef KSWZ64
}
constexpr int NWAVES = 8;
#ifndef MK_N_LAUNCHES
#define MK_N_LAUNCHES 1
#endif
constexpr int PER_PHASE = 10;
constexpr int N_LAUNCHES = MK_N_LAUNCHES;

constexpr int BATCH = 2, T = 8192, D = 1024, M = BATCH * T, DFF = 2816, NFF = 2 * DFF, NIN = 4352, NMOD = 9 * D;
constexpr size_t MiB = 1u << 20;
constexpr size_t WS_CTL = 0, CTL_ZERO_BYTES = 1 * MiB;
constexpr size_t WS_MOD = 512 * 1024;
constexpr size_t WS_SCAL = 1 * MiB, WS_CB1 = WS_SCAL + 4096, WS_CBIN = WS_CB1 + 65536, WS_CB2 = WS_CBIN + 65536;
constexpr size_t WS_RSS0 = 2 * MiB, WS_RSS1 = WS_RSS0 + 256 * 1024, WS_RSS2 = WS_RSS1 + 256 * 1024;
constexpr size_t WS_COS = 3 * MiB, WS_SIN = 5 * MiB;
constexpr size_t WS_W1T = 8 * MiB, WS_W1OT = 19 * MiB, WS_WINT = 25 * MiB, WS_WBRT = 34 * MiB, WS_WOT = 38 * MiB, WS_W2T = 40 * MiB, WS_W2OT = 51 * MiB;
constexpr size_t WS_ABUF = 57 * MiB;
constexpr size_t WS_R1 = 89 * MiB;
constexpr size_t WS_QA = WS_R1, WS_KA = WS_QA + 16 * MiB, WS_VA = WS_KA + 4 * MiB, WS_QB = WS_VA + 4 * MiB, WS_KB = WS_QB + 16 * MiB, WS_VB = WS_KB + 16 * MiB;
constexpr size_t WS_MG = WS_R1;
constexpr size_t WS_GA = 177 * MiB, WS_GB = 209 * MiB, WS_END = 241 * MiB;
static_assert(WS_VB + 16 * MiB <= WS_GA && WS_R1 + (size_t)M * DFF * 2 <= WS_GA && WS_W2OT + (size_t)D * DFF * 2 <= WS_ABUF, "d_ws map");
constexpr int CW_TMO = 0, CW_CODE = 1, CW_BAR = 4096;

constexpr int RING_OFF = 0, RING_BYTES = 131072;
constexpr int LDSCTL_OFF = RING_BYTES, MISC_OFF = LDSCTL_OFF + 320;
constexpr int LDS_BYTES = 147456;
static_assert(MISC_OFF + 128 <= LDS_BYTES && att::ATT_LDS_BYTES <= RING_BYTES, "LDS map");

#define GAS __attribute__((address_space(1)))
#define LAS __attribute__((address_space(3)))
typedef unsigned short bf16;
typedef unsigned v4u __attribute__((ext_vector_type(4)));
typedef float f32x4 __attribute__((ext_vector_type(4)));
typedef short bf16x8 __attribute__((ext_vector_type(8)));
typedef GAS unsigned gu32;
typedef GAS unsigned long long gu64;
#define RLX_AGENT __ATOMIC_RELAXED, __HIP_MEMORY_SCOPE_AGENT
#define LDS_WAIT() asm volatile("s_waitcnt lgkmcnt(0)" ::: "memory")
#define VM_WAIT() asm volatile("s_waitcnt vmcnt(0)" ::: "memory")
__device__ __forceinline__ unsigned long long rt() { return __builtin_amdgcn_s_memrealtime(); }
__device__ __forceinline__ unsigned f2bf(float f) { unsigned u = __builtin_bit_cast(unsigned, f); return (u + 0x7fffu + ((u >> 16) & 1u)) >> 16; }
__device__ __forceinline__ unsigned pk2(float lo, float hi) { return f2bf(lo) | (f2bf(hi) << 16); }

#define XB_TMO      128
#define XB_XCNT(j)  (256  + 64 * (j))
#define XB_XSUB(j)  (1280 + 64 * (j))
#define XB_XGEN(j)  (2304 + 64 * (j))
#define XB_TOP      3328
#define XB_TOPGEN   3392
#define XCD_BAR_WORDS 3456
#define XB_SPIN_CAP (1u << 18)

__device__ __forceinline__ unsigned xb_ld(unsigned* p)              { return __hip_atomic_load(p, __ATOMIC_RELAXED, __HIP_MEMORY_SCOPE_AGENT); }
__device__ __forceinline__ unsigned xb_add(unsigned* p, unsigned v) { return __hip_atomic_fetch_add(p, v, __ATOMIC_RELAXED, __HIP_MEMORY_SCOPE_AGENT); }
__device__ __forceinline__ unsigned xb_xcc_id() { return (unsigned)__builtin_amdgcn_s_getreg((3 << 11) | 20) & 0xFu; }
#define XB_SPIN(cond, bar) do { unsigned _sp = 0; while (cond) { __builtin_amdgcn_s_sleep(1); \
    if ((++_sp & 255u) == 0u) { if (xb_ld(&(bar)[XB_TMO])) break; if (_sp > XB_SPIN_CAP) { atomicAdd(&(bar)[XB_TMO], 1u); break; } } } } while (0)

struct XcdBarrier {
    unsigned* bar; unsigned x;
    volatile LAS unsigned* st;
};

__device__ __forceinline__ XcdBarrier xcd_barrier_post(unsigned* bar, volatile LAS unsigned* st) {
    XcdBarrier b; b.bar = bar; b.x = xb_xcc_id(); b.st = st;
    if (threadIdx.x == 0) (void)xb_add(&bar[XB_XCNT(b.x)], 1u);
    return b;
}
__device__ __forceinline__ void xcd_barrier_complete(unsigned* bar, unsigned x, unsigned& nloc, unsigned& nx) {
    const unsigned G = gridDim.x * gridDim.y * gridDim.z;
    unsigned sum, cnt, mine, sp = 0u;
    for (;;) {
        sum = 0u; cnt = 0u; mine = 0u;
#pragma unroll
        for (unsigned j = 0; j < 16; ++j) { const unsigned c = xb_ld(&bar[XB_XCNT(j)]); sum += c; cnt += (c > 0u) ? 1u : 0u; mine = (j == x) ? c : mine; }
        if (sum == G) break;
        __builtin_amdgcn_s_sleep(1);
        if ((++sp & 255u) == 0u) { if (xb_ld(&bar[XB_TMO])) break; if (sp > XB_SPIN_CAP) { atomicAdd(&bar[XB_TMO], 1u); break; } }
    }
    nloc = mine > 0u ? mine : 1u; nx = cnt > 0u ? cnt : 1u;
}

__device__ __forceinline__ void xcd_barrier(const XcdBarrier& b, const bool leader  ) {
    asm volatile("s_waitcnt vmcnt(0)" ::: "memory");
    __syncthreads();
    if (leader) {
        unsigned* bar = b.bar;
        __builtin_amdgcn_s_waitcnt(0);
        unsigned nloc = b.st[0], nx = b.st[1];
        if (nloc == 0u) { xcd_barrier_complete(bar, b.x, nloc, nx); b.st[0] = nloc; b.st[1] = nx; }
        const unsigned old = xb_add(&bar[XB_XSUB(b.x)], 1u);
        const unsigned gen = old / nloc;
        if (old + 1u == (gen + 1u) * nloc) {
            __builtin_amdgcn_fence(__ATOMIC_RELEASE, "agent");
            asm volatile("s_waitcnt vmcnt(0)" ::: "memory");
            const unsigned og = xb_add(&bar[XB_TOP], 1u);
            const unsigned tg = og / nx;
            if (og + 1u == (tg + 1u) * nx) xb_add(&bar[XB_TOPGEN], 1u);
            else XB_SPIN(xb_ld(&bar[XB_TOPGEN]) == tg, bar);
            __builtin_amdgcn_fence(__ATOMIC_ACQUIRE, "agent");
            xb_add(&bar[XB_XGEN(b.x)], 1u);
            asm volatile("s_waitcnt vmcnt(0)" ::: "memory");
        } else {
            XB_SPIN(xb_ld(&bar[XB_XGEN(b.x)]) == gen, bar);
            __builtin_amdgcn_fence(__ATOMIC_ACQUIRE, "agent");
            asm volatile("s_waitcnt vmcnt(0)" ::: "memory");
        }
    }
    __syncthreads();
}

struct Args { const void* in[26]; float* out; unsigned char* ws; int ph_lo, ph_hi, li, pad; };

__device__ __forceinline__ float wave_sum(float v) {
#pragma unroll
    for (int o = 1; o < 64; o <<= 1) v += __shfl_xor(v, o);
    return v;
}
__device__ __forceinline__ int rowmap(int kind, int n0) {
    if (kind == 1) { const int bj = n0 >= DFF ? 1 : 0, jj = n0 - bj * DFF; return (jj >> 7) * 256 + bj * 128 + (jj & 127); }
    if (kind == 2) { if (n0 >= 2304) return n0; const int g32 = n0 >> 5, head = g32 >> 1, bj = g32 & 1; return (head >> 2) * 256 + bj * 128 + (head & 3) * 32; }
    if (kind == 3) return (n0 >> 7) * 256 + (n0 & 127);
    if (kind == 4) return (n0 >> 7) * 256 + 128 + (n0 & 127);
    return n0;
}
__device__ __forceinline__ void p0_transpose_item(const float* W, int K, int N, bf16* WT, int ldk, int koff, int kind, LAS float* scr, int item, int lane) {
    const int nblk = N / 32, kb = item / nblk, nb = item % nblk, k0 = 64 * kb, n0 = 32 * nb, c0 = rowmap(kind, n0);
#pragma unroll 8
    for (int i = 0; i < 32; ++i) { const int kk = 2 * i + (lane >> 5); scr[kk * 33 + (lane & 31)] = W[(size_t)(k0 + kk) * N + n0 + (lane & 31)]; }
    LDS_WAIT(); asm volatile("" ::: "memory");
    const int c = lane & 7;
#pragma unroll
    for (int j = 0; j < 4; ++j) { const int n = (lane >> 3) + 8 * j; const LAS float* s = scr + (8 * c) * 33 + n;
        v4u o; o.x = pk2(s[0 * 33], s[1 * 33]); o.y = pk2(s[2 * 33], s[3 * 33]); o.z = pk2(s[4 * 33], s[5 * 33]); o.w = pk2(s[6 * 33], s[7 * 33]);
        *(GAS v4u*)(WT + (size_t)(c0 + n) * ldk + koff + k0 + 8 * c) = o; }
    LDS_WAIT(); asm volatile("" ::: "memory");
}

__global__ void __launch_bounds__(NWAVES * 64, 2) layer_fwd(Args args) {
    extern __shared__ __attribute__((aligned(16))) unsigned char lds[];
    LAS unsigned char* ldsl = (LAS unsigned char*)lds;
    volatile LAS unsigned* MISC = (volatile LAS unsigned*)(ldsl + MISC_OFF);
    const int wave = __builtin_amdgcn_readfirstlane((int)threadIdx.x >> 6), lane = MK_LANE(), tid = wave * 64 + lane;
    const int G = gridDim.x; const int bx = blockIdx.x; const int vcu = (G % 8 == 0) ? (bx % 8) * (G / 8) + bx / 8 : bx;
    unsigned char* ws = args.ws;
    gu32* ctl = (gu32*)(ws + WS_CTL);
    const float* x = (const float*)args.in[0]; const float* cvec = (const float*)args.in[1]; const int* positions = (const int*)args.in[2];
    const float* w_mod = (const float*)args.in[3]; const float* b_mod = (const float*)args.in[4];
    const float* norm_ffn1 = (const float*)args.in[5]; const float* w_ffn1_in = (const float*)args.in[6]; const float* w_ffn1_out = (const float*)args.in[7];
    const float* norm_mix = (const float*)args.in[8]; const float* w_in = (const float*)args.in[9];
    const float* qn_a = (const float*)args.in[10]; const float* kn_a = (const float*)args.in[11]; const float* sink_a = (const float*)args.in[12];
    const float* qn_b = (const float*)args.in[13]; const float* kn_b = (const float*)args.in[14];
    const float* lam_q1 = (const float*)args.in[15]; const float* lam_k1 = (const float*)args.in[16]; const float* lam_q2 = (const float*)args.in[17]; const float* lam_k2 = (const float*)args.in[18];
    const float* subln_b = (const float*)args.in[19]; const float* w_branch_a = (const float*)args.in[20]; const float* w_branch_b = (const float*)args.in[21];
    const float* w_out = (const float*)args.in[22]; const float* norm_ffn2 = (const float*)args.in[23]; const float* w_ffn2_in = (const float*)args.in[24]; const float* w_ffn2_out = (const float*)args.in[25];
    float* out = args.out;
    float* MOD = (float*)(ws + WS_MOD); float* SCAL = (float*)(ws + WS_SCAL); float* CB1 = (float*)(ws + WS_CB1); float* CBIN = (float*)(ws + WS_CBIN); float* CB2 = (float*)(ws + WS_CB2);
    float* RSS0 = (float*)(ws + WS_RSS0); float* RSS1 = (float*)(ws + WS_RSS1); float* RSS2 = (float*)(ws + WS_RSS2); float* COST = (float*)(ws + WS_COS); float* SINT = (float*)(ws + WS_SIN);
    bf16* W1T = (bf16*)(ws + WS_W1T); bf16* W1OT = (bf16*)(ws + WS_W1OT); bf16* WINT = (bf16*)(ws + WS_WINT); bf16* WBRT = (bf16*)(ws + WS_WBRT); bf16* WOT = (bf16*)(ws + WS_WOT);
    bf16* W2T = (bf16*)(ws + WS_W2T); bf16* W2OT = (bf16*)(ws + WS_W2OT);
    bf16* ABUF = (bf16*)(ws + WS_ABUF); bf16* HB = (bf16*)(ws + WS_R1); bf16* MG = (bf16*)(ws + WS_MG);
    bf16* QA = (bf16*)(ws + WS_QA); bf16* KA = (bf16*)(ws + WS_KA); bf16* VA = (bf16*)(ws + WS_VA); bf16* QB = (bf16*)(ws + WS_QB); bf16* KB = (bf16*)(ws + WS_KB); bf16* VB = (bf16*)(ws + WS_VB);
    bf16* GA = (bf16*)(ws + WS_GA); bf16* GB = (bf16*)(ws + WS_GB);

    for (int u = tid; u < (LDS_BYTES - LDSCTL_OFF) / 4; u += NWAVES * 64) ((LAS unsigned*)(ldsl + LDSCTL_OFF))[u] = 0u;
    __syncthreads();
    XcdBarrier bar; bar.bar = (unsigned*)(ctl + CW_BAR); bar.x = 0; bar.st = nullptr;
    if (N_LAUNCHES != PER_PHASE) bar = xcd_barrier_post((unsigned*)(ctl + CW_BAR), MISC + 8);
#define GRID_BAR(seam) do { if (N_LAUNCHES == PER_PHASE) { if (tid == 0) __hip_atomic_store(ctl + CW_TMO, 0xBADBA0u | (unsigned)(seam), RLX_AGENT); } else { xcd_barrier(bar, wave == 0 && MK_LANE() == 0); } } while (0)
    const int lo = args.ph_lo, hi = args.ph_hi;
#ifndef PH_MASK
#define PH_MASK 0x3ff
#endif
#define IN(k) (((PH_MASK >> (k)) & 1) && lo <= (k) && (k) < hi)
#define BOTH(k) (IN(k) && IN((k) + 1))
    const int gw = vcu * NWAVES + wave, NGW = G * NWAVES;
    constexpr float QSCALE = 0.125f * 1.4426950408889634f;

    if (IN(0)) {
        LAS float* scr = (LAS float*)(ldsl + RING_OFF + wave * 9216);
        {
            LAS float* ca = (LAS float*)(ldsl + RING_OFF + 73728);
            LAS float* red = ca + 2048;
            for (int i = tid; i < 2 * D; i += NWAVES * 64) { const float v = cvec[i]; ca[i] = v / (1.f + __expf(-v)); }
            __syncthreads();
            for (int it = bx; it < 288; it += G) {
                const int cg = it >> 1, kh = it & 1, j = cg * 64 + lane, kbase = kh * 512 + wave * 64;
                float a0 = 0.f, a1 = 0.f;
#pragma unroll 16
                for (int kk = 0; kk < 64; ++kk) { const float w = w_mod[(size_t)(kbase + kk) * NMOD + j]; a0 += ca[kbase + kk] * w; a1 += ca[D + kbase + kk] * w; }
                red[(wave * 2 + 0) * 64 + lane] = a0; red[(wave * 2 + 1) * 64 + lane] = a1;
                __syncthreads();
                if (tid < 128) { const int b = tid >> 6; float s = (kh == 0) ? b_mod[j] : 0.f;
#pragma unroll
                    for (int w = 0; w < 8; ++w) s += red[(w * 2 + b) * 64 + lane];
                    atomicAdd(MOD + b * NMOD + j, s); }
                __syncthreads();
            }
        }
        {
            constexpr int I_1 = (D / 64) * (NFF / 32), I_1O = (DFF / 64) * (D / 32), I_IN = (D / 64) * (NIN / 32), I_BR = (512 / 64) * (D / 32), I_O = (D / 64) * (D / 32);
            constexpr int NITEMS = 2 * I_1 + 2 * I_1O + I_IN + 2 * I_BR + I_O;
            for (int it = gw; it < NITEMS; it += NGW) {
                int r = it;
                if (r < I_1) { p0_transpose_item(w_ffn1_in, D, NFF, W1T, D, 0, 1, scr, r, lane); continue; } r -= I_1;
                if (r < I_1) { p0_transpose_item(w_ffn2_in, D, NFF, W2T, D, 0, 1, scr, r, lane); continue; } r -= I_1;
                if (r < I_1O) { p0_transpose_item(w_ffn1_out, DFF, D, W1OT, DFF, 0, 0, scr, r, lane); continue; } r -= I_1O;
                if (r < I_1O) { p0_transpose_item(w_ffn2_out, DFF, D, W2OT, DFF, 0, 0, scr, r, lane); continue; } r -= I_1O;
                if (r < I_IN) { p0_transpose_item(w_in, D, NIN, WINT, D, 0, 2, scr, r, lane); continue; } r -= I_IN;
                if (r < I_BR) { p0_transpose_item(w_branch_a, 512, D, WBRT, D, 0, 3, scr, r, lane); continue; } r -= I_BR;
                if (r < I_BR) { p0_transpose_item(w_branch_b, 512, D, WBRT, D, 512, 4, scr, r, lane); continue; } r -= I_BR;
                p0_transpose_item(w_out, D, D, WOT, D, 0, 0, scr, r, lane);
            }
            for (int c = gw; c < 2048; c += NGW) { const int bj = (c >> 7) & 1; *(GAS v4u*)(WBRT + (size_t)c * D + (bj ? 0 : 512) + lane * 8) = (v4u){0u, 0u, 0u, 0u}; }
        }
        {
            LAS float* invf = (LAS float*)(ldsl + RING_OFF + 73728 + 8192 + 4096);
            if (tid < 32) invf[tid] = (float)pow(10000.0, -(double)(2 * tid) / 64.0);
            __syncthreads();
            for (int i = bx * (NWAVES * 64) + tid; i < M * 32; i += G * NWAVES * 64) { const int row = i >> 5, d = i & 31;
                const float ang = (float)positions[row] * invf[d]; COST[i] = (float)cos((double)ang); SINT[i] = (float)sin((double)ang); }
        }
        if (bx == 0 && wave == 0) {
            const float a = wave_sum(lam_q1[lane] * lam_k1[lane]), b2 = wave_sum(lam_q2[lane] * lam_k2[lane]);
            float mqa = fabsf(qn_a[lane]), mka = fabsf(kn_a[lane]), mqb = fabsf(qn_b[lane]), mkb = fabsf(kn_b[lane]);
#pragma unroll
            for (int o = 1; o < 64; o <<= 1) { mqa = fmaxf(mqa, __shfl_xor(mqa, o)); mka = fmaxf(mka, __shfl_xor(mka, o)); mqb = fmaxf(mqb, __shfl_xor(mqb, o)); mkb = fmaxf(mkb, __shfl_xor(mkb, o)); }
            const float bound_a = 8.0f * mqa * mka * 1.001f, bound_b = 8.0f * mqb * mkb * 1.001f, L2E = 1.4426950408889634f;
            if (lane == 0) { const float lam_init = 0.8f - 0.6f * expf(-0.3f * 0.f); SCAL[0] = expf(a) - expf(b2) + lam_init; SCAL[1] = lam_init; SCAL[2] = -bound_b * L2E; }
            if (lane < 8) { const float sk = sink_a[lane], mh = fmaxf(bound_a, sk); SCAL[8 + lane] = -mh * L2E; SCAL[16 + lane] = exp2f((sk - mh) * L2E); }
        }
        if (BOTH(0)) GRID_BAR(0);
    }

    if (IN(1)) {
        for (int m = gw; m < M; m += NGW) {
            const int b = m >> 13; const GAS f32x4* xr = (const GAS f32x4*)(x + (size_t)m * D) + lane;
            f32x4 v[4]; float s = 0.f;
#pragma unroll
            for (int j = 0; j < 4; ++j) { v[j] = xr[64 * j]; s += (v[j].x * v[j].x + v[j].y * v[j].y) + (v[j].z * v[j].z + v[j].w * v[j].w); }
            s = wave_sum(s);
            if (lane == 0) *(f32x4*)(RSS0 + (size_t)m * 4) = (f32x4){s, 0.f, 0.f, 0.f};
            GAS unsigned long long* o8 = (GAS unsigned long long*)(ABUF + (size_t)m * D) + lane;
#pragma unroll
            for (int j = 0; j < 4; ++j) { const int c = 4 * lane + 256 * j; const f32x4 g = *(const f32x4*)(norm_ffn1 + c) * (*(const f32x4*)(MOD + b * NMOD + 1 * D + c) + 1.0f); const f32x4 a = v[j] * g;
                o8[64 * j] = (unsigned long long)pk2(a.x, a.y) | ((unsigned long long)pk2(a.z, a.w) << 32); }
        }
        for (int it = gw; it < NFF + NIN + NFF; it += NGW) {
            const bf16* Bt; float* CB; int c, ncb, shidx;
            if (it < NFF) { Bt = W1T; CB = CB1; c = it; ncb = NFF; shidx = 0; } else if (it < NFF + NIN) { Bt = WINT; CB = CBIN; c = it - NFF; ncb = NIN; shidx = 3; } else { Bt = W2T; CB = CB2; c = it - NFF - NIN; ncb = NFF; shidx = 6; }
            float a0 = 0.f, a1 = 0.f;
#pragma unroll
            for (int hh = 0; hh < 2; ++hh) { const int k = hh * 512 + lane * 8; const v4u w = *(const GAS v4u*)(Bt + (size_t)c * D + k);
                const float wf[8] = {__uint_as_float(w.x << 16), __uint_as_float(w.x & 0xffff0000u), __uint_as_float(w.y << 16), __uint_as_float(w.y & 0xffff0000u),
                                     __uint_as_float(w.z << 16), __uint_as_float(w.z & 0xffff0000u), __uint_as_float(w.w << 16), __uint_as_float(w.w & 0xffff0000u)};
                const float* s0 = MOD + shidx * D + k; const float* s1 = MOD + NMOD + shidx * D + k;
#pragma unroll
                for (int e = 0; e < 8; ++e) { a0 += wf[e] * s0[e]; a1 += wf[e] * s1[e]; } }
            a0 = wave_sum(a0); a1 = wave_sum(a1);
            if (lane == 0) { CB[c] = a0; CB[ncb + c] = a1; }
        }
        if (BOTH(1)) GRID_BAR(1);
    }

    if (IN(2)) {
        pg8::Gemm g{ABUF, W1T, M, NFF, D}; pg8::StaticOrder S; S.init(M, NFF, G, bx);
        pg8::EpiSwiGLU E{HB, DFF, RSS0, CB1, NFF};
        pg8::gemm_phase<pg8::EpiSwiGLU, pg8::StaticOrder, PG8_ALIGN, PG8_SP2>(ldsl + RING_OFF, g, S, E, wave);
        if (BOTH(2)) GRID_BAR(2);
    }
    if (IN(3)) {
        pg8::Gemm g{HB, W1OT, M, D, DFF}; pg8::StaticOrder S; S.init(M, D, G, bx);
        pg8::EpiResid<true, 1> E{x, out, MOD + 2 * D, ABUF, norm_mix, MOD + 4 * D, RSS1};
        pg8::gemm_phase<pg8::EpiResid<true, 1>, pg8::StaticOrder, false, PG8_SP2>(ldsl + RING_OFF, g, S, E, wave);
        if (BOTH(3)) GRID_BAR(3);
    }
    if (IN(4)) {
        pg8::Gemm g{ABUF, WINT, M, NIN, D}; pg8::StaticOrder S; S.init(M, NIN, G, bx);
        pg8::EpiInProj E{QA, KA, VA, QB, KB, VB, GA, GB, RSS1, CBIN, COST, SINT, qn_a, kn_a, qn_b, kn_b, QSCALE};
        pg8::gemm_phase<pg8::EpiInProj, pg8::StaticOrder, PG8_ALIGN, PG8_SP2>(ldsl + RING_OFF, g, S, E, wave);
        if (BOTH(4)) GRID_BAR(4);
    }
    if (IN(5)) {
        char* alds = (char*)lds + RING_OFF;
        const __amdgpu_buffer_rsrc_t wsrs = __builtin_amdgcn_make_buffer_rsrc((void*)ws, (short)0, 0x10000000, 0x00020000);
#ifndef SKIP_WIN
        for (int id = vcu; id < 512; id += G) att::win_unit(wsrs, (const char*)ws, id >> 8, (id >> 5) & 7, id & 31, QA, KA, VA, ABUF, SCAL, alds, wave);
#endif
#ifndef SKIP_DIFF
        for (int id = vcu; id < 256; id += G) att::diff_unit(wsrs, (const char*)ws, id >> 7, (id >> 5) & 3, id & 31, QB, KB, VB, ABUF, SCAL, subln_b, alds, wave);
#endif
        if (BOTH(5)) GRID_BAR(5);
    }
    if (IN(6)) {
        pg8::Gemm g{ABUF, WBRT, M, 2048, D}; pg8::StaticOrder S; S.init(M, 2048, G, bx);
        pg8::EpiBranch E{GA, GB, MG};
        pg8::gemm_phase<pg8::EpiBranch, pg8::StaticOrder, PG8_ALIGN, PG8_SP2>(ldsl + RING_OFF, g, S, E, wave);
        if (BOTH(6)) GRID_BAR(6);
    }
    if (IN(7)) {
        pg8::Gemm g{MG, WOT, M, D, D}; pg8::StaticOrder S; S.init(M, D, G, bx);
        pg8::EpiResid<true, 2> E{out, out, MOD + 5 * D, ABUF, norm_ffn2, MOD + 7 * D, RSS2};
        pg8::gemm_phase<pg8::EpiResid<true, 2>, pg8::StaticOrder, false, PG8_SP2>(ldsl + RING_OFF, g, S, E, wave);
        if (BOTH(7)) GRID_BAR(7);
    }
    if (IN(8)) {
        pg8::Gemm g{ABUF, W2T, M, NFF, D}; pg8::StaticOrder S; S.init(M, NFF, G, bx);
        pg8::EpiSwiGLU E{HB, DFF, RSS2, CB2, NFF};
        pg8::gemm_phase<pg8::EpiSwiGLU, pg8::StaticOrder, PG8_ALIGN, PG8_SP2>(ldsl + RING_OFF, g, S, E, wave);
        if (BOTH(8)) GRID_BAR(8);
    }
    if (IN(9)) {
        pg8::Gemm g{HB, W2OT, M, D, DFF}; pg8::StaticOrder S; S.init(M, D, G, bx);
        pg8::EpiResid<false, 1> E{out, out, MOD + 8 * D, nullptr, nullptr, nullptr, nullptr};
        pg8::gemm_phase<pg8::EpiResid<false, 1>, pg8::StaticOrder, false, PG8_SP2>(ldsl + RING_OFF, g, S, E, wave);
    }
#undef IN
#undef BOTH
#undef GRID_BAR
}

extern "C" void kernel_launch(void* const* d_in, const int* in_sizes, int n_in, void* d_out, int out_size, void* d_ws, size_t ws_size, hipStream_t stream) {
    static int grid = 0;
    if (grid == 0) {
        if (n_in != 26 || in_sizes[0] != M * D || out_size != M * D || ws_size < WS_END) { fprintf(stderr, "kernel_launch: unexpected shapes: n_in %d in0 %d out %d ws %zu (need >= %zu)\n", n_in, n_in > 0 ? in_sizes[0] : -1, out_size, ws_size, (size_t)WS_END); grid = -1; return; }
        int dev = 0, cus = 0;
        if (hipGetDevice(&dev) != hipSuccess || hipDeviceGetAttribute(&cus, hipDeviceAttributeMultiprocessorCount, dev) != hipSuccess) { grid = -1; return; }
        if (hipFuncSetAttribute((const void*)layer_fwd, hipFuncAttributeMaxDynamicSharedMemorySize, LDS_BYTES) != hipSuccess) { fprintf(stderr, "kernel_launch: hipFuncSetAttribute failed\n"); grid = -1; return; }
        int per_cu = 0;
        if (hipOccupancyMaxActiveBlocksPerMultiprocessor(&per_cu, (const void*)layer_fwd, NWAVES * 64, LDS_BYTES) != hipSuccess || per_cu < 1) fprintf(stderr, "kernel_launch: occupancy query says %d\n", per_cu);
        (void)hipGetLastError();
        grid = cus;
        if (grid != 256) fprintf(stderr, "kernel_launch: %d CUs; the one-unit-per-workgroup phases need exactly 256\n", grid);
    }
    if (grid < 0) return;
    (void)hipMemsetAsync((char*)d_ws + WS_CTL, 0, CTL_ZERO_BYTES, stream);
    Args a{};
    for (int i = 0; i < 26; ++i) a.in[i] = d_in[i];
    a.out = (float*)d_out; a.ws = (unsigned char*)d_ws;
    for (int li = 0; li < N_LAUNCHES; ++li) {
        a.ph_lo = (N_LAUNCHES == PER_PHASE) ? li : 0; a.ph_hi = (N_LAUNCHES == PER_PHASE) ? li + 1 : PER_PHASE; a.li = li;
        hipLaunchKernelGGL(layer_fwd, dim3(grid), dim3(NWAVES * 64), LDS_BYTES, stream, a);
    }
}
```

```cpp
#include <hip/hip_runtime.h>
#include <cstdio>
#include <cstdint>
#include <cmath>
__device__ __forceinline__ int mk_lane_() { int l; asm volatile("v_mbcnt_lo_u32_b32 %0, -1, 0\n\tv_mbcnt_hi_u32_b32 %0, -1, %0" : "=v"(l)); return l; }
#define MK_LANE() mk_lane_()
namespace pg8 {
#define PG8_LAS __attribute__((address_space(3)))
typedef unsigned short bf16_t;
typedef short bf16x8 __attribute__((ext_vector_type(8)));
typedef float f32x4 __attribute__((ext_vector_type(4)));
typedef unsigned u32x4 __attribute__((ext_vector_type(4)));
constexpr int BM = 256, BK = 64, HALF = 128, HTB = HALF * BK * 2  , STAGE_BYTES = 8 * HTB, NXCD = 8, WGM = 8;

__host__ __device__ __forceinline__ int lds_byte(int r, int c) { const int st = (r >> 4) * 2 + (c >> 5), rr = r & 15, cc = c & 31, ob = rr * 64 + cc * 2; return st * 1024 + (ob ^ (((ob >> 9) & 1) << 5)); }
__host__ __device__ __forceinline__ void stage_rc(int b, int& R, int& C) { const int st = b / 1024, sb = b % 1024, swz = sb ^ (((sb >> 9) & 1) << 5); R = (st >> 1) * 16 + swz / 64; C = (st & 1) * 32 + (swz % 64) / 2; }
__host__ __device__ __forceinline__ int perm32(int rho) { const int n = rho >> 4, i = rho & 15; return 8 * (i >> 2) + 4 * n + (i & 3); }

struct Unit { int pm, pn, ko; };
struct Gemm { const bf16_t* A; const bf16_t* Bt; int M, N, K; int KL = 0; };

struct StaticOrder {
    int nM, nN, nwg, G, c;
    __host__ __device__ void init(int M, int N, int G_, int c_) { nM = M / BM; nN = N / BM; nwg = nM * nN; G = G_; c = c_; }
    __host__ __device__ bool next(int i, Unit& u) const {
        const long L = (long)i * G + c; if (L >= nwg) return false;
        int wgid = (int)L; { const int q = nwg / NXCD, r = nwg % NXCD, xcd = wgid % NXCD, off = wgid / NXCD; wgid = (xcd < r ? xcd * (q + 1) : r * (q + 1) + (xcd - r) * q) + off; }
        const int nig = WGM * nN, gid = wgid / nig, fm = gid * WGM, gsz = (nM - fm) < WGM ? (nM - fm) : WGM;
        u.pm = fm + ((wgid % nig) % gsz); u.pn = (wgid % nig) / gsz; u.ko = 0; return true;
    }
    __device__ __forceinline__ void a_ready(const Unit&) const {}
    __device__ __forceinline__ void done(const Unit&) const {}
};
struct PairOrder {
    StaticOrder S; int khalf_bytes;
    __host__ __device__ void init(int M, int N, int G_, int c_, int K) { S.init(M, N, G_, c_); khalf_bytes = K;   }
    __host__ __device__ bool next(int i, Unit& u) const { if (!S.next(i >> 1, u)) return false; u.ko = (i & 1) * khalf_bytes; return true; }
    __device__ __forceinline__ void a_ready(const Unit&) const {}
    __device__ __forceinline__ void done(const Unit&) const {}
};

__device__ __forceinline__ unsigned cvt_pk_bf16(float lo, float hi) { unsigned r; asm volatile("v_cvt_pk_bf16_f32 %0, %1, %2" : "=v"(r) : "v"(lo), "v"(hi)); return r; }
__device__ __forceinline__ float bf_lo(unsigned w) { return __uint_as_float(w << 16); }
__device__ __forceinline__ float bf_hi(unsigned w) { return __uint_as_float(w & 0xffff0000u); }
constexpr float RMS_EPS = 1e-6f, LOG2E = 1.4426950408889634f;
__device__ __forceinline__ float row_rinv(const float* rss, int row) { const f32x4 s = *(const f32x4*)(rss + (size_t)row * 4); return rsqrtf(((s[0] + s[1]) + (s[2] + s[3])) * (1.0f / 1024.0f) + RMS_EPS); }
__device__ __forceinline__ float fast_sigmoid(float v) { return __builtin_amdgcn_rcpf(1.0f + __builtin_amdgcn_exp2f(-v * LOG2E)); }

struct EpiSwiGLU {
    static constexpr bool PERM = true, AFTER_DRAIN = false, PREFETCH = true, CHAIN = false;
    bf16_t* H; int ldh; const float* rss; const float* cb; int ncb;
    __device__ __forceinline__ void prefetch(const Unit& u, PG8_LAS unsigned char* buf, int wid, int lane) const {
        if (wid < 4) __builtin_amdgcn_global_load_lds((const unsigned*)(rss + (size_t)(u.pm * BM + wid * 64 + lane) * 4), (PG8_LAS unsigned*)(buf + wid * 1024), 16, 0, 0);
        else if (wid == 4) __builtin_amdgcn_global_load_lds((const unsigned*)(cb + (size_t)(u.pm >> 5) * ncb + u.pn * BM + lane * 4), (PG8_LAS unsigned*)(buf + 4096), 16, 0, 0);
    }
    __device__ __forceinline__ void operator()(const f32x4 (&acc)[2][2][4][2], const Unit& u, int wr, int wc, int fr, int fq, const PG8_LAS unsigned char* buf) const {
        const int outcol = u.pn * HALF + wc * 32 + 8 * fq;
        const PG8_LAS float* cbb = (const PG8_LAS float*)(buf + 4096) + wc * 32 + 8 * fq;
        const f32x4 bg0 = *(const PG8_LAS f32x4*)(cbb), bg1 = *(const PG8_LAS f32x4*)(cbb + 4), bu0 = *(const PG8_LAS f32x4*)(cbb + HALF), bu1 = *(const PG8_LAS f32x4*)(cbb + HALF + 4);
#pragma unroll
        for (int ai = 0; ai < 2; ++ai) {
#pragma unroll
            for (int m = 0; m < 4; ++m) {
                const int row = u.pm * BM + ai * HALF + wr * 64 + m * 16 + fr; const f32x4 sv_ = *(const PG8_LAS f32x4*)(buf + (ai * HALF + wr * 64 + m * 16 + fr) * 16); const float ri = rsqrtf(((sv_[0] + sv_[1]) + (sv_[2] + sv_[3])) * (1.0f / 1024.0f) + RMS_EPS);
                const f32x4 g0 = acc[ai][0][m][0] * ri + bg0, g1 = acc[ai][0][m][1] * ri + bg1, u0 = acc[ai][1][m][0] * ri + bu0, u1 = acc[ai][1][m][1] * ri + bu1;
                float o[8];
#pragma unroll
                for (int j = 0; j < 4; ++j) { o[j] = g0[j] * fast_sigmoid(g0[j]) * u0[j]; o[4 + j] = g1[j] * fast_sigmoid(g1[j]) * u1[j]; }
                u32x4 w; w.x = cvt_pk_bf16(o[0], o[1]); w.y = cvt_pk_bf16(o[2], o[3]); w.z = cvt_pk_bf16(o[4], o[5]); w.w = cvt_pk_bf16(o[6], o[7]);
                *(u32x4*)(H + (size_t)row * ldh + outcol) = w; } }
    }
};

struct EpiInProj {
    static constexpr bool PERM = true, AFTER_DRAIN = false, PREFETCH = true, CHAIN = false;
    bf16_t *QA, *KA, *VA, *QB, *KB, *VB, *GA, *GB; const float* rss; const float* cb; const bf16_t* ropet; const float *qn_a, *kn_a, *qn_b, *kn_b; float qscale;
    __device__ __forceinline__ void prefetch(const Unit& u, PG8_LAS unsigned char* buf, int wid, int lane) const {
        if (wid < 4) __builtin_amdgcn_global_load_lds((const unsigned*)(rss + (size_t)(u.pm * BM + wid * 64 + lane) * 4), (PG8_LAS unsigned*)(buf + wid * 1024), 16, 0, 0);
        else if (wid == 4) __builtin_amdgcn_global_load_lds((const unsigned*)(cb + (size_t)(u.pm >> 5) * 4352 + u.pn * BM + lane * 4), (PG8_LAS unsigned*)(buf + 4096), 16, 0, 0);
    }
    __device__ __forceinline__ void operator()(const f32x4 (&acc)[2][2][4][2], const Unit& u, int wr, int wc, int fr, int fq, const PG8_LAS unsigned char* buf) const {
        const int pn = u.pn;
        int mode; bf16_t* dst; int ld; const float* gain = qn_a; float scale = 1.f;
        if (pn < 2) { mode = 0; dst = QA + (4 * pn + wc) * 64; ld = 512; gain = qn_a; scale = qscale; }
        else if (pn == 2) { if (wc < 2) { mode = 0; dst = KA + wc * 64; ld = 128; gain = kn_a; } else { mode = 1; dst = VA + (wc - 2) * 64; ld = 128; } }
        else if (pn < 5) { mode = 0; dst = QB + (4 * (pn - 3) + wc) * 64; ld = 512; gain = qn_b; scale = qscale; }
        else if (pn < 7) { mode = 0; dst = KB + (4 * (pn - 5) + wc) * 64; ld = 512; gain = kn_b; }
        else if (pn < 9) { mode = 1; dst = VB + (4 * (pn - 7) + wc) * 64; ld = 512; }
        else if (pn < 13) { mode = 2; dst = GA + (pn - 9) * BM + wc * 32; ld = 1024; }
        else { mode = 2; dst = GB + (pn - 13) * BM + wc * 32; ld = 1024; }
        const int bjoff = (mode == 2) ? HALF : 32;
        const PG8_LAS float* cbb = (const PG8_LAS float*)(buf + 4096) + wc * 32 + 8 * fq;
        f32x4 bv[2][2];
#pragma unroll
        for (int bj = 0; bj < 2; ++bj)
#pragma unroll
            for (int n = 0; n < 2; ++n) bv[bj][n] = *(const PG8_LAS f32x4*)(cbb + bj * HALF + 4 * n);
        f32x4 gv[2][2];
#pragma unroll
        for (int bj = 0; bj < 2; ++bj)
#pragma unroll
            for (int n = 0; n < 2; ++n) gv[bj][n] = *(const f32x4*)(gain + bj * 32 + 8 * fq + 4 * n);
#pragma unroll
        for (int ai = 0; ai < 2; ++ai) {
            u32x4 csw[4], snw[4];
            if (mode == 0) {
#pragma unroll
              for (int m = 0; m < 4; ++m) { const bf16_t* tp = ropet + (size_t)(u.pm * BM + ai * HALF + wr * 64 + m * 16 + fr) * 64 + 8 * fq; csw[m] = *(const u32x4*)tp; snw[m] = *(const u32x4*)(tp + 32); } }
#pragma unroll
            for (int m = 0; m < 4; ++m) {
                const int row = u.pm * BM + ai * HALF + wr * 64 + m * 16 + fr; const f32x4 sv_ = *(const PG8_LAS f32x4*)(buf + (ai * HALF + wr * 64 + m * 16 + fr) * 16); const float ri = rsqrtf(((sv_[0] + sv_[1]) + (sv_[2] + sv_[3])) * (1.0f / 1024.0f) + RMS_EPS);
                f32x4 v[2][2];
#pragma unroll
                for (int bj = 0; bj < 2; ++bj)
#pragma unroll
                    for (int n = 0; n < 2; ++n) v[bj][n] = acc[ai][bj][m][n] * ri + bv[bj][n];
                if (mode == 0) {
                    float ss = 0.f;
#pragma unroll
                    for (int bj = 0; bj < 2; ++bj)
#pragma unroll
                        for (int n = 0; n < 2; ++n) ss += (v[bj][n][0] * v[bj][n][0] + v[bj][n][1] * v[bj][n][1]) + (v[bj][n][2] * v[bj][n][2] + v[bj][n][3] * v[bj][n][3]);
                    ss += __shfl_xor(ss, 16); ss += __shfl_xor(ss, 32);
                    const float rn = rsqrtf(ss * (1.0f / 64.0f) + RMS_EPS);
#pragma unroll
                    for (int n = 0; n < 2; ++n) {
                        const unsigned c0_ = n ? csw[m].z : csw[m].x, c1_ = n ? csw[m].w : csw[m].y, s0_ = n ? snw[m].z : snw[m].x, s1_ = n ? snw[m].w : snw[m].y;
                        const f32x4 cs = {bf_lo(c0_), bf_hi(c0_), bf_lo(c1_), bf_hi(c1_)}, sn = {bf_lo(s0_), bf_hi(s0_), bf_lo(s1_), bf_hi(s1_)};
                        const f32x4 lo = v[0][n] * rn * gv[0][n], hi = v[1][n] * rn * gv[1][n];
                        v[0][n] = (lo * cs - hi * sn) * scale; v[1][n] = (hi * cs + lo * sn) * scale; }
                } else if (mode == 2) {
#pragma unroll
                    for (int bj = 0; bj < 2; ++bj)
#pragma unroll
                        for (int n = 0; n < 2; ++n)
#pragma unroll
                            for (int j = 0; j < 4; ++j) v[bj][n][j] = fast_sigmoid(v[bj][n][j]);
                }
                bf16_t* rowp = dst + (size_t)row * ld + 8 * fq;
#pragma unroll
                for (int bj = 0; bj < 2; ++bj) { u32x4 w; w.x = cvt_pk_bf16(v[bj][0][0], v[bj][0][1]); w.y = cvt_pk_bf16(v[bj][0][2], v[bj][0][3]); w.z = cvt_pk_bf16(v[bj][1][0], v[bj][1][1]); w.w = cvt_pk_bf16(v[bj][1][2], v[bj][1][3]);
                    *(u32x4*)(rowp + bj * bjoff) = w; } } }
    }
};

struct EpiBranch {
    static constexpr bool PERM = true, AFTER_DRAIN = false, PREFETCH = false, CHAIN = true;
    const bf16_t* GA; const bf16_t* GB; bf16_t* MG;
    __device__ __forceinline__ void operator()(f32x4 (&acc)[2][2][4][2], const Unit& u, int wr, int wc, int fr, int fq) const {
        const bool second = u.ko != 0; constexpr float TINY = 8.67361738e-19f;
        const unsigned rowoff = (unsigned)((u.pm * BM + wr * 64 + fr) * 1024 + u.pn * BM + wc * 32 + 8 * fq);
#define EB_OFF(ai, bj, m) (rowoff + (unsigned)(((ai) * HALF + (m) * 16) * 1024 + (bj) * HALF))
#define EB_UNPACK(dst, src_) const float dst[8] = {bf_lo((src_).x), bf_hi((src_).x), bf_lo((src_).y), bf_hi((src_).y), bf_lo((src_).z), bf_hi((src_).z), bf_lo((src_).w), bf_hi((src_).w)}
        if (!second) {
#pragma unroll
            for (int ai = 0; ai < 2; ++ai)
#pragma unroll
                for (int bj = 0; bj < 2; ++bj) {
                    u32x4 gbv[4], gav[4];
#pragma unroll
                    for (int m = 0; m < 4; ++m) { gbv[m] = *(const u32x4*)(GB + EB_OFF(ai, bj, m)); gav[m] = *(const u32x4*)(GA + EB_OFF(ai, bj, m)); }
#pragma unroll
                    for (int m = 0; m < 4; ++m) { EB_UNPACK(gb, gbv[m]); EB_UNPACK(ga, gav[m]);
#pragma unroll
                        for (int e = 0; e < 4; ++e) { acc[ai][bj][m][0][e] *= ga[e] * __builtin_amdgcn_rcpf(fmaxf(gb[e], TINY)); acc[ai][bj][m][1][e] *= ga[4 + e] * __builtin_amdgcn_rcpf(fmaxf(gb[4 + e], TINY)); } }
                }
        } else {
#pragma unroll
            for (int ai = 0; ai < 2; ++ai) {
                u32x4 gbv[2][4];
#pragma unroll
                for (int bj = 0; bj < 2; ++bj)
#pragma unroll
                    for (int m = 0; m < 4; ++m) gbv[bj][m] = *(const u32x4*)(GB + EB_OFF(ai, bj, m));
#pragma unroll
                for (int bj = 0; bj < 2; ++bj)
#pragma unroll
                    for (int m = 0; m < 4; ++m) { EB_UNPACK(g0, gbv[bj][m]); float gb[8];
#pragma unroll
                        for (int e = 0; e < 8; ++e) gb[e] = fmaxf(g0[e], TINY);
                        const f32x4 y0 = acc[ai][bj][m][0], y1 = acc[ai][bj][m][1];
                        u32x4 w; w.x = cvt_pk_bf16(gb[0] * y0[0], gb[1] * y0[1]); w.y = cvt_pk_bf16(gb[2] * y0[2], gb[3] * y0[3]); w.z = cvt_pk_bf16(gb[4] * y1[0], gb[5] * y1[1]); w.w = cvt_pk_bf16(gb[6] * y1[2], gb[7] * y1[3]);
                        *(u32x4*)(MG + EB_OFF(ai, bj, m)) = w; }
            }
        }
#undef EB_OFF
#undef EB_UNPACK
    }
};

template <bool WRITE_A, int COEF2, bool RIN_BF16, bool ROUT_BF16> struct EpiResid {
    static constexpr bool PERM = true, AFTER_DRAIN = true, PREFETCH = false, CHAIN = false;
    static constexpr float coef = 0.5f * COEF2; static constexpr int modld = 9216;
    const void* xin; void* xout; const float* gate;
    bf16_t* Aout; const float* gnorm; const float* sc; float* rss_out;
    __device__ __forceinline__ void fused(f32x4 (&acc)[2][2][4][2], const Unit& u, int wr, int wc, int fr, int fq, PG8_LAS unsigned char* lds, int wid, int lane) const {
        const int b = u.pm >> 5, col0 = u.pn * BM + wc * 32 + 8 * fq;
        float ss[2][4];
#pragma unroll
        for (int ai = 0; ai < 2; ++ai)
#pragma unroll
            for (int m = 0; m < 4; ++m) ss[ai][m] = 0.f;
#pragma unroll
        for (int bj = 0; bj < 2; ++bj) {
            f32x4 gt[2], gvv[2];
#pragma unroll
            for (int n = 0; n < 2; ++n) { const int c = col0 + bj * HALF + 4 * n; gt[n] = *(const f32x4*)(gate + (size_t)b * modld + c) * coef;
                if (WRITE_A) gvv[n] = *(const f32x4*)(gnorm + c) * (*(const f32x4*)(sc + (size_t)b * modld + c) + 1.0f); }
#pragma unroll
            for (int ai = 0; ai < 2; ++ai) {
                f32x4 xi[4][2];
#pragma unroll
                for (int m = 0; m < 4; ++m) { const size_t off = (size_t)(u.pm * BM + ai * HALF + wr * 64 + m * 16 + fr) * 1024 + col0 + bj * HALF;
                    if constexpr (RIN_BF16) { const u32x4 w = *(const u32x4*)((const bf16_t*)xin + off); xi[m][0] = (f32x4){bf_lo(w.x), bf_hi(w.x), bf_lo(w.y), bf_hi(w.y)}; xi[m][1] = (f32x4){bf_lo(w.z), bf_hi(w.z), bf_lo(w.w), bf_hi(w.w)}; }
                    else {
#pragma unroll
                        for (int n = 0; n < 2; ++n) xi[m][n] = *(const f32x4*)((const float*)xin + off + 4 * n); } }
#pragma unroll
                for (int m = 0; m < 4; ++m) {
                    const int row = u.pm * BM + ai * HALF + wr * 64 + m * 16 + fr; const size_t off = (size_t)row * 1024 + col0 + bj * HALF; float s = 0.f;
                    f32x4 xo[2];
#pragma unroll
                    for (int n = 0; n < 2; ++n) { xo[n] = xi[m][n] + gt[n] * acc[ai][bj][m][n];
                        if constexpr (!ROUT_BF16) *(f32x4*)((float*)xout + off + 4 * n) = xo[n];
                        if (WRITE_A) s += (xo[n][0] * xo[n][0] + xo[n][1] * xo[n][1]) + (xo[n][2] * xo[n][2] + xo[n][3] * xo[n][3]); }
                    if constexpr (ROUT_BF16) { u32x4 w; w.x = cvt_pk_bf16(xo[0][0], xo[0][1]); w.y = cvt_pk_bf16(xo[0][2], xo[0][3]); w.z = cvt_pk_bf16(xo[1][0], xo[1][1]); w.w = cvt_pk_bf16(xo[1][2], xo[1][3]); *(u32x4*)((bf16_t*)xout + off) = w; }
                    if (WRITE_A) { const f32x4 a0 = xo[0] * gvv[0], a1 = xo[1] * gvv[1]; u32x4 w; w.x = cvt_pk_bf16(a0[0], a0[1]); w.y = cvt_pk_bf16(a0[2], a0[3]); w.z = cvt_pk_bf16(a1[0], a1[1]); w.w = cvt_pk_bf16(a1[2], a1[3]);
                        *(u32x4*)(Aout + off) = w; ss[ai][m] += s; } }
                asm volatile("" ::: "memory"); }
        }
        if (WRITE_A) {
            PG8_LAS float* P = (PG8_LAS float*)lds;
#pragma unroll
            for (int ai = 0; ai < 2; ++ai)
#pragma unroll
                for (int m = 0; m < 4; ++m) { float s = ss[ai][m]; s += __shfl_xor(s, 16); s += __shfl_xor(s, 32); if (fq == 0) P[(ai * HALF + wr * 64 + m * 16 + fr) * 4 + wc] = s; }
            asm volatile("s_waitcnt lgkmcnt(0)" ::: "memory"); __builtin_amdgcn_s_barrier(); asm volatile("" ::: "memory");
            const int t = wid * 64 + lane;
            if (t < 256) { const PG8_LAS float* p = P + t * 4; rss_out[(size_t)(u.pm * BM + t) * 4 + u.pn] = (p[0] + p[1]) + (p[2] + p[3]); }
        }
    }
};

template <class Epi, class Sched, bool ALIGN_EPI = false, bool SP2 = false>
__device__ __forceinline__ void gemm_phase(PG8_LAS unsigned char* lds, const Gemm g, const Sched S, const Epi E, const int wid  ) {
    const int lane = MK_LANE(), tid = wid * 64 + lane, wr = wid >> 2, wc = wid & 3, fr = lane & 15, fq = lane >> 4;
    const int K = g.K, nt = (g.KL ? g.KL : K) / BK;
    unsigned voffA[2], voffB[2];
#pragma unroll
    for (int i = 0; i < 2; ++i) { int R, C; stage_rc(tid * 16 + i * 8192, R, C); const int Rb = Epi::PERM ? ((R & ~31) + perm32(R & 31)) : R;
        voffA[i] = (unsigned)(R * K + C) * 2u; voffB[i] = (unsigned)(Rb * K + C) * 2u; }
    const size_t kstep = (size_t)(BK * 2);
    const size_t hstep = (size_t)HALF * K * 2;
    const size_t tstep = 2 * hstep;
    const unsigned ldsw = (unsigned)wid * 1024u;
    const int aoff = lds_byte(wr * 64 + fr, fq * 8), boff = lds_byte(wc * 32 + fr, fq * 8);
#define PG8_SA(b, h) (((b) * 2 + (h)) * HTB)
#define PG8_SB(b, h) ((4 + (b) * 2 + (h)) * HTB)
#define PG8_STAGE(bufoff, gbase, voff) do { _Pragma("unroll") for (int _i = 0; _i < 2; ++_i) \
        __builtin_amdgcn_global_load_lds((const unsigned*)((const char*)(gbase) + (voff)[_i]), (PG8_LAS unsigned*)(lds + (bufoff) + ldsw + _i * 8192), 16, 0, 0); } while (0)
#define PG8_LDA(dst, b, h) do { _Pragma("unroll") for (int m = 0; m < 4; ++m) _Pragma("unroll") for (int k = 0; k < 2; ++k) dst[m][k] = *(const PG8_LAS bf16x8*)(lds + PG8_SA(b, h) + aoff + m * 2048 + k * 1024); } while (0)
#define PG8_LDB(dst, b, h) do { _Pragma("unroll") for (int n = 0; n < 2; ++n) _Pragma("unroll") for (int k = 0; k < 2; ++k) dst[n][k] = *(const PG8_LAS bf16x8*)(lds + PG8_SB(b, h) + boff + n * 2048 + k * 1024); } while (0)
#define PG8_MMA(ai, bj, At, Bt) do { __builtin_amdgcn_s_setprio(1); _Pragma("unroll") for (int m = 0; m < 4; ++m) _Pragma("unroll") for (int n = 0; n < 2; ++n) _Pragma("unroll") for (int k = 0; k < 2; ++k) \
        acc[ai][bj][m][n] = __builtin_amdgcn_mfma_f32_16x16x32_bf16(Bt[n][k], At[m][k], acc[ai][bj][m][n], 0, 0, 0); __builtin_amdgcn_s_setprio(0); } while (0)
#define PG8_WAIT_V(n) asm volatile("s_waitcnt vmcnt(" #n ")" ::: "memory")
#define PG8_WAIT_L(n) asm volatile("s_waitcnt lgkmcnt(" #n ")" ::: "memory")
#define PG8_BAR __builtin_amdgcn_s_barrier()
#define PG8_SCHED __builtin_amdgcn_sched_barrier(0)
    Unit cur, nxt; int ui = 0;
    if (!S.next(0, cur)) return;
    f32x4 acc[2][2][4][2];
#pragma unroll
    for (int a = 0; a < 2; ++a)
#pragma unroll
        for (int b = 0; b < 2; ++b)
#pragma unroll
            for (int m = 0; m < 4; ++m)
#pragma unroll
                for (int n = 0; n < 2; ++n) acc[a][b][m][n] = (f32x4){0.f, 0.f, 0.f, 0.f};
    bf16x8 At[4][2], B0[2][2], B1[2][2];
    const char* cA = (const char*)g.A + (size_t)cur.pm * tstep + cur.ko; const char* cB = (const char*)g.Bt + (size_t)cur.pn * tstep + cur.ko;
    S.a_ready(cur);
    if constexpr (SP2) {
        PG8_STAGE(PG8_SB(0, 0), cB, voffB); PG8_STAGE(PG8_SB(0, 1), cB + hstep, voffB); PG8_STAGE(PG8_SA(0, 0), cA, voffA); PG8_STAGE(PG8_SA(0, 1), cA + hstep, voffA);
        if (wr == 1) PG8_BAR;
        PG8_WAIT_V(2); PG8_BAR;
        PG8_STAGE(PG8_SB(1, 0), cB + kstep, voffB); PG8_STAGE(PG8_SA(1, 0), cA + kstep, voffA); PG8_STAGE(PG8_SB(1, 1), cB + hstep + kstep, voffB);
        PG8_WAIT_V(6); PG8_BAR;
    } else {
        PG8_STAGE(PG8_SB(0, 0), cB, voffB); PG8_STAGE(PG8_SA(0, 0), cA, voffA); PG8_STAGE(PG8_SB(0, 1), cB + hstep, voffB); PG8_STAGE(PG8_SA(0, 1), cA + hstep, voffA);
        if (wr == 1) PG8_BAR;
        PG8_WAIT_V(4); PG8_BAR;
        PG8_STAGE(PG8_SB(1, 0), cB + kstep, voffB); PG8_STAGE(PG8_SA(1, 0), cA + kstep, voffA); PG8_STAGE(PG8_SB(1, 1), cB + hstep + kstep, voffB);
        PG8_WAIT_V(6); PG8_BAR;
    }
    for (;;) {
        if constexpr (Epi::PREFETCH) E.prefetch(cur, lds + STAGE_BYTES + (ui & 1) * 5120, wid, lane);
        const bool has_next = S.next(ui + 1, nxt);
        const char* nA = has_next ? (const char*)g.A + (size_t)nxt.pm * tstep + nxt.ko : cA; const char* nB = has_next ? (const char*)g.Bt + (size_t)nxt.pn * tstep + nxt.ko : cB;
        for (int t = 0; t < nt; t += 2) {
            const bool last = (t == nt - 2);
            const char* a1 = cA + (size_t)(t + 1) * kstep;
            const char* a2 = last ? nA : cA + (size_t)(t + 2) * kstep; const char* b2 = last ? nB : cB + (size_t)(t + 2) * kstep;
            const char* a3 = a2 + kstep; const char* b3 = b2 + kstep;
            if (last && has_next) S.a_ready(nxt);
            if constexpr (SP2) {
            PG8_LDB(B0, 0, 0); PG8_LDB(B1, 0, 1); PG8_SCHED; PG8_LDA(At, 0, 0); PG8_STAGE(PG8_SA(1, 1), a1 + hstep, voffA);
            PG8_WAIT_V(8); PG8_WAIT_L(0); PG8_BAR; PG8_MMA(0, 0, At, B0); PG8_MMA(0, 1, At, B1); PG8_BAR; PG8_SCHED;
            PG8_LDA(At, 0, 1); PG8_STAGE(PG8_SB(0, 0), b2, voffB); PG8_STAGE(PG8_SB(0, 1), b2 + hstep, voffB); PG8_STAGE(PG8_SA(0, 0), a2, voffA);
            PG8_WAIT_V(8); PG8_WAIT_L(0); PG8_BAR; PG8_MMA(1, 0, At, B0); PG8_MMA(1, 1, At, B1); PG8_BAR; PG8_SCHED;
            PG8_LDB(B0, 1, 0); PG8_LDB(B1, 1, 1); PG8_SCHED; PG8_LDA(At, 1, 0); PG8_STAGE(PG8_SA(0, 1), a2 + hstep, voffA);
            PG8_WAIT_V(8); PG8_WAIT_L(0); PG8_BAR; PG8_MMA(0, 0, At, B0); PG8_MMA(0, 1, At, B1); PG8_BAR; PG8_SCHED;
            PG8_LDA(At, 1, 1); PG8_STAGE(PG8_SB(1, 0), b3, voffB); PG8_STAGE(PG8_SB(1, 1), b3 + hstep, voffB); PG8_STAGE(PG8_SA(1, 0), a3, voffA);
            PG8_WAIT_V(8); PG8_WAIT_L(0); PG8_BAR; PG8_MMA(1, 0, At, B0); PG8_MMA(1, 1, At, B1); PG8_BAR; PG8_SCHED;
            } else {
            PG8_LDB(B0, 0, 0); PG8_SCHED; PG8_LDA(At, 0, 0); PG8_STAGE(PG8_SA(1, 1), a1 + hstep, voffA);
            PG8_WAIT_L(8); PG8_BAR; PG8_WAIT_L(0); PG8_MMA(0, 0, At, B0); PG8_BAR; PG8_SCHED;
            PG8_LDB(B1, 0, 1); PG8_STAGE(PG8_SB(0, 0), b2, voffB);
            PG8_BAR; PG8_WAIT_L(0); PG8_MMA(0, 1, At, B1); PG8_BAR;
            PG8_LDA(At, 0, 1); PG8_STAGE(PG8_SA(0, 0), a2, voffA);
            PG8_BAR; PG8_WAIT_L(0); PG8_MMA(1, 0, At, B0); PG8_BAR; PG8_SCHED;
            PG8_STAGE(PG8_SB(0, 1), b2 + hstep, voffB);
            PG8_WAIT_V(6); PG8_BAR; PG8_MMA(1, 1, At, B1); PG8_BAR;
            PG8_LDB(B0, 1, 0); PG8_SCHED; PG8_LDA(At, 1, 0); PG8_STAGE(PG8_SA(0, 1), a2 + hstep, voffA);
            PG8_WAIT_L(8); PG8_BAR; PG8_WAIT_L(0); PG8_MMA(0, 0, At, B0); PG8_BAR; PG8_SCHED;
            PG8_LDB(B1, 1, 1); PG8_STAGE(PG8_SB(1, 0), b3, voffB);
            PG8_BAR; PG8_WAIT_L(0); PG8_MMA(0, 1, At, B1); PG8_BAR;
            PG8_LDA(At, 1, 1); PG8_STAGE(PG8_SA(1, 0), a3, voffA);
            PG8_BAR; PG8_WAIT_L(0); PG8_MMA(1, 0, At, B0); PG8_BAR; PG8_SCHED;
            PG8_STAGE(PG8_SB(1, 1), b3 + hstep, voffB);
            PG8_WAIT_V(6); PG8_BAR; PG8_MMA(1, 1, At, B1); PG8_BAR;
            }
        }
        if constexpr (ALIGN_EPI) { if (wr == 0) PG8_BAR; }
        if constexpr (!Epi::AFTER_DRAIN) { if constexpr (Epi::PREFETCH) E(acc, cur, wr, wc, fr, fq, lds + STAGE_BYTES + (ui & 1) * 5120); else E(acc, cur, wr, wc, fr, fq); S.done(cur); }
        if (!has_next) break;
        if (!Epi::CHAIN || nxt.ko == 0) {
#pragma unroll
        for (int a = 0; a < 2; ++a)
#pragma unroll
            for (int b = 0; b < 2; ++b)
#pragma unroll
                for (int m = 0; m < 4; ++m)
#pragma unroll
                    for (int n = 0; n < 2; ++n) acc[a][b][m][n] = (f32x4){0.f, 0.f, 0.f, 0.f};
        }
        cur = nxt; cA = nA; cB = nB; ++ui;
        if constexpr (ALIGN_EPI) { if (wr == 1) PG8_BAR; }
    }
    PG8_WAIT_V(0);
    if constexpr (!ALIGN_EPI) { if (wr == 0) PG8_BAR; }
    PG8_BAR;
    if constexpr (Epi::AFTER_DRAIN) { E.fused(acc, cur, wr, wc, fr, fq, lds, wid, lane); S.done(cur); }
#undef PG8_SA
#undef PG8_SB
#undef PG8_STAGE
#undef PG8_LDA
#undef PG8_LDB
#undef PG8_MMA
#undef PG8_WAIT_V
#undef PG8_WAIT_L
#undef PG8_BAR
#undef PG8_SCHED
}
}

#ifndef PG8_SP2
#define PG8_SP2 true
#endif
#ifndef PG8_ALIGN
#define PG8_ALIGN true
#endif
namespace att {
using bf16x8 = __attribute__((ext_vector_type(8))) short;
using s16x4  = __attribute__((ext_vector_type(4))) short;
using f32x16 = __attribute__((ext_vector_type(16))) float;
using u32x4  = __attribute__((ext_vector_type(4))) unsigned;
typedef unsigned short bf16_t;
constexpr int NW = 8, QBLK = 32, KVBLK = 64;
#ifndef ATT_SDEPTH
#define ATT_SDEPTH 1
#endif
#define ATT_SBAR() __builtin_amdgcn_sched_barrier(0)
#define KSWZ64(row, colB) ((row) * 128 + ((colB) ^ ((((row) >> 1) & 7) << 4)))
__device__ __forceinline__ int crow(int r, int hi) { return (r & 3) + 8 * (r >> 2) + 4 * hi; }
__device__ __forceinline__ unsigned cvtpk(float lo, float hi) { unsigned r; asm volatile("v_cvt_pk_bf16_f32 %0, %1, %2" : "=v"(r) : "v"(lo), "v"(hi)); return r; }
__device__ __forceinline__ float bf2f(bf16_t h) { return __uint_as_float((unsigned)h << 16); }
template <int NCB> __device__ __forceinline__ int v_st(int k, int c) { const int kk = k; return ((kk >> 3) * NCB + (c >> 5)) * 512 + ((kk & 7) * 32 + (c & 31)) * 2; }
__device__ __forceinline__ int v_rd_base(int lane) { return ((lane & 3) << 3) | (((lane >> 2) & 3) << 6) | (((lane >> 4) & 1) << 5) | (((lane >> 5) & 1) << 8); }
template <int OFF> __device__ __forceinline__ s16x4 tr_read(int vb) { s16x4 r; asm volatile("ds_read_b64_tr_b16 %0, %1 offset:%2" : "=&v"(r) : "v"(vb), "i"(OFF) : "memory"); return r; }
template <int NCB, int D0> __device__ __forceinline__ void pv_one(f32x16& od, int vb, bf16x8 pa0, bf16x8 pa1, bf16x8 pa2, bf16x8 pa3) {
#define VOFF(ks, half) (D0 * 512 + (2 * (ks) + (half)) * (NCB * 512))
  const s16x4 l0 = tr_read<VOFF(0, 0)>(vb), h0 = tr_read<VOFF(0, 1)>(vb), l1 = tr_read<VOFF(1, 0)>(vb), h1 = tr_read<VOFF(1, 1)>(vb);
  const s16x4 l2 = tr_read<VOFF(2, 0)>(vb), h2 = tr_read<VOFF(2, 1)>(vb), l3 = tr_read<VOFF(3, 0)>(vb), h3 = tr_read<VOFF(3, 1)>(vb);
#undef VOFF
  asm volatile("s_waitcnt lgkmcnt(0)" ::: "memory"); ATT_SBAR();
#define PK(L, H) (bf16x8){L[0], L[1], L[2], L[3], H[0], H[1], H[2], H[3]}
  od = __builtin_amdgcn_mfma_f32_32x32x16_bf16(pa0, PK(l0, h0), od, 0, 0, 0);
  od = __builtin_amdgcn_mfma_f32_32x32x16_bf16(pa1, PK(l1, h1), od, 0, 0, 0);
  od = __builtin_amdgcn_mfma_f32_32x32x16_bf16(pa2, PK(l2, h2), od, 0, 0, 0);
  od = __builtin_amdgcn_mfma_f32_32x32x16_bf16(pa3, PK(l3, h3), od, 0, 0, 0);
#undef PK
}
__device__ __forceinline__ void qkt(f32x16& p0, f32x16& p1, const char* Ks, const bf16x8* qr, const f32x16& negm, int r32, int hi) {
#pragma unroll
  for (int d0 = 0; d0 < 4; ++d0) { const int cb = d0 * 32 + hi * 16;
    const bf16x8 b0 = *reinterpret_cast<const bf16x8*>(Ks + KSWZ64(r32, cb));
    const bf16x8 b1 = *reinterpret_cast<const bf16x8*>(Ks + KSWZ64(32 + r32, cb));
    if (d0 == 0) { p0 = __builtin_amdgcn_mfma_f32_32x32x16_bf16(b0, qr[0], negm, 0, 0, 0); p1 = __builtin_amdgcn_mfma_f32_32x32x16_bf16(b1, qr[0], negm, 0, 0, 0); }
    else { p0 = __builtin_amdgcn_mfma_f32_32x32x16_bf16(b0, qr[d0], p0, 0, 0, 0); p1 = __builtin_amdgcn_mfma_f32_32x32x16_bf16(b1, qr[d0], p1, 0, 0, 0); } }
}
template <bool WIN> __device__ __forceinline__ void wmask(f32x16& p0, f32x16& p1, int qpos, int kbase, int hi) {
  if constexpr (WIN) {
#pragma unroll
    for (int r = 0; r < 16; ++r) { const int k0 = kbase + crow(r, hi) - qpos; if (k0 > 128 || k0 < -128) p0[r] = -INFINITY; if (k0 + 32 > 128 || k0 + 32 < -128) p1[r] = -INFINITY; }
  }
}
__device__ __forceinline__ void exp_half(f32x16& p) {
#pragma unroll
  for (int r = 0; r < 16; ++r) p[r] = __builtin_amdgcn_exp2f(p[r]);
}
__device__ __forceinline__ void finish_sm(f32x16& p0, f32x16& p1, float& l_reg, bf16x8& pa0, bf16x8& pa1, bf16x8& pa2, bf16x8& pa3) {
  exp_half(p1);
  float ps = 0.f;
#pragma unroll
  for (int r = 0; r < 16; ++r) ps += p0[r];
#pragma unroll
  for (int r = 0; r < 16; ++r) ps += p1[r];
  l_reg += ps;
#define PK4(P, BASE, OUT) do { u32x4 w = {cvtpk(P[BASE + 0], P[BASE + 1]), cvtpk(P[BASE + 2], P[BASE + 3]), cvtpk(P[BASE + 4], P[BASE + 5]), cvtpk(P[BASE + 6], P[BASE + 7])}; OUT = *reinterpret_cast<bf16x8*>(&w); } while (0)
  PK4(p0, 0, pa0); PK4(p0, 8, pa1); PK4(p1, 0, pa2); PK4(p1, 8, pa3);
#undef PK4
}
constexpr int NSLOT = 3, LDS_V = 0, LDS_K = NSLOT * KVBLK * 128 * 2, LDS_WS = LDS_K + 4 * KVBLK * 64 * 2, LDS_STG = LDS_WS + NW * 64 * 4, ATT_LDS_BYTES = LDS_STG + NW * 8192;
__device__ __forceinline__ void dma16(unsigned m0v, unsigned voff, __amdgpu_buffer_rsrc_t rs, unsigned soff) {
  unsigned keep;
  asm volatile("s_nop 4\n\ts_mov_b32 %0, m0\n\ts_mov_b32 m0, %1\n\ts_nop 0\n\tbuffer_load_dwordx4 %2, %3, %4 offen lds\n\ts_mov_b32 m0, %0" : "=&s"(keep) : "s"(m0v), "v"(voff), "s"(rs), "s"(soff) : "memory");
}
__device__ __forceinline__ void dma16x2(unsigned m0a, unsigned va, unsigned sa, unsigned m0b, unsigned vb, unsigned sb, __amdgpu_buffer_rsrc_t rs) {
  unsigned keep;
  asm volatile("s_nop 4\n\ts_mov_b32 %0, m0\n\ts_mov_b32 m0, %1\n\ts_nop 0\n\tbuffer_load_dwordx4 %2, %7, %3 offen lds\n\ts_mov_b32 m0, %4\n\ts_nop 0\n\tbuffer_load_dwordx4 %5, %7, %6 offen lds\n\ts_mov_b32 m0, %0"
               : "=&s"(keep) : "s"(m0a), "v"(va), "s"(sa), "s"(m0b), "v"(vb), "s"(sb), "s"(rs) : "memory");
}
__device__ __forceinline__ void dma16x3(unsigned m0a, unsigned va, unsigned sa, unsigned m0b, unsigned vb, unsigned m0c, unsigned vc, unsigned sbc, __amdgpu_buffer_rsrc_t rs) {
  unsigned keep;
  asm volatile("s_nop 4\n\ts_mov_b32 %0, m0\n\ts_mov_b32 m0, %1\n\ts_nop 0\n\tbuffer_load_dwordx4 %2, %9, %3 offen lds\n\ts_mov_b32 m0, %4\n\ts_nop 0\n\tbuffer_load_dwordx4 %5, %9, %8 offen lds\n\ts_mov_b32 m0, %6\n\ts_nop 0\n\tbuffer_load_dwordx4 %7, %9, %8 offen lds\n\ts_mov_b32 m0, %0"
               : "=&s"(keep) : "s"(m0a), "v"(va), "s"(sa), "s"(m0b), "v"(vb), "s"(m0c), "v"(vc), "s"(sbc), "s"(rs) : "memory");
}
template <int NCB, bool WIN>
__device__ __forceinline__ void attn_pass(__amdgpu_buffer_rsrc_t rs, unsigned Qb, unsigned ldq, unsigned Kh, unsigned ldk, unsigned Vh, unsigned ldv, int seq, int qpos0, int kpos0, float negm_s, char* lds, f32x16 (&o)[NCB], float& l_out, const int wid) {
  constexpr int DV = NCB * 32, SLOTV = KVBLK * DV * 2, SLOTK = KVBLK * 64 * 2, NVP = NCB / 2;
  const int lane = MK_LANE(), r32 = lane & 31, hi = lane >> 5;
  const unsigned lds0 = (unsigned)(uintptr_t)lds;
  char* V_lds = lds + LDS_V; char* K_lds = lds + LDS_K;
  bf16x8 qr[4];
  { const unsigned qoff = (unsigned)(wid * QBLK + r32) * ldq + hi * 16;
#pragma unroll
    for (int d0 = 0; d0 < 4; ++d0) { const u32x4 w = __builtin_amdgcn_raw_buffer_load_b128(rs, qoff + d0 * 32, Qb, 0); qr[d0] = __builtin_bit_cast(bf16x8, w); } }
  f32x16 negm; { float ns = negm_s; asm volatile("" : "+v"(ns));
#pragma unroll
  for (int r = 0; r < 16; ++r) negm[r] = ns; }
  asm volatile("" : "+v"(negm));
#pragma unroll
  for (int d = 0; d < NCB; ++d) o[d] = f32x16{};
  float l_reg = 0.f;
  unsigned kvoff, vvoff[NVP];
  { const int ob = wid * 1024 + lane * 16, row = ob >> 7, ch = ((ob >> 4) & 7) ^ ((row >> 1) & 7); kvoff = (unsigned)row * ldk + ch * 16; }
#pragma unroll
  for (int i = 0; i < NVP; ++i) { const int ob = (wid * NVP + i) * 1024 + lane * 16, st = ob >> 9, k = (st / NCB) * 8 + ((ob >> 6) & 7), c = (st % NCB) * 32 + ((ob >> 4) & 3) * 8;
    vvoff[i] = (unsigned)k * ldv + c * 2; }
  const unsigned kdst = lds0 + LDS_K + wid * 1024, vdst = lds0 + LDS_V + wid * NVP * 1024;
#define DMA_K(t, slot) dma16(kdst + (slot) * SLOTK, kvoff, rs, Kh + (unsigned)(t) * (KVBLK * ldk))
#define DMA_V(t, slot) do { _Pragma("unroll") for (int i_ = 0; i_ < NVP; ++i_) dma16(vdst + (slot) * SLOTV + i_ * 1024, vvoff[i_], rs, Vh + (unsigned)(t) * (KVBLK * ldv)); } while (0)
#define WAIT_BAR(N) asm volatile("s_waitcnt vmcnt(" #N ") lgkmcnt(0)\n\ts_barrier" ::: "memory")
#define WAIT_BAR_STEP() do { if (NVP == 2) WAIT_BAR(3); else WAIT_BAR(2); } while (0)
  const int vb0 = (int)(lds0 + LDS_V) + v_rd_base(lane);
  const int qpos = qpos0 + wid * QBLK + r32;
#define PVALL(vb) do { pv_one<NCB, 0>(o[0], vb, pa0, pa1, pa2, pa3); pv_one<NCB, 1>(o[1], vb, pa0, pa1, pa2, pa3); if constexpr (NCB == 4) { pv_one<NCB, 2>(o[2], vb, pa0, pa1, pa2, pa3); pv_one<NCB, 3>(o[3], vb, pa0, pa1, pa2, pa3); } } while (0)
  f32x16 pA0, pA1, pB0, pB1; bf16x8 pa0, pa1, pa2, pa3; const int NT = seq / KVBLK;
  DMA_K(0, 0); DMA_V(0, 0); DMA_K(1, 1);
  if (NVP == 2) WAIT_BAR(3); else WAIT_BAR(2);
  qkt(pA0, pA1, K_lds, qr, negm, r32, hi); wmask<WIN>(pA0, pA1, qpos, kpos0, hi); exp_half(pA0);
  DMA_K(2, 2); DMA_V(1, 1);
  WAIT_BAR_STEP();
  int s0 = 0, s1 = 1, s2 = 2;
#define ROT() do { const int t_ = s0; s0 = s1; s1 = s2; s2 = t_; } while (0)
#define DMA_KV(t) do { if constexpr (NVP == 2) dma16x3(kdst + s0 * SLOTK, kvoff, Kh + (unsigned)((t) + 3) * (KVBLK * ldk), vdst + s2 * SLOTV, vvoff[0], vdst + s2 * SLOTV + 1024, vvoff[NVP - 1], Vh + (unsigned)((t) + 2) * (KVBLK * ldv), rs); \
    else dma16x2(kdst + s0 * SLOTK, kvoff, Kh + (unsigned)((t) + 3) * (KVBLK * ldk), vdst + s2 * SLOTV, vvoff[0], Vh + (unsigned)((t) + 2) * (KVBLK * ldv), rs); } while (0)
  const int wq_lo = qpos0 + wid * QBLK, wq_hi = wq_lo + QBLK - 1;
#define T_NEED(j) (!WIN || ((kpos0 + (j) * KVBLK + KVBLK - 1 >= wq_lo - 128) && (kpos0 + (j) * KVBLK <= wq_hi + 128)))
#define T_FULL(j) ((kpos0 + (j) * KVBLK >= wq_hi - 128) && (kpos0 + (j) * KVBLK + KVBLK - 1 <= wq_lo + 128))
#define STEP(Pc0, Pc1, Pn0, Pn1, t, DOK, DOV, DOQK) do { \
    if (DOK && DOV) DMA_KV(t); else { if (DOK) DMA_K((t) + 3, s0); if (DOV) DMA_V((t) + 2, s2); } \
    const bool nc_ = T_NEED(t), nn_ = DOQK && T_NEED((t) + 1); \
    ATT_SBAR(); if (nn_) { qkt(Pn0, Pn1, K_lds + s1 * SLOTK, qr, negm, r32, hi); if (WIN && !T_FULL((t) + 1)) wmask<WIN>(Pn0, Pn1, qpos, kpos0 + ((t) + 1) * KVBLK, hi); } \
    if (nc_) { finish_sm(Pc0, Pc1, l_reg, pa0, pa1, pa2, pa3); } ATT_SBAR(); \
    if (nc_) { PVALL(vb0 + s0 * SLOTV); } if (nn_) exp_half(Pn0); } while (0)
  int t = 0;
  for (; t + 4 < NT; t += 2) {
    STEP(pA0, pA1, pB0, pB1, t, true, true, true); WAIT_BAR_STEP(); ROT();
    STEP(pB0, pB1, pA0, pA1, t + 1, true, true, true); WAIT_BAR_STEP(); ROT();
  }
  STEP(pA0, pA1, pB0, pB1, t, true, true, true); WAIT_BAR_STEP(); ROT();
  STEP(pB0, pB1, pA0, pA1, t + 1, false, true, true); WAIT_BAR(0); ROT();
  STEP(pA0, pA1, pB0, pB1, t + 2, false, false, true); WAIT_BAR(0); ROT();
  STEP(pB0, pB1, pA0, pA1, t + 3, false, false, false);
  { auto rr = __builtin_amdgcn_permlane32_swap(__float_as_uint(l_reg), __float_as_uint(l_reg), false, false); l_out = __uint_as_float(rr[0]) + __uint_as_float(rr[1]); }
  WAIT_BAR(0);
#undef DMA_K
#undef DMA_V
#undef WAIT_BAR
#undef WAIT_BAR_STEP
#undef PVALL
#undef ROT
#undef STEP
#undef DMA_KV
#undef T_NEED
#undef T_FULL
}
typedef __attribute__((address_space(3))) const char* lds_cptr;
typedef short v4i16_t __attribute__((ext_vector_type(4)));
__device__ __forceinline__ s16x4 vtr(lds_cptr p) { return __builtin_bit_cast(s16x4, __builtin_amdgcn_ds_read_tr16_b64_v4i16((__attribute__((address_space(3))) v4i16_t*)p)); }
__device__ __forceinline__ bf16x8 kld(lds_cptr p) { return *(const __attribute__((address_space(3))) bf16x8*)p; }
__device__ __forceinline__ void attn_pass_d4(__amdgpu_buffer_rsrc_t rs, unsigned Qb, unsigned ldq, unsigned Kh, unsigned ldk, unsigned Vh, unsigned ldv, int seq, float negm_s, char* lds, f32x16 (&o)[4], float& l_out, const int wid) {
  constexpr int SLOTV = KVBLK * 128 * 2, SLOTK = KVBLK * 64 * 2;
  const int lane = MK_LANE(), r32 = lane & 31, hi = lane >> 5;
  const unsigned lds0 = (unsigned)(uintptr_t)lds;
  bf16x8 qr[4];
  { const unsigned qoff = (unsigned)(wid * QBLK + r32) * ldq + hi * 16;
#pragma unroll
    for (int d0 = 0; d0 < 4; ++d0) { const u32x4 w = __builtin_amdgcn_raw_buffer_load_b128(rs, qoff + d0 * 32, Qb, 0); qr[d0] = __builtin_bit_cast(bf16x8, w); } }
  f32x16 negm; { float ns = negm_s; asm volatile("" : "+v"(ns));
#pragma unroll
  for (int r = 0; r < 16; ++r) negm[r] = ns; }
  asm volatile("" : "+v"(negm));
#pragma unroll
  for (int d = 0; d < 4; ++d) o[d] = f32x16{};
  float l_reg = 0.f;
  const unsigned kvoff = (unsigned)lane * ldk + wid * 16;
  unsigned vvoff0, vvoff1;
  { const int ob = (wid * 2 + 0) * 1024 + lane * 16, st = ob >> 9, k = (st / 4) * 8 + ((ob >> 6) & 7), c = (st % 4) * 32 + ((ob >> 4) & 3) * 8; vvoff0 = (unsigned)k * ldv + c * 2; }
  { const int ob = (wid * 2 + 1) * 1024 + lane * 16, st = ob >> 9, k = (st / 4) * 8 + ((ob >> 6) & 7), c = (st % 4) * 32 + ((ob >> 4) & 3) * 8; vvoff1 = (unsigned)k * ldv + c * 2; }
  const unsigned kdst = lds0 + LDS_K + wid * 1024, vdst = lds0 + LDS_V + wid * 2048;
  const lds_cptr kp0 = (lds_cptr)lds + LDS_K + hi * 1024 + r32 * 16;
  const lds_cptr vp0 = (lds_cptr)lds + LDS_V + v_rd_base(lane);
  const int NT = seq / KVBLK;
#define D4_PIN(x) asm volatile("" : "+v"(x))
#define D4_MFMA(a, b, c) __builtin_amdgcn_mfma_f32_32x32x16_bf16(a, b, c, 0, 0, 0)
#define D4_WAIT_BAR(N) asm volatile("s_waitcnt vmcnt(" #N ") lgkmcnt(0)\n\ts_barrier" ::: "memory")
#define D4_KSLOT(t) ((unsigned)((t) & 3) * SLOTK)
#define D4_DMA_K(t) dma16(kdst + D4_KSLOT(t), kvoff, rs, Kh + (unsigned)(t) * (KVBLK * ldk))
#define D4_DMA_V(t, sl) dma16x2(vdst + (sl), vvoff0, Vh + (unsigned)(t) * (KVBLK * ldv), vdst + (sl) + 1024, vvoff1, Vh + (unsigned)(t) * (KVBLK * ldv), rs)
#define D4_DMA_KV(tk, tv, sl) dma16x3(kdst + D4_KSLOT(tk), kvoff, Kh + (unsigned)(tk) * (KVBLK * ldk), vdst + (sl), vvoff0, vdst + (sl) + 1024, vvoff1, Vh + (unsigned)(tv) * (KVBLK * ldv), rs)
  f32x16 pA0, pA1, pB0, pB1; bf16x8 kf[4]; s16x4 vl[5], vh[5]; u32x4 pw0, pw1, pw2, pw3;
#define D4_KRD(buf, kp, j) kf[buf] = kld((kp) + ((j) >> 1) * 2048 + ((j) & 1) * 512)
#define D4_VO(f, half) (((f) >> 2) * 512 + (2 * ((f) & 3) + (half)) * 2048)
#define D4_VRD(f) do { vl[(f) % 5] = vtr(vp_ + D4_VO(f, 0)); vh[(f) % 5] = vtr(vp_ + D4_VO(f, 1)); } while (0)
#define D4_VFR(f) (bf16x8){vl[(f) % 5][0], vl[(f) % 5][1], vl[(f) % 5][2], vl[(f) % 5][3], vh[(f) % 5][0], vh[(f) % 5][1], vh[(f) % 5][2], vh[(f) % 5][3]}
#define D4_PKW(P, i) cvtpk(P[i], P[i + 1])
#define D4_PAF(k) __builtin_bit_cast(bf16x8, pw##k)
  D4_DMA_K(0); D4_DMA_V(0, 0); D4_DMA_K(1); D4_DMA_K(2); D4_DMA_KV(3, 1, SLOTV);
  D4_WAIT_BAR(3);
  { const lds_cptr kp_ = kp0;
    D4_KRD(0, kp_, 0); D4_KRD(1, kp_, 1); D4_KRD(2, kp_, 2); D4_KRD(3, kp_, 3);
    pA0 = D4_MFMA(kf[0], qr[0], negm); pA1 = D4_MFMA(kf[1], qr[0], negm); pA0 = D4_MFMA(kf[2], qr[1], pA0); pA1 = D4_MFMA(kf[3], qr[1], pA1);
    D4_KRD(0, kp_, 4); D4_KRD(1, kp_, 5); D4_KRD(2, kp_, 6); D4_KRD(3, kp_, 7);
    pA0 = D4_MFMA(kf[0], qr[2], pA0); pA1 = D4_MFMA(kf[1], qr[2], pA1); pA0 = D4_MFMA(kf[2], qr[3], pA0); pA1 = D4_MFMA(kf[3], qr[3], pA1);
    exp_half(pA0); exp_half(pA1);
    const lds_cptr kn_ = kp0 + SLOTK;
    D4_KRD(0, kn_, 0); D4_KRD(1, kn_, 1); D4_KRD(2, kn_, 2); D4_KRD(3, kn_, 3); }
  D4_WAIT_BAR(3);
  unsigned sl_prev = 0, sl_cur = SLOTV, sl_next = 2 * SLOTV;
#define D4_ROT() do { sl_prev = sl_cur; sl_cur = sl_next; sl_next = (sl_next == 2u * SLOTV) ? 0u : sl_next + SLOTV; } while (0)
#define D4_EX2(X, i) do { X[i] = __builtin_amdgcn_exp2f(X[i]); X[(i) + 1] = __builtin_amdgcn_exp2f(X[(i) + 1]); } while (0)
#define D4_GAPA(MF, LD, a0, a1, a2, a3, W0, W1, PW) do { MF; LD; sacc += a0; sacc += a1; sacc += a2; sacc += a3; W0; W1; D4_PIN(PW); D4_PIN(sacc); ATT_SBAR(); } while (0)
#define D4_GAPB(i, X, xi, LD) do { o[(i) >> 2] = D4_MFMA(D4_PAFI(i), D4_VFR(i), o[(i) >> 2]); LD; D4_EX2(X, xi); D4_PIN(X); ATT_SBAR(); } while (0)
#define D4_PAFI(i) (((i) & 3) == 0 ? D4_PAF(0) : ((i) & 3) == 1 ? D4_PAF(1) : ((i) & 3) == 2 ? D4_PAF(2) : D4_PAF(3))
#define D4_STEP(C0, C1, P0, P1, t, GK, GV, GL) do { ATT_SBAR(); \
    const lds_cptr vp_ = vp0 + sl_prev; const lds_cptr kp_ = kp0 + D4_KSLOT(t); const lds_cptr kn_ = kp0 + D4_KSLOT((t) + 1); \
    float sacc = P0[0] + P0[1]; ATT_SBAR(); \
    D4_GAPA(C0 = D4_MFMA(kf[0], qr[0], negm), D4_KRD(0, kp_, 4), P0[2], P0[3], P0[4], P0[5],     pw0[0] = D4_PKW(P0, 0),  pw0[1] = D4_PKW(P0, 2),  pw0); \
    D4_GAPA(C1 = D4_MFMA(kf[1], qr[0], negm), D4_KRD(1, kp_, 5), P0[6], P0[7], P0[8], P0[9],     pw0[2] = D4_PKW(P0, 4),  pw0[3] = D4_PKW(P0, 6),  pw0); \
    D4_GAPA(C0 = D4_MFMA(kf[2], qr[1], C0),   D4_KRD(2, kp_, 6), P0[10], P0[11], P0[12], P0[13], pw1[0] = D4_PKW(P0, 8),  pw1[1] = D4_PKW(P0, 10), pw1); \
    D4_GAPA(C1 = D4_MFMA(kf[3], qr[1], C1),   D4_KRD(3, kp_, 7), P0[14], P0[15], P1[0], P1[1],   pw1[2] = D4_PKW(P0, 12), pw1[3] = D4_PKW(P0, 14), pw1); \
    D4_GAPA(C0 = D4_MFMA(kf[0], qr[2], C0),   D4_VRD(0),         P1[2], P1[3], P1[4], P1[5],     pw2[0] = D4_PKW(P1, 0),  pw2[1] = D4_PKW(P1, 2),  pw2); \
    D4_GAPA(C1 = D4_MFMA(kf[1], qr[2], C1),   D4_VRD(1),         P1[6], P1[7], P1[8], P1[9],     pw2[2] = D4_PKW(P1, 4),  pw2[3] = D4_PKW(P1, 6),  pw2); \
    D4_GAPA(C0 = D4_MFMA(kf[2], qr[3], C0),   D4_VRD(2),         P1[10], P1[11], P1[12], P1[13], pw3[0] = D4_PKW(P1, 8),  pw3[1] = D4_PKW(P1, 10), pw3); \
    D4_GAPA(C1 = D4_MFMA(kf[3], qr[3], C1),   do { D4_VRD(3); D4_VRD(4); } while (0), P1[14], P1[15], 0.f, 0.f, pw3[2] = D4_PKW(P1, 12), pw3[3] = D4_PKW(P1, 14), pw3); \
    l_reg += sacc; \
    D4_GAPB(0, C0, 0, D4_VRD(5));   D4_GAPB(1, C0, 2, D4_VRD(6));   D4_GAPB(2, C0, 4, D4_VRD(7));    D4_GAPB(3, C0, 6, D4_VRD(8)); \
    D4_GAPB(4, C0, 8, D4_VRD(9));   D4_GAPB(5, C0, 10, D4_VRD(10)); D4_GAPB(6, C0, 12, D4_VRD(11));  D4_GAPB(7, C0, 14, do { D4_VRD(12); if (GL) D4_KRD(0, kn_, 0); } while (0)); \
    D4_GAPB(8, C1, 0, do { D4_VRD(13); if ((GK) && (GV)) D4_DMA_KV((t) + 3, (t) + 1, sl_next); else if (GV) D4_DMA_V((t) + 1, sl_next); } while (0)); \
    D4_GAPB(9, C1, 2, do { D4_VRD(14); if (GL) D4_KRD(1, kn_, 1); } while (0));  D4_GAPB(10, C1, 4, do { D4_VRD(15); if (GL) D4_KRD(2, kn_, 2); } while (0));  D4_GAPB(11, C1, 6, do { if (GL) D4_KRD(3, kn_, 3); } while (0)); \
    D4_GAPB(12, C1, 8, (void)0); D4_GAPB(13, C1, 10, (void)0); D4_GAPB(14, C1, 12, (void)0); D4_GAPB(15, C1, 14, (void)0); \
    } while (0)
  int t = 1;
  for (; t + 4 < NT; t += 2) {
    D4_STEP(pB0, pB1, pA0, pA1, t, true, true, true);     D4_WAIT_BAR(3); D4_ROT();
    D4_STEP(pA0, pA1, pB0, pB1, t + 1, true, true, true); D4_WAIT_BAR(3); D4_ROT();
  }
  D4_STEP(pB0, pB1, pA0, pA1, t, false, true, true);      D4_WAIT_BAR(2); D4_ROT();
  D4_STEP(pA0, pA1, pB0, pB1, t + 1, false, true, true);  D4_WAIT_BAR(0); D4_ROT();
  D4_STEP(pB0, pB1, pA0, pA1, t + 2, false, false, false);
  { float sacc = pB0[0] + pB0[1];
#pragma unroll
    for (int r = 2; r < 16; ++r) sacc += pB0[r];
#pragma unroll
    for (int r = 0; r < 16; ++r) sacc += pB1[r];
    l_reg += sacc;
    pw0 = (u32x4){D4_PKW(pB0, 0), D4_PKW(pB0, 2), D4_PKW(pB0, 4), D4_PKW(pB0, 6)}; pw1 = (u32x4){D4_PKW(pB0, 8), D4_PKW(pB0, 10), D4_PKW(pB0, 12), D4_PKW(pB0, 14)};
    pw2 = (u32x4){D4_PKW(pB1, 0), D4_PKW(pB1, 2), D4_PKW(pB1, 4), D4_PKW(pB1, 6)}; pw3 = (u32x4){D4_PKW(pB1, 8), D4_PKW(pB1, 10), D4_PKW(pB1, 12), D4_PKW(pB1, 14)};
    const lds_cptr vp_ = vp0 + sl_cur;
    D4_VRD(0); D4_VRD(1); D4_VRD(2); D4_VRD(3); D4_VRD(4);
    o[0] = D4_MFMA(D4_PAF(0), D4_VFR(0), o[0]); D4_VRD(5); o[0] = D4_MFMA(D4_PAF(1), D4_VFR(1), o[0]); D4_VRD(6); o[0] = D4_MFMA(D4_PAF(2), D4_VFR(2), o[0]); D4_VRD(7); o[0] = D4_MFMA(D4_PAF(3), D4_VFR(3), o[0]); D4_VRD(8);
    o[1] = D4_MFMA(D4_PAF(0), D4_VFR(4), o[1]); D4_VRD(9); o[1] = D4_MFMA(D4_PAF(1), D4_VFR(5), o[1]); D4_VRD(10); o[1] = D4_MFMA(D4_PAF(2), D4_VFR(6), o[1]); D4_VRD(11); o[1] = D4_MFMA(D4_PAF(3), D4_VFR(7), o[1]); D4_VRD(12);
    o[2] = D4_MFMA(D4_PAF(0), D4_VFR(8), o[2]); D4_VRD(13); o[2] = D4_MFMA(D4_PAF(1), D4_VFR(9), o[2]); D4_VRD(14); o[2] = D4_MFMA(D4_PAF(2), D4_VFR(10), o[2]); D4_VRD(15); o[2] = D4_MFMA(D4_PAF(3), D4_VFR(11), o[2]);
    o[3] = D4_MFMA(D4_PAF(0), D4_VFR(12), o[3]); o[3] = D4_MFMA(D4_PAF(1), D4_VFR(13), o[3]); o[3] = D4_MFMA(D4_PAF(2), D4_VFR(14), o[3]); o[3] = D4_MFMA(D4_PAF(3), D4_VFR(15), o[3]); }
  { auto rr = __builtin_amdgcn_permlane32_swap(__float_as_uint(l_reg), __float_as_uint(l_reg), false, false); l_out = __uint_as_float(rr[0]) + __uint_as_float(rr[1]); }
  D4_WAIT_BAR(0);
#undef D4_PIN
#undef D4_MFMA
#undef D4_WAIT_BAR
#undef D4_KSLOT
#undef D4_DMA_K
#undef D4_DMA_V
#undef D4_DMA_KV
#undef D4_KRD
#undef D4_VO
#undef D4_VRD
#undef D4_VFR
#undef D4_PKW
#undef D4_PAF
#undef D4_PAFI
#undef D4_ROT
#undef D4_EX2
#undef D4_GAPA
#undef D4_GAPB
#undef D4_STEP
}
__device__ __forceinline__ void row_recips(float l, float extra, float* wsf, int r32, int hi, float (&rli)[16]) {
  if (hi == 0) wsf[r32] = l + extra; asm volatile("s_waitcnt lgkmcnt(0)" ::: "memory");
#pragma unroll
  for (int r = 0; r < 16; ++r) rli[r] = __builtin_amdgcn_rcpf(wsf[crow(r, hi)]);
  asm volatile("s_waitcnt lgkmcnt(0)" ::: "memory");
}

__device__ __forceinline__ void win_unit(__amdgpu_buffer_rsrc_t rs, const char* wsb, int b, int hq, int qb, const bf16_t* QA, const bf16_t* KA, const bf16_t* VA, bf16_t* ACAT, const float* scal, char* lds, const int wid) {
  constexpr int S = 8192;
  const int lane0 = MK_LANE(), kvh = hq >> 2;
  const int q0 = qb * 256; int kbeg = q0 - 128, kend = q0 + 384; if (kbeg < 0) kbeg = 0; if (kend > S) kend = S;
  const size_t rowbase = (size_t)b * S;
  f32x16 o[2]; float l;
  attn_pass<2, true>(rs, (unsigned)((const char*)(QA + (rowbase + q0) * 512 + hq * 64) - wsb), 1024u, (unsigned)((const char*)(KA + (rowbase + kbeg) * 128 + kvh * 64) - wsb), 256u, (unsigned)((const char*)(VA + (rowbase + kbeg) * 128 + kvh * 64) - wsb), 256u, kend - kbeg, q0, kbeg, scal[8 + hq], lds, o, l, wid);
  int r32 = lane0 & 31, hi = lane0 >> 5, lane = lane0; asm volatile("" : "+v"(r32), "+v"(hi), "+v"(lane));
  float* wsf = (float*)(lds + LDS_WS) + wid * 64; float rli[16];
  row_recips(l, scal[16 + hq], wsf, r32, hi, rli);
  bf16_t* stg = (bf16_t*)(lds + LDS_STG) + wid * 4096;
#pragma unroll
  for (int r = 0; r < 16; ++r) { const int orow = crow(r, hi);
#pragma unroll
    for (int d0 = 0; d0 < 2; ++d0) stg[orow * 64 + d0 * 32 + r32] = (bf16_t)(cvtpk(o[d0][r] * rli[r], 0.f) & 0xffffu); }
  asm volatile("s_waitcnt lgkmcnt(0)" ::: "memory");
  const int widl = wid;
  bf16_t* Ow = ACAT + (rowbase + q0) * 1024 + hq * 64 + (unsigned)((widl * QBLK + (lane >> 3)) * 1024 + (lane & 7) * 8);
  const bf16_t* sp = stg + (lane >> 3) * 64 + (lane & 7) * 8;
#pragma unroll
  for (int i = 0; i < 4; ++i) { const u32x4 v = *(const u32x4*)(sp + i * 512); *(u32x4*)(Ow + (size_t)i * 8192) = v; }
  asm volatile("s_waitcnt lgkmcnt(0)" ::: "memory"); __syncthreads();
}

__device__ __forceinline__ void diff_unit(__amdgpu_buffer_rsrc_t rs, const char* wsb, int b, int h, int qb, const bf16_t* QB, const bf16_t* KB, const bf16_t* VB, bf16_t* ACAT, const float* scal, const float* subln, char* lds, const int wid) {
  constexpr int S = 8192;
  const int lane0 = MK_LANE();
  const size_t rowbase = (size_t)b * S; const int q0 = qb * 256;
  float* wsf = (float*)(lds + LDS_WS) + wid * 64; float rli[16];
  bf16_t* stg = (bf16_t*)(lds + LDS_STG) + wid * 4096;
  const float lam = scal[0], post = 1.0f - scal[1], negm_s = scal[2];
#pragma unroll 1
  for (int t = 0; t < 2; ++t) {
    f32x16 o[4]; float l;
    attn_pass_d4(rs, (unsigned)((const char*)(QB + (rowbase + q0) * 512 + (2 * h + t) * 64) - wsb), 1024u, (unsigned)((const char*)(KB + rowbase * 512 + (2 * h + t) * 64) - wsb), 1024u, (unsigned)((const char*)(VB + rowbase * 512 + h * 128) - wsb), 1024u, S, negm_s, lds, o, l, wid);
    int r32 = lane0 & 31, hi = lane0 >> 5, lane = lane0; asm volatile("" : "+v"(r32), "+v"(hi), "+v"(lane));
    row_recips(l, 0.f, wsf, r32, hi, rli);
    if (t == 0) {
#pragma unroll
      for (int r = 0; r < 16; ++r) { const int orow = crow(r, hi);
#pragma unroll
        for (int d0 = 0; d0 < 4; ++d0) stg[orow * 128 + d0 * 32 + r32] = (bf16_t)(cvtpk(o[d0][r] * rli[r], 0.f) & 0xffffu); }
    } else {
      float ss[16];
#pragma unroll
      for (int r = 0; r < 16; ++r) { const int orow = crow(r, hi); float s_ = 0.f;
#pragma unroll
        for (int d0 = 0; d0 < 4; ++d0) { const float v = bf2f(stg[orow * 128 + d0 * 32 + r32]) - lam * (o[d0][r] * rli[r]); o[d0][r] = v; s_ += v * v; }
        ss[r] = s_; }
#pragma unroll
      for (int r = 0; r < 16; ++r) { float s_ = ss[r]; s_ += __shfl_xor(s_, 1); s_ += __shfl_xor(s_, 2); s_ += __shfl_xor(s_, 4); s_ += __shfl_xor(s_, 8); s_ += __shfl_xor(s_, 16); ss[r] = rsqrtf(s_ * (1.0f / 128.0f) + 1e-6f) * post; }
      float sl[4];
#pragma unroll
      for (int d0 = 0; d0 < 4; ++d0) sl[d0] = subln[d0 * 32 + r32];
#pragma unroll
      for (int r = 0; r < 16; ++r) { const int orow = crow(r, hi);
#pragma unroll
        for (int d0 = 0; d0 < 4; ++d0) stg[orow * 128 + d0 * 32 + r32] = (bf16_t)(cvtpk(o[d0][r] * ss[r] * sl[d0], 0.f) & 0xffffu); }
      asm volatile("s_waitcnt lgkmcnt(0)" ::: "memory");
      const int widl = wid;
      bf16_t* Ow = ACAT + (rowbase + q0) * 1024 + 512 + h * 128 + (unsigned)((widl * QBLK + (lane >> 4)) * 1024 + (lane & 15) * 8);
      const bf16_t* sp = stg + (lane >> 4) * 128 + (lane & 15) * 8;
#pragma unroll
      for (int i = 0; i < 8; ++i) { const u32x4 v = *(const u32x4*)(sp + i * 512); *(u32x4*)(Ow + (size_t)i * 4096) = v; }
    }
  }
  asm volatile("s_waitcnt lgkmcnt(0)" ::: "memory"); __syncthreads();
}
#undef ATT_SBAR
#undef KSWZ64
}
constexpr int NWAVES = 8;
#ifndef MK_N_LAUNCHES
#define MK_N_LAUNCHES 1
#endif
constexpr int PER_PHASE = 10;
constexpr int N_LAUNCHES = MK_N_LAUNCHES;

constexpr int BATCH = 2, T = 8192, D = 1024, M = BATCH * T, DFF = 2816, NFF = 2 * DFF, NIN = 4352, NMOD = 9 * D;
constexpr size_t MiB = 1u << 20;
constexpr size_t WS_CTL = 0, CTL_ZERO_BYTES = 1 * MiB;
constexpr size_t WS_MOD = 512 * 1024;
constexpr size_t WS_SCAL = 1 * MiB, WS_CB1 = WS_SCAL + 4096, WS_CBIN = WS_CB1 + 65536, WS_CB2 = WS_CBIN + 65536;
constexpr size_t WS_RSS0 = 2 * MiB, WS_RSS1 = WS_RSS0 + 256 * 1024, WS_RSS2 = WS_RSS1 + 256 * 1024;
constexpr size_t WS_COS = 3 * MiB, WS_SIN = 5 * MiB;
constexpr size_t WS_W1T = 8 * MiB, WS_W1OT = 19 * MiB, WS_WINT = 25 * MiB, WS_WBRT = 34 * MiB, WS_WOT = 38 * MiB, WS_W2T = 40 * MiB, WS_W2OT = 51 * MiB;
constexpr size_t WS_ABUF = 57 * MiB;
constexpr size_t WS_R1 = 89 * MiB;
constexpr size_t WS_QA = WS_R1, WS_KA = WS_QA + 16 * MiB, WS_VA = WS_KA + 4 * MiB, WS_QB = WS_VA + 4 * MiB, WS_KB = WS_QB + 16 * MiB, WS_VB = WS_KB + 16 * MiB;
constexpr size_t WS_MG = WS_R1;
constexpr size_t WS_GA = 177 * MiB, WS_GB = 209 * MiB, WS_END = 241 * MiB;
static_assert(WS_VB + 16 * MiB <= WS_GA && WS_R1 + (size_t)M * DFF * 2 <= WS_GA && WS_W2OT + (size_t)D * DFF * 2 <= WS_ABUF, "d_ws map");
constexpr int CW_TMO = 0, CW_CODE = 1, CW_BAR = 4096;

constexpr int RING_OFF = 0, RING_BYTES = 131072;
constexpr int LDSCTL_OFF = 149504, MISC_OFF = LDSCTL_OFF + 320;
constexpr int LDS_BYTES = 155648;
static_assert(MISC_OFF + 128 <= LDS_BYTES && att::ATT_LDS_BYTES <= LDSCTL_OFF && RING_BYTES <= LDSCTL_OFF, "LDS map");

#define GAS __attribute__((address_space(1)))
#define LAS __attribute__((address_space(3)))
typedef unsigned short bf16;
typedef unsigned v4u __attribute__((ext_vector_type(4)));
typedef float f32x4 __attribute__((ext_vector_type(4)));
typedef short bf16x8 __attribute__((ext_vector_type(8)));
typedef GAS unsigned gu32;
typedef GAS unsigned long long gu64;
#define RLX_AGENT __ATOMIC_RELAXED, __HIP_MEMORY_SCOPE_AGENT
#define LDS_WAIT() asm volatile("s_waitcnt lgkmcnt(0)" ::: "memory")
#define VM_WAIT() asm volatile("s_waitcnt vmcnt(0)" ::: "memory")
__device__ __forceinline__ unsigned long long rt() { return __builtin_amdgcn_s_memrealtime(); }
__device__ __forceinline__ unsigned f2bf(float f) { unsigned u = __builtin_bit_cast(unsigned, f); return (u + 0x7fffu + ((u >> 16) & 1u)) >> 16; }
__device__ __forceinline__ unsigned pk2(float lo, float hi) { return f2bf(lo) | (f2bf(hi) << 16); }

#define XB_TMO      128
#define XB_XCNT(j)  (256  + 64 * (j))
#define XB_XSUB(j)  (1280 + 64 * (j))
#define XB_XGEN(j)  (2304 + 64 * (j))
#define XB_TOP      3328
#define XB_TOPGEN   3392
#define XCD_BAR_WORDS 3456
#define XB_SPIN_CAP (1u << 18)

__device__ __forceinline__ unsigned xb_ld(unsigned* p)              { return __hip_atomic_load(p, __ATOMIC_RELAXED, __HIP_MEMORY_SCOPE_AGENT); }
__device__ __forceinline__ unsigned xb_add(unsigned* p, unsigned v) { return __hip_atomic_fetch_add(p, v, __ATOMIC_RELAXED, __HIP_MEMORY_SCOPE_AGENT); }
__device__ __forceinline__ unsigned xb_xcc_id() { return (unsigned)__builtin_amdgcn_s_getreg((3 << 11) | 20) & 0xFu; }
#define XB_SPIN(cond, bar) do { unsigned _sp = 0; while (cond) { __builtin_amdgcn_s_sleep(1); \
    if ((++_sp & 255u) == 0u) { if (xb_ld(&(bar)[XB_TMO])) break; if (_sp > XB_SPIN_CAP) { atomicAdd(&(bar)[XB_TMO], 1u); break; } } } } while (0)

struct XcdBarrier {
    unsigned* bar; unsigned x;
    volatile LAS unsigned* st;
};

__device__ __forceinline__ XcdBarrier xcd_barrier_post(unsigned* bar, volatile LAS unsigned* st) {
    XcdBarrier b; b.bar = bar; b.x = xb_xcc_id(); b.st = st;
    if (threadIdx.x == 0) (void)xb_add(&bar[XB_XCNT(b.x)], 1u);
    return b;
}
__device__ __forceinline__ void xcd_barrier_complete(unsigned* bar, unsigned x, unsigned& nloc, unsigned& nx) {
    const unsigned G = gridDim.x * gridDim.y * gridDim.z;
    unsigned sum, cnt, mine, sp = 0u;
    for (;;) {
        sum = 0u; cnt = 0u; mine = 0u;
#pragma unroll
        for (unsigned j = 0; j < 16; ++j) { const unsigned c = xb_ld(&bar[XB_XCNT(j)]); sum += c; cnt += (c > 0u) ? 1u : 0u; mine = (j == x) ? c : mine; }
        if (sum == G) break;
        __builtin_amdgcn_s_sleep(1);
        if ((++sp & 255u) == 0u) { if (xb_ld(&bar[XB_TMO])) break; if (sp > XB_SPIN_CAP) { atomicAdd(&bar[XB_TMO], 1u); break; } }
    }
    nloc = mine > 0u ? mine : 1u; nx = cnt > 0u ? cnt : 1u;
}

__device__ __forceinline__ void xcd_barrier(const XcdBarrier& b, const bool leader  ) {
    asm volatile("s_waitcnt vmcnt(0)" ::: "memory");
    __syncthreads();
    if (leader) {
        unsigned* bar = b.bar;
        __builtin_amdgcn_s_waitcnt(0);
        unsigned nloc = b.st[0], nx = b.st[1];
        if (nloc == 0u) { xcd_barrier_complete(bar, b.x, nloc, nx); b.st[0] = nloc; b.st[1] = nx; }
        const unsigned old = xb_add(&bar[XB_XSUB(b.x)], 1u);
        const unsigned gen = old / nloc;
        if (old + 1u == (gen + 1u) * nloc) {
            __builtin_amdgcn_fence(__ATOMIC_RELEASE, "agent");
            asm volatile("s_waitcnt vmcnt(0)" ::: "memory");
            const unsigned og = xb_add(&bar[XB_TOP], 1u);
            const unsigned tg = og / nx;
            asm volatile("buffer_inv sc1" ::: "memory");
            if (og + 1u == (tg + 1u) * nx) xb_add(&bar[XB_TOPGEN], 1u);
            else XB_SPIN(xb_ld(&bar[XB_TOPGEN]) == tg, bar);
            xb_add(&bar[XB_XGEN(b.x)], 1u);
            asm volatile("s_waitcnt vmcnt(0)" ::: "memory");
        } else {
            asm volatile("buffer_inv sc1" ::: "memory");
            XB_SPIN(xb_ld(&bar[XB_XGEN(b.x)]) == gen, bar);
            asm volatile("s_waitcnt vmcnt(0)" ::: "memory");
        }
    }
    __syncthreads();
}

struct Args { const void* in[26]; float* out; unsigned char* ws; int ph_lo, ph_hi, li, pad; };

__device__ __forceinline__ float wave_sum(float v) {
#pragma unroll
    for (int o = 1; o < 64; o <<= 1) v += __shfl_xor(v, o);
    return v;
}
__device__ __forceinline__ int rowmap(int kind, int n0) {
    if (kind == 1) { const int bj = n0 >= DFF ? 1 : 0, jj = n0 - bj * DFF; return (jj >> 7) * 256 + bj * 128 + (jj & 127); }
    if (kind == 2) { if (n0 >= 2304) return n0; const int g32 = n0 >> 5, head = g32 >> 1, bj = g32 & 1; return (head >> 2) * 256 + bj * 128 + (head & 3) * 32; }
    if (kind == 3) return (n0 >> 7) * 256 + (n0 & 127);
    if (kind == 4) return (n0 >> 7) * 256 + 128 + (n0 & 127);
    return n0;
}
struct TItem { const float* src; bf16* dst; int N; int ldk; };
__device__ __forceinline__ TItem p0_item_addr(const float* W, int N, bf16* WT, int ldk, int koff, int kind, int item, int lane) {
    const int nblk = N / 32, kb = item / nblk, nb = item % nblk, k0 = 64 * kb, n0 = 32 * nb, c0 = rowmap(kind, n0), kg = lane & 7, ng = lane >> 3;
    TItem t; t.src = W + (size_t)(k0 + 8 * kg) * N + n0 + 4 * ng; t.dst = WT + (size_t)(c0 + 4 * ng) * ldk + koff + k0 + 8 * kg; t.N = N; t.ldk = ldk; return t;
}
__device__ __forceinline__ void p0_item_load(const TItem& t, f32x4 (&v)[8]) {
#pragma unroll
    for (int j = 0; j < 8; ++j) v[j] = __builtin_nontemporal_load((const f32x4*)(t.src + (size_t)j * t.N));
}
__device__ __forceinline__ void p0_item_store(const TItem& t, const f32x4 (&v)[8]) {
#pragma unroll
    for (int i = 0; i < 4; ++i) { v4u o; o.x = pk2(v[0][i], v[1][i]); o.y = pk2(v[2][i], v[3][i]); o.z = pk2(v[4][i], v[5][i]); o.w = pk2(v[6][i], v[7][i]);
        *(GAS v4u*)(t.dst + (size_t)i * t.ldk) = o; }
}

__device__ __forceinline__ void bias_rows(const bf16* Bt, float* CB, int nrows, const float* sh0, const float* sh1, int gw, int NGW) {
    const int lane = MK_LANE();
    f32x4 s0[2][2], s1[2][2];
#pragma unroll
    for (int hh = 0; hh < 2; ++hh)
#pragma unroll
        for (int q = 0; q < 2; ++q) { s0[hh][q] = *(const f32x4*)(sh0 + hh * 512 + lane * 8 + 4 * q); s1[hh][q] = *(const f32x4*)(sh1 + hh * 512 + lane * 8 + 4 * q); }
    for (int c0 = gw; c0 < nrows; c0 += 3 * NGW) {
        v4u w[3][2];
#pragma unroll
        for (int r = 0; r < 3; ++r) { const int c = c0 + r * NGW;
            if (c < nrows) {
#pragma unroll
                for (int hh = 0; hh < 2; ++hh) w[r][hh] = *(const GAS v4u*)(Bt + (size_t)c * D + hh * 512 + lane * 8); } }
#pragma unroll
        for (int r = 0; r < 3; ++r) { const int c = c0 + r * NGW;
            if (c < nrows) { float a0 = 0.f, a1 = 0.f;
#pragma unroll
                for (int hh = 0; hh < 2; ++hh) { const v4u v = w[r][hh];
                    const float wf[8] = {__uint_as_float(v.x << 16), __uint_as_float(v.x & 0xffff0000u), __uint_as_float(v.y << 16), __uint_as_float(v.y & 0xffff0000u),
                                         __uint_as_float(v.z << 16), __uint_as_float(v.z & 0xffff0000u), __uint_as_float(v.w << 16), __uint_as_float(v.w & 0xffff0000u)};
#pragma unroll
                    for (int e = 0; e < 8; ++e) { a0 += wf[e] * s0[hh][e >> 2][e & 3]; a1 += wf[e] * s1[hh][e >> 2][e & 3]; } }
                a0 = wave_sum(a0); a1 = wave_sum(a1);
                if (lane == 0) { CB[c] = a0; CB[nrows + c] = a1; } } }
    }
}

__global__ void __launch_bounds__(NWAVES * 64, 2) layer_fwd(Args args) {
    extern __shared__ __attribute__((aligned(16))) unsigned char lds[];
    LAS unsigned char* ldsl = (LAS unsigned char*)lds;
    volatile LAS unsigned* MISC = (volatile LAS unsigned*)(ldsl + MISC_OFF);
    const int wave = __builtin_amdgcn_readfirstlane((int)threadIdx.x >> 6), lane = MK_LANE(), tid = wave * 64 + lane;
    const int G = gridDim.x; const int bx = blockIdx.x; const int vcu = (G % 8 == 0) ? (bx % 8) * (G / 8) + bx / 8 : bx;
    unsigned char* ws = args.ws;
    gu32* ctl = (gu32*)(ws + WS_CTL);
    const float* x = (const float*)args.in[0]; const float* cvec = (const float*)args.in[1]; const int* positions = (const int*)args.in[2];
    const float* w_mod = (const float*)args.in[3]; const float* b_mod = (const float*)args.in[4];
    const float* norm_ffn1 = (const float*)args.in[5]; const float* w_ffn1_in = (const float*)args.in[6]; const float* w_ffn1_out = (const float*)args.in[7];
    const float* norm_mix = (const float*)args.in[8]; const float* w_in = (const float*)args.in[9];
    const float* qn_a = (const float*)args.in[10]; const float* kn_a = (const float*)args.in[11]; const float* sink_a = (const float*)args.in[12];
    const float* qn_b = (const float*)args.in[13]; const float* kn_b = (const float*)args.in[14];
    const float* lam_q1 = (const float*)args.in[15]; const float* lam_k1 = (const float*)args.in[16]; const float* lam_q2 = (const float*)args.in[17]; const float* lam_k2 = (const float*)args.in[18];
    const float* subln_b = (const float*)args.in[19]; const float* w_branch_a = (const float*)args.in[20]; const float* w_branch_b = (const float*)args.in[21];
    const float* w_out = (const float*)args.in[22]; const float* norm_ffn2 = (const float*)args.in[23]; const float* w_ffn2_in = (const float*)args.in[24]; const float* w_ffn2_out = (const float*)args.in[25];
    float* out = args.out;
    float* MOD = (float*)(ws + WS_MOD); float* SCAL = (float*)(ws + WS_SCAL); float* CB1 = (float*)(ws + WS_CB1); float* CBIN = (float*)(ws + WS_CBIN); float* CB2 = (float*)(ws + WS_CB2);
    float* RSS0 = (float*)(ws + WS_RSS0); float* RSS1 = (float*)(ws + WS_RSS1); float* RSS2 = (float*)(ws + WS_RSS2); bf16* ROPET = (bf16*)(ws + WS_COS);
    bf16* W1T = (bf16*)(ws + WS_W1T); bf16* W1OT = (bf16*)(ws + WS_W1OT); bf16* WINT = (bf16*)(ws + WS_WINT); bf16* WBRT = (bf16*)(ws + WS_WBRT); bf16* WOT = (bf16*)(ws + WS_WOT);
    bf16* W2T = (bf16*)(ws + WS_W2T); bf16* W2OT = (bf16*)(ws + WS_W2OT);
    bf16* ABUF = (bf16*)(ws + WS_ABUF); bf16* HB = (bf16*)(ws + WS_R1); bf16* MG = (bf16*)(ws + WS_MG);
    bf16* QA = (bf16*)(ws + WS_QA); bf16* KA = (bf16*)(ws + WS_KA); bf16* VA = (bf16*)(ws + WS_VA); bf16* QB = (bf16*)(ws + WS_QB); bf16* KB = (bf16*)(ws + WS_KB); bf16* VB = (bf16*)(ws + WS_VB);
    bf16* GA = (bf16*)(ws + WS_GA); bf16* GB = (bf16*)(ws + WS_GB);
    bf16* X1B = (bf16*)out;
    bf16* X2B = (bf16*)(ws + WS_GA);

    for (int u = tid; u < (LDS_BYTES - LDSCTL_OFF) / 4; u += NWAVES * 64) ((LAS unsigned*)(ldsl + LDSCTL_OFF))[u] = 0u;
    __syncthreads();
    XcdBarrier bar; bar.bar = (unsigned*)(ctl + CW_BAR); bar.x = 0; bar.st = nullptr;
    if (N_LAUNCHES != PER_PHASE) bar = xcd_barrier_post((unsigned*)(ctl + CW_BAR), MISC + 8);
#define GRID_BAR(seam) do { if (N_LAUNCHES == PER_PHASE) { if (tid == 0) __hip_atomic_store(ctl + CW_TMO, 0xBADBA0u | (unsigned)(seam), RLX_AGENT); } else { xcd_barrier(bar, wave == 0 && MK_LANE() == 0); } } while (0)
    const int lo = args.ph_lo, hi = args.ph_hi;
#ifndef PH_MASK
#define PH_MASK 0x3ff
#endif
#define IN(k) (((PH_MASK >> (k)) & 1) && lo <= (k) && (k) < hi)
#define BOTH(k) (IN(k) && IN((k) + 1))
#ifndef REPEAT_MASK
#define REPEAT_MASK 0
#endif
#define REPS(k) for (int rep_ = 0; rep_ <= ((REPEAT_MASK >> (k)) & 1); ++rep_)
    const int gw = vcu * NWAVES + wave, NGW = G * NWAVES;
    constexpr float QSCALE = 0.125f * 1.4426950408889634f;

    if (IN(0)) {
#define MOD_GEMV(IT_BEGIN, IT_END, IT_FIRST, IT_STRIDE, TIDV, LANEV) do { \
            LAS float* ca = (LAS float*)(ldsl + RING_OFF + 73728);              \
            LAS float* red = ca + 2048;                                          \
            for (int i = (TIDV); i < 2 * D; i += NWAVES * 64) { const float v = cvec[i]; ca[i] = v / (1.f + __expf(-v)); } \
            __syncthreads(); \
            for (int it = (IT_BEGIN) + (IT_FIRST); it < (IT_END); it += (IT_STRIDE)) { \
                const int cg = it >> 1, kh = it & 1, j = cg * 64 + (LANEV), kbase = kh * 512 + wave * 64; \
                float wv[64]; \
                _Pragma("unroll") \
                for (int kk = 0; kk < 64; ++kk) wv[kk] = w_mod[(size_t)(kbase + kk) * NMOD + j]; \
                float a0 = 0.f, a1 = 0.f; \
                _Pragma("unroll") \
                for (int kk = 0; kk < 64; ++kk) { a0 += ca[kbase + kk] * wv[kk]; a1 += ca[D + kbase + kk] * wv[kk]; } \
                red[(wave * 2 + 0) * 64 + (LANEV)] = a0; red[(wave * 2 + 1) * 64 + (LANEV)] = a1; \
                __syncthreads(); \
                if ((TIDV) < 128) { const int b = (TIDV) >> 6; float s_ = (kh == 0) ? b_mod[j] : 0.f; \
                    _Pragma("unroll") \
                    for (int w = 0; w < 8; ++w) s_ += red[(w * 2 + b) * 64 + (LANEV)]; \
                    atomicAdd(MOD + b * NMOD + j, s_); } \
                __syncthreads(); \
            } } while (0)
        MOD_GEMV(0, 64, bx, G, tid, lane);
        {
            constexpr int NITEMS = (D / 64) * (NFF / 32);
            auto item_of = [&](int it) -> TItem { return p0_item_addr(w_ffn1_in, NFF, W1T, D, 0, 1, it, lane); };
            for (int it = gw; it < NITEMS; it += 2 * NGW) {
                const int it2 = it + NGW; const bool two = it2 < NITEMS;
                const TItem a = item_of(it), b2 = item_of(two ? it2 : it);
                f32x4 va[8], vb[8];
                p0_item_load(a, va); if (two) p0_item_load(b2, vb);
                p0_item_store(a, va); if (two) p0_item_store(b2, vb);
            }
        }
        if (bx == 0 && wave == 0) {
            const float a = wave_sum(lam_q1[lane] * lam_k1[lane]), b2 = wave_sum(lam_q2[lane] * lam_k2[lane]);
            float mqa = fabsf(qn_a[lane]), mka = fabsf(kn_a[lane]), mqb = fabsf(qn_b[lane]), mkb = fabsf(kn_b[lane]);
#pragma unroll
            for (int o = 1; o < 64; o <<= 1) { mqa = fmaxf(mqa, __shfl_xor(mqa, o)); mka = fmaxf(mka, __shfl_xor(mka, o)); mqb = fmaxf(mqb, __shfl_xor(mqb, o)); mkb = fmaxf(mkb, __shfl_xor(mkb, o)); }
            const float bound_a = 8.0f * mqa * mka * 1.001f, bound_b = 8.0f * mqb * mkb * 1.001f, L2E = 1.4426950408889634f;
            if (lane == 0) { const float lam_init = 0.8f - 0.6f * expf(-0.3f * 0.f); SCAL[0] = expf(a) - expf(b2) + lam_init; SCAL[1] = lam_init; SCAL[2] = -bound_b * L2E; }
            if (lane < 8) { const float sk = sink_a[lane], mh = fmaxf(bound_a, sk); SCAL[8 + lane] = -mh * L2E; SCAL[16 + lane] = exp2f((sk - mh) * L2E); }
        }
        if (BOTH(0)) GRID_BAR(0);
    }

    if (IN(1)) {
        for (int m = gw; m < M; m += NGW) {
            const int b = m >> 13; const GAS f32x4* xr = (const GAS f32x4*)(x + (size_t)m * D) + lane;
            f32x4 v[4]; float s = 0.f;
#pragma unroll
            for (int j = 0; j < 4; ++j) { v[j] = xr[64 * j]; s += (v[j].x * v[j].x + v[j].y * v[j].y) + (v[j].z * v[j].z + v[j].w * v[j].w); }
            s = wave_sum(s);
            if (lane == 0) *(f32x4*)(RSS0 + (size_t)m * 4) = (f32x4){s, 0.f, 0.f, 0.f};
            GAS unsigned long long* o8 = (GAS unsigned long long*)(ABUF + (size_t)m * D) + lane;
#pragma unroll
            for (int j = 0; j < 4; ++j) { const int c = 4 * lane + 256 * j; const f32x4 g = *(const f32x4*)(norm_ffn1 + c) * (*(const f32x4*)(MOD + b * NMOD + 1 * D + c) + 1.0f); const f32x4 a = v[j] * g;
                o8[64 * j] = (unsigned long long)pk2(a.x, a.y) | ((unsigned long long)pk2(a.z, a.w) << 32); }
        }
        bias_rows(W1T, CB1, NFF, MOD + 0 * D, MOD + NMOD + 0 * D, gw, NGW);
        if (BOTH(1)) GRID_BAR(1);
    }

    if (IN(2)) {
        pg8::Gemm g{ABUF, W1T, M, NFF, D}; pg8::StaticOrder S; S.init(M, NFF, G, bx);
        pg8::EpiSwiGLU E{HB, DFF, RSS0, CB1, NFF};
        pg8::gemm_phase<pg8::EpiSwiGLU, pg8::StaticOrder, PG8_ALIGN, PG8_SP2>(ldsl + RING_OFF, g, S, E, wave);
        { pg8::Unit ud; const int nunits = (M / 256) * (NFF / 256), nfull = nunits / G;
          if (!S.next(nfull, ud)) {
            const int nidle = G - (nunits - nfull * G), iw = (bx - (G - nidle)) * NWAVES + wave, NIW = nidle * NWAVES, lane2 = MK_LANE();
            MOD_GEMV(64, 288, bx - (G - nidle), nidle, wave * 64 + lane2, lane2);
            constexpr int I_IN = (D / 64) * (NIN / 32), I_1O = (DFF / 64) * (D / 32), NITEMS = I_IN + I_1O;
            auto item_of = [&](int it) -> TItem { return it < I_IN ? p0_item_addr(w_in, NIN, WINT, D, 0, 2, it, lane2) : p0_item_addr(w_ffn1_out, D, W1OT, DFF, 0, 0, it - I_IN, lane2); };
            for (int it = iw; it < NITEMS; it += 2 * NIW) {
                const int it2 = it + NIW; const bool two = it2 < NITEMS;
                const TItem a = item_of(it), b2 = item_of(two ? it2 : it);
                f32x4 va[8], vb[8];
                p0_item_load(a, va); if (two) p0_item_load(b2, vb);
                p0_item_store(a, va); if (two) p0_item_store(b2, vb);
            }
            { const float invf = (float)pow(10000.0, -(double)(2 * (lane2 & 31)) / 64.0);
              for (int i = iw * 64 + lane2; i < M * 32; i += NIW * 64) { const float ang = (float)positions[i >> 5] * invf; const int row = i >> 5, d = i & 31;
                  ROPET[row * 64 + d] = (bf16)f2bf(cosf(ang)); ROPET[row * 64 + 32 + d] = (bf16)f2bf(sinf(ang)); } }
          } }
        if (BOTH(2)) GRID_BAR(2);
    }
    if (IN(3)) {
        pg8::Gemm g{HB, W1OT, M, D, DFF}; pg8::StaticOrder S; S.init(M, D, G, bx);
        pg8::EpiResid<true, 1, false, true> E{x, X1B, MOD + 2 * D, ABUF, norm_mix, MOD + 4 * D, RSS1};
        pg8::gemm_phase<pg8::EpiResid<true, 1, false, true>, pg8::StaticOrder, false, PG8_SP2>(ldsl + RING_OFF, g, S, E, wave);
        bias_rows(WINT, CBIN, NIN, MOD + 3 * D, MOD + NMOD + 3 * D, gw, NGW);
        if (BOTH(3)) GRID_BAR(3);
    }
    if (IN(4)) {
        pg8::Gemm g{ABUF, WINT, M, NIN, D}; pg8::StaticOrder S; S.init(M, NIN, G, bx);
        pg8::EpiInProj E{QA, KA, VA, QB, KB, VB, GA, GB, RSS1, CBIN, ROPET, qn_a, kn_a, qn_b, kn_b, QSCALE};
        pg8::gemm_phase<pg8::EpiInProj, pg8::StaticOrder, PG8_ALIGN, PG8_SP2>(ldsl + RING_OFF, g, S, E, wave);
        { pg8::Unit ud; const int nunits = (M / 256) * (NIN / 256), nfull = nunits / G;
          if (!S.next(nfull, ud)) {
            const int nidle = G - (nunits - nfull * G), iw = (bx - (G - nidle)) * NWAVES + wave, NIW = nidle * NWAVES, lane2 = MK_LANE();
            constexpr int I_1 = (D / 64) * (NFF / 32), I_1O = (DFF / 64) * (D / 32), I_BR = (512 / 64) * (D / 32), I_O = (D / 64) * (D / 32);
            constexpr int NITEMS = 2 * I_BR + I_O + I_1 + I_1O;
            auto item_of = [&](int it) -> TItem {
                int r = it;
                if (r < I_BR) return p0_item_addr(w_branch_a, D, WBRT, D, 0, 0, r, lane2); r -= I_BR;
                if (r < I_BR) return p0_item_addr(w_branch_b, D, WBRT, D, 512, 0, r, lane2); r -= I_BR;
                if (r < I_O) return p0_item_addr(w_out, D, WOT, D, 0, 0, r, lane2); r -= I_O;
                if (r < I_1) return p0_item_addr(w_ffn2_in, NFF, W2T, D, 0, 1, r, lane2); r -= I_1;
                return p0_item_addr(w_ffn2_out, D, W2OT, DFF, 0, 0, r, lane2);
            };
            for (int it = iw; it < NITEMS; it += 2 * NIW) {
                const int it2 = it + NIW; const bool two = it2 < NITEMS;
                const TItem a = item_of(it), b2 = item_of(two ? it2 : it);
                f32x4 va[8], vb[8];
                p0_item_load(a, va); if (two) p0_item_load(b2, vb);
                p0_item_store(a, va); if (two) p0_item_store(b2, vb);
            }
          } }
        if (BOTH(4)) GRID_BAR(4);
    }
    if (IN(5)) {
        char* alds = (char*)lds + RING_OFF;
        const __amdgpu_buffer_rsrc_t wsrs = __builtin_amdgcn_make_buffer_rsrc((void*)ws, (short)0, 0x10000000, 0x00020000);
#ifndef SKIP_WIN
        for (int id = vcu; id < 512; id += G) att::win_unit(wsrs, (const char*)ws, id >> 8, (id >> 5) & 7, id & 31, QA, KA, VA, ABUF, SCAL, alds, wave);
#endif
#ifndef SKIP_DIFF
        for (int id = vcu; id < 256; id += G) att::diff_unit(wsrs, (const char*)ws, id >> 7, (id >> 5) & 3, id & 31, QB, KB, VB, ABUF, SCAL, subln_b, alds, wave);
#endif
        if (BOTH(5)) GRID_BAR(5);
    }
    if (IN(6)) {
        pg8::Gemm g{ABUF, WBRT, M, D, D, 512}; pg8::PairOrder S; S.init(M, D, G, bx, D);
        pg8::EpiBranch E{GA, GB, MG};
        pg8::gemm_phase<pg8::EpiBranch, pg8::PairOrder, PG8_ALIGN, PG8_SP2>(ldsl + RING_OFF, g, S, E, wave);
        if (BOTH(6)) GRID_BAR(6);
    }
    if (IN(7)) {
        pg8::Gemm g{MG, WOT, M, D, D}; pg8::StaticOrder S; S.init(M, D, G, bx);
        pg8::EpiResid<true, 2, true, true> E{X1B, X2B, MOD + 5 * D, ABUF, norm_ffn2, MOD + 7 * D, RSS2};
        pg8::gemm_phase<pg8::EpiResid<true, 2, true, true>, pg8::StaticOrder, false, PG8_SP2>(ldsl + RING_OFF, g, S, E, wave);
        bias_rows(W2T, CB2, NFF, MOD + 6 * D, MOD + NMOD + 6 * D, gw, NGW);
        if (BOTH(7)) GRID_BAR(7);
    }
    if (IN(8)) {
        pg8::Gemm g{ABUF, W2T, M, NFF, D}; pg8::StaticOrder S; S.init(M, NFF, G, bx);
        pg8::EpiSwiGLU E{HB, DFF, RSS2, CB2, NFF};
        pg8::gemm_phase<pg8::EpiSwiGLU, pg8::StaticOrder, PG8_ALIGN, PG8_SP2>(ldsl + RING_OFF, g, S, E, wave);
        if (BOTH(8)) GRID_BAR(8);
    }
    if (IN(9)) {
        pg8::Gemm g{HB, W2OT, M, D, DFF}; pg8::StaticOrder S; S.init(M, D, G, bx);
        pg8::EpiResid<false, 1, true, false> E{X2B, out, MOD + 8 * D, nullptr, nullptr, nullptr, nullptr};
        pg8::gemm_phase<pg8::EpiResid<false, 1, true, false>, pg8::StaticOrder, false, PG8_SP2>(ldsl + RING_OFF, g, S, E, wave);
    }
#undef IN
#undef BOTH
#undef GRID_BAR
}

extern "C" void kernel_launch(void* const* d_in, const int* in_sizes, int n_in, void* d_out, int out_size, void* d_ws, size_t ws_size, hipStream_t stream) {
    static int grid = 0;
    if (grid == 0) {
        if (n_in != 26 || in_sizes[0] != M * D || out_size != M * D || ws_size < WS_END) { fprintf(stderr, "kernel_launch: unexpected shapes: n_in %d in0 %d out %d ws %zu (need >= %zu)\n", n_in, n_in > 0 ? in_sizes[0] : -1, out_size, ws_size, (size_t)WS_END); grid = -1; return; }
        int dev = 0, cus = 0;
        if (hipGetDevice(&dev) != hipSuccess || hipDeviceGetAttribute(&cus, hipDeviceAttributeMultiprocessorCount, dev) != hipSuccess) { grid = -1; return; }
        if (hipFuncSetAttribute((const void*)layer_fwd, hipFuncAttributeMaxDynamicSharedMemorySize, LDS_BYTES) != hipSuccess) { fprintf(stderr, "kernel_launch: hipFuncSetAttribute failed\n"); grid = -1; return; }
        int per_cu = 0;
        if (hipOccupancyMaxActiveBlocksPerMultiprocessor(&per_cu, (const void*)layer_fwd, NWAVES * 64, LDS_BYTES) != hipSuccess || per_cu < 1) fprintf(stderr, "kernel_launch: occupancy query says %d\n", per_cu);
        (void)hipGetLastError();
        grid = cus;
        if (grid != 256) fprintf(stderr, "kernel_launch: %d CUs; the one-unit-per-workgroup phases need exactly 256\n", grid);
    }
    if (grid < 0) return;
    (void)hipMemsetAsync((char*)d_ws + WS_CTL, 0, CTL_ZERO_BYTES, stream);
    Args a{};
    for (int i = 0; i < 26; ++i) a.in[i] = d_in[i];
    a.out = (float*)d_out; a.ws = (unsigned char*)d_ws;
    for (int li = 0; li < N_LAUNCHES; ++li) {
        a.ph_lo = (N_LAUNCHES == PER_PHASE) ? li : 0; a.ph_hi = (N_LAUNCHES == PER_PHASE) ? li + 1 : PER_PHASE; a.li = li;
        hipLaunchKernelGGL(layer_fwd, dim3(grid), dim3(NWAVES * 64), LDS_BYTES, stream, a);
    }
}
```

```cpp
#include <hip/hip_runtime.h>
#include <cstdio>
#include <cstdint>
#include <cmath>
__device__ __forceinline__ int mk_lane_() { int l; asm volatile("v_mbcnt_lo_u32_b32 %0, -1, 0\n\tv_mbcnt_hi_u32_b32 %0, -1, %0" : "=v"(l)); return l; }
#define MK_LANE() mk_lane_()
namespace pg8 {
#define PG8_LAS __attribute__((address_space(3)))
typedef unsigned short bf16_t;
typedef short bf16x8 __attribute__((ext_vector_type(8)));
typedef float f32x4 __attribute__((ext_vector_type(4)));
typedef unsigned u32x4 __attribute__((ext_vector_type(4)));
constexpr int BM = 256, BK = 64, HALF = 128, HTB = HALF * BK * 2  , STAGE_BYTES = 8 * HTB, NXCD = 8, WGM = 8;

__host__ __device__ __forceinline__ int lds_byte(int r, int c) { const int st = (r >> 4) * 2 + (c >> 5), rr = r & 15, cc = c & 31, ob = rr * 64 + cc * 2; return st * 1024 + (ob ^ (((ob >> 9) & 1) << 5)); }
__host__ __device__ __forceinline__ void stage_rc(int b, int& R, int& C) { const int st = b / 1024, sb = b % 1024, swz = sb ^ (((sb >> 9) & 1) << 5); R = (st >> 1) * 16 + swz / 64; C = (st & 1) * 32 + (swz % 64) / 2; }
__host__ __device__ __forceinline__ int perm32(int rho) { const int n = rho >> 4, i = rho & 15; return 8 * (i >> 2) + 4 * n + (i & 3); }

struct Unit { int pm, pn, ko; };
struct Gemm { const bf16_t* A; const bf16_t* Bt; int M, N, K; int KL = 0; };

struct StaticOrder {
    int nM, nN, nwg, G, c;
    __host__ __device__ void init(int M, int N, int G_, int c_) { nM = M / BM; nN = N / BM; nwg = nM * nN; G = G_; c = c_; }
    __host__ __device__ bool next(int i, Unit& u) const {
        const long L = (long)i * G + c; if (L >= nwg) return false;
        int wgid = (int)L; { const int q = nwg / NXCD, r = nwg % NXCD, xcd = wgid % NXCD, off = wgid / NXCD; wgid = (xcd < r ? xcd * (q + 1) : r * (q + 1) + (xcd - r) * q) + off; }
        const int nig = WGM * nN, gid = wgid / nig, fm = gid * WGM, gsz = (nM - fm) < WGM ? (nM - fm) : WGM;
        u.pm = fm + ((wgid % nig) % gsz); u.pn = (wgid % nig) / gsz; u.ko = 0; return true;
    }
    __device__ __forceinline__ void a_ready(const Unit&) const {}
    __device__ __forceinline__ void done(const Unit&) const {}
};
struct PairOrder {
    StaticOrder S; int khalf_bytes;
    __host__ __device__ void init(int M, int N, int G_, int c_, int K) { S.init(M, N, G_, c_); khalf_bytes = K;   }
    __host__ __device__ bool next(int i, Unit& u) const { if (!S.next(i >> 1, u)) return false; u.ko = (i & 1) * khalf_bytes; return true; }
    __device__ __forceinline__ void a_ready(const Unit&) const {}
    __device__ __forceinline__ void done(const Unit&) const {}
};

__device__ __forceinline__ unsigned cvt_pk_bf16(float lo, float hi) { unsigned r; asm volatile("v_cvt_pk_bf16_f32 %0, %1, %2" : "=v"(r) : "v"(lo), "v"(hi)); return r; }
__device__ __forceinline__ float bf_lo(unsigned w) { return __uint_as_float(w << 16); }
__device__ __forceinline__ float bf_hi(unsigned w) { return __uint_as_float(w & 0xffff0000u); }
constexpr float RMS_EPS = 1e-6f, LOG2E = 1.4426950408889634f;
__device__ __forceinline__ float row_rinv(const float* rss, int row) { const f32x4 s = *(const f32x4*)(rss + (size_t)row * 4); return rsqrtf(((s[0] + s[1]) + (s[2] + s[3])) * (1.0f / 1024.0f) + RMS_EPS); }
__device__ __forceinline__ float fast_sigmoid(float v) { return __builtin_amdgcn_rcpf(1.0f + __builtin_amdgcn_exp2f(-v * LOG2E)); }

struct EpiSwiGLU {
    static constexpr bool PERM = true, AFTER_DRAIN = false, PREFETCH = true, CHAIN = false;
    bf16_t* H; int ldh; const float* rss; const float* cb; int ncb;
    __device__ __forceinline__ void prefetch(const Unit& u, PG8_LAS unsigned char* buf, int wid, int lane) const {
        if (wid < 4) __builtin_amdgcn_global_load_lds((const unsigned*)(rss + (size_t)(u.pm * BM + wid * 64 + lane) * 4), (PG8_LAS unsigned*)(buf + wid * 1024), 16, 0, 0);
        else if (wid == 4) __builtin_amdgcn_global_load_lds((const unsigned*)(cb + (size_t)(u.pm >> 5) * ncb + u.pn * BM + lane * 4), (PG8_LAS unsigned*)(buf + 4096), 16, 0, 0);
    }
    __device__ __forceinline__ void operator()(const f32x4 (&acc)[2][2][4][2], const Unit& u, int wr, int wc, int fr, int fq, const PG8_LAS unsigned char* buf) const {
        const int outcol = u.pn * HALF + wc * 32 + 8 * fq;
        const PG8_LAS float* cbb = (const PG8_LAS float*)(buf + 4096) + wc * 32 + 8 * fq;
        const f32x4 bg0 = *(const PG8_LAS f32x4*)(cbb), bg1 = *(const PG8_LAS f32x4*)(cbb + 4), bu0 = *(const PG8_LAS f32x4*)(cbb + HALF), bu1 = *(const PG8_LAS f32x4*)(cbb + HALF + 4);
#pragma unroll
        for (int ai = 0; ai < 2; ++ai) {
#pragma unroll
            for (int m = 0; m < 4; ++m) {
                const int row = u.pm * BM + ai * HALF + wr * 64 + m * 16 + fr; const f32x4 sv_ = *(const PG8_LAS f32x4*)(buf + (ai * HALF + wr * 64 + m * 16 + fr) * 16); const float ri = rsqrtf(((sv_[0] + sv_[1]) + (sv_[2] + sv_[3])) * (1.0f / 1024.0f) + RMS_EPS);
                const f32x4 g0 = acc[ai][0][m][0] * ri + bg0, g1 = acc[ai][0][m][1] * ri + bg1, u0 = acc[ai][1][m][0] * ri + bu0, u1 = acc[ai][1][m][1] * ri + bu1;
                float o[8];
#pragma unroll
                for (int j = 0; j < 4; ++j) { o[j] = g0[j] * fast_sigmoid(g0[j]) * u0[j]; o[4 + j] = g1[j] * fast_sigmoid(g1[j]) * u1[j]; }
                u32x4 w; w.x = cvt_pk_bf16(o[0], o[1]); w.y = cvt_pk_bf16(o[2], o[3]); w.z = cvt_pk_bf16(o[4], o[5]); w.w = cvt_pk_bf16(o[6], o[7]);
                *(u32x4*)(H + (size_t)row * ldh + outcol) = w; } }
    }
};

struct EpiInProj {
    static constexpr bool PERM = true, AFTER_DRAIN = false, PREFETCH = true, CHAIN = false;
    bf16_t *QA, *KA, *VA, *QB, *KB, *VB, *GA, *GB; const float* rss; const float* cb; const bf16_t* ropet; const float *qn_a, *kn_a, *qn_b, *kn_b; float qscale;
    __device__ __forceinline__ void prefetch(const Unit& u, PG8_LAS unsigned char* buf, int wid, int lane) const {
        if (wid < 4) __builtin_amdgcn_global_load_lds((const unsigned*)(rss + (size_t)(u.pm * BM + wid * 64 + lane) * 4), (PG8_LAS unsigned*)(buf + wid * 1024), 16, 0, 0);
        else if (wid == 4) __builtin_amdgcn_global_load_lds((const unsigned*)(cb + (size_t)(u.pm >> 5) * 4352 + u.pn * BM + lane * 4), (PG8_LAS unsigned*)(buf + 4096), 16, 0, 0);
    }
    __device__ __forceinline__ void operator()(const f32x4 (&acc)[2][2][4][2], const Unit& u, int wr, int wc, int fr, int fq, const PG8_LAS unsigned char* buf) const {
        const int pn = u.pn;
        int mode; bf16_t* dst; int ld; const float* gain = qn_a; float scale = 1.f;
        if (pn < 2) { mode = 0; dst = QA + (4 * pn + wc) * 64; ld = 512; gain = qn_a; scale = qscale; }
        else if (pn == 2) { if (wc < 2) { mode = 0; dst = KA + wc * 64; ld = 128; gain = kn_a; } else { mode = 1; dst = VA + (wc - 2) * 64; ld = 128; } }
        else if (pn < 5) { mode = 0; dst = QB + (4 * (pn - 3) + wc) * 64; ld = 512; gain = qn_b; scale = qscale; }
        else if (pn < 7) { mode = 0; dst = KB + (4 * (pn - 5) + wc) * 64; ld = 512; gain = kn_b; }
        else if (pn < 9) { mode = 1; dst = VB + (4 * (pn - 7) + wc) * 64; ld = 512; }
        else if (pn < 13) { mode = 2; dst = GA + (pn - 9) * BM + wc * 32; ld = 1024; }
        else { mode = 2; dst = GB + (pn - 13) * BM + wc * 32; ld = 1024; }
        const int bjoff = (mode == 2) ? HALF : 32;
        const PG8_LAS float* cbb = (const PG8_LAS float*)(buf + 4096) + wc * 32 + 8 * fq;
        f32x4 bv[2][2];
#pragma unroll
        for (int bj = 0; bj < 2; ++bj)
#pragma unroll
            for (int n = 0; n < 2; ++n) bv[bj][n] = *(const PG8_LAS f32x4*)(cbb + bj * HALF + 4 * n);
        f32x4 gv[2][2];
#pragma unroll
        for (int bj = 0; bj < 2; ++bj)
#pragma unroll
            for (int n = 0; n < 2; ++n) gv[bj][n] = *(const f32x4*)(gain + bj * 32 + 8 * fq + 4 * n);
#pragma unroll
        for (int ai = 0; ai < 2; ++ai) {
            u32x4 csw[4], snw[4];
            if (mode == 0) {
#pragma unroll
              for (int m = 0; m < 4; ++m) { const bf16_t* tp = ropet + (size_t)(u.pm * BM + ai * HALF + wr * 64 + m * 16 + fr) * 64 + 8 * fq; csw[m] = *(const u32x4*)tp; snw[m] = *(const u32x4*)(tp + 32); } }
#pragma unroll
            for (int m = 0; m < 4; ++m) {
                const int row = u.pm * BM + ai * HALF + wr * 64 + m * 16 + fr; const f32x4 sv_ = *(const PG8_LAS f32x4*)(buf + (ai * HALF + wr * 64 + m * 16 + fr) * 16); const float ri = rsqrtf(((sv_[0] + sv_[1]) + (sv_[2] + sv_[3])) * (1.0f / 1024.0f) + RMS_EPS);
                f32x4 v[2][2];
#pragma unroll
                for (int bj = 0; bj < 2; ++bj)
#pragma unroll
                    for (int n = 0; n < 2; ++n) v[bj][n] = acc[ai][bj][m][n] * ri + bv[bj][n];
                if (mode == 0) {
                    float ss = 0.f;
#pragma unroll
                    for (int bj = 0; bj < 2; ++bj)
#pragma unroll
                        for (int n = 0; n < 2; ++n) ss += (v[bj][n][0] * v[bj][n][0] + v[bj][n][1] * v[bj][n][1]) + (v[bj][n][2] * v[bj][n][2] + v[bj][n][3] * v[bj][n][3]);
                    ss += __shfl_xor(ss, 16); ss += __shfl_xor(ss, 32);
                    const float rn = rsqrtf(ss * (1.0f / 64.0f) + RMS_EPS);
#pragma unroll
                    for (int n = 0; n < 2; ++n) {
                        const unsigned c0_ = n ? csw[m].z : csw[m].x, c1_ = n ? csw[m].w : csw[m].y, s0_ = n ? snw[m].z : snw[m].x, s1_ = n ? snw[m].w : snw[m].y;
                        const f32x4 cs = {bf_lo(c0_), bf_hi(c0_), bf_lo(c1_), bf_hi(c1_)}, sn = {bf_lo(s0_), bf_hi(s0_), bf_lo(s1_), bf_hi(s1_)};
                        const f32x4 lo = v[0][n] * rn * gv[0][n], hi = v[1][n] * rn * gv[1][n];
                        v[0][n] = (lo * cs - hi * sn) * scale; v[1][n] = (hi * cs + lo * sn) * scale; }
                } else if (mode == 2) {
#pragma unroll
                    for (int bj = 0; bj < 2; ++bj)
#pragma unroll
                        for (int n = 0; n < 2; ++n)
#pragma unroll
                            for (int j = 0; j < 4; ++j) v[bj][n][j] = fast_sigmoid(v[bj][n][j]);
                }
                bf16_t* rowp = dst + (size_t)row * ld + 8 * fq;
#pragma unroll
                for (int bj = 0; bj < 2; ++bj) { u32x4 w; w.x = cvt_pk_bf16(v[bj][0][0], v[bj][0][1]); w.y = cvt_pk_bf16(v[bj][0][2], v[bj][0][3]); w.z = cvt_pk_bf16(v[bj][1][0], v[bj][1][1]); w.w = cvt_pk_bf16(v[bj][1][2], v[bj][1][3]);
                    *(u32x4*)(rowp + bj * bjoff) = w; } } }
    }
};

struct EpiBranch {
    static constexpr bool PERM = true, AFTER_DRAIN = false, PREFETCH = false, CHAIN = true;
    const bf16_t* GA; const bf16_t* GB; bf16_t* MG;
    __device__ __forceinline__ void operator()(f32x4 (&acc)[2][2][4][2], const Unit& u, int wr, int wc, int fr, int fq) const {
        const bool second = u.ko != 0; constexpr float TINY = 8.67361738e-19f;
        const unsigned rowoff = (unsigned)((u.pm * BM + wr * 64 + fr) * 1024 + u.pn * BM + wc * 32 + 8 * fq);
#define EB_OFF(ai, bj, m) (rowoff + (unsigned)(((ai) * HALF + (m) * 16) * 1024 + (bj) * HALF))
#define EB_UNPACK(dst, src_) const float dst[8] = {bf_lo((src_).x), bf_hi((src_).x), bf_lo((src_).y), bf_hi((src_).y), bf_lo((src_).z), bf_hi((src_).z), bf_lo((src_).w), bf_hi((src_).w)}
        if (!second) {
#pragma unroll
            for (int ai = 0; ai < 2; ++ai)
#pragma unroll
                for (int bj = 0; bj < 2; ++bj) {
                    u32x4 gbv[4], gav[4];
#pragma unroll
                    for (int m = 0; m < 4; ++m) { gbv[m] = *(const u32x4*)(GB + EB_OFF(ai, bj, m)); gav[m] = *(const u32x4*)(GA + EB_OFF(ai, bj, m)); }
#pragma unroll
                    for (int m = 0; m < 4; ++m) { EB_UNPACK(gb, gbv[m]); EB_UNPACK(ga, gav[m]);
#pragma unroll
                        for (int e = 0; e < 4; ++e) { acc[ai][bj][m][0][e] *= ga[e] * __builtin_amdgcn_rcpf(fmaxf(gb[e], TINY)); acc[ai][bj][m][1][e] *= ga[4 + e] * __builtin_amdgcn_rcpf(fmaxf(gb[4 + e], TINY)); } }
                }
        } else {
#pragma unroll
            for (int ai = 0; ai < 2; ++ai) {
                u32x4 gbv[2][4];
#pragma unroll
                for (int bj = 0; bj < 2; ++bj)
#pragma unroll
                    for (int m = 0; m < 4; ++m) gbv[bj][m] = *(const u32x4*)(GB + EB_OFF(ai, bj, m));
#pragma unroll
                for (int bj = 0; bj < 2; ++bj)
#pragma unroll
                    for (int m = 0; m < 4; ++m) { EB_UNPACK(g0, gbv[bj][m]); float gb[8];
#pragma unroll
                        for (int e = 0; e < 8; ++e) gb[e] = fmaxf(g0[e], TINY);
                        const f32x4 y0 = acc[ai][bj][m][0], y1 = acc[ai][bj][m][1];
                        u32x4 w; w.x = cvt_pk_bf16(gb[0] * y0[0], gb[1] * y0[1]); w.y = cvt_pk_bf16(gb[2] * y0[2], gb[3] * y0[3]); w.z = cvt_pk_bf16(gb[4] * y1[0], gb[5] * y1[1]); w.w = cvt_pk_bf16(gb[6] * y1[2], gb[7] * y1[3]);
                        *(u32x4*)(MG + EB_OFF(ai, bj, m)) = w; }
            }
        }
#undef EB_OFF
#undef EB_UNPACK
    }
};

template <bool WRITE_A, int COEF2, bool RIN_BF16, bool ROUT_BF16> struct EpiResid {
    static constexpr bool PERM = true, AFTER_DRAIN = true, PREFETCH = false, CHAIN = false;
    static constexpr float coef = 0.5f * COEF2; static constexpr int modld = 9216;
    const void* xin; void* xout; const float* gate;
    bf16_t* Aout; const float* gnorm; const float* sc; float* rss_out;
    __device__ __forceinline__ void fused(f32x4 (&acc)[2][2][4][2], const Unit& u, int wr, int wc, int fr, int fq, PG8_LAS unsigned char* lds, int wid, int lane) const {
        const int b = u.pm >> 5, col0 = u.pn * BM + wc * 32 + 8 * fq;
        float ss[2][4];
#pragma unroll
        for (int ai = 0; ai < 2; ++ai)
#pragma unroll
            for (int m = 0; m < 4; ++m) ss[ai][m] = 0.f;
#pragma unroll
        for (int bj = 0; bj < 2; ++bj) {
            f32x4 gt[2], gvv[2];
#pragma unroll
            for (int n = 0; n < 2; ++n) { const int c = col0 + bj * HALF + 4 * n; gt[n] = *(const f32x4*)(gate + (size_t)b * modld + c) * coef;
                if (WRITE_A) gvv[n] = *(const f32x4*)(gnorm + c) * (*(const f32x4*)(sc + (size_t)b * modld + c) + 1.0f); }
#pragma unroll
            for (int ai = 0; ai < 2; ++ai) {
                f32x4 xi[4][2];
#pragma unroll
                for (int m = 0; m < 4; ++m) { const size_t off = (size_t)(u.pm * BM + ai * HALF + wr * 64 + m * 16 + fr) * 1024 + col0 + bj * HALF;
                    if constexpr (RIN_BF16) { const u32x4 w = *(const u32x4*)((const bf16_t*)xin + off); xi[m][0] = (f32x4){bf_lo(w.x), bf_hi(w.x), bf_lo(w.y), bf_hi(w.y)}; xi[m][1] = (f32x4){bf_lo(w.z), bf_hi(w.z), bf_lo(w.w), bf_hi(w.w)}; }
                    else {
#pragma unroll
                        for (int n = 0; n < 2; ++n) xi[m][n] = *(const f32x4*)((const float*)xin + off + 4 * n); } }
#pragma unroll
                for (int m = 0; m < 4; ++m) {
                    const int row = u.pm * BM + ai * HALF + wr * 64 + m * 16 + fr; const size_t off = (size_t)row * 1024 + col0 + bj * HALF; float s = 0.f;
                    f32x4 xo[2];
#pragma unroll
                    for (int n = 0; n < 2; ++n) { xo[n] = xi[m][n] + gt[n] * acc[ai][bj][m][n];
                        if constexpr (!ROUT_BF16) *(f32x4*)((float*)xout + off + 4 * n) = xo[n];
                        if (WRITE_A) s += (xo[n][0] * xo[n][0] + xo[n][1] * xo[n][1]) + (xo[n][2] * xo[n][2] + xo[n][3] * xo[n][3]); }
                    if constexpr (ROUT_BF16) { u32x4 w; w.x = cvt_pk_bf16(xo[0][0], xo[0][1]); w.y = cvt_pk_bf16(xo[0][2], xo[0][3]); w.z = cvt_pk_bf16(xo[1][0], xo[1][1]); w.w = cvt_pk_bf16(xo[1][2], xo[1][3]); *(u32x4*)((bf16_t*)xout + off) = w; }
                    if (WRITE_A) { const f32x4 a0 = xo[0] * gvv[0], a1 = xo[1] * gvv[1]; u32x4 w; w.x = cvt_pk_bf16(a0[0], a0[1]); w.y = cvt_pk_bf16(a0[2], a0[3]); w.z = cvt_pk_bf16(a1[0], a1[1]); w.w = cvt_pk_bf16(a1[2], a1[3]);
                        *(u32x4*)(Aout + off) = w; ss[ai][m] += s; } }
                asm volatile("" ::: "memory"); }
        }
        if (WRITE_A) {
            PG8_LAS float* P = (PG8_LAS float*)lds;
#pragma unroll
            for (int ai = 0; ai < 2; ++ai)
#pragma unroll
                for (int m = 0; m < 4; ++m) { float s = ss[ai][m]; s += __shfl_xor(s, 16); s += __shfl_xor(s, 32); if (fq == 0) P[(ai * HALF + wr * 64 + m * 16 + fr) * 4 + wc] = s; }
            asm volatile("s_waitcnt lgkmcnt(0)" ::: "memory"); __builtin_amdgcn_s_barrier(); asm volatile("" ::: "memory");
            const int t = wid * 64 + lane;
            if (t < 256) { const PG8_LAS float* p = P + t * 4; rss_out[(size_t)(u.pm * BM + t) * 4 + u.pn] = (p[0] + p[1]) + (p[2] + p[3]); }
        }
    }
};

template <class Epi, class Sched, bool ALIGN_EPI = false, bool SP2 = false>
__device__ __forceinline__ void gemm_phase(PG8_LAS unsigned char* lds, const Gemm g, const Sched S, const Epi E, const int wid  ) {
    const int lane = MK_LANE(), tid = wid * 64 + lane, wr = wid >> 2, wc = wid & 3, fr = lane & 15, fq = lane >> 4;
    const int K = g.K, nt = (g.KL ? g.KL : K) / BK;
    unsigned voffA[2], voffB[2];
#pragma unroll
    for (int i = 0; i < 2; ++i) { int R, C; stage_rc(tid * 16 + i * 8192, R, C); const int Rb = Epi::PERM ? ((R & ~31) + perm32(R & 31)) : R;
        voffA[i] = (unsigned)(R * K + C) * 2u; voffB[i] = (unsigned)(Rb * K + C) * 2u; }
    const size_t kstep = (size_t)(BK * 2);
    const size_t hstep = (size_t)HALF * K * 2;
    const size_t tstep = 2 * hstep;
    const unsigned ldsw = (unsigned)wid * 1024u;
    const int aoff = lds_byte(wr * 64 + fr, fq * 8), boff = lds_byte(wc * 32 + fr, fq * 8);
#define PG8_SA(b, h) (((b) * 2 + (h)) * HTB)
#define PG8_SB(b, h) ((4 + (b) * 2 + (h)) * HTB)
#define PG8_STAGE(bufoff, gbase, voff) do { _Pragma("unroll") for (int _i = 0; _i < 2; ++_i) \
        __builtin_amdgcn_global_load_lds((const unsigned*)((const char*)(gbase) + (voff)[_i]), (PG8_LAS unsigned*)(lds + (bufoff) + ldsw + _i * 8192), 16, 0, 0); } while (0)
#define PG8_LDA(dst, b, h) do { _Pragma("unroll") for (int m = 0; m < 4; ++m) _Pragma("unroll") for (int k = 0; k < 2; ++k) dst[m][k] = *(const PG8_LAS bf16x8*)(lds + PG8_SA(b, h) + aoff + m * 2048 + k * 1024); } while (0)
#define PG8_LDB(dst, b, h) do { _Pragma("unroll") for (int n = 0; n < 2; ++n) _Pragma("unroll") for (int k = 0; k < 2; ++k) dst[n][k] = *(const PG8_LAS bf16x8*)(lds + PG8_SB(b, h) + boff + n * 2048 + k * 1024); } while (0)
#define PG8_MMA(ai, bj, At, Bt) do { __builtin_amdgcn_s_setprio(1); _Pragma("unroll") for (int m = 0; m < 4; ++m) _Pragma("unroll") for (int n = 0; n < 2; ++n) _Pragma("unroll") for (int k = 0; k < 2; ++k) \
        acc[ai][bj][m][n] = __builtin_amdgcn_mfma_f32_16x16x32_bf16(Bt[n][k], At[m][k], acc[ai][bj][m][n], 0, 0, 0); __builtin_amdgcn_s_setprio(0); } while (0)
#define PG8_WAIT_V(n) asm volatile("s_waitcnt vmcnt(" #n ")" ::: "memory")
#define PG8_WAIT_L(n) asm volatile("s_waitcnt lgkmcnt(" #n ")" ::: "memory")
#define PG8_BAR __builtin_amdgcn_s_barrier()
#define PG8_SCHED __builtin_amdgcn_sched_barrier(0)
    Unit cur, nxt; int ui = 0;
    if (!S.next(0, cur)) return;
    f32x4 acc[2][2][4][2];
#pragma unroll
    for (int a = 0; a < 2; ++a)
#pragma unroll
        for (int b = 0; b < 2; ++b)
#pragma unroll
            for (int m = 0; m < 4; ++m)
#pragma unroll
                for (int n = 0; n < 2; ++n) acc[a][b][m][n] = (f32x4){0.f, 0.f, 0.f, 0.f};
    bf16x8 At[4][2], B0[2][2], B1[2][2];
    const char* cA = (const char*)g.A + (size_t)cur.pm * tstep + cur.ko; const char* cB = (const char*)g.Bt + (size_t)cur.pn * tstep + cur.ko;
    S.a_ready(cur);
    if constexpr (SP2) {
        PG8_STAGE(PG8_SB(0, 0), cB, voffB); PG8_STAGE(PG8_SB(0, 1), cB + hstep, voffB); PG8_STAGE(PG8_SA(0, 0), cA, voffA); PG8_STAGE(PG8_SA(0, 1), cA + hstep, voffA);
        if (wr == 1) PG8_BAR;
        PG8_WAIT_V(2); PG8_BAR;
        PG8_STAGE(PG8_SB(1, 0), cB + kstep, voffB); PG8_STAGE(PG8_SA(1, 0), cA + kstep, voffA); PG8_STAGE(PG8_SB(1, 1), cB + hstep + kstep, voffB);
        PG8_WAIT_V(6); PG8_BAR;
    } else {
        PG8_STAGE(PG8_SB(0, 0), cB, voffB); PG8_STAGE(PG8_SA(0, 0), cA, voffA); PG8_STAGE(PG8_SB(0, 1), cB + hstep, voffB); PG8_STAGE(PG8_SA(0, 1), cA + hstep, voffA);
        if (wr == 1) PG8_BAR;
        PG8_WAIT_V(4); PG8_BAR;
        PG8_STAGE(PG8_SB(1, 0), cB + kstep, voffB); PG8_STAGE(PG8_SA(1, 0), cA + kstep, voffA); PG8_STAGE(PG8_SB(1, 1), cB + hstep + kstep, voffB);
        PG8_WAIT_V(6); PG8_BAR;
    }
    for (;;) {
        if constexpr (Epi::PREFETCH) E.prefetch(cur, lds + STAGE_BYTES + (ui & 1) * 5120, wid, lane);
        const bool has_next = S.next(ui + 1, nxt);
        const char* nA = has_next ? (const char*)g.A + (size_t)nxt.pm * tstep + nxt.ko : cA; const char* nB = has_next ? (const char*)g.Bt + (size_t)nxt.pn * tstep + nxt.ko : cB;
        for (int t = 0; t < nt; t += 2) {
            const bool last = (t == nt - 2);
            const char* a1 = cA + (size_t)(t + 1) * kstep;
            const char* a2 = last ? nA : cA + (size_t)(t + 2) * kstep; const char* b2 = last ? nB : cB + (size_t)(t + 2) * kstep;
            const char* a3 = a2 + kstep; const char* b3 = b2 + kstep;
            if (last && has_next) S.a_ready(nxt);
            if constexpr (SP2) {
            PG8_LDB(B0, 0, 0); PG8_LDB(B1, 0, 1); PG8_SCHED; PG8_LDA(At, 0, 0); PG8_STAGE(PG8_SA(1, 1), a1 + hstep, voffA);
            PG8_WAIT_V(8); PG8_WAIT_L(0); PG8_BAR; PG8_MMA(0, 0, At, B0); PG8_MMA(0, 1, At, B1); PG8_BAR; PG8_SCHED;
            PG8_LDA(At, 0, 1); PG8_STAGE(PG8_SB(0, 0), b2, voffB); PG8_STAGE(PG8_SB(0, 1), b2 + hstep, voffB); PG8_STAGE(PG8_SA(0, 0), a2, voffA);
            PG8_WAIT_V(8); PG8_WAIT_L(0); PG8_BAR; PG8_MMA(1, 0, At, B0); PG8_MMA(1, 1, At, B1); PG8_BAR; PG8_SCHED;
            PG8_LDB(B0, 1, 0); PG8_LDB(B1, 1, 1); PG8_SCHED; PG8_LDA(At, 1, 0); PG8_STAGE(PG8_SA(0, 1), a2 + hstep, voffA);
            PG8_WAIT_V(8); PG8_WAIT_L(0); PG8_BAR; PG8_MMA(0, 0, At, B0); PG8_MMA(0, 1, At, B1); PG8_BAR; PG8_SCHED;
            PG8_LDA(At, 1, 1); PG8_STAGE(PG8_SB(1, 0), b3, voffB); PG8_STAGE(PG8_SB(1, 1), b3 + hstep, voffB); PG8_STAGE(PG8_SA(1, 0), a3, voffA);
            PG8_WAIT_V(8); PG8_WAIT_L(0); PG8_BAR; PG8_MMA(1, 0, At, B0); PG8_MMA(1, 1, At, B1); PG8_BAR; PG8_SCHED;
            } else {
            PG8_LDB(B0, 0, 0); PG8_SCHED; PG8_LDA(At, 0, 0); PG8_STAGE(PG8_SA(1, 1), a1 + hstep, voffA);
            PG8_WAIT_L(8); PG8_BAR; PG8_WAIT_L(0); PG8_MMA(0, 0, At, B0); PG8_BAR; PG8_SCHED;
            PG8_LDB(B1, 0, 1); PG8_STAGE(PG8_SB(0, 0), b2, voffB);
            PG8_BAR; PG8_WAIT_L(0); PG8_MMA(0, 1, At, B1); PG8_BAR;
            PG8_LDA(At, 0, 1); PG8_STAGE(PG8_SA(0, 0), a2, voffA);
            PG8_BAR; PG8_WAIT_L(0); PG8_MMA(1, 0, At, B0); PG8_BAR; PG8_SCHED;
            PG8_STAGE(PG8_SB(0, 1), b2 + hstep, voffB);
            PG8_WAIT_V(6); PG8_BAR; PG8_MMA(1, 1, At, B1); PG8_BAR;
            PG8_LDB(B0, 1, 0); PG8_SCHED; PG8_LDA(At, 1, 0); PG8_STAGE(PG8_SA(0, 1), a2 + hstep, voffA);
            PG8_WAIT_L(8); PG8_BAR; PG8_WAIT_L(0); PG8_MMA(0, 0, At, B0); PG8_BAR; PG8_SCHED;
            PG8_LDB(B1, 1, 1); PG8_STAGE(PG8_SB(1, 0), b3, voffB);
            PG8_BAR; PG8_WAIT_L(0); PG8_MMA(0, 1, At, B1); PG8_BAR;
            PG8_LDA(At, 1, 1); PG8_STAGE(PG8_SA(1, 0), a3, voffA);
            PG8_BAR; PG8_WAIT_L(0); PG8_MMA(1, 0, At, B0); PG8_BAR; PG8_SCHED;
            PG8_STAGE(PG8_SB(1, 1), b3 + hstep, voffB);
            PG8_WAIT_V(6); PG8_BAR; PG8_MMA(1, 1, At, B1); PG8_BAR;
            }
        }
        if constexpr (ALIGN_EPI) { if (wr == 0) PG8_BAR; }
        if constexpr (!Epi::AFTER_DRAIN) { if constexpr (Epi::PREFETCH) E(acc, cur, wr, wc, fr, fq, lds + STAGE_BYTES + (ui & 1) * 5120); else E(acc, cur, wr, wc, fr, fq); S.done(cur); }
        if (!has_next) break;
        if (!Epi::CHAIN || nxt.ko == 0) {
#pragma unroll
        for (int a = 0; a < 2; ++a)
#pragma unroll
            for (int b = 0; b < 2; ++b)
#pragma unroll
                for (int m = 0; m < 4; ++m)
#pragma unroll
                    for (int n = 0; n < 2; ++n) acc[a][b][m][n] = (f32x4){0.f, 0.f, 0.f, 0.f};
        }
        cur = nxt; cA = nA; cB = nB; ++ui;
        if constexpr (ALIGN_EPI) { if (wr == 1) PG8_BAR; }
    }
    PG8_WAIT_V(0);
    if constexpr (!ALIGN_EPI) { if (wr == 0) PG8_BAR; }
    PG8_BAR;
    if constexpr (Epi::AFTER_DRAIN) { E.fused(acc, cur, wr, wc, fr, fq, lds, wid, lane); S.done(cur); }
#undef PG8_SA
#undef PG8_SB
#undef PG8_STAGE
#undef PG8_LDA
#undef PG8_LDB
#undef PG8_MMA
#undef PG8_WAIT_V
#undef PG8_WAIT_L
#undef PG8_BAR
#undef PG8_SCHED
}
}

#ifndef PG8_SP2
#define PG8_SP2 true
#endif
#ifndef PG8_ALIGN
#define PG8_ALIGN true
#endif
namespace att {
using bf16x8 = __attribute__((ext_vector_type(8))) short;
using s16x4  = __attribute__((ext_vector_type(4))) short;
using f32x16 = __attribute__((ext_vector_type(16))) float;
using u32x4  = __attribute__((ext_vector_type(4))) unsigned;
typedef unsigned short bf16_t;
constexpr int NW = 8, QBLK = 32, KVBLK = 64;
#ifndef ATT_SDEPTH
#define ATT_SDEPTH 1
#endif
#define ATT_SBAR() __builtin_amdgcn_sched_barrier(0)
#define KSWZ64(row, colB) ((row) * 128 + ((colB) ^ ((((row) >> 1) & 7) << 4)))
__device__ __forceinline__ int crow(int r, int hi) { return (r & 3) + 8 * (r >> 2) + 4 * hi; }
__device__ __forceinline__ unsigned cvtpk(float lo, float hi) { unsigned r; asm volatile("v_cvt_pk_bf16_f32 %0, %1, %2" : "=v"(r) : "v"(lo), "v"(hi)); return r; }
__device__ __forceinline__ float bf2f(bf16_t h) { return __uint_as_float((unsigned)h << 16); }
template <int NCB> __device__ __forceinline__ int v_st(int k, int c) { const int kk = k; return ((kk >> 3) * NCB + (c >> 5)) * 512 + ((kk & 7) * 32 + (c & 31)) * 2; }
__device__ __forceinline__ int v_rd_base(int lane) { return ((lane & 3) << 3) | (((lane >> 2) & 3) << 6) | (((lane >> 4) & 1) << 5) | (((lane >> 5) & 1) << 8); }
template <int OFF> __device__ __forceinline__ s16x4 tr_read(int vb) { s16x4 r; asm volatile("ds_read_b64_tr_b16 %0, %1 offset:%2" : "=&v"(r) : "v"(vb), "i"(OFF) : "memory"); return r; }
template <int NCB, int D0> __device__ __forceinline__ void pv_one(f32x16& od, int vb, bf16x8 pa0, bf16x8 pa1, bf16x8 pa2, bf16x8 pa3) {
#define VOFF(ks, half) (D0 * 512 + (2 * (ks) + (half)) * (NCB * 512))
  const s16x4 l0 = tr_read<VOFF(0, 0)>(vb), h0 = tr_read<VOFF(0, 1)>(vb), l1 = tr_read<VOFF(1, 0)>(vb), h1 = tr_read<VOFF(1, 1)>(vb);
  const s16x4 l2 = tr_read<VOFF(2, 0)>(vb), h2 = tr_read<VOFF(2, 1)>(vb), l3 = tr_read<VOFF(3, 0)>(vb), h3 = tr_read<VOFF(3, 1)>(vb);
#undef VOFF
  asm volatile("s_waitcnt lgkmcnt(0)" ::: "memory"); ATT_SBAR();
#define PK(L, H) (bf16x8){L[0], L[1], L[2], L[3], H[0], H[1], H[2], H[3]}
  od = __builtin_amdgcn_mfma_f32_32x32x16_bf16(pa0, PK(l0, h0), od, 0, 0, 0);
  od = __builtin_amdgcn_mfma_f32_32x32x16_bf16(pa1, PK(l1, h1), od, 0, 0, 0);
  od = __builtin_amdgcn_mfma_f32_32x32x16_bf16(pa2, PK(l2, h2), od, 0, 0, 0);
  od = __builtin_amdgcn_mfma_f32_32x32x16_bf16(pa3, PK(l3, h3), od, 0, 0, 0);
#undef PK
}
__device__ __forceinline__ void qkt(f32x16& p0, f32x16& p1, const char* Ks, const bf16x8* qr, const f32x16& negm, int r32, int hi) {
#pragma unroll
  for (int d0 = 0; d0 < 4; ++d0) { const int cb = d0 * 32 + hi * 16;
    const bf16x8 b0 = *reinterpret_cast<const bf16x8*>(Ks + KSWZ64(r32, cb));
    const bf16x8 b1 = *reinterpret_cast<const bf16x8*>(Ks + KSWZ64(32 + r32, cb));
    if (d0 == 0) { p0 = __builtin_amdgcn_mfma_f32_32x32x16_bf16(b0, qr[0], negm, 0, 0, 0); p1 = __builtin_amdgcn_mfma_f32_32x32x16_bf16(b1, qr[0], negm, 0, 0, 0); }
    else { p0 = __builtin_amdgcn_mfma_f32_32x32x16_bf16(b0, qr[d0], p0, 0, 0, 0); p1 = __builtin_amdgcn_mfma_f32_32x32x16_bf16(b1, qr[d0], p1, 0, 0, 0); } }
}
template <bool WIN> __device__ __forceinline__ void wmask(f32x16& p0, f32x16& p1, int qpos, int kbase, int hi) {
  if constexpr (WIN) {
#pragma unroll
    for (int r = 0; r < 16; ++r) { const int k0 = kbase + crow(r, hi) - qpos; if (k0 > 128 || k0 < -128) p0[r] = -INFINITY; if (k0 + 32 > 128 || k0 + 32 < -128) p1[r] = -INFINITY; }
  }
}
__device__ __forceinline__ void exp_half(f32x16& p) {
#pragma unroll
  for (int r = 0; r < 16; ++r) p[r] = __builtin_amdgcn_exp2f(p[r]);
}
__device__ __forceinline__ void finish_sm(f32x16& p0, f32x16& p1, float& l_reg, bf16x8& pa0, bf16x8& pa1, bf16x8& pa2, bf16x8& pa3) {
  exp_half(p1);
  float ps = 0.f;
#pragma unroll
  for (int r = 0; r < 16; ++r) ps += p0[r];
#pragma unroll
  for (int r = 0; r < 16; ++r) ps += p1[r];
  l_reg += ps;
#define PK4(P, BASE, OUT) do { u32x4 w = {cvtpk(P[BASE + 0], P[BASE + 1]), cvtpk(P[BASE + 2], P[BASE + 3]), cvtpk(P[BASE + 4], P[BASE + 5]), cvtpk(P[BASE + 6], P[BASE + 7])}; OUT = *reinterpret_cast<bf16x8*>(&w); } while (0)
  PK4(p0, 0, pa0); PK4(p0, 8, pa1); PK4(p1, 0, pa2); PK4(p1, 8, pa3);
#undef PK4
}
constexpr int NSLOT = 3, LDS_V = 0, LDS_K = NSLOT * KVBLK * 128 * 2, LDS_WS = LDS_K + 4 * KVBLK * 64 * 2, LDS_STG = LDS_WS + NW * 64 * 4, ATT_LDS_BYTES = LDS_STG + NW * 8192;
__device__ __forceinline__ void dma16(unsigned m0v, unsigned voff, __amdgpu_buffer_rsrc_t rs, unsigned soff) {
  unsigned keep;
  asm volatile("s_nop 4\n\ts_mov_b32 %0, m0\n\ts_mov_b32 m0, %1\n\ts_nop 0\n\tbuffer_load_dwordx4 %2, %3, %4 offen lds\n\ts_mov_b32 m0, %0" : "=&s"(keep) : "s"(m0v), "v"(voff), "s"(rs), "s"(soff) : "memory");
}
__device__ __forceinline__ void dma16x2(unsigned m0a, unsigned va, unsigned sa, unsigned m0b, unsigned vb, unsigned sb, __amdgpu_buffer_rsrc_t rs) {
  unsigned keep;
  asm volatile("s_nop 4\n\ts_mov_b32 %0, m0\n\ts_mov_b32 m0, %1\n\ts_nop 0\n\tbuffer_load_dwordx4 %2, %7, %3 offen lds\n\ts_mov_b32 m0, %4\n\ts_nop 0\n\tbuffer_load_dwordx4 %5, %7, %6 offen lds\n\ts_mov_b32 m0, %0"
               : "=&s"(keep) : "s"(m0a), "v"(va), "s"(sa), "s"(m0b), "v"(vb), "s"(sb), "s"(rs) : "memory");
}
__device__ __forceinline__ void dma16x3(unsigned m0a, unsigned va, unsigned sa, unsigned m0b, unsigned vb, unsigned m0c, unsigned vc, unsigned sbc, __amdgpu_buffer_rsrc_t rs) {
  unsigned keep;
  asm volatile("s_nop 4\n\ts_mov_b32 %0, m0\n\ts_mov_b32 m0, %1\n\ts_nop 0\n\tbuffer_load_dwordx4 %2, %9, %3 offen lds\n\ts_mov_b32 m0, %4\n\ts_nop 0\n\tbuffer_load_dwordx4 %5, %9, %8 offen lds\n\ts_mov_b32 m0, %6\n\ts_nop 0\n\tbuffer_load_dwordx4 %7, %9, %8 offen lds\n\ts_mov_b32 m0, %0"
               : "=&s"(keep) : "s"(m0a), "v"(va), "s"(sa), "s"(m0b), "v"(vb), "s"(m0c), "v"(vc), "s"(sbc), "s"(rs) : "memory");
}
template <int NCB, bool WIN>
__device__ __forceinline__ void attn_pass(__amdgpu_buffer_rsrc_t rs, unsigned Qb, unsigned ldq, unsigned Kh, unsigned ldk, unsigned Vh, unsigned ldv, int seq, int qpos0, int kpos0, float negm_s, char* lds, f32x16 (&o)[NCB], float& l_out, const int wid) {
  constexpr int DV = NCB * 32, SLOTV = KVBLK * DV * 2, SLOTK = KVBLK * 64 * 2, NVP = NCB / 2;
  const int lane = MK_LANE(), r32 = lane & 31, hi = lane >> 5;
  const unsigned lds0 = (unsigned)(uintptr_t)lds;
  char* V_lds = lds + LDS_V; char* K_lds = lds + LDS_K;
  bf16x8 qr[4];
  { const unsigned qoff = (unsigned)(wid * QBLK + r32) * ldq + hi * 16;
#pragma unroll
    for (int d0 = 0; d0 < 4; ++d0) { const u32x4 w = __builtin_amdgcn_raw_buffer_load_b128(rs, qoff + d0 * 32, Qb, 0); qr[d0] = __builtin_bit_cast(bf16x8, w); } }
  f32x16 negm; { float ns = negm_s; asm volatile("" : "+v"(ns));
#pragma unroll
  for (int r = 0; r < 16; ++r) negm[r] = ns; }
  asm volatile("" : "+v"(negm));
#pragma unroll
  for (int d = 0; d < NCB; ++d) o[d] = f32x16{};
  float l_reg = 0.f;
  unsigned kvoff, vvoff[NVP];
  { const int ob = wid * 1024 + lane * 16, row = ob >> 7, ch = ((ob >> 4) & 7) ^ ((row >> 1) & 7); kvoff = (unsigned)row * ldk + ch * 16; }
#pragma unroll
  for (int i = 0; i < NVP; ++i) { const int ob = (wid * NVP + i) * 1024 + lane * 16, st = ob >> 9, k = (st / NCB) * 8 + ((ob >> 6) & 7), c = (st % NCB) * 32 + ((ob >> 4) & 3) * 8;
    vvoff[i] = (unsigned)k * ldv + c * 2; }
  const unsigned kdst = lds0 + LDS_K + wid * 1024, vdst = lds0 + LDS_V + wid * NVP * 1024;
#define DMA_K(t, slot) dma16(kdst + (slot) * SLOTK, kvoff, rs, Kh + (unsigned)(t) * (KVBLK * ldk))
#define DMA_V(t, slot) do { _Pragma("unroll") for (int i_ = 0; i_ < NVP; ++i_) dma16(vdst + (slot) * SLOTV + i_ * 1024, vvoff[i_], rs, Vh + (unsigned)(t) * (KVBLK * ldv)); } while (0)
#define WAIT_BAR(N) asm volatile("s_waitcnt vmcnt(" #N ") lgkmcnt(0)\n\ts_barrier" ::: "memory")
#define WAIT_BAR_STEP() do { if (NVP == 2) WAIT_BAR(3); else WAIT_BAR(2); } while (0)
  const int vb0 = (int)(lds0 + LDS_V) + v_rd_base(lane);
  const int qpos = qpos0 + wid * QBLK + r32;
#define PVALL(vb) do { pv_one<NCB, 0>(o[0], vb, pa0, pa1, pa2, pa3); pv_one<NCB, 1>(o[1], vb, pa0, pa1, pa2, pa3); if constexpr (NCB == 4) { pv_one<NCB, 2>(o[2], vb, pa0, pa1, pa2, pa3); pv_one<NCB, 3>(o[3], vb, pa0, pa1, pa2, pa3); } } while (0)
  f32x16 pA0, pA1, pB0, pB1; bf16x8 pa0, pa1, pa2, pa3; const int NT = seq / KVBLK;
  DMA_K(0, 0); DMA_V(0, 0); DMA_K(1, 1);
  if (NVP == 2) WAIT_BAR(3); else WAIT_BAR(2);
  qkt(pA0, pA1, K_lds, qr, negm, r32, hi); wmask<WIN>(pA0, pA1, qpos, kpos0, hi); exp_half(pA0);
  DMA_K(2, 2); DMA_V(1, 1);
  WAIT_BAR_STEP();
  int s0 = 0, s1 = 1, s2 = 2;
#define ROT() do { const int t_ = s0; s0 = s1; s1 = s2; s2 = t_; } while (0)
#define DMA_KV(t) do { if constexpr (NVP == 2) dma16x3(kdst + s0 * SLOTK, kvoff, Kh + (unsigned)((t) + 3) * (KVBLK * ldk), vdst + s2 * SLOTV, vvoff[0], vdst + s2 * SLOTV + 1024, vvoff[NVP - 1], Vh + (unsigned)((t) + 2) * (KVBLK * ldv), rs); \
    else dma16x2(kdst + s0 * SLOTK, kvoff, Kh + (unsigned)((t) + 3) * (KVBLK * ldk), vdst + s2 * SLOTV, vvoff[0], Vh + (unsigned)((t) + 2) * (KVBLK * ldv), rs); } while (0)
  const int wq_lo = qpos0 + wid * QBLK, wq_hi = wq_lo + QBLK - 1;
#define T_NEED(j) (!WIN || ((kpos0 + (j) * KVBLK + KVBLK - 1 >= wq_lo - 128) && (kpos0 + (j) * KVBLK <= wq_hi + 128)))
#define T_FULL(j) ((kpos0 + (j) * KVBLK >= wq_hi - 128) && (kpos0 + (j) * KVBLK + KVBLK - 1 <= wq_lo + 128))
#define STEP(Pc0, Pc1, Pn0, Pn1, t, DOK, DOV, DOQK) do { \
    if (DOK && DOV) DMA_KV(t); else { if (DOK) DMA_K((t) + 3, s0); if (DOV) DMA_V((t) + 2, s2); } \
    const bool nc_ = T_NEED(t), nn_ = DOQK && T_NEED((t) + 1); \
    ATT_SBAR(); if (nn_) { qkt(Pn0, Pn1, K_lds + s1 * SLOTK, qr, negm, r32, hi); if (WIN && !T_FULL((t) + 1)) wmask<WIN>(Pn0, Pn1, qpos, kpos0 + ((t) + 1) * KVBLK, hi); } \
    if (nc_) { finish_sm(Pc0, Pc1, l_reg, pa0, pa1, pa2, pa3); } ATT_SBAR(); \
    if (nc_) { PVALL(vb0 + s0 * SLOTV); } if (nn_) exp_half(Pn0); } while (0)
  int t = 0;
  for (; t + 4 < NT; t += 2) {
    STEP(pA0, pA1, pB0, pB1, t, true, true, true); WAIT_BAR_STEP(); ROT();
    STEP(pB0, pB1, pA0, pA1, t + 1, true, true, true); WAIT_BAR_STEP(); ROT();
  }
  STEP(pA0, pA1, pB0, pB1, t, true, true, true); WAIT_BAR_STEP(); ROT();
  STEP(pB0, pB1, pA0, pA1, t + 1, false, true, true); WAIT_BAR(0); ROT();
  STEP(pA0, pA1, pB0, pB1, t + 2, false, false, true); WAIT_BAR(0); ROT();
  STEP(pB0, pB1, pA0, pA1, t + 3, false, false, false);
  { auto rr = __builtin_amdgcn_permlane32_swap(__float_as_uint(l_reg), __float_as_uint(l_reg), false, false); l_out = __uint_as_float(rr[0]) + __uint_as_float(rr[1]); }
  WAIT_BAR(0);
#undef DMA_K
#undef DMA_V
#undef WAIT_BAR
#undef WAIT_BAR_STEP
#undef PVALL
#undef ROT
#undef STEP
#undef DMA_KV
#undef T_NEED
#undef T_FULL
}
typedef __attribute__((address_space(3))) const char* lds_cptr;
typedef short v4i16_t __attribute__((ext_vector_type(4)));
__device__ __forceinline__ s16x4 vtr(lds_cptr p) { return __builtin_bit_cast(s16x4, __builtin_amdgcn_ds_read_tr16_b64_v4i16((__attribute__((address_space(3))) v4i16_t*)p)); }
__device__ __forceinline__ bf16x8 kld(lds_cptr p) { return *(const __attribute__((address_space(3))) bf16x8*)p; }
__device__ __forceinline__ void attn_pass_d4(__amdgpu_buffer_rsrc_t rs, unsigned Qb, unsigned ldq, unsigned Kh, unsigned ldk, unsigned Vh, unsigned ldv, int seq, float negm_s, char* lds, f32x16 (&o)[4], float& l_out, const int wid) {
  constexpr int SLOTV = KVBLK * 128 * 2, SLOTK = KVBLK * 64 * 2;
  const int lane = MK_LANE(), r32 = lane & 31, hi = lane >> 5;
  const unsigned lds0 = (unsigned)(uintptr_t)lds;
  bf16x8 qr[4];
  { const unsigned qoff = (unsigned)(wid * QBLK + r32) * ldq + hi * 16;
#pragma unroll
    for (int d0 = 0; d0 < 4; ++d0) { const u32x4 w = __builtin_amdgcn_raw_buffer_load_b128(rs, qoff + d0 * 32, Qb, 0); qr[d0] = __builtin_bit_cast(bf16x8, w); } }
  f32x16 negm; { float ns = negm_s; asm volatile("" : "+v"(ns));
#pragma unroll
  for (int r = 0; r < 16; ++r) negm[r] = ns; }
  asm volatile("" : "+v"(negm));
#pragma unroll
  for (int d = 0; d < 4; ++d) o[d] = f32x16{};
  float l_reg = 0.f;
  const unsigned kvoff = (unsigned)lane * ldk + wid * 16;
  unsigned vvoff0, vvoff1;
  { const int ob = (wid * 2 + 0) * 1024 + lane * 16, st = ob >> 9, k = (st / 4) * 8 + ((ob >> 6) & 7), c = (st % 4) * 32 + ((ob >> 4) & 3) * 8; vvoff0 = (unsigned)k * ldv + c * 2; }
  { const int ob = (wid * 2 + 1) * 1024 + lane * 16, st = ob >> 9, k = (st / 4) * 8 + ((ob >> 6) & 7), c = (st % 4) * 32 + ((ob >> 4) & 3) * 8; vvoff1 = (unsigned)k * ldv + c * 2; }
  const unsigned kdst = lds0 + LDS_K + wid * 1024, vdst = lds0 + LDS_V + wid * 2048;
  const lds_cptr kp0 = (lds_cptr)lds + LDS_K + hi * 1024 + r32 * 16;
  const lds_cptr vp0 = (lds_cptr)lds + LDS_V + v_rd_base(lane);
  const int NT = seq / KVBLK;
#define D4_PIN(x) asm volatile("" : "+v"(x))
#define D4_MFMA(a, b, c) __builtin_amdgcn_mfma_f32_32x32x16_bf16(a, b, c, 0, 0, 0)
#define D4_WAIT_BAR(N) asm volatile("s_waitcnt vmcnt(" #N ") lgkmcnt(0)\n\ts_barrier" ::: "memory")
#define D4_KSLOT(t) ((unsigned)((t) & 3) * SLOTK)
#define D4_DMA_K(t) dma16(kdst + D4_KSLOT(t), kvoff, rs, Kh + (unsigned)(t) * (KVBLK * ldk))
#define D4_DMA_V(t, sl) dma16x2(vdst + (sl), vvoff0, Vh + (unsigned)(t) * (KVBLK * ldv), vdst + (sl) + 1024, vvoff1, Vh + (unsigned)(t) * (KVBLK * ldv), rs)
#define D4_DMA_KV(tk, tv, sl) dma16x3(kdst + D4_KSLOT(tk), kvoff, Kh + (unsigned)(tk) * (KVBLK * ldk), vdst + (sl), vvoff0, vdst + (sl) + 1024, vvoff1, Vh + (unsigned)(tv) * (KVBLK * ldv), rs)
  f32x16 pA0, pA1, pB0, pB1; bf16x8 kf[4]; s16x4 vl[5], vh[5]; u32x4 pw0, pw1, pw2, pw3;
#define D4_KRD(buf, kp, j) kf[buf] = kld((kp) + ((j) >> 1) * 2048 + ((j) & 1) * 512)
#define D4_VO(f, half) (((f) >> 2) * 512 + (2 * ((f) & 3) + (half)) * 2048)
#define D4_VRD(f) do { vl[(f) % 5] = vtr(vp_ + D4_VO(f, 0)); vh[(f) % 5] = vtr(vp_ + D4_VO(f, 1)); } while (0)
#define D4_VFR(f) (bf16x8){vl[(f) % 5][0], vl[(f) % 5][1], vl[(f) % 5][2], vl[(f) % 5][3], vh[(f) % 5][0], vh[(f) % 5][1], vh[(f) % 5][2], vh[(f) % 5][3]}
#define D4_PKW(P, i) cvtpk(P[i], P[i + 1])
#define D4_PAF(k) __builtin_bit_cast(bf16x8, pw##k)
  D4_DMA_K(0); D4_DMA_V(0, 0); D4_DMA_K(1); D4_DMA_K(2); D4_DMA_KV(3, 1, SLOTV);
  D4_WAIT_BAR(3);
  { const lds_cptr kp_ = kp0;
    D4_KRD(0, kp_, 0); D4_KRD(1, kp_, 1); D4_KRD(2, kp_, 2); D4_KRD(3, kp_, 3);
    pA0 = D4_MFMA(kf[0], qr[0], negm); pA1 = D4_MFMA(kf[1], qr[0], negm); pA0 = D4_MFMA(kf[2], qr[1], pA0); pA1 = D4_MFMA(kf[3], qr[1], pA1);
    D4_KRD(0, kp_, 4); D4_KRD(1, kp_, 5); D4_KRD(2, kp_, 6); D4_KRD(3, kp_, 7);
    pA0 = D4_MFMA(kf[0], qr[2], pA0); pA1 = D4_MFMA(kf[1], qr[2], pA1); pA0 = D4_MFMA(kf[2], qr[3], pA0); pA1 = D4_MFMA(kf[3], qr[3], pA1);
    exp_half(pA0); exp_half(pA1);
    const lds_cptr kn_ = kp0 + SLOTK;
    D4_KRD(0, kn_, 0); D4_KRD(1, kn_, 1); D4_KRD(2, kn_, 2); D4_KRD(3, kn_, 3); }
  D4_WAIT_BAR(3);
  unsigned sl_prev = 0, sl_cur = SLOTV, sl_next = 2 * SLOTV;
#define D4_ROT() do { sl_prev = sl_cur; sl_cur = sl_next; sl_next = (sl_next == 2u * SLOTV) ? 0u : sl_next + SLOTV; } while (0)
#define D4_EX2(X, i) do { X[i] = __builtin_amdgcn_exp2f(X[i]); X[(i) + 1] = __builtin_amdgcn_exp2f(X[(i) + 1]); } while (0)
#define D4_GAPA(MF, LD, a0, a1, a2, a3, W0, W1, PW) do { MF; LD; sacc += a0; sacc += a1; sacc += a2; sacc += a3; W0; W1; D4_PIN(PW); D4_PIN(sacc); ATT_SBAR(); } while (0)
#define D4_GAPB(i, X, xi, LD) do { o[(i) >> 2] = D4_MFMA(D4_PAFI(i), D4_VFR(i), o[(i) >> 2]); LD; D4_EX2(X, xi); D4_PIN(X); ATT_SBAR(); } while (0)
#define D4_PAFI(i) (((i) & 3) == 0 ? D4_PAF(0) : ((i) & 3) == 1 ? D4_PAF(1) : ((i) & 3) == 2 ? D4_PAF(2) : D4_PAF(3))
#define D4_STEP(C0, C1, P0, P1, t, GK, GV, GL) do { ATT_SBAR(); \
    const lds_cptr vp_ = vp0 + sl_prev; const lds_cptr kp_ = kp0 + D4_KSLOT(t); const lds_cptr kn_ = kp0 + D4_KSLOT((t) + 1); \
    float sacc = P0[0] + P0[1]; ATT_SBAR(); \
    D4_GAPA(C0 = D4_MFMA(kf[0], qr[0], negm), D4_KRD(0, kp_, 4), P0[2], P0[3], P0[4], P0[5],     pw0[0] = D4_PKW(P0, 0),  pw0[1] = D4_PKW(P0, 2),  pw0); \
    D4_GAPA(C1 = D4_MFMA(kf[1], qr[0], negm), D4_KRD(1, kp_, 5), P0[6], P0[7], P0[8], P0[9],     pw0[2] = D4_PKW(P0, 4),  pw0[3] = D4_PKW(P0, 6),  pw0); \
    D4_GAPA(C0 = D4_MFMA(kf[2], qr[1], C0),   D4_KRD(2, kp_, 6), P0[10], P0[11], P0[12], P0[13], pw1[0] = D4_PKW(P0, 8),  pw1[1] = D4_PKW(P0, 10), pw1); \
    D4_GAPA(C1 = D4_MFMA(kf[3], qr[1], C1),   D4_KRD(3, kp_, 7), P0[14], P0[15], P1[0], P1[1],   pw1[2] = D4_PKW(P0, 12), pw1[3] = D4_PKW(P0, 14), pw1); \
    D4_GAPA(C0 = D4_MFMA(kf[0], qr[2], C0),   D4_VRD(0),         P1[2], P1[3], P1[4], P1[5],     pw2[0] = D4_PKW(P1, 0),  pw2[1] = D4_PKW(P1, 2),  pw2); \
    D4_GAPA(C1 = D4_MFMA(kf[1], qr[2], C1),   D4_VRD(1),         P1[6], P1[7], P1[8], P1[9],     pw2[2] = D4_PKW(P1, 4),  pw2[3] = D4_PKW(P1, 6),  pw2); \
    D4_GAPA(C0 = D4_MFMA(kf[2], qr[3], C0),   D4_VRD(2),         P1[10], P1[11], P1[12], P1[13], pw3[0] = D4_PKW(P1, 8),  pw3[1] = D4_PKW(P1, 10), pw3); \
    D4_GAPA(C1 = D4_MFMA(kf[3], qr[3], C1),   do { D4_VRD(3); D4_VRD(4); } while (0), P1[14], P1[15], 0.f, 0.f, pw3[2] = D4_PKW(P1, 12), pw3[3] = D4_PKW(P1, 14), pw3); \
    l_reg += sacc; \
    D4_GAPB(0, C0, 0, D4_VRD(5));   D4_GAPB(1, C0, 2, D4_VRD(6));   D4_GAPB(2, C0, 4, D4_VRD(7));    D4_GAPB(3, C0, 6, D4_VRD(8)); \
    D4_GAPB(4, C0, 8, D4_VRD(9));   D4_GAPB(5, C0, 10, D4_VRD(10)); D4_GAPB(6, C0, 12, D4_VRD(11));  D4_GAPB(7, C0, 14, do { D4_VRD(12); if (GL) D4_KRD(0, kn_, 0); } while (0)); \
    D4_GAPB(8, C1, 0, do { D4_VRD(13); if ((GK) && (GV)) D4_DMA_KV((t) + 3, (t) + 1, sl_next); else if (GV) D4_DMA_V((t) + 1, sl_next); } while (0)); \
    D4_GAPB(9, C1, 2, do { D4_VRD(14); if (GL) D4_KRD(1, kn_, 1); } while (0));  D4_GAPB(10, C1, 4, do { D4_VRD(15); if (GL) D4_KRD(2, kn_, 2); } while (0));  D4_GAPB(11, C1, 6, do { if (GL) D4_KRD(3, kn_, 3); } while (0)); \
    D4_GAPB(12, C1, 8, (void)0); D4_GAPB(13, C1, 10, (void)0); D4_GAPB(14, C1, 12, (void)0); D4_GAPB(15, C1, 14, (void)0); \
    } while (0)
  int t = 1;
  for (; t + 4 < NT; t += 2) {
    D4_STEP(pB0, pB1, pA0, pA1, t, true, true, true);     D4_WAIT_BAR(3); D4_ROT();
    D4_STEP(pA0, pA1, pB0, pB1, t + 1, true, true, true); D4_WAIT_BAR(3); D4_ROT();
  }
  D4_STEP(pB0, pB1, pA0, pA1, t, false, true, true);      D4_WAIT_BAR(2); D4_ROT();
  D4_STEP(pA0, pA1, pB0, pB1, t + 1, false, true, true);  D4_WAIT_BAR(0); D4_ROT();
  D4_STEP(pB0, pB1, pA0, pA1, t + 2, false, false, false);
  { float sacc = pB0[0] + pB0[1];
#pragma unroll
    for (int r = 2; r < 16; ++r) sacc += pB0[r];
#pragma unroll
    for (int r = 0; r < 16; ++r) sacc += pB1[r];
    l_reg += sacc;
    pw0 = (u32x4){D4_PKW(pB0, 0), D4_PKW(pB0, 2), D4_PKW(pB0, 4), D4_PKW(pB0, 6)}; pw1 = (u32x4){D4_PKW(pB0, 8), D4_PKW(pB0, 10), D4_PKW(pB0, 12), D4_PKW(pB0, 14)};
    pw2 = (u32x4){D4_PKW(pB1, 0), D4_PKW(pB1, 2), D4_PKW(pB1, 4), D4_PKW(pB1, 6)}; pw3 = (u32x4){D4_PKW(pB1, 8), D4_PKW(pB1, 10), D4_PKW(pB1, 12), D4_PKW(pB1, 14)};
    const lds_cptr vp_ = vp0 + sl_cur;
    D4_VRD(0); D4_VRD(1); D4_VRD(2); D4_VRD(3); D4_VRD(4);
    o[0] = D4_MFMA(D4_PAF(0), D4_VFR(0), o[0]); D4_VRD(5); o[0] = D4_MFMA(D4_PAF(1), D4_VFR(1), o[0]); D4_VRD(6); o[0] = D4_MFMA(D4_PAF(2), D4_VFR(2), o[0]); D4_VRD(7); o[0] = D4_MFMA(D4_PAF(3), D4_VFR(3), o[0]); D4_VRD(8);
    o[1] = D4_MFMA(D4_PAF(0), D4_VFR(4), o[1]); D4_VRD(9); o[1] = D4_MFMA(D4_PAF(1), D4_VFR(5), o[1]); D4_VRD(10); o[1] = D4_MFMA(D4_PAF(2), D4_VFR(6), o[1]); D4_VRD(11); o[1] = D4_MFMA(D4_PAF(3), D4_VFR(7), o[1]); D4_VRD(12);
    o[2] = D4_MFMA(D4_PAF(0), D4_VFR(8), o[2]); D4_VRD(13); o[2] = D4_MFMA(D4_PAF(1), D4_VFR(9), o[2]); D4_VRD(14); o[2] = D4_MFMA(D4_PAF(2), D4_VFR(10), o[2]); D4_VRD(15); o[2] = D4_MFMA(D4_PAF(3), D4_VFR(11), o[2]);
    o[3] = D4_MFMA(D4_PAF(0), D4_VFR(12), o[3]); o[3] = D4_MFMA(D4_PAF(1), D4_VFR(13), o[3]); o[3] = D4_MFMA(D4_PAF(2), D4_VFR(14), o[3]); o[3] = D4_MFMA(D4_PAF(3), D4_VFR(15), o[3]); }
  { auto rr = __builtin_amdgcn_permlane32_swap(__float_as_uint(l_reg), __float_as_uint(l_reg), false, false); l_out = __uint_as_float(rr[0]) + __uint_as_float(rr[1]); }
  D4_WAIT_BAR(0);
#undef D4_PIN
#undef D4_MFMA
#undef D4_WAIT_BAR
#undef D4_KSLOT
#undef D4_DMA_K
#undef D4_DMA_V
#undef D4_DMA_KV
#undef D4_KRD
#undef D4_VO
#undef D4_VRD
#undef D4_VFR
#undef D4_PKW
#undef D4_PAF
#undef D4_PAFI
#undef D4_ROT
#undef D4_EX2
#undef D4_GAPA
#undef D4_GAPB
#undef D4_STEP
}
__device__ __forceinline__ void row_recips(float l, float extra, float* wsf, int r32, int hi, float (&rli)[16]) {
  if (hi == 0) wsf[r32] = l + extra; asm volatile("s_waitcnt lgkmcnt(0)" ::: "memory");
#pragma unroll
  for (int r = 0; r < 16; ++r) rli[r] = __builtin_amdgcn_rcpf(wsf[crow(r, hi)]);
  asm volatile("s_waitcnt lgkmcnt(0)" ::: "memory");
}

__device__ __forceinline__ void win_unit(__amdgpu_buffer_rsrc_t rs, const char* wsb, int b, int hq, int qb, const bf16_t* QA, const bf16_t* KA, const bf16_t* VA, bf16_t* ACAT, const float* scal, char* lds, const int wid) {
  constexpr int S = 8192;
  const int lane0 = MK_LANE(), kvh = hq >> 2;
  const int q0 = qb * 256; int kbeg = q0 - 128, kend = q0 + 384; if (kbeg < 0) kbeg = 0; if (kend > S) kend = S;
  const size_t rowbase = (size_t)b * S;
  f32x16 o[2]; float l;
  attn_pass<2, true>(rs, (unsigned)((const char*)(QA + (rowbase + q0) * 512 + hq * 64) - wsb), 1024u, (unsigned)((const char*)(KA + (rowbase + kbeg) * 128 + kvh * 64) - wsb), 256u, (unsigned)((const char*)(VA + (rowbase + kbeg) * 128 + kvh * 64) - wsb), 256u, kend - kbeg, q0, kbeg, scal[8 + hq], lds, o, l, wid);
  int r32 = lane0 & 31, hi = lane0 >> 5, lane = lane0; asm volatile("" : "+v"(r32), "+v"(hi), "+v"(lane));
  float* wsf = (float*)(lds + LDS_WS) + wid * 64; float rli[16];
  row_recips(l, scal[16 + hq], wsf, r32, hi, rli);
  bf16_t* stg = (bf16_t*)(lds + LDS_STG) + wid * 4096;
#pragma unroll
  for (int r = 0; r < 16; ++r) { const int orow = crow(r, hi);
#pragma unroll
    for (int d0 = 0; d0 < 2; ++d0) stg[orow * 64 + d0 * 32 + r32] = (bf16_t)(cvtpk(o[d0][r] * rli[r], 0.f) & 0xffffu); }
  asm volatile("s_waitcnt lgkmcnt(0)" ::: "memory");
  const int widl = wid;
  bf16_t* Ow = ACAT + (rowbase + q0) * 1024 + hq * 64 + (unsigned)((widl * QBLK + (lane >> 3)) * 1024 + (lane & 7) * 8);
  const bf16_t* sp = stg + (lane >> 3) * 64 + (lane & 7) * 8;
#pragma unroll
  for (int i = 0; i < 4; ++i) { const u32x4 v = *(const u32x4*)(sp + i * 512); *(u32x4*)(Ow + (size_t)i * 8192) = v; }
  asm volatile("s_waitcnt lgkmcnt(0)" ::: "memory"); __syncthreads();
}

__device__ __forceinline__ void win_unit2(__amdgpu_buffer_rsrc_t rs, const char* wsb, int b, int kvh, int qb, int pair, const bf16_t* QA, const bf16_t* KA, const bf16_t* VA, bf16_t* ACAT, const float* scal, char* lds, const int wid) {
  constexpr int S = 8192, W_K = 65536, W_WS = 131072;
  const int lane = MK_LANE(), r32 = lane & 31, hi = lane >> 5;
  const unsigned lds0 = (unsigned)(uintptr_t)lds;
  const int q0 = qb * 256, kb0 = q0 - 128; const size_t rowbase = (size_t)b * S;
  const unsigned Kb = (unsigned)((const char*)(KA + rowbase * 128 + kvh * 64) - wsb), Vb = (unsigned)((const char*)(VA + rowbase * 128 + kvh * 64) - wsb);
  { const unsigned kvoff = (unsigned)lane * 256u + wid * 16;
    const int ob = wid * 1024 + lane * 16, st = ob >> 9, k = (st / 2) * 8 + ((ob >> 6) & 7), c = (st % 2) * 32 + ((ob >> 4) & 3) * 8; const unsigned vvoff = (unsigned)k * 256u + c * 2;
#pragma unroll
    for (int j = 0; j < 8; ++j) { const int ks = kb0 + 64 * j;
      if (ks >= 0 && ks < S) dma16x2(lds0 + W_K + j * 8192 + wid * 1024, kvoff, Kb + (unsigned)ks * 256u, lds0 + j * 8192 + wid * 1024, vvoff, Vb + (unsigned)ks * 256u, rs); } }
  asm volatile("s_waitcnt vmcnt(0)\n\ts_barrier" ::: "memory");
  const lds_cptr kp0 = (lds_cptr)lds + W_K + hi * 1024 + r32 * 16;
  const lds_cptr vp0 = (lds_cptr)lds + v_rd_base(lane);
  float* wsf = (float*)(lds + W_WS) + wid * 64;
  const int qrow0 = q0 + wid * QBLK, qpos = qrow0 + r32, jlo = wid >> 1;
#pragma unroll 1
  for (int hh = 0; hh < 2; ++hh) {
    const int hq = kvh * 4 + pair * 2 + hh;
    bf16x8 qr[4];
    { const unsigned Qb = (unsigned)((const char*)(QA + (rowbase + q0) * 512 + hq * 64) - wsb), qoff = (unsigned)(wid * QBLK + r32) * 1024u + hi * 16;
#pragma unroll
      for (int d0 = 0; d0 < 4; ++d0) { const u32x4 w = __builtin_amdgcn_raw_buffer_load_b128(rs, qoff + d0 * 32, Qb, 0); qr[d0] = __builtin_bit_cast(bf16x8, w); } }
    f32x16 negm; { float ns = scal[8 + hq]; asm volatile("" : "+v"(ns));
#pragma unroll
    for (int r = 0; r < 16; ++r) negm[r] = ns; }
    f32x16 o0 = f32x16{}, o1 = f32x16{}; float l_reg = 0.f;
#pragma unroll 1
    for (int i = 0; i < 5; ++i) {
      const int j = jlo + i, ks = kb0 + 64 * j;
      if (ks < 0 || ks >= S) continue;
      const lds_cptr kp = kp0 + j * 8192; const lds_cptr vp = vp0 + j * 8192;
      f32x16 p0, p1;
#pragma unroll
      for (int d0 = 0; d0 < 4; ++d0) { const bf16x8 k0 = kld(kp + d0 * 2048), k1 = kld(kp + d0 * 2048 + 512);
        if (d0 == 0) { p0 = __builtin_amdgcn_mfma_f32_32x32x16_bf16(k0, qr[0], negm, 0, 0, 0); p1 = __builtin_amdgcn_mfma_f32_32x32x16_bf16(k1, qr[0], negm, 0, 0, 0); }
        else { p0 = __builtin_amdgcn_mfma_f32_32x32x16_bf16(k0, qr[d0], p0, 0, 0, 0); p1 = __builtin_amdgcn_mfma_f32_32x32x16_bf16(k1, qr[d0], p1, 0, 0, 0); } }
      if (!((ks >= qrow0 + QBLK - 1 - 128) && (ks + 63 <= qrow0 + 128))) wmask<true>(p0, p1, qpos, ks, hi);
      exp_half(p0); exp_half(p1);
      float ps = 0.f;
#pragma unroll
      for (int r = 0; r < 16; ++r) ps += p0[r];
#pragma unroll
      for (int r = 0; r < 16; ++r) ps += p1[r];
      l_reg += ps;
      bf16x8 pa0, pa1, pa2, pa3;
#define W2_PK4(P, BASE, OUT) do { u32x4 w = {cvtpk(P[BASE + 0], P[BASE + 1]), cvtpk(P[BASE + 2], P[BASE + 3]), cvtpk(P[BASE + 4], P[BASE + 5]), cvtpk(P[BASE + 6], P[BASE + 7])}; OUT = *reinterpret_cast<bf16x8*>(&w); } while (0)
      W2_PK4(p0, 0, pa0); W2_PK4(p0, 8, pa1); W2_PK4(p1, 0, pa2); W2_PK4(p1, 8, pa3);
#undef W2_PK4
#define W2_VF(D0, ks_) ({ const s16x4 l_ = vtr(vp + (D0) * 512 + (2 * (ks_)) * 1024), h_ = vtr(vp + (D0) * 512 + (2 * (ks_) + 1) * 1024); (bf16x8){l_[0], l_[1], l_[2], l_[3], h_[0], h_[1], h_[2], h_[3]}; })
      o0 = __builtin_amdgcn_mfma_f32_32x32x16_bf16(pa0, W2_VF(0, 0), o0, 0, 0, 0); o1 = __builtin_amdgcn_mfma_f32_32x32x16_bf16(pa0, W2_VF(1, 0), o1, 0, 0, 0);
      o0 = __builtin_amdgcn_mfma_f32_32x32x16_bf16(pa1, W2_VF(0, 1), o0, 0, 0, 0); o1 = __builtin_amdgcn_mfma_f32_32x32x16_bf16(pa1, W2_VF(1, 1), o1, 0, 0, 0);
      o0 = __builtin_amdgcn_mfma_f32_32x32x16_bf16(pa2, W2_VF(0, 2), o0, 0, 0, 0); o1 = __builtin_amdgcn_mfma_f32_32x32x16_bf16(pa2, W2_VF(1, 2), o1, 0, 0, 0);
      o0 = __builtin_amdgcn_mfma_f32_32x32x16_bf16(pa3, W2_VF(0, 3), o0, 0, 0, 0); o1 = __builtin_amdgcn_mfma_f32_32x32x16_bf16(pa3, W2_VF(1, 3), o1, 0, 0, 0);
#undef W2_VF
    }
    float l; { auto rr = __builtin_amdgcn_permlane32_swap(__float_as_uint(l_reg), __float_as_uint(l_reg), false, false); l = __uint_as_float(rr[0]) + __uint_as_float(rr[1]); }
    float rli[16];
    row_recips(l, scal[16 + hq], wsf, r32, hi, rli);
    bf16_t* stg = (bf16_t*)(lds + W_WS + 2048) + wid * 1024;
    bf16_t* Ow = ACAT + (rowbase + q0 + wid * QBLK) * 1024 + hq * 64;
#pragma unroll
    for (int g = 0; g < 2; ++g) {
#pragma unroll
      for (int rr = 0; rr < 8; ++rr) { const int r = 8 * g + rr, srow = crow(r, hi) - 16 * g;
        stg[srow * 64 + r32] = (bf16_t)(cvtpk(o0[r] * rli[r], 0.f) & 0xffffu); stg[srow * 64 + 32 + r32] = (bf16_t)(cvtpk(o1[r] * rli[r], 0.f) & 0xffffu); }
      asm volatile("s_waitcnt lgkmcnt(0)" ::: "memory");
#pragma unroll
      for (int i = 0; i < 2; ++i) { const int row = i * 8 + (lane >> 3), ch = lane & 7; const u32x4 v = *(const u32x4*)(stg + row * 64 + ch * 8); *(u32x4*)(Ow + (size_t)(16 * g + row) * 1024 + ch * 8) = v; }
      asm volatile("s_waitcnt lgkmcnt(0)" ::: "memory"); }
  }
  asm volatile("s_waitcnt lgkmcnt(0)" ::: "memory"); __syncthreads();
}

__device__ __forceinline__ void diff_unit(__amdgpu_buffer_rsrc_t rs, const char* wsb, int b, int h, int qb, const bf16_t* QB, const bf16_t* KB, const bf16_t* VB, bf16_t* ACAT, const float* scal, const float* subln, char* lds, const int wid) {
  constexpr int S = 8192;
  const int lane0 = MK_LANE();
  const size_t rowbase = (size_t)b * S; const int q0 = qb * 256;
  float* wsf = (float*)(lds + LDS_WS) + wid * 64; float rli[16];
  bf16_t* stg = (bf16_t*)(lds + LDS_STG) + wid * 4096;
  const float lam = scal[0], post = 1.0f - scal[1], negm_s = scal[2];
#pragma unroll 1
  for (int t = 0; t < 2; ++t) {
    f32x16 o[4]; float l;
    attn_pass_d4(rs, (unsigned)((const char*)(QB + (rowbase + q0) * 512 + (2 * h + t) * 64) - wsb), 1024u, (unsigned)((const char*)(KB + rowbase * 512 + (2 * h + t) * 64) - wsb), 1024u, (unsigned)((const char*)(VB + rowbase * 512 + h * 128) - wsb), 1024u, S, negm_s, lds, o, l, wid);
    int r32 = lane0 & 31, hi = lane0 >> 5, lane = lane0; asm volatile("" : "+v"(r32), "+v"(hi), "+v"(lane));
    row_recips(l, 0.f, wsf, r32, hi, rli);
    if (t == 0) {
#pragma unroll
      for (int r = 0; r < 16; ++r) { const int orow = crow(r, hi);
#pragma unroll
        for (int d0 = 0; d0 < 4; ++d0) stg[orow * 128 + d0 * 32 + r32] = (bf16_t)(cvtpk(o[d0][r] * rli[r], 0.f) & 0xffffu); }
    } else {
      float ss[16];
#pragma unroll
      for (int r = 0; r < 16; ++r) { const int orow = crow(r, hi); float s_ = 0.f;
#pragma unroll
        for (int d0 = 0; d0 < 4; ++d0) { const float v = bf2f(stg[orow * 128 + d0 * 32 + r32]) - lam * (o[d0][r] * rli[r]); o[d0][r] = v; s_ += v * v; }
        ss[r] = s_; }
#pragma unroll
      for (int r = 0; r < 16; ++r) { float s_ = ss[r]; s_ += __shfl_xor(s_, 1); s_ += __shfl_xor(s_, 2); s_ += __shfl_xor(s_, 4); s_ += __shfl_xor(s_, 8); s_ += __shfl_xor(s_, 16); ss[r] = rsqrtf(s_ * (1.0f / 128.0f) + 1e-6f) * post; }
      float sl[4];
#pragma unroll
      for (int d0 = 0; d0 < 4; ++d0) sl[d0] = subln[d0 * 32 + r32];
#pragma unroll
      for (int r = 0; r < 16; ++r) { const int orow = crow(r, hi);
#pragma unroll
        for (int d0 = 0; d0 < 4; ++d0) stg[orow * 128 + d0 * 32 + r32] = (bf16_t)(cvtpk(o[d0][r] * ss[r] * sl[d0], 0.f) & 0xffffu); }
      asm volatile("s_waitcnt lgkmcnt(0)" ::: "memory");
      const int widl = wid;
      bf16_t* Ow = ACAT + (rowbase + q0) * 1024 + 512 + h * 128 + (unsigned)((widl * QBLK + (lane >> 4)) * 1024 + (lane & 15) * 8);
      const bf16_t* sp = stg + (lane >> 4) * 128 + (lane & 15) * 8;
#pragma unroll
      for (int i = 0; i < 8; ++i) { const u32x4 v = *(const u32x4*)(sp + i * 512); *(u32x4*)(Ow + (size_t)i * 4096) = v; }
    }
  }
  asm volatile("s_waitcnt lgkmcnt(0)" ::: "memory"); __syncthreads();
}
#undef ATT_SBAR
#undef KSWZ64
}
constexpr int NWAVES = 8;
#ifndef MK_N_LAUNCHES
#define MK_N_LAUNCHES 1
#endif
constexpr int PER_PHASE = 10;
constexpr int N_LAUNCHES = MK_N_LAUNCHES;

constexpr int BATCH = 2, T = 8192, D = 1024, M = BATCH * T, DFF = 2816, NFF = 2 * DFF, NIN = 4352, NMOD = 9 * D;
constexpr size_t MiB = 1u << 20;
constexpr size_t WS_CTL = 0, CTL_ZERO_BYTES = 1 * MiB;
constexpr size_t WS_MOD = 512 * 1024;
constexpr size_t WS_SCAL = 1 * MiB, WS_CB1 = WS_SCAL + 4096, WS_CBIN = WS_CB1 + 65536, WS_CB2 = WS_CBIN + 65536;
constexpr size_t WS_RSS0 = 2 * MiB, WS_RSS1 = WS_RSS0 + 256 * 1024, WS_RSS2 = WS_RSS1 + 256 * 1024;
constexpr size_t WS_COS = 3 * MiB, WS_SIN = 5 * MiB;
constexpr size_t WS_W1T = 8 * MiB, WS_W1OT = 19 * MiB, WS_WINT = 25 * MiB, WS_WBRT = 34 * MiB, WS_WOT = 38 * MiB, WS_W2T = 40 * MiB, WS_W2OT = 51 * MiB;
constexpr size_t WS_ABUF = 57 * MiB;
constexpr size_t WS_R1 = 89 * MiB;
constexpr size_t WS_QA = WS_R1, WS_KA = WS_QA + 16 * MiB, WS_VA = WS_KA + 4 * MiB, WS_QB = WS_VA + 4 * MiB, WS_KB = WS_QB + 16 * MiB, WS_VB = WS_KB + 16 * MiB;
constexpr size_t WS_MG = WS_R1;
constexpr size_t WS_GA = 177 * MiB, WS_GB = 209 * MiB, WS_END = 241 * MiB;
static_assert(WS_VB + 16 * MiB <= WS_GA && WS_R1 + (size_t)M * DFF * 2 <= WS_GA && WS_W2OT + (size_t)D * DFF * 2 <= WS_ABUF, "d_ws map");
constexpr int CW_TMO = 0, CW_CODE = 1, CW_BAR = 4096;

constexpr int RING_OFF = 0, RING_BYTES = 131072;
constexpr int LDSCTL_OFF = 149504, MISC_OFF = LDSCTL_OFF + 320;
constexpr int LDS_BYTES = 155648;
static_assert(MISC_OFF + 128 <= LDS_BYTES && att::ATT_LDS_BYTES <= LDSCTL_OFF && RING_BYTES <= LDSCTL_OFF, "LDS map");

#define GAS __attribute__((address_space(1)))
#define LAS __attribute__((address_space(3)))
typedef unsigned short bf16;
typedef unsigned v4u __attribute__((ext_vector_type(4)));
typedef float f32x4 __attribute__((ext_vector_type(4)));
typedef short bf16x8 __attribute__((ext_vector_type(8)));
typedef GAS unsigned gu32;
typedef GAS unsigned long long gu64;
#define RLX_AGENT __ATOMIC_RELAXED, __HIP_MEMORY_SCOPE_AGENT
#define LDS_WAIT() asm volatile("s_waitcnt lgkmcnt(0)" ::: "memory")
#define VM_WAIT() asm volatile("s_waitcnt vmcnt(0)" ::: "memory")
__device__ __forceinline__ unsigned long long rt() { return __builtin_amdgcn_s_memrealtime(); }
__device__ __forceinline__ unsigned f2bf(float f) { unsigned u = __builtin_bit_cast(unsigned, f); return (u + 0x7fffu + ((u >> 16) & 1u)) >> 16; }
__device__ __forceinline__ unsigned pk2(float lo, float hi) { return f2bf(lo) | (f2bf(hi) << 16); }

#define XB_TMO      128
#define XB_XCNT(j)  (256  + 64 * (j))
#define XB_XSUB(j)  (1280 + 64 * (j))
#define XB_XGEN(j)  (2304 + 64 * (j))
#define XB_TOP      3328
#define XB_TOPGEN   3392
#define XCD_BAR_WORDS 3456
#define XB_SPIN_CAP (1u << 18)

__device__ __forceinline__ unsigned xb_ld(unsigned* p)              { return __hip_atomic_load(p, __ATOMIC_RELAXED, __HIP_MEMORY_SCOPE_AGENT); }
__device__ __forceinline__ unsigned xb_add(unsigned* p, unsigned v) { return __hip_atomic_fetch_add(p, v, __ATOMIC_RELAXED, __HIP_MEMORY_SCOPE_AGENT); }
__device__ __forceinline__ unsigned xb_xcc_id() { return (unsigned)__builtin_amdgcn_s_getreg((3 << 11) | 20) & 0xFu; }
#define XB_SPIN(cond, bar) do { unsigned _sp = 0; while (cond) { __builtin_amdgcn_s_sleep(1); \
    if ((++_sp & 255u) == 0u) { if (xb_ld(&(bar)[XB_TMO])) break; if (_sp > XB_SPIN_CAP) { atomicAdd(&(bar)[XB_TMO], 1u); break; } } } } while (0)

struct XcdBarrier {
    unsigned* bar; unsigned x;
    volatile LAS unsigned* st;
};

__device__ __forceinline__ XcdBarrier xcd_barrier_post(unsigned* bar, volatile LAS unsigned* st) {
    XcdBarrier b; b.bar = bar; b.x = xb_xcc_id(); b.st = st;
    if (threadIdx.x == 0) (void)xb_add(&bar[XB_XCNT(b.x)], 1u);
    return b;
}
__device__ __forceinline__ void xcd_barrier_complete(unsigned* bar, unsigned x, unsigned& nloc, unsigned& nx) {
    const unsigned G = gridDim.x * gridDim.y * gridDim.z;
    unsigned sum, cnt, mine, sp = 0u;
    for (;;) {
        sum = 0u; cnt = 0u; mine = 0u;
#pragma unroll
        for (unsigned j = 0; j < 16; ++j) { const unsigned c = xb_ld(&bar[XB_XCNT(j)]); sum += c; cnt += (c > 0u) ? 1u : 0u; mine = (j == x) ? c : mine; }
        if (sum == G) break;
        __builtin_amdgcn_s_sleep(1);
        if ((++sp & 255u) == 0u) { if (xb_ld(&bar[XB_TMO])) break; if (sp > XB_SPIN_CAP) { atomicAdd(&bar[XB_TMO], 1u); break; } }
    }
    nloc = mine > 0u ? mine : 1u; nx = cnt > 0u ? cnt : 1u;
}

__device__ __forceinline__ void xcd_barrier(const XcdBarrier& b, const bool leader  ) {
    asm volatile("s_waitcnt vmcnt(0)" ::: "memory");
    __syncthreads();
    if (leader) {
        unsigned* bar = b.bar;
        __builtin_amdgcn_s_waitcnt(0);
        unsigned nloc = b.st[0], nx = b.st[1];
        if (nloc == 0u) { xcd_barrier_complete(bar, b.x, nloc, nx); b.st[0] = nloc; b.st[1] = nx; }
        const unsigned old = xb_add(&bar[XB_XSUB(b.x)], 1u);
        const unsigned gen = old / nloc;
        if (old + 1u == (gen + 1u) * nloc) {
            __builtin_amdgcn_fence(__ATOMIC_RELEASE, "agent");
            asm volatile("s_waitcnt vmcnt(0)" ::: "memory");
            const unsigned og = xb_add(&bar[XB_TOP], 1u);
            const unsigned tg = og / nx;
            asm volatile("buffer_inv sc1" ::: "memory");
            if (og + 1u == (tg + 1u) * nx) xb_add(&bar[XB_TOPGEN], 1u);
            else XB_SPIN(xb_ld(&bar[XB_TOPGEN]) == tg, bar);
            xb_add(&bar[XB_XGEN(b.x)], 1u);
            asm volatile("s_waitcnt vmcnt(0)" ::: "memory");
        } else {
            asm volatile("buffer_inv sc1" ::: "memory");
            XB_SPIN(xb_ld(&bar[XB_XGEN(b.x)]) == gen, bar);
            asm volatile("s_waitcnt vmcnt(0)" ::: "memory");
        }
    }
    __syncthreads();
}

struct Args { const void* in[26]; float* out; unsigned char* ws; int ph_lo, ph_hi, li, pad; };

__device__ __forceinline__ float wave_sum(float v) {
#pragma unroll
    for (int o = 1; o < 64; o <<= 1) v += __shfl_xor(v, o);
    return v;
}
__device__ __forceinline__ int rowmap(int kind, int n0) {
    if (kind == 1) { const int bj = n0 >= DFF ? 1 : 0, jj = n0 - bj * DFF; return (jj >> 7) * 256 + bj * 128 + (jj & 127); }
    if (kind == 2) { if (n0 >= 2304) return n0; const int g32 = n0 >> 5, head = g32 >> 1, bj = g32 & 1; return (head >> 2) * 256 + bj * 128 + (head & 3) * 32; }
    if (kind == 3) return (n0 >> 7) * 256 + (n0 & 127);
    if (kind == 4) return (n0 >> 7) * 256 + 128 + (n0 & 127);
    return n0;
}
struct TItem { const float* src; bf16* dst; int N; int ldk; };
__device__ __forceinline__ TItem p0_item_addr(const float* W, int N, bf16* WT, int ldk, int koff, int kind, int item, int lane) {
    const int nblk = N / 32, kb = item / nblk, nb = item % nblk, k0 = 64 * kb, n0 = 32 * nb, c0 = rowmap(kind, n0), kg = lane & 7, ng = lane >> 3;
    TItem t; t.src = W + (size_t)(k0 + 8 * kg) * N + n0 + 4 * ng; t.dst = WT + (size_t)(c0 + 4 * ng) * ldk + koff + k0 + 8 * kg; t.N = N; t.ldk = ldk; return t;
}
__device__ __forceinline__ void p0_item_load(const TItem& t, f32x4 (&v)[8]) {
#pragma unroll
    for (int j = 0; j < 8; ++j) v[j] = __builtin_nontemporal_load((const f32x4*)(t.src + (size_t)j * t.N));
}
__device__ __forceinline__ void p0_item_store(const TItem& t, const f32x4 (&v)[8]) {
#pragma unroll
    for (int i = 0; i < 4; ++i) { v4u o; o.x = pk2(v[0][i], v[1][i]); o.y = pk2(v[2][i], v[3][i]); o.z = pk2(v[4][i], v[5][i]); o.w = pk2(v[6][i], v[7][i]);
        *(GAS v4u*)(t.dst + (size_t)i * t.ldk) = o; }
}

__device__ __forceinline__ void bias_rows(const bf16* Bt, float* CB, int nrows, const float* sh0, const float* sh1, int gw, int NGW) {
    const int lane = MK_LANE();
    f32x4 s0[2][2], s1[2][2];
#pragma unroll
    for (int hh = 0; hh < 2; ++hh)
#pragma unroll
        for (int q = 0; q < 2; ++q) { s0[hh][q] = *(const f32x4*)(sh0 + hh * 512 + lane * 8 + 4 * q); s1[hh][q] = *(const f32x4*)(sh1 + hh * 512 + lane * 8 + 4 * q); }
    for (int c0 = gw; c0 < nrows; c0 += 3 * NGW) {
        v4u w[3][2];
#pragma unroll
        for (int r = 0; r < 3; ++r) { const int c = c0 + r * NGW;
            if (c < nrows) {
#pragma unroll
                for (int hh = 0; hh < 2; ++hh) w[r][hh] = *(const GAS v4u*)(Bt + (size_t)c * D + hh * 512 + lane * 8); } }
#pragma unroll
        for (int r = 0; r < 3; ++r) { const int c = c0 + r * NGW;
            if (c < nrows) { float a0 = 0.f, a1 = 0.f;
#pragma unroll
                for (int hh = 0; hh < 2; ++hh) { const v4u v = w[r][hh];
                    const float wf[8] = {__uint_as_float(v.x << 16), __uint_as_float(v.x & 0xffff0000u), __uint_as_float(v.y << 16), __uint_as_float(v.y & 0xffff0000u),
                                         __uint_as_float(v.z << 16), __uint_as_float(v.z & 0xffff0000u), __uint_as_float(v.w << 16), __uint_as_float(v.w & 0xffff0000u)};
#pragma unroll
                    for (int e = 0; e < 8; ++e) { a0 += wf[e] * s0[hh][e >> 2][e & 3]; a1 += wf[e] * s1[hh][e >> 2][e & 3]; } }
                a0 = wave_sum(a0); a1 = wave_sum(a1);
                if (lane == 0) { CB[c] = a0; CB[nrows + c] = a1; } } }
    }
}

__global__ void __launch_bounds__(NWAVES * 64, 2) layer_fwd(Args args) {
    extern __shared__ __attribute__((aligned(16))) unsigned char lds[];
    LAS unsigned char* ldsl = (LAS unsigned char*)lds;
    volatile LAS unsigned* MISC = (volatile LAS unsigned*)(ldsl + MISC_OFF);
    const int wave = __builtin_amdgcn_readfirstlane((int)threadIdx.x >> 6), lane = MK_LANE(), tid = wave * 64 + lane;
    const int G = gridDim.x; const int bx = blockIdx.x; const int vcu = (G % 8 == 0) ? (bx % 8) * (G / 8) + bx / 8 : bx;
    unsigned char* ws = args.ws;
    gu32* ctl = (gu32*)(ws + WS_CTL);
    const float* x = (const float*)args.in[0]; const float* cvec = (const float*)args.in[1]; const int* positions = (const int*)args.in[2];
    const float* w_mod = (const float*)args.in[3]; const float* b_mod = (const float*)args.in[4];
    const float* norm_ffn1 = (const float*)args.in[5]; const float* w_ffn1_in = (const float*)args.in[6]; const float* w_ffn1_out = (const float*)args.in[7];
    const float* norm_mix = (const float*)args.in[8]; const float* w_in = (const float*)args.in[9];
    const float* qn_a = (const float*)args.in[10]; const float* kn_a = (const float*)args.in[11]; const float* sink_a = (const float*)args.in[12];
    const float* qn_b = (const float*)args.in[13]; const float* kn_b = (const float*)args.in[14];
    const float* lam_q1 = (const float*)args.in[15]; const float* lam_k1 = (const float*)args.in[16]; const float* lam_q2 = (const float*)args.in[17]; const float* lam_k2 = (const float*)args.in[18];
    const float* subln_b = (const float*)args.in[19]; const float* w_branch_a = (const float*)args.in[20]; const float* w_branch_b = (const float*)args.in[21];
    const float* w_out = (const float*)args.in[22]; const float* norm_ffn2 = (const float*)args.in[23]; const float* w_ffn2_in = (const float*)args.in[24]; const float* w_ffn2_out = (const float*)args.in[25];
    float* out = args.out;
    float* MOD = (float*)(ws + WS_MOD); float* SCAL = (float*)(ws + WS_SCAL); float* CB1 = (float*)(ws + WS_CB1); float* CBIN = (float*)(ws + WS_CBIN); float* CB2 = (float*)(ws + WS_CB2);
    float* RSS0 = (float*)(ws + WS_RSS0); float* RSS1 = (float*)(ws + WS_RSS1); float* RSS2 = (float*)(ws + WS_RSS2); bf16* ROPET = (bf16*)(ws + WS_COS);
    bf16* W1T = (bf16*)(ws + WS_W1T); bf16* W1OT = (bf16*)(ws + WS_W1OT); bf16* WINT = (bf16*)(ws + WS_WINT); bf16* WBRT = (bf16*)(ws + WS_WBRT); bf16* WOT = (bf16*)(ws + WS_WOT);
    bf16* W2T = (bf16*)(ws + WS_W2T); bf16* W2OT = (bf16*)(ws + WS_W2OT);
    bf16* ABUF = (bf16*)(ws + WS_ABUF); bf16* HB = (bf16*)(ws + WS_R1); bf16* MG = (bf16*)(ws + WS_MG);
    bf16* QA = (bf16*)(ws + WS_QA); bf16* KA = (bf16*)(ws + WS_KA); bf16* VA = (bf16*)(ws + WS_VA); bf16* QB = (bf16*)(ws + WS_QB); bf16* KB = (bf16*)(ws + WS_KB); bf16* VB = (bf16*)(ws + WS_VB);
    bf16* GA = (bf16*)(ws + WS_GA); bf16* GB = (bf16*)(ws + WS_GB);
    bf16* X1B = (bf16*)out;
    bf16* X2B = (bf16*)(ws + WS_GA);

    for (int u = tid; u < (LDS_BYTES - LDSCTL_OFF) / 4; u += NWAVES * 64) ((LAS unsigned*)(ldsl + LDSCTL_OFF))[u] = 0u;
    __syncthreads();
    XcdBarrier bar; bar.bar = (unsigned*)(ctl + CW_BAR); bar.x = 0; bar.st = nullptr;
    if (N_LAUNCHES != PER_PHASE) bar = xcd_barrier_post((unsigned*)(ctl + CW_BAR), MISC + 8);
#define GRID_BAR(seam) do { if (N_LAUNCHES == PER_PHASE) { if (tid == 0) __hip_atomic_store(ctl + CW_TMO, 0xBADBA0u | (unsigned)(seam), RLX_AGENT); } else { xcd_barrier(bar, wave == 0 && MK_LANE() == 0); } } while (0)
    const int lo = args.ph_lo, hi = args.ph_hi;
#ifndef PH_MASK
#define PH_MASK 0x3ff
#endif
#define IN(k) (((PH_MASK >> (k)) & 1) && lo <= (k) && (k) < hi)
#define BOTH(k) (IN(k) && IN((k) + 1))
#ifndef REPEAT_MASK
#define REPEAT_MASK 0
#endif
#define REPS(k) for (int rep_ = 0; rep_ <= ((REPEAT_MASK >> (k)) & 1); ++rep_)
    const int gw = vcu * NWAVES + wave, NGW = G * NWAVES;
    constexpr float QSCALE = 0.125f * 1.4426950408889634f;

    if (IN(0)) {
#define MOD_GEMV(IT_BEGIN, IT_END, IT_FIRST, IT_STRIDE, TIDV, LANEV) do { \
            LAS float* ca = (LAS float*)(ldsl + RING_OFF + 73728);              \
            LAS float* red = ca + 2048;                                          \
            for (int i = (TIDV); i < 2 * D; i += NWAVES * 64) { const float v = cvec[i]; ca[i] = v / (1.f + __expf(-v)); } \
            __syncthreads(); \
            for (int it = (IT_BEGIN) + (IT_FIRST); it < (IT_END); it += (IT_STRIDE)) { \
                const int cg = it >> 1, kh = it & 1, j = cg * 64 + (LANEV), kbase = kh * 512 + wave * 64; \
                float wv[64]; \
                _Pragma("unroll") \
                for (int kk = 0; kk < 64; ++kk) wv[kk] = w_mod[(size_t)(kbase + kk) * NMOD + j]; \
                float a0 = 0.f, a1 = 0.f; \
                _Pragma("unroll") \
                for (int kk = 0; kk < 64; ++kk) { a0 += ca[kbase + kk] * wv[kk]; a1 += ca[D + kbase + kk] * wv[kk]; } \
                red[(wave * 2 + 0) * 64 + (LANEV)] = a0; red[(wave * 2 + 1) * 64 + (LANEV)] = a1; \
                __syncthreads(); \
                if ((TIDV) < 128) { const int b = (TIDV) >> 6; float s_ = (kh == 0) ? b_mod[j] : 0.f; \
                    _Pragma("unroll") \
                    for (int w = 0; w < 8; ++w) s_ += red[(w * 2 + b) * 64 + (LANEV)]; \
                    atomicAdd(MOD + b * NMOD + j, s_); } \
                __syncthreads(); \
            } } while (0)
        MOD_GEMV(0, 64, bx, G, tid, lane);
        {
            constexpr int NITEMS = (D / 64) * (NFF / 32);
            auto item_of = [&](int it) -> TItem { return p0_item_addr(w_ffn1_in, NFF, W1T, D, 0, 1, it, lane); };
            for (int it = gw; it < NITEMS; it += 2 * NGW) {
                const int it2 = it + NGW; const bool two = it2 < NITEMS;
                const TItem a = item_of(it), b2 = item_of(two ? it2 : it);
                f32x4 va[8], vb[8];
                p0_item_load(a, va); if (two) p0_item_load(b2, vb);
                p0_item_store(a, va); if (two) p0_item_store(b2, vb);
            }
        }
        if (bx == 0 && wave == 0) {
            const float a = wave_sum(lam_q1[lane] * lam_k1[lane]), b2 = wave_sum(lam_q2[lane] * lam_k2[lane]);
            float mqa = fabsf(qn_a[lane]), mka = fabsf(kn_a[lane]), mqb = fabsf(qn_b[lane]), mkb = fabsf(kn_b[lane]);
#pragma unroll
            for (int o = 1; o < 64; o <<= 1) { mqa = fmaxf(mqa, __shfl_xor(mqa, o)); mka = fmaxf(mka, __shfl_xor(mka, o)); mqb = fmaxf(mqb, __shfl_xor(mqb, o)); mkb = fmaxf(mkb, __shfl_xor(mkb, o)); }
            const float bound_a = 8.0f * mqa * mka * 1.001f, bound_b = 8.0f * mqb * mkb * 1.001f, L2E = 1.4426950408889634f;
            if (lane == 0) { const float lam_init = 0.8f - 0.6f * expf(-0.3f * 0.f); SCAL[0] = expf(a) - expf(b2) + lam_init; SCAL[1] = lam_init; SCAL[2] = -bound_b * L2E; }
            if (lane < 8) { const float sk = sink_a[lane], mh = fmaxf(bound_a, sk); SCAL[8 + lane] = -mh * L2E; SCAL[16 + lane] = exp2f((sk - mh) * L2E); }
        }
        if (BOTH(0)) GRID_BAR(0);
    }

    if (IN(1)) {
        for (int m = gw; m < M; m += NGW) {
            const int b = m >> 13; const GAS f32x4* xr = (const GAS f32x4*)(x + (size_t)m * D) + lane;
            f32x4 v[4]; float s = 0.f;
#pragma unroll
            for (int j = 0; j < 4; ++j) { v[j] = xr[64 * j]; s += (v[j].x * v[j].x + v[j].y * v[j].y) + (v[j].z * v[j].z + v[j].w * v[j].w); }
            s = wave_sum(s);
            if (lane == 0) *(f32x4*)(RSS0 + (size_t)m * 4) = (f32x4){s, 0.f, 0.f, 0.f};
            GAS unsigned long long* o8 = (GAS unsigned long long*)(ABUF + (size_t)m * D) + lane;
#pragma unroll
            for (int j = 0; j < 4; ++j) { const int c = 4 * lane + 256 * j; const f32x4 g = *(const f32x4*)(norm_ffn1 + c) * (*(const f32x4*)(MOD + b * NMOD + 1 * D + c) + 1.0f); const f32x4 a = v[j] * g;
                o8[64 * j] = (unsigned long long)pk2(a.x, a.y) | ((unsigned long long)pk2(a.z, a.w) << 32); }
        }
        bias_rows(W1T, CB1, NFF, MOD + 0 * D, MOD + NMOD + 0 * D, gw, NGW);
        if (BOTH(1)) GRID_BAR(1);
    }

    if (IN(2)) {
        pg8::Gemm g{ABUF, W1T, M, NFF, D}; pg8::StaticOrder S; S.init(M, NFF, G, bx);
        pg8::EpiSwiGLU E{HB, DFF, RSS0, CB1, NFF};
        pg8::gemm_phase<pg8::EpiSwiGLU, pg8::StaticOrder, PG8_ALIGN, PG8_SP2>(ldsl + RING_OFF, g, S, E, wave);
        { pg8::Unit ud; const int nunits = (M / 256) * (NFF / 256), nfull = nunits / G;
          if (!S.next(nfull, ud)) {
            const int nidle = G - (nunits - nfull * G), iw = (bx - (G - nidle)) * NWAVES + wave, NIW = nidle * NWAVES, lane2 = MK_LANE();
            MOD_GEMV(64, 288, bx - (G - nidle), nidle, wave * 64 + lane2, lane2);
            constexpr int I_IN = (D / 64) * (NIN / 32), I_1O = (DFF / 64) * (D / 32), NITEMS = I_IN + I_1O;
            auto item_of = [&](int it) -> TItem { return it < I_IN ? p0_item_addr(w_in, NIN, WINT, D, 0, 2, it, lane2) : p0_item_addr(w_ffn1_out, D, W1OT, DFF, 0, 0, it - I_IN, lane2); };
            for (int it = iw; it < NITEMS; it += 2 * NIW) {
                const int it2 = it + NIW; const bool two = it2 < NITEMS;
                const TItem a = item_of(it), b2 = item_of(two ? it2 : it);
                f32x4 va[8], vb[8];
                p0_item_load(a, va); if (two) p0_item_load(b2, vb);
                p0_item_store(a, va); if (two) p0_item_store(b2, vb);
            }
            { const float invf = (float)pow(10000.0, -(double)(2 * (lane2 & 31)) / 64.0);
              for (int i = iw * 64 + lane2; i < M * 32; i += NIW * 64) { const float ang = (float)positions[i >> 5] * invf; const int row = i >> 5, d = i & 31;
                  ROPET[row * 64 + d] = (bf16)f2bf(cosf(ang)); ROPET[row * 64 + 32 + d] = (bf16)f2bf(sinf(ang)); } }
          } }
        if (BOTH(2)) GRID_BAR(2);
    }
    if (IN(3)) {
        pg8::Gemm g{HB, W1OT, M, D, DFF}; pg8::StaticOrder S; S.init(M, D, G, bx);
        pg8::EpiResid<true, 1, false, true> E{x, X1B, MOD + 2 * D, ABUF, norm_mix, MOD + 4 * D, RSS1};
        pg8::gemm_phase<pg8::EpiResid<true, 1, false, true>, pg8::StaticOrder, false, PG8_SP2>(ldsl + RING_OFF, g, S, E, wave);
        bias_rows(WINT, CBIN, NIN, MOD + 3 * D, MOD + NMOD + 3 * D, gw, NGW);
        if (BOTH(3)) GRID_BAR(3);
    }
    if (IN(4)) {
        pg8::Gemm g{ABUF, WINT, M, NIN, D}; pg8::StaticOrder S; S.init(M, NIN, G, bx);
        pg8::EpiInProj E{QA, KA, VA, QB, KB, VB, GA, GB, RSS1, CBIN, ROPET, qn_a, kn_a, qn_b, kn_b, QSCALE};
        pg8::gemm_phase<pg8::EpiInProj, pg8::StaticOrder, PG8_ALIGN, PG8_SP2>(ldsl + RING_OFF, g, S, E, wave);
        { pg8::Unit ud; const int nunits = (M / 256) * (NIN / 256), nfull = nunits / G;
          if (!S.next(nfull, ud)) {
            const int nidle = G - (nunits - nfull * G), iw = (bx - (G - nidle)) * NWAVES + wave, NIW = nidle * NWAVES, lane2 = MK_LANE();
            constexpr int I_1 = (D / 64) * (NFF / 32), I_1O = (DFF / 64) * (D / 32), I_BR = (512 / 64) * (D / 32), I_O = (D / 64) * (D / 32);
            constexpr int NITEMS = 2 * I_BR + I_O + I_1 + I_1O;
            auto item_of = [&](int it) -> TItem {
                int r = it;
                if (r < I_BR) return p0_item_addr(w_branch_a, D, WBRT, D, 0, 0, r, lane2); r -= I_BR;
                if (r < I_BR) return p0_item_addr(w_branch_b, D, WBRT, D, 512, 0, r, lane2); r -= I_BR;
                if (r < I_O) return p0_item_addr(w_out, D, WOT, D, 0, 0, r, lane2); r -= I_O;
                if (r < I_1) return p0_item_addr(w_ffn2_in, NFF, W2T, D, 0, 1, r, lane2); r -= I_1;
                return p0_item_addr(w_ffn2_out, D, W2OT, DFF, 0, 0, r, lane2);
            };
            for (int it = iw; it < NITEMS; it += 2 * NIW) {
                const int it2 = it + NIW; const bool two = it2 < NITEMS;
                const TItem a = item_of(it), b2 = item_of(two ? it2 : it);
                f32x4 va[8], vb[8];
                p0_item_load(a, va); if (two) p0_item_load(b2, vb);
                p0_item_store(a, va); if (two) p0_item_store(b2, vb);
            }
          } }
        if (BOTH(4)) GRID_BAR(4);
    }
    if (IN(5)) {
        char* alds = (char*)lds + RING_OFF;
        const __amdgpu_buffer_rsrc_t wsrs = __builtin_amdgcn_make_buffer_rsrc((void*)ws, (short)0, 0x10000000, 0x00020000);
#ifndef SKIP_WIN
        for (int id = vcu; id < 256; id += G) att::win_unit2(wsrs, (const char*)ws, id >> 7, (id >> 6) & 1, id & 31, (id >> 5) & 1, QA, KA, VA, ABUF, SCAL, alds, wave);
#endif
#ifndef SKIP_DIFF
        for (int id = vcu; id < 256; id += G) att::diff_unit(wsrs, (const char*)ws, id >> 7, (id >> 5) & 3, id & 31, QB, KB, VB, ABUF, SCAL, subln_b, alds, wave);
#endif
        if (BOTH(5)) GRID_BAR(5);
    }
    if (IN(6)) {
        pg8::Gemm g{ABUF, WBRT, M, D, D, 512}; pg8::PairOrder S; S.init(M, D, G, bx, D);
        pg8::EpiBranch E{GA, GB, MG};
        pg8::gemm_phase<pg8::EpiBranch, pg8::PairOrder, PG8_ALIGN, PG8_SP2>(ldsl + RING_OFF, g, S, E, wave);
        if (BOTH(6)) GRID_BAR(6);
    }
    if (IN(7)) {
        pg8::Gemm g{MG, WOT, M, D, D}; pg8::StaticOrder S; S.init(M, D, G, bx);
        pg8::EpiResid<true, 2, true, true> E{X1B, X2B, MOD + 5 * D, ABUF, norm_ffn2, MOD + 7 * D, RSS2};
        pg8::gemm_phase<pg8::EpiResid<true, 2, true, true>, pg8::StaticOrder, false, PG8_SP2>(ldsl + RING_OFF, g, S, E, wave);
        bias_rows(W2T, CB2, NFF, MOD + 6 * D, MOD + NMOD + 6 * D, gw, NGW);
        if (BOTH(7)) GRID_BAR(7);
    }
    if (IN(8)) {
        pg8::Gemm g{ABUF, W2T, M, NFF, D}; pg8::StaticOrder S; S.init(M, NFF, G, bx);
        pg8::EpiSwiGLU E{HB, DFF, RSS2, CB2, NFF};
        pg8::gemm_phase<pg8::EpiSwiGLU, pg8::StaticOrder, PG8_ALIGN, PG8_SP2>(ldsl + RING_OFF, g, S, E, wave);
        if (BOTH(8)) GRID_BAR(8);
    }
    if (IN(9)) {
        pg8::Gemm g{HB, W2OT, M, D, DFF}; pg8::StaticOrder S; S.init(M, D, G, bx);
        pg8::EpiResid<false, 1, true, false> E{X2B, out, MOD + 8 * D, nullptr, nullptr, nullptr, nullptr};
        pg8::gemm_phase<pg8::EpiResid<false, 1, true, false>, pg8::StaticOrder, false, PG8_SP2>(ldsl + RING_OFF, g, S, E, wave);
    }
#undef IN
#undef BOTH
#undef GRID_BAR
}

extern "C" void kernel_launch(void* const* d_in, const int* in_sizes, int n_in, void* d_out, int out_size, void* d_ws, size_t ws_size, hipStream_t stream) {
    static int grid = 0;
    if (grid == 0) {
        if (n_in != 26 || in_sizes[0] != M * D || out_size != M * D || ws_size < WS_END) { fprintf(stderr, "kernel_launch: unexpected shapes: n_in %d in0 %d out %d ws %zu (need >= %zu)\n", n_in, n_in > 0 ? in_sizes[0] : -1, out_size, ws_size, (size_t)WS_END); grid = -1; return; }
        int dev = 0, cus = 0;
        if (hipGetDevice(&dev) != hipSuccess || hipDeviceGetAttribute(&cus, hipDeviceAttributeMultiprocessorCount, dev) != hipSuccess) { grid = -1; return; }
        if (hipFuncSetAttribute((const void*)layer_fwd, hipFuncAttributeMaxDynamicSharedMemorySize, LDS_BYTES) != hipSuccess) { fprintf(stderr, "kernel_launch: hipFuncSetAttribute failed\n"); grid = -1; return; }
        int per_cu = 0;
        if (hipOccupancyMaxActiveBlocksPerMultiprocessor(&per_cu, (const void*)layer_fwd, NWAVES * 64, LDS_BYTES) != hipSuccess || per_cu < 1) fprintf(stderr, "kernel_launch: occupancy query says %d\n", per_cu);
        (void)hipGetLastError();
        grid = cus;
        if (grid != 256) fprintf(stderr, "kernel_launch: %d CUs; the one-unit-per-workgroup phases need exactly 256\n", grid);
    }
    if (grid < 0) return;
    (void)hipMemsetAsync((char*)d_ws + WS_CTL, 0, CTL_ZERO_BYTES, stream);
    Args a{};
    for (int i = 0; i < 26; ++i) a.in[i] = d_in[i];
    a.out = (float*)d_out; a.ws = (unsigned char*)d_ws;
    for (int li = 0; li < N_LAUNCHES; ++li) {
        a.ph_lo = (N_LAUNCHES == PER_PHASE) ? li : 0; a.ph_hi = (N_LAUNCHES == PER_PHASE) ? li + 1 : PER_PHASE; a.li = li;
        hipLaunchKernelGGL(layer_fwd, dim3(grid), dim3(NWAVES * 64), LDS_BYTES, stream, a);
    }
}
```

```cpp
#include <hip/hip_runtime.h>
#include <cstdio>
#include <cstdint>
#include <cmath>
__device__ __forceinline__ int mk_lane_() { int l; asm volatile("v_mbcnt_lo_u32_b32 %0, -1, 0\n\tv_mbcnt_hi_u32_b32 %0, -1, %0" : "=v"(l)); return l; }
#define MK_LANE() mk_lane_()
namespace pg8 {
#define PG8_LAS __attribute__((address_space(3)))
typedef unsigned short bf16_t;
typedef short bf16x8 __attribute__((ext_vector_type(8)));
typedef float f32x4 __attribute__((ext_vector_type(4)));
typedef unsigned u32x4 __attribute__((ext_vector_type(4)));
constexpr int BM = 256, BK = 64, HALF = 128, HTB = HALF * BK * 2  , STAGE_BYTES = 8 * HTB, NXCD = 8, WGM = 8;

__host__ __device__ __forceinline__ int lds_byte(int r, int c) { const int st = (r >> 4) * 2 + (c >> 5), rr = r & 15, cc = c & 31, ob = rr * 64 + cc * 2; return st * 1024 + (ob ^ (((ob >> 9) & 1) << 5)); }
__host__ __device__ __forceinline__ void stage_rc(int b, int& R, int& C) { const int st = b / 1024, sb = b % 1024, swz = sb ^ (((sb >> 9) & 1) << 5); R = (st >> 1) * 16 + swz / 64; C = (st & 1) * 32 + (swz % 64) / 2; }
__host__ __device__ __forceinline__ int perm32(int rho) { const int n = rho >> 4, i = rho & 15; return 8 * (i >> 2) + 4 * n + (i & 3); }

struct Unit { int pm, pn, ko; };
struct Gemm { const bf16_t* A; const bf16_t* Bt; int M, N, K; int KL = 0; };

struct StaticOrder {
    int nM, nN, nwg, G, c;
    __host__ __device__ void init(int M, int N, int G_, int c_) { nM = M / BM; nN = N / BM; nwg = nM * nN; G = G_; c = c_; }
    __host__ __device__ bool next(int i, Unit& u) const {
        const long L = (long)i * G + c; if (L >= nwg) return false;
        int wgid = (int)L; { const int q = nwg / NXCD, r = nwg % NXCD, xcd = wgid % NXCD, off = wgid / NXCD; wgid = (xcd < r ? xcd * (q + 1) : r * (q + 1) + (xcd - r) * q) + off; }
        const int nig = WGM * nN, gid = wgid / nig, fm = gid * WGM, gsz = (nM - fm) < WGM ? (nM - fm) : WGM;
        u.pm = fm + ((wgid % nig) % gsz); u.pn = (wgid % nig) / gsz; u.ko = 0; return true;
    }
    __device__ __forceinline__ void a_ready(const Unit&) const {}
    __device__ __forceinline__ void done(const Unit&) const {}
};
struct PairOrder {
    StaticOrder S; int khalf_bytes;
    __host__ __device__ void init(int M, int N, int G_, int c_, int K) { S.init(M, N, G_, c_); khalf_bytes = K;   }
    __host__ __device__ bool next(int i, Unit& u) const { if (!S.next(i >> 1, u)) return false; u.ko = (i & 1) * khalf_bytes; return true; }
    __device__ __forceinline__ void a_ready(const Unit&) const {}
    __device__ __forceinline__ void done(const Unit&) const {}
};

__device__ __forceinline__ unsigned cvt_pk_bf16(float lo, float hi) { unsigned r; asm volatile("v_cvt_pk_bf16_f32 %0, %1, %2" : "=v"(r) : "v"(lo), "v"(hi)); return r; }
__device__ __forceinline__ float bf_lo(unsigned w) { return __uint_as_float(w << 16); }
__device__ __forceinline__ float bf_hi(unsigned w) { return __uint_as_float(w & 0xffff0000u); }
constexpr float RMS_EPS = 1e-6f, LOG2E = 1.4426950408889634f;
__device__ __forceinline__ float row_rinv(const float* rss, int row) { const f32x4 s = *(const f32x4*)(rss + (size_t)row * 4); return rsqrtf(((s[0] + s[1]) + (s[2] + s[3])) * (1.0f / 1024.0f) + RMS_EPS); }
__device__ __forceinline__ float fast_sigmoid(float v) { return __builtin_amdgcn_rcpf(1.0f + __builtin_amdgcn_exp2f(-v * LOG2E)); }

struct EpiSwiGLU {
    static constexpr bool PERM = true, AFTER_DRAIN = false, PREFETCH = true, CHAIN = false;
    bf16_t* H; int ldh; const float* rss; const float* cb; int ncb;
    __device__ __forceinline__ void prefetch(const Unit& u, PG8_LAS unsigned char* buf, int wid, int lane) const {
        if (wid < 4) __builtin_amdgcn_global_load_lds((const unsigned*)(rss + (size_t)(u.pm * BM + wid * 64 + lane) * 4), (PG8_LAS unsigned*)(buf + wid * 1024), 16, 0, 0);
        else if (wid == 4) __builtin_amdgcn_global_load_lds((const unsigned*)(cb + (size_t)(u.pm >> 5) * ncb + u.pn * BM + lane * 4), (PG8_LAS unsigned*)(buf + 4096), 16, 0, 0);
    }
    __device__ __forceinline__ void operator()(const f32x4 (&acc)[2][2][4][2], const Unit& u, int wr, int wc, int fr, int fq, const PG8_LAS unsigned char* buf) const {
        const int outcol = u.pn * HALF + wc * 32 + 8 * fq;
        const PG8_LAS float* cbb = (const PG8_LAS float*)(buf + 4096) + wc * 32 + 8 * fq;
        const f32x4 bg0 = *(const PG8_LAS f32x4*)(cbb), bg1 = *(const PG8_LAS f32x4*)(cbb + 4), bu0 = *(const PG8_LAS f32x4*)(cbb + HALF), bu1 = *(const PG8_LAS f32x4*)(cbb + HALF + 4);
#pragma unroll
        for (int ai = 0; ai < 2; ++ai) {
#pragma unroll
            for (int m = 0; m < 4; ++m) {
                const int row = u.pm * BM + ai * HALF + wr * 64 + m * 16 + fr; const f32x4 sv_ = *(const PG8_LAS f32x4*)(buf + (ai * HALF + wr * 64 + m * 16 + fr) * 16); const float ri = rsqrtf(((sv_[0] + sv_[1]) + (sv_[2] + sv_[3])) * (1.0f / 1024.0f) + RMS_EPS);
                const f32x4 g0 = acc[ai][0][m][0] * ri + bg0, g1 = acc[ai][0][m][1] * ri + bg1, u0 = acc[ai][1][m][0] * ri + bu0, u1 = acc[ai][1][m][1] * ri + bu1;
                float o[8];
#pragma unroll
                for (int j = 0; j < 4; ++j) { o[j] = g0[j] * fast_sigmoid(g0[j]) * u0[j]; o[4 + j] = g1[j] * fast_sigmoid(g1[j]) * u1[j]; }
                u32x4 w; w.x = cvt_pk_bf16(o[0], o[1]); w.y = cvt_pk_bf16(o[2], o[3]); w.z = cvt_pk_bf16(o[4], o[5]); w.w = cvt_pk_bf16(o[6], o[7]);
                *(u32x4*)(H + (size_t)row * ldh + outcol) = w; } }
    }
};

struct EpiInProj {
    static constexpr bool PERM = true, AFTER_DRAIN = false, PREFETCH = true, CHAIN = false;
    bf16_t *QA, *KA, *VA, *QB, *KB, *VB, *GA, *GB; const float* rss; const float* cb; const bf16_t* ropet; const float *qn_a, *kn_a, *qn_b, *kn_b; float qscale;
    __device__ __forceinline__ void prefetch(const Unit& u, PG8_LAS unsigned char* buf, int wid, int lane) const {
        if (wid < 4) __builtin_amdgcn_global_load_lds((const unsigned*)(rss + (size_t)(u.pm * BM + wid * 64 + lane) * 4), (PG8_LAS unsigned*)(buf + wid * 1024), 16, 0, 0);
        else if (wid == 4) __builtin_amdgcn_global_load_lds((const unsigned*)(cb + (size_t)(u.pm >> 5) * 4352 + u.pn * BM + lane * 4), (PG8_LAS unsigned*)(buf + 4096), 16, 0, 0);
    }
    __device__ __forceinline__ void operator()(const f32x4 (&acc)[2][2][4][2], const Unit& u, int wr, int wc, int fr, int fq, const PG8_LAS unsigned char* buf) const {
        const int pn = u.pn;
        int mode; bf16_t* dst; int ld; const float* gain = qn_a; float scale = 1.f;
        if (pn < 2) { mode = 0; dst = QA + (4 * pn + wc) * 64; ld = 512; gain = qn_a; scale = qscale; }
        else if (pn == 2) { if (wc < 2) { mode = 0; dst = KA + wc * 64; ld = 128; gain = kn_a; } else { mode = 1; dst = VA + (wc - 2) * 64; ld = 128; } }
        else if (pn < 5) { mode = 0; dst = QB + (4 * (pn - 3) + wc) * 64; ld = 512; gain = qn_b; scale = qscale; }
        else if (pn < 7) { mode = 0; dst = KB + (4 * (pn - 5) + wc) * 64; ld = 512; gain = kn_b; }
        else if (pn < 9) { mode = 1; dst = VB + (4 * (pn - 7) + wc) * 64; ld = 512; }
        else if (pn < 13) { mode = 2; dst = GA + (pn - 9) * BM + wc * 32; ld = 1024; }
        else { mode = 2; dst = GB + (pn - 13) * BM + wc * 32; ld = 1024; }
        const int bjoff = (mode == 2) ? HALF : 32;
        const PG8_LAS float* cbb = (const PG8_LAS float*)(buf + 4096) + wc * 32 + 8 * fq;
        f32x4 bv[2][2];
#pragma unroll
        for (int bj = 0; bj < 2; ++bj)
#pragma unroll
            for (int n = 0; n < 2; ++n) bv[bj][n] = *(const PG8_LAS f32x4*)(cbb + bj * HALF + 4 * n);
        f32x4 gv[2][2];
#pragma unroll
        for (int bj = 0; bj < 2; ++bj)
#pragma unroll
            for (int n = 0; n < 2; ++n) gv[bj][n] = *(const f32x4*)(gain + bj * 32 + 8 * fq + 4 * n);
#pragma unroll
        for (int ai = 0; ai < 2; ++ai) {
            u32x4 csw[4], snw[4];
            if (mode == 0) {
#pragma unroll
              for (int m = 0; m < 4; ++m) { const bf16_t* tp = ropet + (size_t)(u.pm * BM + ai * HALF + wr * 64 + m * 16 + fr) * 64 + 8 * fq; csw[m] = *(const u32x4*)tp; snw[m] = *(const u32x4*)(tp + 32); } }
#pragma unroll
            for (int m = 0; m < 4; ++m) {
                const int row = u.pm * BM + ai * HALF + wr * 64 + m * 16 + fr; const f32x4 sv_ = *(const PG8_LAS f32x4*)(buf + (ai * HALF + wr * 64 + m * 16 + fr) * 16); const float ri = rsqrtf(((sv_[0] + sv_[1]) + (sv_[2] + sv_[3])) * (1.0f / 1024.0f) + RMS_EPS);
                f32x4 v[2][2];
#pragma unroll
                for (int bj = 0; bj < 2; ++bj)
#pragma unroll
                    for (int n = 0; n < 2; ++n) v[bj][n] = acc[ai][bj][m][n] * ri + bv[bj][n];
                if (mode == 0) {
                    float ss = 0.f;
#pragma unroll
                    for (int bj = 0; bj < 2; ++bj)
#pragma unroll
                        for (int n = 0; n < 2; ++n) ss += (v[bj][n][0] * v[bj][n][0] + v[bj][n][1] * v[bj][n][1]) + (v[bj][n][2] * v[bj][n][2] + v[bj][n][3] * v[bj][n][3]);
                    ss += __shfl_xor(ss, 16); ss += __shfl_xor(ss, 32);
                    const float rn = rsqrtf(ss * (1.0f / 64.0f) + RMS_EPS);
#pragma unroll
                    for (int n = 0; n < 2; ++n) {
                        const unsigned c0_ = n ? csw[m].z : csw[m].x, c1_ = n ? csw[m].w : csw[m].y, s0_ = n ? snw[m].z : snw[m].x, s1_ = n ? snw[m].w : snw[m].y;
                        const f32x4 cs = {bf_lo(c0_), bf_hi(c0_), bf_lo(c1_), bf_hi(c1_)}, sn = {bf_lo(s0_), bf_hi(s0_), bf_lo(s1_), bf_hi(s1_)};
                        const f32x4 lo = v[0][n] * rn * gv[0][n], hi = v[1][n] * rn * gv[1][n];
                        v[0][n] = (lo * cs - hi * sn) * scale; v[1][n] = (hi * cs + lo * sn) * scale; }
                } else if (mode == 2) {
#pragma unroll
                    for (int bj = 0; bj < 2; ++bj)
#pragma unroll
                        for (int n = 0; n < 2; ++n)
#pragma unroll
                            for (int j = 0; j < 4; ++j) v[bj][n][j] = fast_sigmoid(v[bj][n][j]);
                }
                bf16_t* rowp = dst + (size_t)row * ld + 8 * fq;
#pragma unroll
                for (int bj = 0; bj < 2; ++bj) { u32x4 w; w.x = cvt_pk_bf16(v[bj][0][0], v[bj][0][1]); w.y = cvt_pk_bf16(v[bj][0][2], v[bj][0][3]); w.z = cvt_pk_bf16(v[bj][1][0], v[bj][1][1]); w.w = cvt_pk_bf16(v[bj][1][2], v[bj][1][3]);
                    *(u32x4*)(rowp + bj * bjoff) = w; } } }
    }
};

struct EpiBranch {
    static constexpr bool PERM = true, AFTER_DRAIN = false, PREFETCH = false, CHAIN = true;
    const bf16_t* GA; const bf16_t* GB; bf16_t* MG;
    __device__ __forceinline__ void operator()(f32x4 (&acc)[2][2][4][2], const Unit& u, int wr, int wc, int fr, int fq) const {
        const bool second = u.ko != 0; constexpr float TINY = 8.67361738e-19f;
        const unsigned rowoff = (unsigned)((u.pm * BM + wr * 64 + fr) * 1024 + u.pn * BM + wc * 32 + 8 * fq);
#define EB_OFF(ai, bj, m) (rowoff + (unsigned)(((ai) * HALF + (m) * 16) * 1024 + (bj) * HALF))
#define EB_UNPACK(dst, src_) const float dst[8] = {bf_lo((src_).x), bf_hi((src_).x), bf_lo((src_).y), bf_hi((src_).y), bf_lo((src_).z), bf_hi((src_).z), bf_lo((src_).w), bf_hi((src_).w)}
        if (!second) {
#pragma unroll
            for (int ai = 0; ai < 2; ++ai)
#pragma unroll
                for (int bj = 0; bj < 2; ++bj) {
                    u32x4 gbv[4], gav[4];
#pragma unroll
                    for (int m = 0; m < 4; ++m) { gbv[m] = *(const u32x4*)(GB + EB_OFF(ai, bj, m)); gav[m] = *(const u32x4*)(GA + EB_OFF(ai, bj, m)); }
#pragma unroll
                    for (int m = 0; m < 4; ++m) { EB_UNPACK(gb, gbv[m]); EB_UNPACK(ga, gav[m]);
#pragma unroll
                        for (int e = 0; e < 4; ++e) { acc[ai][bj][m][0][e] *= ga[e] * __builtin_amdgcn_rcpf(fmaxf(gb[e], TINY)); acc[ai][bj][m][1][e] *= ga[4 + e] * __builtin_amdgcn_rcpf(fmaxf(gb[4 + e], TINY)); } }
                }
        } else {
#pragma unroll
            for (int ai = 0; ai < 2; ++ai) {
                u32x4 gbv[2][4];
#pragma unroll
                for (int bj = 0; bj < 2; ++bj)
#pragma unroll
                    for (int m = 0; m < 4; ++m) gbv[bj][m] = *(const u32x4*)(GB + EB_OFF(ai, bj, m));
#pragma unroll
                for (int bj = 0; bj < 2; ++bj)
#pragma unroll
                    for (int m = 0; m < 4; ++m) { EB_UNPACK(g0, gbv[bj][m]); float gb[8];
#pragma unroll
                        for (int e = 0; e < 8; ++e) gb[e] = fmaxf(g0[e], TINY);
                        const f32x4 y0 = acc[ai][bj][m][0], y1 = acc[ai][bj][m][1];
                        u32x4 w; w.x = cvt_pk_bf16(gb[0] * y0[0], gb[1] * y0[1]); w.y = cvt_pk_bf16(gb[2] * y0[2], gb[3] * y0[3]); w.z = cvt_pk_bf16(gb[4] * y1[0], gb[5] * y1[1]); w.w = cvt_pk_bf16(gb[6] * y1[2], gb[7] * y1[3]);
                        *(u32x4*)(MG + EB_OFF(ai, bj, m)) = w; }
            }
        }
#undef EB_OFF
#undef EB_UNPACK
    }
};

template <bool WRITE_A, int COEF2, bool RIN_BF16, bool ROUT_BF16> struct EpiResid {
    static constexpr bool PERM = true, AFTER_DRAIN = true, PREFETCH = false, CHAIN = false;
    static constexpr float coef = 0.5f * COEF2; static constexpr int modld = 9216;
    const void* xin; void* xout; const float* gate;
    bf16_t* Aout; const float* gnorm; const float* sc; float* rss_out;
    __device__ __forceinline__ void fused(f32x4 (&acc)[2][2][4][2], const Unit& u, int wr, int wc, int fr, int fq, PG8_LAS unsigned char* lds, int wid, int lane) const {
        const int b = u.pm >> 5, col0 = u.pn * BM + wc * 32 + 8 * fq;
        float ss[2][4];
#pragma unroll
        for (int ai = 0; ai < 2; ++ai)
#pragma unroll
            for (int m = 0; m < 4; ++m) ss[ai][m] = 0.f;
#pragma unroll
        for (int bj = 0; bj < 2; ++bj) {
            f32x4 gt[2], gvv[2];
#pragma unroll
            for (int n = 0; n < 2; ++n) { const int c = col0 + bj * HALF + 4 * n; gt[n] = *(const f32x4*)(gate + (size_t)b * modld + c) * coef;
                if (WRITE_A) gvv[n] = *(const f32x4*)(gnorm + c) * (*(const f32x4*)(sc + (size_t)b * modld + c) + 1.0f); }
#pragma unroll
            for (int ai = 0; ai < 2; ++ai) {
                f32x4 xi[4][2];
#pragma unroll
                for (int m = 0; m < 4; ++m) { const size_t off = (size_t)(u.pm * BM + ai * HALF + wr * 64 + m * 16 + fr) * 1024 + col0 + bj * HALF;
                    if constexpr (RIN_BF16) { const u32x4 w = *(const u32x4*)((const bf16_t*)xin + off); xi[m][0] = (f32x4){bf_lo(w.x), bf_hi(w.x), bf_lo(w.y), bf_hi(w.y)}; xi[m][1] = (f32x4){bf_lo(w.z), bf_hi(w.z), bf_lo(w.w), bf_hi(w.w)}; }
                    else {
#pragma unroll
                        for (int n = 0; n < 2; ++n) xi[m][n] = *(const f32x4*)((const float*)xin + off + 4 * n); } }
#pragma unroll
                for (int m = 0; m < 4; ++m) {
                    const int row = u.pm * BM + ai * HALF + wr * 64 + m * 16 + fr; const size_t off = (size_t)row * 1024 + col0 + bj * HALF; float s = 0.f;
                    f32x4 xo[2];
#pragma unroll
                    for (int n = 0; n < 2; ++n) { xo[n] = xi[m][n] + gt[n] * acc[ai][bj][m][n];
                        if constexpr (!ROUT_BF16) *(f32x4*)((float*)xout + off + 4 * n) = xo[n];
                        if (WRITE_A) s += (xo[n][0] * xo[n][0] + xo[n][1] * xo[n][1]) + (xo[n][2] * xo[n][2] + xo[n][3] * xo[n][3]); }
                    if constexpr (ROUT_BF16) { u32x4 w; w.x = cvt_pk_bf16(xo[0][0], xo[0][1]); w.y = cvt_pk_bf16(xo[0][2], xo[0][3]); w.z = cvt_pk_bf16(xo[1][0], xo[1][1]); w.w = cvt_pk_bf16(xo[1][2], xo[1][3]); *(u32x4*)((bf16_t*)xout + off) = w; }
                    if (WRITE_A) { const f32x4 a0 = xo[0] * gvv[0], a1 = xo[1] * gvv[1]; u32x4 w; w.x = cvt_pk_bf16(a0[0], a0[1]); w.y = cvt_pk_bf16(a0[2], a0[3]); w.z = cvt_pk_bf16(a1[0], a1[1]); w.w = cvt_pk_bf16(a1[2], a1[3]);
                        *(u32x4*)(Aout + off) = w; ss[ai][m] += s; } }
                asm volatile("" ::: "memory"); }
        }
        if (WRITE_A) {
            PG8_LAS float* P = (PG8_LAS float*)lds;
#pragma unroll
            for (int ai = 0; ai < 2; ++ai)
#pragma unroll
                for (int m = 0; m < 4; ++m) { float s = ss[ai][m]; s += __shfl_xor(s, 16); s += __shfl_xor(s, 32); if (fq == 0) P[(ai * HALF + wr * 64 + m * 16 + fr) * 4 + wc] = s; }
            asm volatile("s_waitcnt lgkmcnt(0)" ::: "memory"); __builtin_amdgcn_s_barrier(); asm volatile("" ::: "memory");
            const int t = wid * 64 + lane;
            if (t < 256) { const PG8_LAS float* p = P + t * 4; rss_out[(size_t)(u.pm * BM + t) * 4 + u.pn] = (p[0] + p[1]) + (p[2] + p[3]); }
        }
    }
};

template <class Epi, class Sched, bool ALIGN_EPI = false, bool SP2 = false>
__device__ __forceinline__ void gemm_phase(PG8_LAS unsigned char* lds, const Gemm g, const Sched S, const Epi E, const int wid  ) {
    const int lane = MK_LANE(), tid = wid * 64 + lane, wr = wid >> 2, wc = wid & 3, fr = lane & 15, fq = lane >> 4;
    const int K = g.K, nt = (g.KL ? g.KL : K) / BK;
    unsigned voffA[2], voffB[2];
#pragma unroll
    for (int i = 0; i < 2; ++i) { int R, C; stage_rc(tid * 16 + i * 8192, R, C); const int Rb = Epi::PERM ? ((R & ~31) + perm32(R & 31)) : R;
        voffA[i] = (unsigned)(R * K + C) * 2u; voffB[i] = (unsigned)(Rb * K + C) * 2u; }
    const size_t kstep = (size_t)(BK * 2);
    const size_t hstep = (size_t)HALF * K * 2;
    const size_t tstep = 2 * hstep;
    const unsigned ldsw = (unsigned)wid * 1024u;
    const int aoff = lds_byte(wr * 64 + fr, fq * 8), boff = lds_byte(wc * 32 + fr, fq * 8);
#define PG8_SA(b, h) (((b) * 2 + (h)) * HTB)
#define PG8_SB(b, h) ((4 + (b) * 2 + (h)) * HTB)
#define PG8_STAGE(bufoff, gbase, voff) do { _Pragma("unroll") for (int _i = 0; _i < 2; ++_i) \
        __builtin_amdgcn_global_load_lds((const unsigned*)((const char*)(gbase) + (voff)[_i]), (PG8_LAS unsigned*)(lds + (bufoff) + ldsw + _i * 8192), 16, 0, 0); } while (0)
#define PG8_LDA(dst, b, h) do { _Pragma("unroll") for (int m = 0; m < 4; ++m) _Pragma("unroll") for (int k = 0; k < 2; ++k) dst[m][k] = *(const PG8_LAS bf16x8*)(lds + PG8_SA(b, h) + aoff + m * 2048 + k * 1024); } while (0)
#define PG8_LDB(dst, b, h) do { _Pragma("unroll") for (int n = 0; n < 2; ++n) _Pragma("unroll") for (int k = 0; k < 2; ++k) dst[n][k] = *(const PG8_LAS bf16x8*)(lds + PG8_SB(b, h) + boff + n * 2048 + k * 1024); } while (0)
#define PG8_MMA(ai, bj, At, Bt) do { __builtin_amdgcn_s_setprio(1); _Pragma("unroll") for (int m = 0; m < 4; ++m) _Pragma("unroll") for (int n = 0; n < 2; ++n) _Pragma("unroll") for (int k = 0; k < 2; ++k) \
        acc[ai][bj][m][n] = __builtin_amdgcn_mfma_f32_16x16x32_bf16(Bt[n][k], At[m][k], acc[ai][bj][m][n], 0, 0, 0); __builtin_amdgcn_s_setprio(0); } while (0)
#define PG8_WAIT_V(n) asm volatile("s_waitcnt vmcnt(" #n ")" ::: "memory")
#define PG8_WAIT_L(n) asm volatile("s_waitcnt lgkmcnt(" #n ")" ::: "memory")
#define PG8_BAR __builtin_amdgcn_s_barrier()
#define PG8_SCHED __builtin_amdgcn_sched_barrier(0)
    Unit cur, nxt; int ui = 0;
    if (!S.next(0, cur)) return;
    f32x4 acc[2][2][4][2];
#pragma unroll
    for (int a = 0; a < 2; ++a)
#pragma unroll
        for (int b = 0; b < 2; ++b)
#pragma unroll
            for (int m = 0; m < 4; ++m)
#pragma unroll
                for (int n = 0; n < 2; ++n) acc[a][b][m][n] = (f32x4){0.f, 0.f, 0.f, 0.f};
    bf16x8 At[4][2], B0[2][2], B1[2][2];
    const char* cA = (const char*)g.A + (size_t)cur.pm * tstep + cur.ko; const char* cB = (const char*)g.Bt + (size_t)cur.pn * tstep + cur.ko;
    S.a_ready(cur);
    if constexpr (SP2) {
        PG8_STAGE(PG8_SB(0, 0), cB, voffB); PG8_STAGE(PG8_SB(0, 1), cB + hstep, voffB); PG8_STAGE(PG8_SA(0, 0), cA, voffA); PG8_STAGE(PG8_SA(0, 1), cA + hstep, voffA);
        if (wr == 1) PG8_BAR;
        PG8_WAIT_V(2); PG8_BAR;
        PG8_STAGE(PG8_SB(1, 0), cB + kstep, voffB); PG8_STAGE(PG8_SA(1, 0), cA + kstep, voffA); PG8_STAGE(PG8_SB(1, 1), cB + hstep + kstep, voffB);
        PG8_WAIT_V(6); PG8_BAR;
    } else {
        PG8_STAGE(PG8_SB(0, 0), cB, voffB); PG8_STAGE(PG8_SA(0, 0), cA, voffA); PG8_STAGE(PG8_SB(0, 1), cB + hstep, voffB); PG8_STAGE(PG8_SA(0, 1), cA + hstep, voffA);
        if (wr == 1) PG8_BAR;
        PG8_WAIT_V(4); PG8_BAR;
        PG8_STAGE(PG8_SB(1, 0), cB + kstep, voffB); PG8_STAGE(PG8_SA(1, 0), cA + kstep, voffA); PG8_STAGE(PG8_SB(1, 1), cB + hstep + kstep, voffB);
        PG8_WAIT_V(6); PG8_BAR;
    }
    for (;;) {
        if constexpr (Epi::PREFETCH) E.prefetch(cur, lds + STAGE_BYTES + (ui & 1) * 5120, wid, lane);
        const bool has_next = S.next(ui + 1, nxt);
        const char* nA = has_next ? (const char*)g.A + (size_t)nxt.pm * tstep + nxt.ko : cA; const char* nB = has_next ? (const char*)g.Bt + (size_t)nxt.pn * tstep + nxt.ko : cB;
        for (int t = 0; t < nt; t += 2) {
            const bool last = (t == nt - 2);
            const char* a1 = cA + (size_t)(t + 1) * kstep;
            const char* a2 = last ? nA : cA + (size_t)(t + 2) * kstep; const char* b2 = last ? nB : cB + (size_t)(t + 2) * kstep;
            const char* a3 = a2 + kstep; const char* b3 = b2 + kstep;
            if (last && has_next) S.a_ready(nxt);
            if constexpr (SP2) {
            PG8_LDB(B0, 0, 0); PG8_LDB(B1, 0, 1); PG8_SCHED; PG8_LDA(At, 0, 0); PG8_STAGE(PG8_SA(1, 1), a1 + hstep, voffA);
            PG8_WAIT_V(8); PG8_WAIT_L(0); PG8_BAR; PG8_MMA(0, 0, At, B0); PG8_MMA(0, 1, At, B1); PG8_BAR; PG8_SCHED;
            PG8_LDA(At, 0, 1); PG8_STAGE(PG8_SB(0, 0), b2, voffB); PG8_STAGE(PG8_SB(0, 1), b2 + hstep, voffB); PG8_STAGE(PG8_SA(0, 0), a2, voffA);
            PG8_WAIT_V(8); PG8_WAIT_L(0); PG8_BAR; PG8_MMA(1, 0, At, B0); PG8_MMA(1, 1, At, B1); PG8_BAR; PG8_SCHED;
            PG8_LDB(B0, 1, 0); PG8_LDB(B1, 1, 1); PG8_SCHED; PG8_LDA(At, 1, 0); PG8_STAGE(PG8_SA(0, 1), a2 + hstep, voffA);
            PG8_WAIT_V(8); PG8_WAIT_L(0); PG8_BAR; PG8_MMA(0, 0, At, B0); PG8_MMA(0, 1, At, B1); PG8_BAR; PG8_SCHED;
            PG8_LDA(At, 1, 1); PG8_STAGE(PG8_SB(1, 0), b3, voffB); PG8_STAGE(PG8_SB(1, 1), b3 + hstep, voffB); PG8_STAGE(PG8_SA(1, 0), a3, voffA);
            PG8_WAIT_V(8); PG8_WAIT_L(0); PG8_BAR; PG8_MMA(1, 0, At, B0); PG8_MMA(1, 1, At, B1); PG8_BAR; PG8_SCHED;
            } else {
            PG8_LDB(B0, 0, 0); PG8_SCHED; PG8_LDA(At, 0, 0); PG8_STAGE(PG8_SA(1, 1), a1 + hstep, voffA);
            PG8_WAIT_L(8); PG8_BAR; PG8_WAIT_L(0); PG8_MMA(0, 0, At, B0); PG8_BAR; PG8_SCHED;
            PG8_LDB(B1, 0, 1); PG8_STAGE(PG8_SB(0, 0), b2, voffB);
            PG8_BAR; PG8_WAIT_L(0); PG8_MMA(0, 1, At, B1); PG8_BAR;
            PG8_LDA(At, 0, 1); PG8_STAGE(PG8_SA(0, 0), a2, voffA);
            PG8_BAR; PG8_WAIT_L(0); PG8_MMA(1, 0, At, B0); PG8_BAR; PG8_SCHED;
            PG8_STAGE(PG8_SB(0, 1), b2 + hstep, voffB);
            PG8_WAIT_V(6); PG8_BAR; PG8_MMA(1, 1, At, B1); PG8_BAR;
            PG8_LDB(B0, 1, 0); PG8_SCHED; PG8_LDA(At, 1, 0); PG8_STAGE(PG8_SA(0, 1), a2 + hstep, voffA);
            PG8_WAIT_L(8); PG8_BAR; PG8_WAIT_L(0); PG8_MMA(0, 0, At, B0); PG8_BAR; PG8_SCHED;
            PG8_LDB(B1, 1, 1); PG8_STAGE(PG8_SB(1, 0), b3, voffB);
            PG8_BAR; PG8_WAIT_L(0); PG8_MMA(0, 1, At, B1); PG8_BAR;
            PG8_LDA(At, 1, 1); PG8_STAGE(PG8_SA(1, 0), a3, voffA);
            PG8_BAR; PG8_WAIT_L(0); PG8_MMA(1, 0, At, B0); PG8_BAR; PG8_SCHED;
            PG8_STAGE(PG8_SB(1, 1), b3 + hstep, voffB);
            PG8_WAIT_V(6); PG8_BAR; PG8_MMA(1, 1, At, B1); PG8_BAR;
            }
        }
        if constexpr (ALIGN_EPI) { if (wr == 0) PG8_BAR; }
        if constexpr (!Epi::AFTER_DRAIN) { if constexpr (Epi::PREFETCH) E(acc, cur, wr, wc, fr, fq, lds + STAGE_BYTES + (ui & 1) * 5120); else E(acc, cur, wr, wc, fr, fq); S.done(cur); }
        if (!has_next) break;
        if (!Epi::CHAIN || nxt.ko == 0) {
#pragma unroll
        for (int a = 0; a < 2; ++a)
#pragma unroll
            for (int b = 0; b < 2; ++b)
#pragma unroll
                for (int m = 0; m < 4; ++m)
#pragma unroll
                    for (int n = 0; n < 2; ++n) acc[a][b][m][n] = (f32x4){0.f, 0.f, 0.f, 0.f};
        }
        cur = nxt; cA = nA; cB = nB; ++ui;
        if constexpr (ALIGN_EPI) { if (wr == 1) PG8_BAR; }
    }
    PG8_WAIT_V(0);
    if constexpr (!ALIGN_EPI) { if (wr == 0) PG8_BAR; }
    PG8_BAR;
    if constexpr (Epi::AFTER_DRAIN) { E.fused(acc, cur, wr, wc, fr, fq, lds, wid, lane); S.done(cur); }
#undef PG8_SA
#undef PG8_SB
#undef PG8_STAGE
#undef PG8_LDA
#undef PG8_LDB
#undef PG8_MMA
#undef PG8_WAIT_V
#undef PG8_WAIT_L
#undef PG8_BAR
#undef PG8_SCHED
}
}

#ifndef PG8_SP2
#define PG8_SP2 true
#endif
#ifndef PG8_ALIGN
#define PG8_ALIGN true
#endif
namespace att {
using bf16x8 = __attribute__((ext_vector_type(8))) short;
using s16x4  = __attribute__((ext_vector_type(4))) short;
using f32x16 = __attribute__((ext_vector_type(16))) float;
using u32x4  = __attribute__((ext_vector_type(4))) unsigned;
typedef unsigned short bf16_t;
constexpr int NW = 8, QBLK = 32, KVBLK = 64;
#ifndef ATT_SDEPTH
#define ATT_SDEPTH 1
#endif
#define ATT_SBAR() __builtin_amdgcn_sched_barrier(0)
#define KSWZ64(row, colB) ((row) * 128 + ((colB) ^ ((((row) >> 1) & 7) << 4)))
__device__ __forceinline__ int crow(int r, int hi) { return (r & 3) + 8 * (r >> 2) + 4 * hi; }
__device__ __forceinline__ unsigned cvtpk(float lo, float hi) { unsigned r; asm volatile("v_cvt_pk_bf16_f32 %0, %1, %2" : "=v"(r) : "v"(lo), "v"(hi)); return r; }
__device__ __forceinline__ float bf2f(bf16_t h) { return __uint_as_float((unsigned)h << 16); }
template <int NCB> __device__ __forceinline__ int v_st(int k, int c) { const int kk = k; return ((kk >> 3) * NCB + (c >> 5)) * 512 + ((kk & 7) * 32 + (c & 31)) * 2; }
__device__ __forceinline__ int v_rd_base(int lane) { return ((lane & 3) << 3) | (((lane >> 2) & 3) << 6) | (((lane >> 4) & 1) << 5) | (((lane >> 5) & 1) << 8); }
template <int OFF> __device__ __forceinline__ s16x4 tr_read(int vb) { s16x4 r; asm volatile("ds_read_b64_tr_b16 %0, %1 offset:%2" : "=&v"(r) : "v"(vb), "i"(OFF) : "memory"); return r; }
template <int NCB, int D0> __device__ __forceinline__ void pv_one(f32x16& od, int vb, bf16x8 pa0, bf16x8 pa1, bf16x8 pa2, bf16x8 pa3) {
#define VOFF(ks, half) (D0 * 512 + (2 * (ks) + (half)) * (NCB * 512))
  const s16x4 l0 = tr_read<VOFF(0, 0)>(vb), h0 = tr_read<VOFF(0, 1)>(vb), l1 = tr_read<VOFF(1, 0)>(vb), h1 = tr_read<VOFF(1, 1)>(vb);
  const s16x4 l2 = tr_read<VOFF(2, 0)>(vb), h2 = tr_read<VOFF(2, 1)>(vb), l3 = tr_read<VOFF(3, 0)>(vb), h3 = tr_read<VOFF(3, 1)>(vb);
#undef VOFF
  asm volatile("s_waitcnt lgkmcnt(0)" ::: "memory"); ATT_SBAR();
#define PK(L, H) (bf16x8){L[0], L[1], L[2], L[3], H[0], H[1], H[2], H[3]}
  od = __builtin_amdgcn_mfma_f32_32x32x16_bf16(pa0, PK(l0, h0), od, 0, 0, 0);
  od = __builtin_amdgcn_mfma_f32_32x32x16_bf16(pa1, PK(l1, h1), od, 0, 0, 0);
  od = __builtin_amdgcn_mfma_f32_32x32x16_bf16(pa2, PK(l2, h2), od, 0, 0, 0);
  od = __builtin_amdgcn_mfma_f32_32x32x16_bf16(pa3, PK(l3, h3), od, 0, 0, 0);
#undef PK
}
__device__ __forceinline__ void qkt(f32x16& p0, f32x16& p1, const char* Ks, const bf16x8* qr, const f32x16& negm, int r32, int hi) {
#pragma unroll
  for (int d0 = 0; d0 < 4; ++d0) { const int cb = d0 * 32 + hi * 16;
    const bf16x8 b0 = *reinterpret_cast<const bf16x8*>(Ks + KSWZ64(r32, cb));
    const bf16x8 b1 = *reinterpret_cast<const bf16x8*>(Ks + KSWZ64(32 + r32, cb));
    if (d0 == 0) { p0 = __builtin_amdgcn_mfma_f32_32x32x16_bf16(b0, qr[0], negm, 0, 0, 0); p1 = __builtin_amdgcn_mfma_f32_32x32x16_bf16(b1, qr[0], negm, 0, 0, 0); }
    else { p0 = __builtin_amdgcn_mfma_f32_32x32x16_bf16(b0, qr[d0], p0, 0, 0, 0); p1 = __builtin_amdgcn_mfma_f32_32x32x16_bf16(b1, qr[d0], p1, 0, 0, 0); } }
}
template <bool WIN> __device__ __forceinline__ void wmask(f32x16& p0, f32x16& p1, int qpos, int kbase, int hi) {
  if constexpr (WIN) {
#pragma unroll
    for (int r = 0; r < 16; ++r) { const int k0 = kbase + crow(r, hi) - qpos; if (k0 > 128 || k0 < -128) p0[r] = -INFINITY; if (k0 + 32 > 128 || k0 + 32 < -128) p1[r] = -INFINITY; }
  }
}
__device__ __forceinline__ void exp_half(f32x16& p) {
#pragma unroll
  for (int r = 0; r < 16; ++r) p[r] = __builtin_amdgcn_exp2f(p[r]);
}
__device__ __forceinline__ void finish_sm(f32x16& p0, f32x16& p1, float& l_reg, bf16x8& pa0, bf16x8& pa1, bf16x8& pa2, bf16x8& pa3) {
  exp_half(p1);
  float ps = 0.f;
#pragma unroll
  for (int r = 0; r < 16; ++r) ps += p0[r];
#pragma unroll
  for (int r = 0; r < 16; ++r) ps += p1[r];
  l_reg += ps;
#define PK4(P, BASE, OUT) do { u32x4 w = {cvtpk(P[BASE + 0], P[BASE + 1]), cvtpk(P[BASE + 2], P[BASE + 3]), cvtpk(P[BASE + 4], P[BASE + 5]), cvtpk(P[BASE + 6], P[BASE + 7])}; OUT = *reinterpret_cast<bf16x8*>(&w); } while (0)
  PK4(p0, 0, pa0); PK4(p0, 8, pa1); PK4(p1, 0, pa2); PK4(p1, 8, pa3);
#undef PK4
}
constexpr int NSLOT = 3, LDS_V = 0, LDS_K = NSLOT * KVBLK * 128 * 2, LDS_WS = LDS_K + 4 * KVBLK * 64 * 2, LDS_STG = LDS_WS + NW * 64 * 4, ATT_LDS_BYTES = LDS_STG + NW * 8192;
__device__ __forceinline__ void dma16(unsigned m0v, unsigned voff, __amdgpu_buffer_rsrc_t rs, unsigned soff) {
  unsigned keep;
  asm volatile("s_nop 4\n\ts_mov_b32 %0, m0\n\ts_mov_b32 m0, %1\n\ts_nop 0\n\tbuffer_load_dwordx4 %2, %3, %4 offen lds\n\ts_mov_b32 m0, %0" : "=&s"(keep) : "s"(m0v), "v"(voff), "s"(rs), "s"(soff) : "memory");
}
__device__ __forceinline__ void dma16x2(unsigned m0a, unsigned va, unsigned sa, unsigned m0b, unsigned vb, unsigned sb, __amdgpu_buffer_rsrc_t rs) {
  unsigned keep;
  asm volatile("s_nop 4\n\ts_mov_b32 %0, m0\n\ts_mov_b32 m0, %1\n\ts_nop 0\n\tbuffer_load_dwordx4 %2, %7, %3 offen lds\n\ts_mov_b32 m0, %4\n\ts_nop 0\n\tbuffer_load_dwordx4 %5, %7, %6 offen lds\n\ts_mov_b32 m0, %0"
               : "=&s"(keep) : "s"(m0a), "v"(va), "s"(sa), "s"(m0b), "v"(vb), "s"(sb), "s"(rs) : "memory");
}
__device__ __forceinline__ void dma16x3(unsigned m0a, unsigned va, unsigned sa, unsigned m0b, unsigned vb, unsigned m0c, unsigned vc, unsigned sbc, __amdgpu_buffer_rsrc_t rs) {
  unsigned keep;
  asm volatile("s_nop 4\n\ts_mov_b32 %0, m0\n\ts_mov_b32 m0, %1\n\ts_nop 0\n\tbuffer_load_dwordx4 %2, %9, %3 offen lds\n\ts_mov_b32 m0, %4\n\ts_nop 0\n\tbuffer_load_dwordx4 %5, %9, %8 offen lds\n\ts_mov_b32 m0, %6\n\ts_nop 0\n\tbuffer_load_dwordx4 %7, %9, %8 offen lds\n\ts_mov_b32 m0, %0"
               : "=&s"(keep) : "s"(m0a), "v"(va), "s"(sa), "s"(m0b), "v"(vb), "s"(m0c), "v"(vc), "s"(sbc), "s"(rs) : "memory");
}
template <int NCB, bool WIN>
__device__ __forceinline__ void attn_pass(__amdgpu_buffer_rsrc_t rs, unsigned Qb, unsigned ldq, unsigned Kh, unsigned ldk, unsigned Vh, unsigned ldv, int seq, int qpos0, int kpos0, float negm_s, char* lds, f32x16 (&o)[NCB], float& l_out, const int wid) {
  constexpr int DV = NCB * 32, SLOTV = KVBLK * DV * 2, SLOTK = KVBLK * 64 * 2, NVP = NCB / 2;
  const int lane = MK_LANE(), r32 = lane & 31, hi = lane >> 5;
  const unsigned lds0 = (unsigned)(uintptr_t)lds;
  char* V_lds = lds + LDS_V; char* K_lds = lds + LDS_K;
  bf16x8 qr[4];
  { const unsigned qoff = (unsigned)(wid * QBLK + r32) * ldq + hi * 16;
#pragma unroll
    for (int d0 = 0; d0 < 4; ++d0) { const u32x4 w = __builtin_amdgcn_raw_buffer_load_b128(rs, qoff + d0 * 32, Qb, 0); qr[d0] = __builtin_bit_cast(bf16x8, w); } }
  f32x16 negm; { float ns = negm_s; asm volatile("" : "+v"(ns));
#pragma unroll
  for (int r = 0; r < 16; ++r) negm[r] = ns; }
  asm volatile("" : "+v"(negm));
#pragma unroll
  for (int d = 0; d < NCB; ++d) o[d] = f32x16{};
  float l_reg = 0.f;
  unsigned kvoff, vvoff[NVP];
  { const int ob = wid * 1024 + lane * 16, row = ob >> 7, ch = ((ob >> 4) & 7) ^ ((row >> 1) & 7); kvoff = (unsigned)row * ldk + ch * 16; }
#pragma unroll
  for (int i = 0; i < NVP; ++i) { const int ob = (wid * NVP + i) * 1024 + lane * 16, st = ob >> 9, k = (st / NCB) * 8 + ((ob >> 6) & 7), c = (st % NCB) * 32 + ((ob >> 4) & 3) * 8;
    vvoff[i] = (unsigned)k * ldv + c * 2; }
  const unsigned kdst = lds0 + LDS_K + wid * 1024, vdst = lds0 + LDS_V + wid * NVP * 1024;
#define DMA_K(t, slot) dma16(kdst + (slot) * SLOTK, kvoff, rs, Kh + (unsigned)(t) * (KVBLK * ldk))
#define DMA_V(t, slot) do { _Pragma("unroll") for (int i_ = 0; i_ < NVP; ++i_) dma16(vdst + (slot) * SLOTV + i_ * 1024, vvoff[i_], rs, Vh + (unsigned)(t) * (KVBLK * ldv)); } while (0)
#define WAIT_BAR(N) asm volatile("s_waitcnt vmcnt(" #N ") lgkmcnt(0)\n\ts_barrier" ::: "memory")
#define WAIT_BAR_STEP() do { if (NVP == 2) WAIT_BAR(3); else WAIT_BAR(2); } while (0)
  const int vb0 = (int)(lds0 + LDS_V) + v_rd_base(lane);
  const int qpos = qpos0 + wid * QBLK + r32;
#define PVALL(vb) do { pv_one<NCB, 0>(o[0], vb, pa0, pa1, pa2, pa3); pv_one<NCB, 1>(o[1], vb, pa0, pa1, pa2, pa3); if constexpr (NCB == 4) { pv_one<NCB, 2>(o[2], vb, pa0, pa1, pa2, pa3); pv_one<NCB, 3>(o[3], vb, pa0, pa1, pa2, pa3); } } while (0)
  f32x16 pA0, pA1, pB0, pB1; bf16x8 pa0, pa1, pa2, pa3; const int NT = seq / KVBLK;
  DMA_K(0, 0); DMA_V(0, 0); DMA_K(1, 1);
  if (NVP == 2) WAIT_BAR(3); else WAIT_BAR(2);
  qkt(pA0, pA1, K_lds, qr, negm, r32, hi); wmask<WIN>(pA0, pA1, qpos, kpos0, hi); exp_half(pA0);
  DMA_K(2, 2); DMA_V(1, 1);
  WAIT_BAR_STEP();
  int s0 = 0, s1 = 1, s2 = 2;
#define ROT() do { const int t_ = s0; s0 = s1; s1 = s2; s2 = t_; } while (0)
#define DMA_KV(t) do { if constexpr (NVP == 2) dma16x3(kdst + s0 * SLOTK, kvoff, Kh + (unsigned)((t) + 3) * (KVBLK * ldk), vdst + s2 * SLOTV, vvoff[0], vdst + s2 * SLOTV + 1024, vvoff[NVP - 1], Vh + (unsigned)((t) + 2) * (KVBLK * ldv), rs); \
    else dma16x2(kdst + s0 * SLOTK, kvoff, Kh + (unsigned)((t) + 3) * (KVBLK * ldk), vdst + s2 * SLOTV, vvoff[0], Vh + (unsigned)((t) + 2) * (KVBLK * ldv), rs); } while (0)
  const int wq_lo = qpos0 + wid * QBLK, wq_hi = wq_lo + QBLK - 1;
#define T_NEED(j) (!WIN || ((kpos0 + (j) * KVBLK + KVBLK - 1 >= wq_lo - 128) && (kpos0 + (j) * KVBLK <= wq_hi + 128)))
#define T_FULL(j) ((kpos0 + (j) * KVBLK >= wq_hi - 128) && (kpos0 + (j) * KVBLK + KVBLK - 1 <= wq_lo + 128))
#define STEP(Pc0, Pc1, Pn0, Pn1, t, DOK, DOV, DOQK) do { \
    if (DOK && DOV) DMA_KV(t); else { if (DOK) DMA_K((t) + 3, s0); if (DOV) DMA_V((t) + 2, s2); } \
    const bool nc_ = T_NEED(t), nn_ = DOQK && T_NEED((t) + 1); \
    ATT_SBAR(); if (nn_) { qkt(Pn0, Pn1, K_lds + s1 * SLOTK, qr, negm, r32, hi); if (WIN && !T_FULL((t) + 1)) wmask<WIN>(Pn0, Pn1, qpos, kpos0 + ((t) + 1) * KVBLK, hi); } \
    if (nc_) { finish_sm(Pc0, Pc1, l_reg, pa0, pa1, pa2, pa3); } ATT_SBAR(); \
    if (nc_) { PVALL(vb0 + s0 * SLOTV); } if (nn_) exp_half(Pn0); } while (0)
  int t = 0;
  for (; t + 4 < NT; t += 2) {
    STEP(pA0, pA1, pB0, pB1, t, true, true, true); WAIT_BAR_STEP(); ROT();
    STEP(pB0, pB1, pA0, pA1, t + 1, true, true, true); WAIT_BAR_STEP(); ROT();
  }
  STEP(pA0, pA1, pB0, pB1, t, true, true, true); WAIT_BAR_STEP(); ROT();
  STEP(pB0, pB1, pA0, pA1, t + 1, false, true, true); WAIT_BAR(0); ROT();
  STEP(pA0, pA1, pB0, pB1, t + 2, false, false, true); WAIT_BAR(0); ROT();
  STEP(pB0, pB1, pA0, pA1, t + 3, false, false, false);
  { auto rr = __builtin_amdgcn_permlane32_swap(__float_as_uint(l_reg), __float_as_uint(l_reg), false, false); l_out = __uint_as_float(rr[0]) + __uint_as_float(rr[1]); }
  WAIT_BAR(0);
#undef DMA_K
#undef DMA_V
#undef WAIT_BAR
#undef WAIT_BAR_STEP
#undef PVALL
#undef ROT
#undef STEP
#undef DMA_KV
#undef T_NEED
#undef T_FULL
}
typedef __attribute__((address_space(3))) const char* lds_cptr;
typedef short v4i16_t __attribute__((ext_vector_type(4)));
__device__ __forceinline__ s16x4 vtr(lds_cptr p) { return __builtin_bit_cast(s16x4, __builtin_amdgcn_ds_read_tr16_b64_v4i16((__attribute__((address_space(3))) v4i16_t*)p)); }
__device__ __forceinline__ bf16x8 kld(lds_cptr p) { return *(const __attribute__((address_space(3))) bf16x8*)p; }
__device__ __forceinline__ void attn_pass_d4(__amdgpu_buffer_rsrc_t rs, unsigned Qb, unsigned ldq, unsigned Kh, unsigned ldk, unsigned Vh, unsigned ldv, int seq, float negm_s, char* lds, f32x16 (&o)[4], float& l_out, const int wid) {
  constexpr int SLOTV = KVBLK * 128 * 2, SLOTK = KVBLK * 64 * 2;
  const int lane = MK_LANE(), r32 = lane & 31, hi = lane >> 5;
  const unsigned lds0 = (unsigned)(uintptr_t)lds;
  bf16x8 qr[4];
  { const unsigned qoff = (unsigned)(wid * QBLK + r32) * ldq + hi * 16;
#pragma unroll
    for (int d0 = 0; d0 < 4; ++d0) { const u32x4 w = __builtin_amdgcn_raw_buffer_load_b128(rs, qoff + d0 * 32, Qb, 0); qr[d0] = __builtin_bit_cast(bf16x8, w); } }
  f32x16 negm; { float ns = negm_s; asm volatile("" : "+v"(ns));
#pragma unroll
  for (int r = 0; r < 16; ++r) negm[r] = ns; }
  asm volatile("" : "+v"(negm));
#pragma unroll
  for (int d = 0; d < 4; ++d) o[d] = f32x16{};
  float l_reg = 0.f;
  const unsigned kvoff = (unsigned)lane * ldk + wid * 16;
  unsigned vvoff0, vvoff1;
  { const int ob = (wid * 2 + 0) * 1024 + lane * 16, st = ob >> 9, k = (st / 4) * 8 + ((ob >> 6) & 7), c = (st % 4) * 32 + ((ob >> 4) & 3) * 8; vvoff0 = (unsigned)k * ldv + c * 2; }
  { const int ob = (wid * 2 + 1) * 1024 + lane * 16, st = ob >> 9, k = (st / 4) * 8 + ((ob >> 6) & 7), c = (st % 4) * 32 + ((ob >> 4) & 3) * 8; vvoff1 = (unsigned)k * ldv + c * 2; }
  const unsigned kdst = lds0 + LDS_K + wid * 1024, vdst = lds0 + LDS_V + wid * 2048;
  const lds_cptr kp0 = (lds_cptr)lds + LDS_K + hi * 1024 + r32 * 16;
  const lds_cptr vp0 = (lds_cptr)lds + LDS_V + v_rd_base(lane);
  const int NT = seq / KVBLK;
#define D4_PIN(x) asm volatile("" : "+v"(x))
#define D4_MFMA(a, b, c) __builtin_amdgcn_mfma_f32_32x32x16_bf16(a, b, c, 0, 0, 0)
#define D4_WAIT_BAR(N) asm volatile("s_waitcnt vmcnt(" #N ") lgkmcnt(0)\n\ts_barrier" ::: "memory")
#define D4_KSLOT(t) ((unsigned)((t) & 3) * SLOTK)
#define D4_DMA_K(t) dma16(kdst + D4_KSLOT(t), kvoff, rs, Kh + (unsigned)(t) * (KVBLK * ldk))
#define D4_DMA_V(t, sl) dma16x2(vdst + (sl), vvoff0, Vh + (unsigned)(t) * (KVBLK * ldv), vdst + (sl) + 1024, vvoff1, Vh + (unsigned)(t) * (KVBLK * ldv), rs)
#define D4_DMA_KV(tk, tv, sl) dma16x3(kdst + D4_KSLOT(tk), kvoff, Kh + (unsigned)(tk) * (KVBLK * ldk), vdst + (sl), vvoff0, vdst + (sl) + 1024, vvoff1, Vh + (unsigned)(tv) * (KVBLK * ldv), rs)
  f32x16 pA0, pA1, pB0, pB1; bf16x8 kf[4]; s16x4 vl[5], vh[5]; u32x4 pw0, pw1, pw2, pw3;
#define D4_KRD(buf, kp, j) kf[buf] = kld((kp) + ((j) >> 1) * 2048 + ((j) & 1) * 512)
#define D4_VO(f, half) (((f) >> 2) * 512 + (2 * ((f) & 3) + (half)) * 2048)
#define D4_VRD(f) do { vl[(f) % 5] = vtr(vp_ + D4_VO(f, 0)); vh[(f) % 5] = vtr(vp_ + D4_VO(f, 1)); } while (0)
#define D4_VFR(f) (bf16x8){vl[(f) % 5][0], vl[(f) % 5][1], vl[(f) % 5][2], vl[(f) % 5][3], vh[(f) % 5][0], vh[(f) % 5][1], vh[(f) % 5][2], vh[(f) % 5][3]}
#define D4_PKW(P, i) cvtpk(P[i], P[i + 1])
#define D4_PAF(k) __builtin_bit_cast(bf16x8, pw##k)
  D4_DMA_K(0); D4_DMA_V(0, 0); D4_DMA_K(1); D4_DMA_K(2); D4_DMA_KV(3, 1, SLOTV);
  D4_WAIT_BAR(3);
  { const lds_cptr kp_ = kp0;
    D4_KRD(0, kp_, 0); D4_KRD(1, kp_, 1); D4_KRD(2, kp_, 2); D4_KRD(3, kp_, 3);
    pA0 = D4_MFMA(kf[0], qr[0], negm); pA1 = D4_MFMA(kf[1], qr[0], negm); pA0 = D4_MFMA(kf[2], qr[1], pA0); pA1 = D4_MFMA(kf[3], qr[1], pA1);
    D4_KRD(0, kp_, 4); D4_KRD(1, kp_, 5); D4_KRD(2, kp_, 6); D4_KRD(3, kp_, 7);
    pA0 = D4_MFMA(kf[0], qr[2], pA0); pA1 = D4_MFMA(kf[1], qr[2], pA1); pA0 = D4_MFMA(kf[2], qr[3], pA0); pA1 = D4_MFMA(kf[3], qr[3], pA1);
    exp_half(pA0); exp_half(pA1);
    const lds_cptr kn_ = kp0 + SLOTK;
    D4_KRD(0, kn_, 0); D4_KRD(1, kn_, 1); D4_KRD(2, kn_, 2); D4_KRD(3, kn_, 3); }
  D4_WAIT_BAR(3);
  unsigned sl_prev = 0, sl_cur = SLOTV, sl_next = 2 * SLOTV;
#define D4_ROT() do { sl_prev = sl_cur; sl_cur = sl_next; sl_next = (sl_next == 2u * SLOTV) ? 0u : sl_next + SLOTV; } while (0)
#define D4_EX2(X, i) do { X[i] = __builtin_amdgcn_exp2f(X[i]); X[(i) + 1] = __builtin_amdgcn_exp2f(X[(i) + 1]); } while (0)
#define D4_GAPA(MF, LD, a0, a1, a2, a3, W0, W1, PW) do { MF; LD; sacc += a0; sacc += a1; sacc += a2; sacc += a3; W0; W1; D4_PIN(PW); D4_PIN(sacc); ATT_SBAR(); } while (0)
#define D4_GAPB(i, X, xi, LD) do { o[(i) >> 2] = D4_MFMA(D4_PAFI(i), D4_VFR(i), o[(i) >> 2]); LD; D4_EX2(X, xi); D4_PIN(X); ATT_SBAR(); } while (0)
#define D4_PAFI(i) (((i) & 3) == 0 ? D4_PAF(0) : ((i) & 3) == 1 ? D4_PAF(1) : ((i) & 3) == 2 ? D4_PAF(2) : D4_PAF(3))
#define D4_PHA(C0, C1, P0, P1, t, VR) do { ATT_SBAR(); \
    const lds_cptr vp_ = vp0 + sl_prev; const lds_cptr kp_ = kp0 + D4_KSLOT(t); \
    float sacc = P0[0] + P0[1]; ATT_SBAR(); \
    D4_GAPA(C0 = D4_MFMA(kf[0], qr[0], negm), D4_KRD(0, kp_, 4), P0[2], P0[3], P0[4], P0[5],     pw0[0] = D4_PKW(P0, 0),  pw0[1] = D4_PKW(P0, 2),  pw0); \
    D4_GAPA(C1 = D4_MFMA(kf[1], qr[0], negm), D4_KRD(1, kp_, 5), P0[6], P0[7], P0[8], P0[9],     pw0[2] = D4_PKW(P0, 4),  pw0[3] = D4_PKW(P0, 6),  pw0); \
    D4_GAPA(C0 = D4_MFMA(kf[2], qr[1], C0),   D4_KRD(2, kp_, 6), P0[10], P0[11], P0[12], P0[13], pw1[0] = D4_PKW(P0, 8),  pw1[1] = D4_PKW(P0, 10), pw1); \
    D4_GAPA(C1 = D4_MFMA(kf[3], qr[1], C1),   D4_KRD(3, kp_, 7), P0[14], P0[15], P1[0], P1[1],   pw1[2] = D4_PKW(P0, 12), pw1[3] = D4_PKW(P0, 14), pw1); \
    D4_GAPA(C0 = D4_MFMA(kf[0], qr[2], C0),   do { if (VR) D4_VRD(0); } while (0), P1[2], P1[3], P1[4], P1[5],     pw2[0] = D4_PKW(P1, 0),  pw2[1] = D4_PKW(P1, 2),  pw2); \
    D4_GAPA(C1 = D4_MFMA(kf[1], qr[2], C1),   do { if (VR) D4_VRD(1); } while (0), P1[6], P1[7], P1[8], P1[9],     pw2[2] = D4_PKW(P1, 4),  pw2[3] = D4_PKW(P1, 6),  pw2); \
    D4_GAPA(C0 = D4_MFMA(kf[2], qr[3], C0),   do { if (VR) D4_VRD(2); } while (0), P1[10], P1[11], P1[12], P1[13], pw3[0] = D4_PKW(P1, 8),  pw3[1] = D4_PKW(P1, 10), pw3); \
    D4_GAPA(C1 = D4_MFMA(kf[3], qr[3], C1),   do { if (VR) { D4_VRD(3); D4_VRD(4); } } while (0), P1[14], P1[15], 0.f, 0.f, pw3[2] = D4_PKW(P1, 12), pw3[3] = D4_PKW(P1, 14), pw3); \
    l_reg += sacc; } while (0)
#define D4_PHB(C0, C1, t, GK, GV, GL, PRE) do { ATT_SBAR(); \
    const lds_cptr vp_ = vp0 + sl_prev; const lds_cptr kn_ = kp0 + D4_KSLOT((t) + 1); \
    if (PRE) { D4_VRD(0); D4_VRD(1); D4_VRD(2); D4_VRD(3); D4_VRD(4); ATT_SBAR(); } \
    D4_GAPB(0, C0, 0, D4_VRD(5));   D4_GAPB(1, C0, 2, D4_VRD(6));   D4_GAPB(2, C0, 4, D4_VRD(7));    D4_GAPB(3, C0, 6, D4_VRD(8)); \
    D4_GAPB(4, C0, 8, D4_VRD(9));   D4_GAPB(5, C0, 10, D4_VRD(10)); D4_GAPB(6, C0, 12, D4_VRD(11));  D4_GAPB(7, C0, 14, do { D4_VRD(12); if (GL) D4_KRD(0, kn_, 0); } while (0)); \
    D4_GAPB(8, C1, 0, do { D4_VRD(13); if ((GK) && (GV)) D4_DMA_KV((t) + 3, (t) + 1, sl_next); else if (GV) D4_DMA_V((t) + 1, sl_next); } while (0)); \
    D4_GAPB(9, C1, 2, do { D4_VRD(14); if (GL) D4_KRD(1, kn_, 1); } while (0));  D4_GAPB(10, C1, 4, do { D4_VRD(15); if (GL) D4_KRD(2, kn_, 2); } while (0));  D4_GAPB(11, C1, 6, do { if (GL) D4_KRD(3, kn_, 3); } while (0)); \
    D4_GAPB(12, C1, 8, (void)0); D4_GAPB(13, C1, 10, (void)0); D4_GAPB(14, C1, 12, (void)0); D4_GAPB(15, C1, 14, (void)0); \
    } while (0)
  if (wid < 4) {
    int t = 1;
    for (; t + 4 < NT; t += 2) {
      D4_PHA(pB0, pB1, pA0, pA1, t, true);     D4_PHB(pB0, pB1, t, true, true, true, false);     D4_WAIT_BAR(3); D4_ROT();
      D4_PHA(pA0, pA1, pB0, pB1, t + 1, true); D4_PHB(pA0, pA1, t + 1, true, true, true, false); D4_WAIT_BAR(3); D4_ROT();
    }
    D4_PHA(pB0, pB1, pA0, pA1, t, true);     D4_PHB(pB0, pB1, t, false, true, true, false);      D4_WAIT_BAR(2); D4_ROT();
    D4_PHA(pA0, pA1, pB0, pB1, t + 1, true); D4_PHB(pA0, pA1, t + 1, false, true, true, false);  D4_WAIT_BAR(0); D4_ROT();
    D4_PHA(pB0, pB1, pA0, pA1, t + 2, true); D4_PHB(pB0, pB1, t + 2, false, false, false, false);
  } else {
    D4_PHA(pB0, pB1, pA0, pA1, 1, false);
    int t = 1;
    for (; t + 4 < NT; t += 2) {
      D4_PHB(pB0, pB1, t, true, true, true, true);     D4_PHA(pA0, pA1, pB0, pB1, t + 1, false); D4_WAIT_BAR(3); D4_ROT();
      D4_PHB(pA0, pA1, t + 1, true, true, true, true); D4_PHA(pB0, pB1, pA0, pA1, t + 2, false); D4_WAIT_BAR(3); D4_ROT();
    }
    D4_PHB(pB0, pB1, t, false, true, true, true);      D4_PHA(pA0, pA1, pB0, pB1, t + 1, false); D4_WAIT_BAR(2); D4_ROT();
    D4_PHB(pA0, pA1, t + 1, false, true, true, true);  D4_PHA(pB0, pB1, pA0, pA1, t + 2, false); D4_WAIT_BAR(0); D4_ROT();
    D4_PHB(pB0, pB1, t + 2, false, false, false, true);
  }
  { float sacc = pB0[0] + pB0[1];
#pragma unroll
    for (int r = 2; r < 16; ++r) sacc += pB0[r];
#pragma unroll
    for (int r = 0; r < 16; ++r) sacc += pB1[r];
    l_reg += sacc;
    pw0 = (u32x4){D4_PKW(pB0, 0), D4_PKW(pB0, 2), D4_PKW(pB0, 4), D4_PKW(pB0, 6)}; pw1 = (u32x4){D4_PKW(pB0, 8), D4_PKW(pB0, 10), D4_PKW(pB0, 12), D4_PKW(pB0, 14)};
    pw2 = (u32x4){D4_PKW(pB1, 0), D4_PKW(pB1, 2), D4_PKW(pB1, 4), D4_PKW(pB1, 6)}; pw3 = (u32x4){D4_PKW(pB1, 8), D4_PKW(pB1, 10), D4_PKW(pB1, 12), D4_PKW(pB1, 14)};
    const lds_cptr vp_ = vp0 + sl_cur;
    D4_VRD(0); D4_VRD(1); D4_VRD(2); D4_VRD(3); D4_VRD(4);
    o[0] = D4_MFMA(D4_PAF(0), D4_VFR(0), o[0]); D4_VRD(5); o[0] = D4_MFMA(D4_PAF(1), D4_VFR(1), o[0]); D4_VRD(6); o[0] = D4_MFMA(D4_PAF(2), D4_VFR(2), o[0]); D4_VRD(7); o[0] = D4_MFMA(D4_PAF(3), D4_VFR(3), o[0]); D4_VRD(8);
    o[1] = D4_MFMA(D4_PAF(0), D4_VFR(4), o[1]); D4_VRD(9); o[1] = D4_MFMA(D4_PAF(1), D4_VFR(5), o[1]); D4_VRD(10); o[1] = D4_MFMA(D4_PAF(2), D4_VFR(6), o[1]); D4_VRD(11); o[1] = D4_MFMA(D4_PAF(3), D4_VFR(7), o[1]); D4_VRD(12);
    o[2] = D4_MFMA(D4_PAF(0), D4_VFR(8), o[2]); D4_VRD(13); o[2] = D4_MFMA(D4_PAF(1), D4_VFR(9), o[2]); D4_VRD(14); o[2] = D4_MFMA(D4_PAF(2), D4_VFR(10), o[2]); D4_VRD(15); o[2] = D4_MFMA(D4_PAF(3), D4_VFR(11), o[2]);
    o[3] = D4_MFMA(D4_PAF(0), D4_VFR(12), o[3]); o[3] = D4_MFMA(D4_PAF(1), D4_VFR(13), o[3]); o[3] = D4_MFMA(D4_PAF(2), D4_VFR(14), o[3]); o[3] = D4_MFMA(D4_PAF(3), D4_VFR(15), o[3]); }
  { auto rr = __builtin_amdgcn_permlane32_swap(__float_as_uint(l_reg), __float_as_uint(l_reg), false, false); l_out = __uint_as_float(rr[0]) + __uint_as_float(rr[1]); }
  D4_WAIT_BAR(0);
#undef D4_PIN
#undef D4_MFMA
#undef D4_WAIT_BAR
#undef D4_KSLOT
#undef D4_DMA_K
#undef D4_DMA_V
#undef D4_DMA_KV
#undef D4_KRD
#undef D4_VO
#undef D4_VRD
#undef D4_VFR
#undef D4_PKW
#undef D4_PAF
#undef D4_PAFI
#undef D4_ROT
#undef D4_EX2
#undef D4_GAPA
#undef D4_GAPB
#undef D4_PHA
#undef D4_PHB
}
__device__ __forceinline__ void row_recips(float l, float extra, float* wsf, int r32, int hi, float (&rli)[16]) {
  if (hi == 0) wsf[r32] = l + extra; asm volatile("s_waitcnt lgkmcnt(0)" ::: "memory");
#pragma unroll
  for (int r = 0; r < 16; ++r) rli[r] = __builtin_amdgcn_rcpf(wsf[crow(r, hi)]);
  asm volatile("s_waitcnt lgkmcnt(0)" ::: "memory");
}

__device__ __forceinline__ void win_unit(__amdgpu_buffer_rsrc_t rs, const char* wsb, int b, int hq, int qb, const bf16_t* QA, const bf16_t* KA, const bf16_t* VA, bf16_t* ACAT, const float* scal, char* lds, const int wid) {
  constexpr int S = 8192;
  const int lane0 = MK_LANE(), kvh = hq >> 2;
  const int q0 = qb * 256; int kbeg = q0 - 128, kend = q0 + 384; if (kbeg < 0) kbeg = 0; if (kend > S) kend = S;
  const size_t rowbase = (size_t)b * S;
  f32x16 o[2]; float l;
  attn_pass<2, true>(rs, (unsigned)((const char*)(QA + (rowbase + q0) * 512 + hq * 64) - wsb), 1024u, (unsigned)((const char*)(KA + (rowbase + kbeg) * 128 + kvh * 64) - wsb), 256u, (unsigned)((const char*)(VA + (rowbase + kbeg) * 128 + kvh * 64) - wsb), 256u, kend - kbeg, q0, kbeg, scal[8 + hq], lds, o, l, wid);
  int r32 = lane0 & 31, hi = lane0 >> 5, lane = lane0; asm volatile("" : "+v"(r32), "+v"(hi), "+v"(lane));
  float* wsf = (float*)(lds + LDS_WS) + wid * 64; float rli[16];
  row_recips(l, scal[16 + hq], wsf, r32, hi, rli);
  bf16_t* stg = (bf16_t*)(lds + LDS_STG) + wid * 4096;
#pragma unroll
  for (int r = 0; r < 16; ++r) { const int orow = crow(r, hi);
#pragma unroll
    for (int d0 = 0; d0 < 2; ++d0) stg[orow * 64 + d0 * 32 + r32] = (bf16_t)(cvtpk(o[d0][r] * rli[r], 0.f) & 0xffffu); }
  asm volatile("s_waitcnt lgkmcnt(0)" ::: "memory");
  const int widl = wid;
  bf16_t* Ow = ACAT + (rowbase + q0) * 1024 + hq * 64 + (unsigned)((widl * QBLK + (lane >> 3)) * 1024 + (lane & 7) * 8);
  const bf16_t* sp = stg + (lane >> 3) * 64 + (lane & 7) * 8;
#pragma unroll
  for (int i = 0; i < 4; ++i) { const u32x4 v = *(const u32x4*)(sp + i * 512); *(u32x4*)(Ow + (size_t)i * 8192) = v; }
  asm volatile("s_waitcnt lgkmcnt(0)" ::: "memory"); __syncthreads();
}

__device__ __forceinline__ void win_unit2(__amdgpu_buffer_rsrc_t rs, const char* wsb, int b, int kvh, int qb, int pair, const bf16_t* QA, const bf16_t* KA, const bf16_t* VA, bf16_t* ACAT, const float* scal, char* lds, const int wid) {
  constexpr int S = 8192, W_K = 65536, W_WS = 131072;
  const int lane = MK_LANE(), r32 = lane & 31, hi = lane >> 5;
  const unsigned lds0 = (unsigned)(uintptr_t)lds;
  const int q0 = qb * 256, kb0 = q0 - 128; const size_t rowbase = (size_t)b * S;
  const unsigned Kb = (unsigned)((const char*)(KA + rowbase * 128 + kvh * 64) - wsb), Vb = (unsigned)((const char*)(VA + rowbase * 128 + kvh * 64) - wsb);
  { const unsigned kvoff = (unsigned)lane * 256u + wid * 16;
    const int ob = wid * 1024 + lane * 16, st = ob >> 9, k = (st / 2) * 8 + ((ob >> 6) & 7), c = (st % 2) * 32 + ((ob >> 4) & 3) * 8; const unsigned vvoff = (unsigned)k * 256u + c * 2;
#pragma unroll
    for (int j = 0; j < 8; ++j) { const int ks = kb0 + 64 * j;
      if (ks >= 0 && ks < S) dma16x2(lds0 + W_K + j * 8192 + wid * 1024, kvoff, Kb + (unsigned)ks * 256u, lds0 + j * 8192 + wid * 1024, vvoff, Vb + (unsigned)ks * 256u, rs); } }
  asm volatile("s_waitcnt vmcnt(0)\n\ts_barrier" ::: "memory");
  const lds_cptr kp0 = (lds_cptr)lds + W_K + hi * 1024 + r32 * 16;
  const lds_cptr vp0 = (lds_cptr)lds + v_rd_base(lane);
  float* wsf = (float*)(lds + W_WS) + wid * 64;
  const int qrow0 = q0 + wid * QBLK, qpos = qrow0 + r32, jlo = wid >> 1;
#pragma unroll 1
  for (int hh = 0; hh < 2; ++hh) {
    const int hq = kvh * 4 + pair * 2 + hh;
    bf16x8 qr[4];
    { const unsigned Qb = (unsigned)((const char*)(QA + (rowbase + q0) * 512 + hq * 64) - wsb), qoff = (unsigned)(wid * QBLK + r32) * 1024u + hi * 16;
#pragma unroll
      for (int d0 = 0; d0 < 4; ++d0) { const u32x4 w = __builtin_amdgcn_raw_buffer_load_b128(rs, qoff + d0 * 32, Qb, 0); qr[d0] = __builtin_bit_cast(bf16x8, w); } }
    f32x16 negm; { float ns = scal[8 + hq]; asm volatile("" : "+v"(ns));
#pragma unroll
    for (int r = 0; r < 16; ++r) negm[r] = ns; }
    f32x16 o0 = f32x16{}, o1 = f32x16{}; float l_reg = 0.f;
#pragma unroll 1
    for (int i = 0; i < 5; ++i) {
      const int j = jlo + i, ks = kb0 + 64 * j;
      if (ks < 0 || ks >= S) continue;
      const lds_cptr kp = kp0 + j * 8192; const lds_cptr vp = vp0 + j * 8192;
      f32x16 p0, p1;
#pragma unroll
      for (int d0 = 0; d0 < 4; ++d0) { const bf16x8 k0 = kld(kp + d0 * 2048), k1 = kld(kp + d0 * 2048 + 512);
        if (d0 == 0) { p0 = __builtin_amdgcn_mfma_f32_32x32x16_bf16(k0, qr[0], negm, 0, 0, 0); p1 = __builtin_amdgcn_mfma_f32_32x32x16_bf16(k1, qr[0], negm, 0, 0, 0); }
        else { p0 = __builtin_amdgcn_mfma_f32_32x32x16_bf16(k0, qr[d0], p0, 0, 0, 0); p1 = __builtin_amdgcn_mfma_f32_32x32x16_bf16(k1, qr[d0], p1, 0, 0, 0); } }
      if (!((ks >= qrow0 + QBLK - 1 - 128) && (ks + 63 <= qrow0 + 128))) wmask<true>(p0, p1, qpos, ks, hi);
      exp_half(p0); exp_half(p1);
      float ps = 0.f;
#pragma unroll
      for (int r = 0; r < 16; ++r) ps += p0[r];
#pragma unroll
      for (int r = 0; r < 16; ++r) ps += p1[r];
      l_reg += ps;
      bf16x8 pa0, pa1, pa2, pa3;
#define W2_PK4(P, BASE, OUT) do { u32x4 w = {cvtpk(P[BASE + 0], P[BASE + 1]), cvtpk(P[BASE + 2], P[BASE + 3]), cvtpk(P[BASE + 4], P[BASE + 5]), cvtpk(P[BASE + 6], P[BASE + 7])}; OUT = *reinterpret_cast<bf16x8*>(&w); } while (0)
      W2_PK4(p0, 0, pa0); W2_PK4(p0, 8, pa1); W2_PK4(p1, 0, pa2); W2_PK4(p1, 8, pa3);
#undef W2_PK4
#define W2_VF(D0, ks_) ({ const s16x4 l_ = vtr(vp + (D0) * 512 + (2 * (ks_)) * 1024), h_ = vtr(vp + (D0) * 512 + (2 * (ks_) + 1) * 1024); (bf16x8){l_[0], l_[1], l_[2], l_[3], h_[0], h_[1], h_[2], h_[3]}; })
      o0 = __builtin_amdgcn_mfma_f32_32x32x16_bf16(pa0, W2_VF(0, 0), o0, 0, 0, 0); o1 = __builtin_amdgcn_mfma_f32_32x32x16_bf16(pa0, W2_VF(1, 0), o1, 0, 0, 0);
      o0 = __builtin_amdgcn_mfma_f32_32x32x16_bf16(pa1, W2_VF(0, 1), o0, 0, 0, 0); o1 = __builtin_amdgcn_mfma_f32_32x32x16_bf16(pa1, W2_VF(1, 1), o1, 0, 0, 0);
      o0 = __builtin_amdgcn_mfma_f32_32x32x16_bf16(pa2, W2_VF(0, 2), o0, 0, 0, 0); o1 = __builtin_amdgcn_mfma_f32_32x32x16_bf16(pa2, W2_VF(1, 2), o1, 0, 0, 0);
      o0 = __builtin_amdgcn_mfma_f32_32x32x16_bf16(pa3, W2_VF(0, 3), o0, 0, 0, 0); o1 = __builtin_amdgcn_mfma_f32_32x32x16_bf16(pa3, W2_VF(1, 3), o1, 0, 0, 0);
#undef W2_VF
    }
    float l; { auto rr = __builtin_amdgcn_permlane32_swap(__float_as_uint(l_reg), __float_as_uint(l_reg), false, false); l = __uint_as_float(rr[0]) + __uint_as_float(rr[1]); }
    float rli[16];
    row_recips(l, scal[16 + hq], wsf, r32, hi, rli);
    bf16_t* stg = (bf16_t*)(lds + W_WS + 2048) + wid * 1024;
    bf16_t* Ow = ACAT + (rowbase + q0 + wid * QBLK) * 1024 + hq * 64;
#pragma unroll
    for (int g = 0; g < 2; ++g) {
#pragma unroll
      for (int rr = 0; rr < 8; ++rr) { const int r = 8 * g + rr, srow = crow(r, hi) - 16 * g;
        stg[srow * 64 + r32] = (bf16_t)(cvtpk(o0[r] * rli[r], 0.f) & 0xffffu); stg[srow * 64 + 32 + r32] = (bf16_t)(cvtpk(o1[r] * rli[r], 0.f) & 0xffffu); }
      asm volatile("s_waitcnt lgkmcnt(0)" ::: "memory");
#pragma unroll
      for (int i = 0; i < 2; ++i) { const int row = i * 8 + (lane >> 3), ch = lane & 7; const u32x4 v = *(const u32x4*)(stg + row * 64 + ch * 8); *(u32x4*)(Ow + (size_t)(16 * g + row) * 1024 + ch * 8) = v; }
      asm volatile("s_waitcnt lgkmcnt(0)" ::: "memory"); }
  }
  asm volatile("s_waitcnt lgkmcnt(0)" ::: "memory"); __syncthreads();
}

__device__ __forceinline__ void diff_unit(__amdgpu_buffer_rsrc_t rs, const char* wsb, int b, int h, int qb, const bf16_t* QB, const bf16_t* KB, const bf16_t* VB, bf16_t* ACAT, const float* scal, const float* subln, char* lds, const int wid) {
  constexpr int S = 8192;
  const size_t rowbase = (size_t)b * S; const int q0 = qb * 256;
  float* wsf = (float*)(lds + LDS_WS) + wid * 64; float rli[16];
  bf16_t* stg = (bf16_t*)(lds + LDS_STG) + wid * 4096;
#pragma unroll 1
  for (int t = 0; t < 2; ++t) {
    f32x16 o[4]; float l; const float negm_s = scal[2];
    attn_pass_d4(rs, (unsigned)((const char*)(QB + (rowbase + q0) * 512 + (2 * h + t) * 64) - wsb), 1024u, (unsigned)((const char*)(KB + rowbase * 512 + (2 * h + t) * 64) - wsb), 1024u, (unsigned)((const char*)(VB + rowbase * 512 + h * 128) - wsb), 1024u, S, negm_s, lds, o, l, wid);
    const int lane1 = MK_LANE(); int r32 = lane1 & 31, hi = lane1 >> 5, lane = lane1; asm volatile("" : "+v"(r32), "+v"(hi), "+v"(lane));
    row_recips(l, 0.f, wsf, r32, hi, rli);
    if (t == 0) {
#pragma unroll
      for (int r = 0; r < 16; ++r) { const int orow = crow(r, hi);
#pragma unroll
        for (int d0 = 0; d0 < 4; ++d0) stg[orow * 128 + d0 * 32 + r32] = (bf16_t)(cvtpk(o[d0][r] * rli[r], 0.f) & 0xffffu); }
    } else {
      const float lam = scal[0], post = 1.0f - scal[1];
      float ss[16];
#pragma unroll
      for (int r = 0; r < 16; ++r) { const int orow = crow(r, hi); float s_ = 0.f;
#pragma unroll
        for (int d0 = 0; d0 < 4; ++d0) { const float v = bf2f(stg[orow * 128 + d0 * 32 + r32]) - lam * (o[d0][r] * rli[r]); o[d0][r] = v; s_ += v * v; }
        ss[r] = s_; }
#pragma unroll
      for (int r = 0; r < 16; ++r) { float s_ = ss[r]; s_ += __shfl_xor(s_, 1); s_ += __shfl_xor(s_, 2); s_ += __shfl_xor(s_, 4); s_ += __shfl_xor(s_, 8); s_ += __shfl_xor(s_, 16); ss[r] = rsqrtf(s_ * (1.0f / 128.0f) + 1e-6f) * post; }
      float sl[4];
#pragma unroll
      for (int d0 = 0; d0 < 4; ++d0) sl[d0] = subln[d0 * 32 + r32];
#pragma unroll
      for (int r = 0; r < 16; ++r) { const int orow = crow(r, hi);
#pragma unroll
        for (int d0 = 0; d0 < 4; ++d0) stg[orow * 128 + d0 * 32 + r32] = (bf16_t)(cvtpk(o[d0][r] * ss[r] * sl[d0], 0.f) & 0xffffu); }
      asm volatile("s_waitcnt lgkmcnt(0)" ::: "memory");
      const int widl = wid;
      bf16_t* Ow = ACAT + (rowbase + q0) * 1024 + 512 + h * 128 + (unsigned)((widl * QBLK + (lane >> 4)) * 1024 + (lane & 15) * 8);
      const bf16_t* sp = stg + (lane >> 4) * 128 + (lane & 15) * 8;
#pragma unroll
      for (int i = 0; i < 8; ++i) { const u32x4 v = *(const u32x4*)(sp + i * 512); *(u32x4*)(Ow + (size_t)i * 4096) = v; }
    }
  }
  asm volatile("s_waitcnt lgkmcnt(0)" ::: "memory"); __syncthreads();
}
#undef ATT_SBAR
#undef KSWZ64
}
constexpr int NWAVES = 8;
#ifndef MK_N_LAUNCHES
#define MK_N_LAUNCHES 1
#endif
constexpr int PER_PHASE = 10;
constexpr int N_LAUNCHES = MK_N_LAUNCHES;

constexpr int BATCH = 2, T = 8192, D = 1024, M = BATCH * T, DFF = 2816, NFF = 2 * DFF, NIN = 4352, NMOD = 9 * D;
constexpr size_t MiB = 1u << 20;
constexpr size_t WS_CTL = 0, CTL_ZERO_BYTES = 1 * MiB;
constexpr size_t WS_MOD = 512 * 1024;
constexpr size_t WS_SCAL = 1 * MiB, WS_CB1 = WS_SCAL + 4096, WS_CBIN = WS_CB1 + 65536, WS_CB2 = WS_CBIN + 65536;
constexpr size_t WS_RSS0 = 2 * MiB, WS_RSS1 = WS_RSS0 + 256 * 1024, WS_RSS2 = WS_RSS1 + 256 * 1024;
constexpr size_t WS_COS = 3 * MiB, WS_SIN = 5 * MiB;
constexpr size_t WS_W1T = 8 * MiB, WS_W1OT = 19 * MiB, WS_WINT = 25 * MiB, WS_WBRT = 34 * MiB, WS_WOT = 38 * MiB, WS_W2T = 40 * MiB, WS_W2OT = 51 * MiB;
constexpr size_t WS_ABUF = 57 * MiB;
constexpr size_t WS_R1 = 89 * MiB;
constexpr size_t WS_QA = WS_R1, WS_KA = WS_QA + 16 * MiB, WS_VA = WS_KA + 4 * MiB, WS_QB = WS_VA + 4 * MiB, WS_KB = WS_QB + 16 * MiB, WS_VB = WS_KB + 16 * MiB;
constexpr size_t WS_MG = WS_R1;
constexpr size_t WS_GA = 177 * MiB, WS_GB = 209 * MiB, WS_END = 241 * MiB;
static_assert(WS_VB + 16 * MiB <= WS_GA && WS_R1 + (size_t)M * DFF * 2 <= WS_GA && WS_W2OT + (size_t)D * DFF * 2 <= WS_ABUF, "d_ws map");
constexpr int CW_TMO = 0, CW_CODE = 1, CW_BAR = 4096;

constexpr int RING_OFF = 0, RING_BYTES = 131072;
constexpr int LDSCTL_OFF = 149504, MISC_OFF = LDSCTL_OFF + 320;
constexpr int LDS_BYTES = 155648;
static_assert(MISC_OFF + 128 <= LDS_BYTES && att::ATT_LDS_BYTES <= LDSCTL_OFF && RING_BYTES <= LDSCTL_OFF, "LDS map");

#define GAS __attribute__((address_space(1)))
#define LAS __attribute__((address_space(3)))
typedef unsigned short bf16;
typedef unsigned v4u __attribute__((ext_vector_type(4)));
typedef float f32x4 __attribute__((ext_vector_type(4)));
typedef short bf16x8 __attribute__((ext_vector_type(8)));
typedef GAS unsigned gu32;
typedef GAS unsigned long long gu64;
#define RLX_AGENT __ATOMIC_RELAXED, __HIP_MEMORY_SCOPE_AGENT
#define LDS_WAIT() asm volatile("s_waitcnt lgkmcnt(0)" ::: "memory")
#define VM_WAIT() asm volatile("s_waitcnt vmcnt(0)" ::: "memory")
__device__ __forceinline__ unsigned long long rt() { return __builtin_amdgcn_s_memrealtime(); }
__device__ __forceinline__ unsigned f2bf(float f) { unsigned u = __builtin_bit_cast(unsigned, f); return (u + 0x7fffu + ((u >> 16) & 1u)) >> 16; }
__device__ __forceinline__ unsigned pk2(float lo, float hi) { return f2bf(lo) | (f2bf(hi) << 16); }

#define XB_TMO      128
#define XB_XCNT(j)  (256  + 64 * (j))
#define XB_XSUB(j)  (1280 + 64 * (j))
#define XB_XGEN(j)  (2304 + 64 * (j))
#define XB_TOP      3328
#define XB_TOPGEN   3392
#define XCD_BAR_WORDS 3456
#define XB_SPIN_CAP (1u << 18)

__device__ __forceinline__ unsigned xb_ld(unsigned* p)              { return __hip_atomic_load(p, __ATOMIC_RELAXED, __HIP_MEMORY_SCOPE_AGENT); }
__device__ __forceinline__ unsigned xb_add(unsigned* p, unsigned v) { return __hip_atomic_fetch_add(p, v, __ATOMIC_RELAXED, __HIP_MEMORY_SCOPE_AGENT); }
__device__ __forceinline__ unsigned xb_xcc_id() { return (unsigned)__builtin_amdgcn_s_getreg((3 << 11) | 20) & 0xFu; }
#define XB_SPIN(cond, bar) do { unsigned _sp = 0; while (cond) { __builtin_amdgcn_s_sleep(1); \
    if ((++_sp & 255u) == 0u) { if (xb_ld(&(bar)[XB_TMO])) break; if (_sp > XB_SPIN_CAP) { atomicAdd(&(bar)[XB_TMO], 1u); break; } } } } while (0)

struct XcdBarrier {
    unsigned* bar; unsigned x;
    volatile LAS unsigned* st;
};

__device__ __forceinline__ XcdBarrier xcd_barrier_post(unsigned* bar, volatile LAS unsigned* st) {
    XcdBarrier b; b.bar = bar; b.x = xb_xcc_id(); b.st = st;
    if (threadIdx.x == 0) (void)xb_add(&bar[XB_XCNT(b.x)], 1u);
    return b;
}
__device__ __forceinline__ void xcd_barrier_complete(unsigned* bar, unsigned x, unsigned& nloc, unsigned& nx) {
    const unsigned G = gridDim.x * gridDim.y * gridDim.z;
    unsigned sum, cnt, mine, sp = 0u;
    for (;;) {
        sum = 0u; cnt = 0u; mine = 0u;
#pragma unroll
        for (unsigned j = 0; j < 16; ++j) { const unsigned c = xb_ld(&bar[XB_XCNT(j)]); sum += c; cnt += (c > 0u) ? 1u : 0u; mine = (j == x) ? c : mine; }
        if (sum == G) break;
        __builtin_amdgcn_s_sleep(1);
        if ((++sp & 255u) == 0u) { if (xb_ld(&bar[XB_TMO])) break; if (sp > XB_SPIN_CAP) { atomicAdd(&bar[XB_TMO], 1u); break; } }
    }
    nloc = mine > 0u ? mine : 1u; nx = cnt > 0u ? cnt : 1u;
}

__device__ __forceinline__ void xcd_barrier(const XcdBarrier& b, const bool leader  ) {
    asm volatile("s_waitcnt vmcnt(0)" ::: "memory");
    __syncthreads();
    if (leader) {
        unsigned* bar = b.bar;
        __builtin_amdgcn_s_waitcnt(0);
        unsigned nloc = b.st[0], nx = b.st[1];
        if (nloc == 0u) { xcd_barrier_complete(bar, b.x, nloc, nx); b.st[0] = nloc; b.st[1] = nx; }
        const unsigned old = xb_add(&bar[XB_XSUB(b.x)], 1u);
        const unsigned gen = old / nloc;
        if (old + 1u == (gen + 1u) * nloc) {
            __builtin_amdgcn_fence(__ATOMIC_RELEASE, "agent");
            asm volatile("s_waitcnt vmcnt(0)" ::: "memory");
            const unsigned og = xb_add(&bar[XB_TOP], 1u);
            const unsigned tg = og / nx;
            asm volatile("buffer_inv sc1" ::: "memory");
            if (og + 1u == (tg + 1u) * nx) xb_add(&bar[XB_TOPGEN], 1u);
            else XB_SPIN(xb_ld(&bar[XB_TOPGEN]) == tg, bar);
            xb_add(&bar[XB_XGEN(b.x)], 1u);
            asm volatile("s_waitcnt vmcnt(0)" ::: "memory");
        } else {
            asm volatile("buffer_inv sc1" ::: "memory");
            XB_SPIN(xb_ld(&bar[XB_XGEN(b.x)]) == gen, bar);
            asm volatile("s_waitcnt vmcnt(0)" ::: "memory");
        }
    }
    __syncthreads();
}

struct Args { const void* in[26]; float* out; unsigned char* ws; int ph_lo, ph_hi, li, pad; };

__device__ __forceinline__ float wave_sum(float v) {
#pragma unroll
    for (int o = 1; o < 64; o <<= 1) v += __shfl_xor(v, o);
    return v;
}
__device__ __forceinline__ int rowmap(int kind, int n0) {
    if (kind == 1) { const int bj = n0 >= DFF ? 1 : 0, jj = n0 - bj * DFF; return (jj >> 7) * 256 + bj * 128 + (jj & 127); }
    if (kind == 2) { if (n0 >= 2304) return n0; const int g32 = n0 >> 5, head = g32 >> 1, bj = g32 & 1; return (head >> 2) * 256 + bj * 128 + (head & 3) * 32; }
    if (kind == 3) return (n0 >> 7) * 256 + (n0 & 127);
    if (kind == 4) return (n0 >> 7) * 256 + 128 + (n0 & 127);
    return n0;
}
struct TItem { const float* src; bf16* dst; int N; int ldk; };
__device__ __forceinline__ TItem p0_item_addr(const float* W, int N, bf16* WT, int ldk, int koff, int kind, int item, int lane) {
    const int nblk = N / 32, kb = item / nblk, nb = item % nblk, k0 = 64 * kb, n0 = 32 * nb, c0 = rowmap(kind, n0), kg = lane & 7, ng = lane >> 3;
    TItem t; t.src = W + (size_t)(k0 + 8 * kg) * N + n0 + 4 * ng; t.dst = WT + (size_t)(c0 + 4 * ng) * ldk + koff + k0 + 8 * kg; t.N = N; t.ldk = ldk; return t;
}
__device__ __forceinline__ void p0_item_load(const TItem& t, f32x4 (&v)[8]) {
#pragma unroll
    for (int j = 0; j < 8; ++j) v[j] = __builtin_nontemporal_load((const f32x4*)(t.src + (size_t)j * t.N));
}
__device__ __forceinline__ void p0_item_store(const TItem& t, const f32x4 (&v)[8]) {
#pragma unroll
    for (int i = 0; i < 4; ++i) { v4u o; o.x = pk2(v[0][i], v[1][i]); o.y = pk2(v[2][i], v[3][i]); o.z = pk2(v[4][i], v[5][i]); o.w = pk2(v[6][i], v[7][i]);
        *(GAS v4u*)(t.dst + (size_t)i * t.ldk) = o; }
}

__device__ __forceinline__ void bias_rows(const bf16* Bt, float* CB, int nrows, const float* sh0, const float* sh1, int gw, int NGW) {
    const int lane = MK_LANE();
    f32x4 s0[2][2], s1[2][2];
#pragma unroll
    for (int hh = 0; hh < 2; ++hh)
#pragma unroll
        for (int q = 0; q < 2; ++q) { s0[hh][q] = *(const f32x4*)(sh0 + hh * 512 + lane * 8 + 4 * q); s1[hh][q] = *(const f32x4*)(sh1 + hh * 512 + lane * 8 + 4 * q); }
    for (int c0 = gw; c0 < nrows; c0 += 3 * NGW) {
        v4u w[3][2];
#pragma unroll
        for (int r = 0; r < 3; ++r) { const int c = c0 + r * NGW;
            if (c < nrows) {
#pragma unroll
                for (int hh = 0; hh < 2; ++hh) w[r][hh] = *(const GAS v4u*)(Bt + (size_t)c * D + hh * 512 + lane * 8); } }
#pragma unroll
        for (int r = 0; r < 3; ++r) { const int c = c0 + r * NGW;
            if (c < nrows) { float a0 = 0.f, a1 = 0.f;
#pragma unroll
                for (int hh = 0; hh < 2; ++hh) { const v4u v = w[r][hh];
                    const float wf[8] = {__uint_as_float(v.x << 16), __uint_as_float(v.x & 0xffff0000u), __uint_as_float(v.y << 16), __uint_as_float(v.y & 0xffff0000u),
                                         __uint_as_float(v.z << 16), __uint_as_float(v.z & 0xffff0000u), __uint_as_float(v.w << 16), __uint_as_float(v.w & 0xffff0000u)};
#pragma unroll
                    for (int e = 0; e < 8; ++e) { a0 += wf[e] * s0[hh][e >> 2][e & 3]; a1 += wf[e] * s1[hh][e >> 2][e & 3]; } }
                a0 = wave_sum(a0); a1 = wave_sum(a1);
                if (lane == 0) { CB[c] = a0; CB[nrows + c] = a1; } } }
    }
}

__global__ void __launch_bounds__(NWAVES * 64, 2) layer_fwd(Args args) {
    extern __shared__ __attribute__((aligned(16))) unsigned char lds[];
    LAS unsigned char* ldsl = (LAS unsigned char*)lds;
    volatile LAS unsigned* MISC = (volatile LAS unsigned*)(ldsl + MISC_OFF);
    const int wave = __builtin_amdgcn_readfirstlane((int)threadIdx.x >> 6), lane = MK_LANE(), tid = wave * 64 + lane;
    const int G = gridDim.x; const int bx = blockIdx.x; const int vcu = (G % 8 == 0) ? (bx % 8) * (G / 8) + bx / 8 : bx;
    unsigned char* ws = args.ws;
    gu32* ctl = (gu32*)(ws + WS_CTL);
    const float* x = (const float*)args.in[0]; const float* cvec = (const float*)args.in[1]; const int* positions = (const int*)args.in[2];
    const float* w_mod = (const float*)args.in[3]; const float* b_mod = (const float*)args.in[4];
    const float* norm_ffn1 = (const float*)args.in[5]; const float* w_ffn1_in = (const float*)args.in[6]; const float* w_ffn1_out = (const float*)args.in[7];
    const float* norm_mix = (const float*)args.in[8]; const float* w_in = (const float*)args.in[9];
    const float* qn_a = (const float*)args.in[10]; const float* kn_a = (const float*)args.in[11]; const float* sink_a = (const float*)args.in[12];
    const float* qn_b = (const float*)args.in[13]; const float* kn_b = (const float*)args.in[14];
    const float* lam_q1 = (const float*)args.in[15]; const float* lam_k1 = (const float*)args.in[16]; const float* lam_q2 = (const float*)args.in[17]; const float* lam_k2 = (const float*)args.in[18];
    const float* subln_b = (const float*)args.in[19]; const float* w_branch_a = (const float*)args.in[20]; const float* w_branch_b = (const float*)args.in[21];
    const float* w_out = (const float*)args.in[22]; const float* norm_ffn2 = (const float*)args.in[23]; const float* w_ffn2_in = (const float*)args.in[24]; const float* w_ffn2_out = (const float*)args.in[25];
    float* out = args.out;
    float* MOD = (float*)(ws + WS_MOD); float* SCAL = (float*)(ws + WS_SCAL); float* CB1 = (float*)(ws + WS_CB1); float* CBIN = (float*)(ws + WS_CBIN); float* CB2 = (float*)(ws + WS_CB2);
    float* RSS0 = (float*)(ws + WS_RSS0); float* RSS1 = (float*)(ws + WS_RSS1); float* RSS2 = (float*)(ws + WS_RSS2); bf16* ROPET = (bf16*)(ws + WS_COS);
    bf16* W1T = (bf16*)(ws + WS_W1T); bf16* W1OT = (bf16*)(ws + WS_W1OT); bf16* WINT = (bf16*)(ws + WS_WINT); bf16* WBRT = (bf16*)(ws + WS_WBRT); bf16* WOT = (bf16*)(ws + WS_WOT);
    bf16* W2T = (bf16*)(ws + WS_W2T); bf16* W2OT = (bf16*)(ws + WS_W2OT);
    bf16* ABUF = (bf16*)(ws + WS_ABUF); bf16* HB = (bf16*)(ws + WS_R1); bf16* MG = (bf16*)(ws + WS_MG);
    bf16* QA = (bf16*)(ws + WS_QA); bf16* KA = (bf16*)(ws + WS_KA); bf16* VA = (bf16*)(ws + WS_VA); bf16* QB = (bf16*)(ws + WS_QB); bf16* KB = (bf16*)(ws + WS_KB); bf16* VB = (bf16*)(ws + WS_VB);
    bf16* GA = (bf16*)(ws + WS_GA); bf16* GB = (bf16*)(ws + WS_GB);
    bf16* X1B = (bf16*)out;
    bf16* X2B = (bf16*)(ws + WS_GA);

    for (int u = tid; u < (LDS_BYTES - LDSCTL_OFF) / 4; u += NWAVES * 64) ((LAS unsigned*)(ldsl + LDSCTL_OFF))[u] = 0u;
    __syncthreads();
    XcdBarrier bar; bar.bar = (unsigned*)(ctl + CW_BAR); bar.x = 0; bar.st = nullptr;
    if (N_LAUNCHES != PER_PHASE) bar = xcd_barrier_post((unsigned*)(ctl + CW_BAR), MISC + 8);
#define GRID_BAR(seam) do { if (N_LAUNCHES == PER_PHASE) { if (tid == 0) __hip_atomic_store(ctl + CW_TMO, 0xBADBA0u | (unsigned)(seam), RLX_AGENT); } else { xcd_barrier(bar, wave == 0 && MK_LANE() == 0); } } while (0)
    const int lo = args.ph_lo, hi = args.ph_hi;
#ifndef PH_MASK
#define PH_MASK 0x3ff
#endif
#define IN(k) (((PH_MASK >> (k)) & 1) && lo <= (k) && (k) < hi)
#define BOTH(k) (IN(k) && IN((k) + 1))
#ifndef REPEAT_MASK
#define REPEAT_MASK 0
#endif
#define REPS(k) for (int rep_ = 0; rep_ <= ((REPEAT_MASK >> (k)) & 1); ++rep_)
    const int gw = vcu * NWAVES + wave, NGW = G * NWAVES;
    constexpr float QSCALE = 0.125f * 1.4426950408889634f;

    if (IN(0)) {
#define MOD_GEMV(IT_BEGIN, IT_END, IT_FIRST, IT_STRIDE, TIDV, LANEV) do { \
            LAS float* ca = (LAS float*)(ldsl + RING_OFF + 73728);              \
            LAS float* red = ca + 2048;                                          \
            for (int i = (TIDV); i < 2 * D; i += NWAVES * 64) { const float v = cvec[i]; ca[i] = v / (1.f + __expf(-v)); } \
            __syncthreads(); \
            for (int it = (IT_BEGIN) + (IT_FIRST); it < (IT_END); it += (IT_STRIDE)) { \
                const int cg = it >> 1, kh = it & 1, j = cg * 64 + (LANEV), kbase = kh * 512 + wave * 64; \
                float wv[64]; \
                _Pragma("unroll") \
                for (int kk = 0; kk < 64; ++kk) wv[kk] = w_mod[(size_t)(kbase + kk) * NMOD + j]; \
                float a0 = 0.f, a1 = 0.f; \
                _Pragma("unroll") \
                for (int kk = 0; kk < 64; ++kk) { a0 += ca[kbase + kk] * wv[kk]; a1 += ca[D + kbase + kk] * wv[kk]; } \
                red[(wave * 2 + 0) * 64 + (LANEV)] = a0; red[(wave * 2 + 1) * 64 + (LANEV)] = a1; \
                __syncthreads(); \
                if ((TIDV) < 128) { const int b = (TIDV) >> 6; float s_ = (kh == 0) ? b_mod[j] : 0.f; \
                    _Pragma("unroll") \
                    for (int w = 0; w < 8; ++w) s_ += red[(w * 2 + b) * 64 + (LANEV)]; \
                    atomicAdd(MOD + b * NMOD + j, s_); } \
                __syncthreads(); \
            } } while (0)
        MOD_GEMV(0, 64, bx, G, tid, lane);
        {
            constexpr int NITEMS = (D / 64) * (NFF / 32);
            auto item_of = [&](int it) -> TItem { return p0_item_addr(w_ffn1_in, NFF, W1T, D, 0, 1, it, lane); };
            for (int it = gw; it < NITEMS; it += 2 * NGW) {
                const int it2 = it + NGW; const bool two = it2 < NITEMS;
                const TItem a = item_of(it), b2 = item_of(two ? it2 : it);
                f32x4 va[8], vb[8];
                p0_item_load(a, va); if (two) p0_item_load(b2, vb);
                p0_item_store(a, va); if (two) p0_item_store(b2, vb);
            }
        }
        if (bx == 0 && wave == 0) {
            const float a = wave_sum(lam_q1[lane] * lam_k1[lane]), b2 = wave_sum(lam_q2[lane] * lam_k2[lane]);
            float mqa = fabsf(qn_a[lane]), mka = fabsf(kn_a[lane]), mqb = fabsf(qn_b[lane]), mkb = fabsf(kn_b[lane]);
#pragma unroll
            for (int o = 1; o < 64; o <<= 1) { mqa = fmaxf(mqa, __shfl_xor(mqa, o)); mka = fmaxf(mka, __shfl_xor(mka, o)); mqb = fmaxf(mqb, __shfl_xor(mqb, o)); mkb = fmaxf(mkb, __shfl_xor(mkb, o)); }
            const float bound_a = 8.0f * mqa * mka * 1.001f, bound_b = 8.0f * mqb * mkb * 1.001f, L2E = 1.4426950408889634f;
            if (lane == 0) { const float lam_init = 0.8f - 0.6f * expf(-0.3f * 0.f); SCAL[0] = expf(a) - expf(b2) + lam_init; SCAL[1] = lam_init; SCAL[2] = -bound_b * L2E; }
            if (lane < 8) { const float sk = sink_a[lane], mh = fmaxf(bound_a, sk); SCAL[8 + lane] = -mh * L2E; SCAL[16 + lane] = exp2f((sk - mh) * L2E); }
        }
        if (BOTH(0)) GRID_BAR(0);
    }

    if (IN(1)) {
        for (int m = gw; m < M; m += NGW) {
            const int b = m >> 13; const GAS f32x4* xr = (const GAS f32x4*)(x + (size_t)m * D) + lane;
            f32x4 v[4]; float s = 0.f;
#pragma unroll
            for (int j = 0; j < 4; ++j) { v[j] = xr[64 * j]; s += (v[j].x * v[j].x + v[j].y * v[j].y) + (v[j].z * v[j].z + v[j].w * v[j].w); }
            s = wave_sum(s);
            if (lane == 0) *(f32x4*)(RSS0 + (size_t)m * 4) = (f32x4){s, 0.f, 0.f, 0.f};
            GAS unsigned long long* o8 = (GAS unsigned long long*)(ABUF + (size_t)m * D) + lane;
#pragma unroll
            for (int j = 0; j < 4; ++j) { const int c = 4 * lane + 256 * j; const f32x4 g = *(const f32x4*)(norm_ffn1 + c) * (*(const f32x4*)(MOD + b * NMOD + 1 * D + c) + 1.0f); const f32x4 a = v[j] * g;
                o8[64 * j] = (unsigned long long)pk2(a.x, a.y) | ((unsigned long long)pk2(a.z, a.w) << 32); }
        }
        bias_rows(W1T, CB1, NFF, MOD + 0 * D, MOD + NMOD + 0 * D, gw, NGW);
        if (BOTH(1)) GRID_BAR(1);
    }

    if (IN(2)) {
        pg8::Gemm g{ABUF, W1T, M, NFF, D}; pg8::StaticOrder S; S.init(M, NFF, G, bx);
        pg8::EpiSwiGLU E{HB, DFF, RSS0, CB1, NFF};
        pg8::gemm_phase<pg8::EpiSwiGLU, pg8::StaticOrder, PG8_ALIGN, PG8_SP2>(ldsl + RING_OFF, g, S, E, wave);
        { pg8::Unit ud; const int nunits = (M / 256) * (NFF / 256), nfull = nunits / G;
          if (!S.next(nfull, ud)) {
            const int nidle = G - (nunits - nfull * G), iw = (bx - (G - nidle)) * NWAVES + wave, NIW = nidle * NWAVES, lane2 = MK_LANE();
            MOD_GEMV(64, 288, bx - (G - nidle), nidle, wave * 64 + lane2, lane2);
            constexpr int I_IN = (D / 64) * (NIN / 32), I_1O = (DFF / 64) * (D / 32), NITEMS = I_IN + I_1O;
            auto item_of = [&](int it) -> TItem { return it < I_IN ? p0_item_addr(w_in, NIN, WINT, D, 0, 2, it, lane2) : p0_item_addr(w_ffn1_out, D, W1OT, DFF, 0, 0, it - I_IN, lane2); };
            for (int it = iw; it < NITEMS; it += 2 * NIW) {
                const int it2 = it + NIW; const bool two = it2 < NITEMS;
                const TItem a = item_of(it), b2 = item_of(two ? it2 : it);
                f32x4 va[8], vb[8];
                p0_item_load(a, va); if (two) p0_item_load(b2, vb);
                p0_item_store(a, va); if (two) p0_item_store(b2, vb);
            }
            { const float invf = (float)pow(10000.0, -(double)(2 * (lane2 & 31)) / 64.0);
              for (int i = iw * 64 + lane2; i < M * 32; i += NIW * 64) { const float ang = (float)positions[i >> 5] * invf; const int row = i >> 5, d = i & 31;
                  ROPET[row * 64 + d] = (bf16)f2bf(cosf(ang)); ROPET[row * 64 + 32 + d] = (bf16)f2bf(sinf(ang)); } }
          } }
        if (BOTH(2)) GRID_BAR(2);
    }
    if (IN(3)) {
        pg8::Gemm g{HB, W1OT, M, D, DFF}; pg8::StaticOrder S; S.init(M, D, G, bx);
        pg8::EpiResid<true, 1, false, true> E{x, X1B, MOD + 2 * D, ABUF, norm_mix, MOD + 4 * D, RSS1};
        pg8::gemm_phase<pg8::EpiResid<true, 1, false, true>, pg8::StaticOrder, false, PG8_SP2>(ldsl + RING_OFF, g, S, E, wave);
        bias_rows(WINT, CBIN, NIN, MOD + 3 * D, MOD + NMOD + 3 * D, gw, NGW);
        if (BOTH(3)) GRID_BAR(3);
    }
    if (IN(4)) {
        pg8::Gemm g{ABUF, WINT, M, NIN, D}; pg8::StaticOrder S; S.init(M, NIN, G, bx);
        pg8::EpiInProj E{QA, KA, VA, QB, KB, VB, GA, GB, RSS1, CBIN, ROPET, qn_a, kn_a, qn_b, kn_b, QSCALE};
        pg8::gemm_phase<pg8::EpiInProj, pg8::StaticOrder, PG8_ALIGN, PG8_SP2>(ldsl + RING_OFF, g, S, E, wave);
        { pg8::Unit ud; const int nunits = (M / 256) * (NIN / 256), nfull = nunits / G;
          if (!S.next(nfull, ud)) {
            const int nidle = G - (nunits - nfull * G), iw = (bx - (G - nidle)) * NWAVES + wave, NIW = nidle * NWAVES, lane2 = MK_LANE();
            constexpr int I_1 = (D / 64) * (NFF / 32), I_1O = (DFF / 64) * (D / 32), I_BR = (512 / 64) * (D / 32), I_O = (D / 64) * (D / 32);
            constexpr int NITEMS = 2 * I_BR + I_O + I_1 + I_1O;
            auto item_of = [&](int it) -> TItem {
                int r = it;
                if (r < I_BR) return p0_item_addr(w_branch_a, D, WBRT, D, 0, 0, r, lane2); r -= I_BR;
                if (r < I_BR) return p0_item_addr(w_branch_b, D, WBRT, D, 512, 0, r, lane2); r -= I_BR;
                if (r < I_O) return p0_item_addr(w_out, D, WOT, D, 0, 0, r, lane2); r -= I_O;
                if (r < I_1) return p0_item_addr(w_ffn2_in, NFF, W2T, D, 0, 1, r, lane2); r -= I_1;
                return p0_item_addr(w_ffn2_out, D, W2OT, DFF, 0, 0, r, lane2);
            };
            for (int it = iw; it < NITEMS; it += 2 * NIW) {
                const int it2 = it + NIW; const bool two = it2 < NITEMS;
                const TItem a = item_of(it), b2 = item_of(two ? it2 : it);
                f32x4 va[8], vb[8];
                p0_item_load(a, va); if (two) p0_item_load(b2, vb);
                p0_item_store(a, va); if (two) p0_item_store(b2, vb);
            }
          } }
        if (BOTH(4)) GRID_BAR(4);
    }
    if (IN(5)) {
        char* alds = (char*)lds + RING_OFF;
        const __amdgpu_buffer_rsrc_t wsrs = __builtin_amdgcn_make_buffer_rsrc((void*)ws, (short)0, 0x10000000, 0x00020000);
#ifndef SKIP_WIN
        for (int id = vcu; id < 256; id += G) att::win_unit2(wsrs, (const char*)ws, id >> 7, (id >> 6) & 1, id & 31, (id >> 5) & 1, QA, KA, VA, ABUF, SCAL, alds, wave);
#endif
#ifndef SKIP_DIFF
        for (int id = vcu; id < 256; id += G) att::diff_unit(wsrs, (const char*)ws, id >> 7, (id >> 5) & 3, id & 31, QB, KB, VB, ABUF, SCAL, subln_b, alds, wave);
#endif
        if (BOTH(5)) GRID_BAR(5);
    }
    if (IN(6)) {
        pg8::Gemm g{ABUF, WBRT, M, D, D, 512}; pg8::PairOrder S; S.init(M, D, G, bx, D);
        pg8::EpiBranch E{GA, GB, MG};
        pg8::gemm_phase<pg8::EpiBranch, pg8::PairOrder, PG8_ALIGN, PG8_SP2>(ldsl + RING_OFF, g, S, E, wave);
        if (BOTH(6)) GRID_BAR(6);
    }
    if (IN(7)) {
        pg8::Gemm g{MG, WOT, M, D, D}; pg8::StaticOrder S; S.init(M, D, G, bx);
        pg8::EpiResid<true, 2, true, true> E{X1B, X2B, MOD + 5 * D, ABUF, norm_ffn2, MOD + 7 * D, RSS2};
        pg8::gemm_phase<pg8::EpiResid<true, 2, true, true>, pg8::StaticOrder, false, PG8_SP2>(ldsl + RING_OFF, g, S, E, wave);
        bias_rows(W2T, CB2, NFF, MOD + 6 * D, MOD + NMOD + 6 * D, gw, NGW);
        if (BOTH(7)) GRID_BAR(7);
    }
    if (IN(8)) {
        pg8::Gemm g{ABUF, W2T, M, NFF, D}; pg8::StaticOrder S; S.init(M, NFF, G, bx);
        pg8::EpiSwiGLU E{HB, DFF, RSS2, CB2, NFF};
        pg8::gemm_phase<pg8::EpiSwiGLU, pg8::StaticOrder, PG8_ALIGN, PG8_SP2>(ldsl + RING_OFF, g, S, E, wave);
        if (BOTH(8)) GRID_BAR(8);
    }
    if (IN(9)) {
        pg8::Gemm g{HB, W2OT, M, D, DFF}; pg8::StaticOrder S; S.init(M, D, G, bx);
        pg8::EpiResid<false, 1, true, false> E{X2B, out, MOD + 8 * D, nullptr, nullptr, nullptr, nullptr};
        pg8::gemm_phase<pg8::EpiResid<false, 1, true, false>, pg8::StaticOrder, false, PG8_SP2>(ldsl + RING_OFF, g, S, E, wave);
    }
#undef IN
#undef BOTH
#undef GRID_BAR
}

extern "C" void kernel_launch(void* const* d_in, const int* in_sizes, int n_in, void* d_out, int out_size, void* d_ws, size_t ws_size, hipStream_t stream) {
    static int grid = 0;
    if (grid == 0) {
        if (n_in != 26 || in_sizes[0] != M * D || out_size != M * D || ws_size < WS_END) { fprintf(stderr, "kernel_launch: unexpected shapes: n_in %d in0 %d out %d ws %zu (need >= %zu)\n", n_in, n_in > 0 ? in_sizes[0] : -1, out_size, ws_size, (size_t)WS_END); grid = -1; return; }
        int dev = 0, cus = 0;
        if (hipGetDevice(&dev) != hipSuccess || hipDeviceGetAttribute(&cus, hipDeviceAttributeMultiprocessorCount, dev) != hipSuccess) { grid = -1; return; }
        if (hipFuncSetAttribute((const void*)layer_fwd, hipFuncAttributeMaxDynamicSharedMemorySize, LDS_BYTES) != hipSuccess) { fprintf(stderr, "kernel_launch: hipFuncSetAttribute failed\n"); grid = -1; return; }
        int per_cu = 0;
        if (hipOccupancyMaxActiveBlocksPerMultiprocessor(&per_cu, (const void*)layer_fwd, NWAVES * 64, LDS_BYTES) != hipSuccess || per_cu < 1) fprintf(stderr, "kernel_launch: occupancy query says %d\n", per_cu);
        (void)hipGetLastError();
        grid = cus;
        if (grid != 256) fprintf(stderr, "kernel_launch: %d CUs; the one-unit-per-workgroup phases need exactly 256\n", grid);
    }
    if (grid < 0) return;
    (void)hipMemsetAsync((char*)d_ws + WS_CTL, 0, CTL_ZERO_BYTES, stream);
    Args a{};
    for (int i = 0; i < 26; ++i) a.in[i] = d_in[i];
    a.out = (float*)d_out; a.ws = (unsigned char*)d_ws;
    for (int li = 0; li < N_LAUNCHES; ++li) {
        a.ph_lo = (N_LAUNCHES == PER_PHASE) ? li : 0; a.ph_hi = (N_LAUNCHES == PER_PHASE) ? li + 1 : PER_PHASE; a.li = li;
        hipLaunchKernelGGL(layer_fwd, dim3(grid), dim3(NWAVES * 64), LDS_BYTES, stream, a);
    }
}
```

```cpp
#include <hip/hip_runtime.h>
#include <cstdio>
#include <cstdint>
#include <cmath>
__device__ __forceinline__ int mk_lane_() { int l; asm volatile("v_mbcnt_lo_u32_b32 %0, -1, 0\n\tv_mbcnt_hi_u32_b32 %0, -1, %0" : "=v"(l)); return l; }
#define MK_LANE() mk_lane_()
namespace pg8 {
#define PG8_LAS __attribute__((address_space(3)))
typedef unsigned short bf16_t;
typedef short bf16x8 __attribute__((ext_vector_type(8)));
typedef float f32x4 __attribute__((ext_vector_type(4)));
typedef unsigned u32x4 __attribute__((ext_vector_type(4)));
constexpr int BM = 256, BK = 64, HALF = 128, HTB = HALF * BK * 2  , STAGE_BYTES = 8 * HTB, NXCD = 8, WGM = 8;

__host__ __device__ __forceinline__ int lds_byte(int r, int c) { const int st = (r >> 4) * 2 + (c >> 5), rr = r & 15, cc = c & 31, ob = rr * 64 + cc * 2; return st * 1024 + (ob ^ (((ob >> 9) & 1) << 5)); }
__host__ __device__ __forceinline__ void stage_rc(int b, int& R, int& C) { const int st = b / 1024, sb = b % 1024, swz = sb ^ (((sb >> 9) & 1) << 5); R = (st >> 1) * 16 + swz / 64; C = (st & 1) * 32 + (swz % 64) / 2; }
__host__ __device__ __forceinline__ int perm32(int rho) { const int n = rho >> 4, i = rho & 15; return 8 * (i >> 2) + 4 * n + (i & 3); }

struct Unit { int pm, pn, ko; };
struct Gemm { const bf16_t* A; const bf16_t* Bt; int M, N, K; int KL = 0; };

struct StaticOrder {
    int nM, nN, nwg, G, c;
    __host__ __device__ void init(int M, int N, int G_, int c_) { nM = M / BM; nN = N / BM; nwg = nM * nN; G = G_; c = c_; }
    __host__ __device__ bool next(int i, Unit& u) const {
        const long L = (long)i * G + c; if (L >= nwg) return false;
        int wgid = (int)L; { const int q = nwg / NXCD, r = nwg % NXCD, xcd = wgid % NXCD, off = wgid / NXCD; wgid = (xcd < r ? xcd * (q + 1) : r * (q + 1) + (xcd - r) * q) + off; }
        const int nig = WGM * nN, gid = wgid / nig, fm = gid * WGM, gsz = (nM - fm) < WGM ? (nM - fm) : WGM;
        u.pm = fm + ((wgid % nig) % gsz); u.pn = (wgid % nig) / gsz; u.ko = 0; return true;
    }
    __device__ __forceinline__ void a_ready(const Unit&) const {}
    __device__ __forceinline__ void done(const Unit&) const {}
};
struct PairOrder {
    StaticOrder S; int khalf_bytes;
    __host__ __device__ void init(int M, int N, int G_, int c_, int K) { S.init(M, N, G_, c_); khalf_bytes = K;   }
    __host__ __device__ bool next(int i, Unit& u) const { if (!S.next(i >> 1, u)) return false; u.ko = (i & 1) * khalf_bytes; return true; }
    __device__ __forceinline__ void a_ready(const Unit&) const {}
    __device__ __forceinline__ void done(const Unit&) const {}
};

__device__ __forceinline__ unsigned cvt_pk_bf16(float lo, float hi) { unsigned r; asm volatile("v_cvt_pk_bf16_f32 %0, %1, %2" : "=v"(r) : "v"(lo), "v"(hi)); return r; }
__device__ __forceinline__ float bf_lo(unsigned w) { return __uint_as_float(w << 16); }
__device__ __forceinline__ float bf_hi(unsigned w) { return __uint_as_float(w & 0xffff0000u); }
constexpr float RMS_EPS = 1e-6f, LOG2E = 1.4426950408889634f;
__device__ __forceinline__ float row_rinv(const float* rss, int row) { const f32x4 s = *(const f32x4*)(rss + (size_t)row * 4); return rsqrtf(((s[0] + s[1]) + (s[2] + s[3])) * (1.0f / 1024.0f) + RMS_EPS); }
__device__ __forceinline__ float fast_sigmoid(float v) { return __builtin_amdgcn_rcpf(1.0f + __builtin_amdgcn_exp2f(-v * LOG2E)); }

struct EpiSwiGLU {
    static constexpr bool PERM = true, AFTER_DRAIN = false, PREFETCH = true, CHAIN = false;
    bf16_t* H; int ldh; const float* rss; const float* cb; int ncb;
    __device__ __forceinline__ void prefetch(const Unit& u, PG8_LAS unsigned char* buf, int wid, int lane) const {
        if (wid < 4) __builtin_amdgcn_global_load_lds((const unsigned*)(rss + (size_t)(u.pm * BM + wid * 64 + lane) * 4), (PG8_LAS unsigned*)(buf + wid * 1024), 16, 0, 0);
        else if (wid == 4) __builtin_amdgcn_global_load_lds((const unsigned*)(cb + (size_t)(u.pm >> 5) * ncb + u.pn * BM + lane * 4), (PG8_LAS unsigned*)(buf + 4096), 16, 0, 0);
    }
    __device__ __forceinline__ void operator()(const f32x4 (&acc)[2][2][4][2], const Unit& u, int wr, int wc, int fr, int fq, const PG8_LAS unsigned char* buf) const {
        const int outcol = u.pn * HALF + wc * 32 + 8 * fq;
        const PG8_LAS float* cbb = (const PG8_LAS float*)(buf + 4096) + wc * 32 + 8 * fq;
        const f32x4 bg0 = *(const PG8_LAS f32x4*)(cbb), bg1 = *(const PG8_LAS f32x4*)(cbb + 4), bu0 = *(const PG8_LAS f32x4*)(cbb + HALF), bu1 = *(const PG8_LAS f32x4*)(cbb + HALF + 4);
#pragma unroll
        for (int ai = 0; ai < 2; ++ai) {
#pragma unroll
            for (int m = 0; m < 4; ++m) {
                const int row = u.pm * BM + ai * HALF + wr * 64 + m * 16 + fr; const f32x4 sv_ = *(const PG8_LAS f32x4*)(buf + (ai * HALF + wr * 64 + m * 16 + fr) * 16); const float ri = rsqrtf(((sv_[0] + sv_[1]) + (sv_[2] + sv_[3])) * (1.0f / 1024.0f) + RMS_EPS);
                const f32x4 g0 = acc[ai][0][m][0] * ri + bg0, g1 = acc[ai][0][m][1] * ri + bg1, u0 = acc[ai][1][m][0] * ri + bu0, u1 = acc[ai][1][m][1] * ri + bu1;
                float o[8];
#pragma unroll
                for (int j = 0; j < 4; ++j) { o[j] = g0[j] * fast_sigmoid(g0[j]) * u0[j]; o[4 + j] = g1[j] * fast_sigmoid(g1[j]) * u1[j]; }
                u32x4 w; w.x = cvt_pk_bf16(o[0], o[1]); w.y = cvt_pk_bf16(o[2], o[3]); w.z = cvt_pk_bf16(o[4], o[5]); w.w = cvt_pk_bf16(o[6], o[7]);
                *(u32x4*)(H + (size_t)row * ldh + outcol) = w; } }
    }
};

struct EpiInProj {
    static constexpr bool PERM = true, AFTER_DRAIN = false, PREFETCH = true, CHAIN = false;
    bf16_t *QA, *KA, *VA, *QB, *KB, *VB, *GA, *GB; const float* rss; const float* cb; const bf16_t* ropet; const float *qn_a, *kn_a, *qn_b, *kn_b; float qscale;
    __device__ __forceinline__ void prefetch(const Unit& u, PG8_LAS unsigned char* buf, int wid, int lane) const {
        if (wid < 4) __builtin_amdgcn_global_load_lds((const unsigned*)(rss + (size_t)(u.pm * BM + wid * 64 + lane) * 4), (PG8_LAS unsigned*)(buf + wid * 1024), 16, 0, 0);
        else if (wid == 4) __builtin_amdgcn_global_load_lds((const unsigned*)(cb + (size_t)(u.pm >> 5) * 4352 + u.pn * BM + lane * 4), (PG8_LAS unsigned*)(buf + 4096), 16, 0, 0);
    }
    __device__ __forceinline__ void operator()(const f32x4 (&acc)[2][2][4][2], const Unit& u, int wr, int wc, int fr, int fq, const PG8_LAS unsigned char* buf) const {
        const int pn = u.pn;
        int mode; bf16_t* dst; int ld; const float* gain = qn_a; float scale = 1.f;
        if (pn < 2) { mode = 0; dst = QA + (4 * pn + wc) * 64; ld = 512; gain = qn_a; scale = qscale; }
        else if (pn == 2) { if (wc < 2) { mode = 0; dst = KA + wc * 64; ld = 128; gain = kn_a; } else { mode = 1; dst = VA + (wc - 2) * 64; ld = 128; } }
        else if (pn < 5) { mode = 0; dst = QB + (4 * (pn - 3) + wc) * 64; ld = 512; gain = qn_b; scale = qscale; }
        else if (pn < 7) { mode = 0; dst = KB + (4 * (pn - 5) + wc) * 64; ld = 512; gain = kn_b; }
        else if (pn < 9) { mode = 1; dst = VB + (4 * (pn - 7) + wc) * 64; ld = 512; }
        else if (pn < 13) { mode = 2; dst = GA + (pn - 9) * BM + wc * 32; ld = 1024; }
        else { mode = 2; dst = GB + (pn - 13) * BM + wc * 32; ld = 1024; }
        const int bjoff = (mode == 2) ? HALF : 32;
        const PG8_LAS float* cbb = (const PG8_LAS float*)(buf + 4096) + wc * 32 + 8 * fq;
        f32x4 bv[2][2];
#pragma unroll
        for (int bj = 0; bj < 2; ++bj)
#pragma unroll
            for (int n = 0; n < 2; ++n) bv[bj][n] = *(const PG8_LAS f32x4*)(cbb + bj * HALF + 4 * n);
        f32x4 gv[2][2];
#pragma unroll
        for (int bj = 0; bj < 2; ++bj)
#pragma unroll
            for (int n = 0; n < 2; ++n) gv[bj][n] = *(const f32x4*)(gain + bj * 32 + 8 * fq + 4 * n);
#pragma unroll
        for (int ai = 0; ai < 2; ++ai) {
            u32x4 csw[4], snw[4];
            if (mode == 0) {
#pragma unroll
              for (int m = 0; m < 4; ++m) { const bf16_t* tp = ropet + (size_t)(u.pm * BM + ai * HALF + wr * 64 + m * 16 + fr) * 64 + 8 * fq; csw[m] = *(const u32x4*)tp; snw[m] = *(const u32x4*)(tp + 32); } }
#pragma unroll
            for (int m = 0; m < 4; ++m) {
                const int row = u.pm * BM + ai * HALF + wr * 64 + m * 16 + fr; const f32x4 sv_ = *(const PG8_LAS f32x4*)(buf + (ai * HALF + wr * 64 + m * 16 + fr) * 16); const float ri = rsqrtf(((sv_[0] + sv_[1]) + (sv_[2] + sv_[3])) * (1.0f / 1024.0f) + RMS_EPS);
                f32x4 v[2][2];
#pragma unroll
                for (int bj = 0; bj < 2; ++bj)
#pragma unroll
                    for (int n = 0; n < 2; ++n) v[bj][n] = acc[ai][bj][m][n] * ri + bv[bj][n];
                if (mode == 0) {
                    float ss = 0.f;
#pragma unroll
                    for (int bj = 0; bj < 2; ++bj)
#pragma unroll
                        for (int n = 0; n < 2; ++n) ss += (v[bj][n][0] * v[bj][n][0] + v[bj][n][1] * v[bj][n][1]) + (v[bj][n][2] * v[bj][n][2] + v[bj][n][3] * v[bj][n][3]);
                    ss += __shfl_xor(ss, 16); ss += __shfl_xor(ss, 32);
                    const float rn = rsqrtf(ss * (1.0f / 64.0f) + RMS_EPS);
#pragma unroll
                    for (int n = 0; n < 2; ++n) {
                        const unsigned c0_ = n ? csw[m].z : csw[m].x, c1_ = n ? csw[m].w : csw[m].y, s0_ = n ? snw[m].z : snw[m].x, s1_ = n ? snw[m].w : snw[m].y;
                        const f32x4 cs = {bf_lo(c0_), bf_hi(c0_), bf_lo(c1_), bf_hi(c1_)}, sn = {bf_lo(s0_), bf_hi(s0_), bf_lo(s1_), bf_hi(s1_)};
                        const f32x4 lo = v[0][n] * rn * gv[0][n], hi = v[1][n] * rn * gv[1][n];
                        v[0][n] = (lo * cs - hi * sn) * scale; v[1][n] = (hi * cs + lo * sn) * scale; }
                } else if (mode == 2) {
#pragma unroll
                    for (int bj = 0; bj < 2; ++bj)
#pragma unroll
                        for (int n = 0; n < 2; ++n)
#pragma unroll
                            for (int j = 0; j < 4; ++j) v[bj][n][j] = fast_sigmoid(v[bj][n][j]);
                }
                bf16_t* rowp = dst + (size_t)row * ld + 8 * fq;
#pragma unroll
                for (int bj = 0; bj < 2; ++bj) { u32x4 w; w.x = cvt_pk_bf16(v[bj][0][0], v[bj][0][1]); w.y = cvt_pk_bf16(v[bj][0][2], v[bj][0][3]); w.z = cvt_pk_bf16(v[bj][1][0], v[bj][1][1]); w.w = cvt_pk_bf16(v[bj][1][2], v[bj][1][3]);
                    *(u32x4*)(rowp + bj * bjoff) = w; } } }
    }
};

struct EpiBranch {
    static constexpr bool PERM = true, AFTER_DRAIN = false, PREFETCH = false, CHAIN = true;
    const bf16_t* GA; const bf16_t* GB; bf16_t* MG;
    __device__ __forceinline__ void operator()(f32x4 (&acc)[2][2][4][2], const Unit& u, int wr, int wc, int fr, int fq) const {
        const bool second = u.ko != 0; constexpr float TINY = 8.67361738e-19f;
        const unsigned rowoff = (unsigned)((u.pm * BM + wr * 64 + fr) * 1024 + u.pn * BM + wc * 32 + 8 * fq);
#define EB_OFF(ai, bj, m) (rowoff + (unsigned)(((ai) * HALF + (m) * 16) * 1024 + (bj) * HALF))
#define EB_UNPACK(dst, src_) const float dst[8] = {bf_lo((src_).x), bf_hi((src_).x), bf_lo((src_).y), bf_hi((src_).y), bf_lo((src_).z), bf_hi((src_).z), bf_lo((src_).w), bf_hi((src_).w)}
        if (!second) {
#pragma unroll
            for (int ai = 0; ai < 2; ++ai)
#pragma unroll
                for (int bj = 0; bj < 2; ++bj) {
                    u32x4 gbv[4], gav[4];
#pragma unroll
                    for (int m = 0; m < 4; ++m) { gbv[m] = *(const u32x4*)(GB + EB_OFF(ai, bj, m)); gav[m] = *(const u32x4*)(GA + EB_OFF(ai, bj, m)); }
#pragma unroll
                    for (int m = 0; m < 4; ++m) { EB_UNPACK(gb, gbv[m]); EB_UNPACK(ga, gav[m]);
#pragma unroll
                        for (int e = 0; e < 4; ++e) { acc[ai][bj][m][0][e] *= ga[e] * __builtin_amdgcn_rcpf(fmaxf(gb[e], TINY)); acc[ai][bj][m][1][e] *= ga[4 + e] * __builtin_amdgcn_rcpf(fmaxf(gb[4 + e], TINY)); } }
                }
        } else {
#pragma unroll
            for (int ai = 0; ai < 2; ++ai) {
                u32x4 gbv[2][4];
#pragma unroll
                for (int bj = 0; bj < 2; ++bj)
#pragma unroll
                    for (int m = 0; m < 4; ++m) gbv[bj][m] = *(const u32x4*)(GB + EB_OFF(ai, bj, m));
#pragma unroll
                for (int bj = 0; bj < 2; ++bj)
#pragma unroll
                    for (int m = 0; m < 4; ++m) { EB_UNPACK(g0, gbv[bj][m]); float gb[8];
#pragma unroll
                        for (int e = 0; e < 8; ++e) gb[e] = fmaxf(g0[e], TINY);
                        const f32x4 y0 = acc[ai][bj][m][0], y1 = acc[ai][bj][m][1];
                        u32x4 w; w.x = cvt_pk_bf16(gb[0] * y0[0], gb[1] * y0[1]); w.y = cvt_pk_bf16(gb[2] * y0[2], gb[3] * y0[3]); w.z = cvt_pk_bf16(gb[4] * y1[0], gb[5] * y1[1]); w.w = cvt_pk_bf16(gb[6] * y1[2], gb[7] * y1[3]);
                        *(u32x4*)(MG + EB_OFF(ai, bj, m)) = w; }
            }
        }
#undef EB_OFF
#undef EB_UNPACK
    }
};

template <bool WRITE_A, int COEF2, bool RIN_BF16, bool ROUT_BF16> struct EpiResid {
    static constexpr bool PERM = true, AFTER_DRAIN = true, PREFETCH = false, CHAIN = false;
    static constexpr float coef = 0.5f * COEF2; static constexpr int modld = 9216;
    const void* xin; void* xout; const float* gate;
    bf16_t* Aout; const float* gnorm; const float* sc; float* rss_out;
    __device__ __forceinline__ void fused(f32x4 (&acc)[2][2][4][2], const Unit& u, int wr, int wc, int fr, int fq, PG8_LAS unsigned char* lds, int wid, int lane) const {
        const int b = u.pm >> 5, col0 = u.pn * BM + wc * 32 + 8 * fq;
        float ss[2][4];
#pragma unroll
        for (int ai = 0; ai < 2; ++ai)
#pragma unroll
            for (int m = 0; m < 4; ++m) ss[ai][m] = 0.f;
#pragma unroll
        for (int bj = 0; bj < 2; ++bj) {
            f32x4 gt[2], gvv[2];
#pragma unroll
            for (int n = 0; n < 2; ++n) { const int c = col0 + bj * HALF + 4 * n; gt[n] = *(const f32x4*)(gate + (size_t)b * modld + c) * coef;
                if (WRITE_A) gvv[n] = *(const f32x4*)(gnorm + c) * (*(const f32x4*)(sc + (size_t)b * modld + c) + 1.0f); }
#pragma unroll
            for (int ai = 0; ai < 2; ++ai) {
                f32x4 xi[4][2];
#pragma unroll
                for (int m = 0; m < 4; ++m) { const size_t off = (size_t)(u.pm * BM + ai * HALF + wr * 64 + m * 16 + fr) * 1024 + col0 + bj * HALF;
                    if constexpr (RIN_BF16) { const u32x4 w = *(const u32x4*)((const bf16_t*)xin + off); xi[m][0] = (f32x4){bf_lo(w.x), bf_hi(w.x), bf_lo(w.y), bf_hi(w.y)}; xi[m][1] = (f32x4){bf_lo(w.z), bf_hi(w.z), bf_lo(w.w), bf_hi(w.w)}; }
                    else {
#pragma unroll
                        for (int n = 0; n < 2; ++n) xi[m][n] = *(const f32x4*)((const float*)xin + off + 4 * n); } }
#pragma unroll
                for (int m = 0; m < 4; ++m) {
                    const int row = u.pm * BM + ai * HALF + wr * 64 + m * 16 + fr; const size_t off = (size_t)row * 1024 + col0 + bj * HALF; float s = 0.f;
                    f32x4 xo[2];
#pragma unroll
                    for (int n = 0; n < 2; ++n) { xo[n] = xi[m][n] + gt[n] * acc[ai][bj][m][n];
                        if constexpr (!ROUT_BF16) *(f32x4*)((float*)xout + off + 4 * n) = xo[n];
                        if (WRITE_A) s += (xo[n][0] * xo[n][0] + xo[n][1] * xo[n][1]) + (xo[n][2] * xo[n][2] + xo[n][3] * xo[n][3]); }
                    if constexpr (ROUT_BF16) { u32x4 w; w.x = cvt_pk_bf16(xo[0][0], xo[0][1]); w.y = cvt_pk_bf16(xo[0][2], xo[0][3]); w.z = cvt_pk_bf16(xo[1][0], xo[1][1]); w.w = cvt_pk_bf16(xo[1][2], xo[1][3]); *(u32x4*)((bf16_t*)xout + off) = w; }
                    if (WRITE_A) { const f32x4 a0 = xo[0] * gvv[0], a1 = xo[1] * gvv[1]; u32x4 w; w.x = cvt_pk_bf16(a0[0], a0[1]); w.y = cvt_pk_bf16(a0[2], a0[3]); w.z = cvt_pk_bf16(a1[0], a1[1]); w.w = cvt_pk_bf16(a1[2], a1[3]);
                        *(u32x4*)(Aout + off) = w; ss[ai][m] += s; } }
                asm volatile("" ::: "memory"); }
        }
        if (WRITE_A) {
            PG8_LAS float* P = (PG8_LAS float*)lds;
#pragma unroll
            for (int ai = 0; ai < 2; ++ai)
#pragma unroll
                for (int m = 0; m < 4; ++m) { float s = ss[ai][m]; s += __shfl_xor(s, 16); s += __shfl_xor(s, 32); if (fq == 0) P[(ai * HALF + wr * 64 + m * 16 + fr) * 4 + wc] = s; }
            asm volatile("s_waitcnt lgkmcnt(0)" ::: "memory"); __builtin_amdgcn_s_barrier(); asm volatile("" ::: "memory");
            const int t = wid * 64 + lane;
            if (t < 256) { const PG8_LAS float* p = P + t * 4; rss_out[(size_t)(u.pm * BM + t) * 4 + u.pn] = (p[0] + p[1]) + (p[2] + p[3]); }
        }
    }
};

template <class Epi, class Sched, bool ALIGN_EPI = false, bool SP2 = false>
__device__ __forceinline__ void gemm_phase(PG8_LAS unsigned char* lds, const Gemm g, const Sched S, const Epi E, const int wid  ) {
    const int lane = MK_LANE(), tid = wid * 64 + lane, wr = wid >> 2, wc = wid & 3, fr = lane & 15, fq = lane >> 4;
    const int K = g.K, nt = (g.KL ? g.KL : K) / BK;
    unsigned voffA[2], voffB[2];
#pragma unroll
    for (int i = 0; i < 2; ++i) { int R, C; stage_rc(tid * 16 + i * 8192, R, C); const int Rb = Epi::PERM ? ((R & ~31) + perm32(R & 31)) : R;
        voffA[i] = (unsigned)(R * K + C) * 2u; voffB[i] = (unsigned)(Rb * K + C) * 2u; }
    const size_t kstep = (size_t)(BK * 2);
    const size_t hstep = (size_t)HALF * K * 2;
    const size_t tstep = 2 * hstep;
    const unsigned ldsw = (unsigned)wid * 1024u;
    const int aoff = lds_byte(wr * 64 + fr, fq * 8), boff = lds_byte(wc * 32 + fr, fq * 8);
#define PG8_SA(b, h) (((b) * 2 + (h)) * HTB)
#define PG8_SB(b, h) ((4 + (b) * 2 + (h)) * HTB)
#define PG8_STAGE(bufoff, gbase, voff) do { _Pragma("unroll") for (int _i = 0; _i < 2; ++_i) \
        __builtin_amdgcn_global_load_lds((const unsigned*)((const char*)(gbase) + (voff)[_i]), (PG8_LAS unsigned*)(lds + (bufoff) + ldsw + _i * 8192), 16, 0, 0); } while (0)
#define PG8_LDA(dst, b, h) do { _Pragma("unroll") for (int m = 0; m < 4; ++m) _Pragma("unroll") for (int k = 0; k < 2; ++k) dst[m][k] = *(const PG8_LAS bf16x8*)(lds + PG8_SA(b, h) + aoff + m * 2048 + k * 1024); } while (0)
#define PG8_LDB(dst, b, h) do { _Pragma("unroll") for (int n = 0; n < 2; ++n) _Pragma("unroll") for (int k = 0; k < 2; ++k) dst[n][k] = *(const PG8_LAS bf16x8*)(lds + PG8_SB(b, h) + boff + n * 2048 + k * 1024); } while (0)
#define PG8_MMA(ai, bj, At, Bt) do { __builtin_amdgcn_s_setprio(1); _Pragma("unroll") for (int m = 0; m < 4; ++m) _Pragma("unroll") for (int n = 0; n < 2; ++n) _Pragma("unroll") for (int k = 0; k < 2; ++k) \
        acc[ai][bj][m][n] = __builtin_amdgcn_mfma_f32_16x16x32_bf16(Bt[n][k], At[m][k], acc[ai][bj][m][n], 0, 0, 0); __builtin_amdgcn_s_setprio(0); } while (0)
#define PG8_WAIT_V(n) asm volatile("s_waitcnt vmcnt(" #n ")" ::: "memory")
#define PG8_WAIT_L(n) asm volatile("s_waitcnt lgkmcnt(" #n ")" ::: "memory")
#define PG8_BAR __builtin_amdgcn_s_barrier()
#define PG8_SCHED __builtin_amdgcn_sched_barrier(0)
    Unit cur, nxt; int ui = 0;
    if (!S.next(0, cur)) return;
    f32x4 acc[2][2][4][2];
#pragma unroll
    for (int a = 0; a < 2; ++a)
#pragma unroll
        for (int b = 0; b < 2; ++b)
#pragma unroll
            for (int m = 0; m < 4; ++m)
#pragma unroll
                for (int n = 0; n < 2; ++n) acc[a][b][m][n] = (f32x4){0.f, 0.f, 0.f, 0.f};
    bf16x8 At[4][2], B0[2][2], B1[2][2];
    const char* cA = (const char*)g.A + (size_t)cur.pm * tstep + cur.ko; const char* cB = (const char*)g.Bt + (size_t)cur.pn * tstep + cur.ko;
    S.a_ready(cur);
    if constexpr (SP2) {
        PG8_STAGE(PG8_SB(0, 0), cB, voffB); PG8_STAGE(PG8_SB(0, 1), cB + hstep, voffB); PG8_STAGE(PG8_SA(0, 0), cA, voffA); PG8_STAGE(PG8_SA(0, 1), cA + hstep, voffA);
        if (wr == 1) PG8_BAR;
        PG8_WAIT_V(2); PG8_BAR;
        PG8_STAGE(PG8_SB(1, 0), cB + kstep, voffB); PG8_STAGE(PG8_SA(1, 0), cA + kstep, voffA); PG8_STAGE(PG8_SB(1, 1), cB + hstep + kstep, voffB);
        PG8_WAIT_V(6); PG8_BAR;
    } else {
        PG8_STAGE(PG8_SB(0, 0), cB, voffB); PG8_STAGE(PG8_SA(0, 0), cA, voffA); PG8_STAGE(PG8_SB(0, 1), cB + hstep, voffB); PG8_STAGE(PG8_SA(0, 1), cA + hstep, voffA);
        if (wr == 1) PG8_BAR;
        PG8_WAIT_V(4); PG8_BAR;
        PG8_STAGE(PG8_SB(1, 0), cB + kstep, voffB); PG8_STAGE(PG8_SA(1, 0), cA + kstep, voffA); PG8_STAGE(PG8_SB(1, 1), cB + hstep + kstep, voffB);
        PG8_WAIT_V(6); PG8_BAR;
    }
    for (;;) {
        if constexpr (Epi::PREFETCH) E.prefetch(cur, lds + STAGE_BYTES + (ui & 1) * 5120, wid, lane);
        const bool has_next = S.next(ui + 1, nxt);
        const char* nA = has_next ? (const char*)g.A + (size_t)nxt.pm * tstep + nxt.ko : cA; const char* nB = has_next ? (const char*)g.Bt + (size_t)nxt.pn * tstep + nxt.ko : cB;
        for (int t = 0; t < nt; t += 2) {
            const bool last = (t == nt - 2);
            const char* a1 = cA + (size_t)(t + 1) * kstep;
            const char* a2 = last ? nA : cA + (size_t)(t + 2) * kstep; const char* b2 = last ? nB : cB + (size_t)(t + 2) * kstep;
            const char* a3 = a2 + kstep; const char* b3 = b2 + kstep;
            if (last && has_next) S.a_ready(nxt);
            if constexpr (SP2) {
            PG8_LDB(B0, 0, 0); PG8_LDB(B1, 0, 1); PG8_SCHED; PG8_LDA(At, 0, 0); PG8_STAGE(PG8_SA(1, 1), a1 + hstep, voffA);
            PG8_WAIT_V(8); PG8_WAIT_L(0); PG8_BAR; PG8_MMA(0, 0, At, B0); PG8_MMA(0, 1, At, B1); PG8_BAR; PG8_SCHED;
            PG8_LDA(At, 0, 1); PG8_STAGE(PG8_SB(0, 0), b2, voffB); PG8_STAGE(PG8_SB(0, 1), b2 + hstep, voffB); PG8_STAGE(PG8_SA(0, 0), a2, voffA);
            PG8_WAIT_V(8); PG8_WAIT_L(0); PG8_BAR; PG8_MMA(1, 0, At, B0); PG8_MMA(1, 1, At, B1); PG8_BAR; PG8_SCHED;
            PG8_LDB(B0, 1, 0); PG8_LDB(B1, 1, 1); PG8_SCHED; PG8_LDA(At, 1, 0); PG8_STAGE(PG8_SA(0, 1), a2 + hstep, voffA);
            PG8_WAIT_V(8); PG8_WAIT_L(0); PG8_BAR; PG8_MMA(0, 0, At, B0); PG8_MMA(0, 1, At, B1); PG8_BAR; PG8_SCHED;
            PG8_LDA(At, 1, 1); PG8_STAGE(PG8_SB(1, 0), b3, voffB); PG8_STAGE(PG8_SB(1, 1), b3 + hstep, voffB); PG8_STAGE(PG8_SA(1, 0), a3, voffA);
            PG8_WAIT_V(8); PG8_WAIT_L(0); PG8_BAR; PG8_MMA(1, 0, At, B0); PG8_MMA(1, 1, At, B1); PG8_BAR; PG8_SCHED;
            } else {
            PG8_LDB(B0, 0, 0); PG8_SCHED; PG8_LDA(At, 0, 0); PG8_STAGE(PG8_SA(1, 1), a1 + hstep, voffA);
            PG8_WAIT_L(8); PG8_BAR; PG8_WAIT_L(0); PG8_MMA(0, 0, At, B0); PG8_BAR; PG8_SCHED;
            PG8_LDB(B1, 0, 1); PG8_STAGE(PG8_SB(0, 0), b2, voffB);
            PG8_BAR; PG8_WAIT_L(0); PG8_MMA(0, 1, At, B1); PG8_BAR;
            PG8_LDA(At, 0, 1); PG8_STAGE(PG8_SA(0, 0), a2, voffA);
            PG8_BAR; PG8_WAIT_L(0); PG8_MMA(1, 0, At, B0); PG8_BAR; PG8_SCHED;
            PG8_STAGE(PG8_SB(0, 1), b2 + hstep, voffB);
            PG8_WAIT_V(6); PG8_BAR; PG8_MMA(1, 1, At, B1); PG8_BAR;
            PG8_LDB(B0, 1, 0); PG8_SCHED; PG8_LDA(At, 1, 0); PG8_STAGE(PG8_SA(0, 1), a2 + hstep, voffA);
            PG8_WAIT_L(8); PG8_BAR; PG8_WAIT_L(0); PG8_MMA(0, 0, At, B0); PG8_BAR; PG8_SCHED;
            PG8_LDB(B1, 1, 1); PG8_STAGE(PG8_SB(1, 0), b3, voffB);
            PG8_BAR; PG8_WAIT_L(0); PG8_MMA(0, 1, At, B1); PG8_BAR;
            PG8_LDA(At, 1, 1); PG8_STAGE(PG8_SA(1, 0), a3, voffA);
            PG8_BAR; PG8_WAIT_L(0); PG8_MMA(1, 0, At, B0); PG8_BAR; PG8_SCHED;
            PG8_STAGE(PG8_SB(1, 1), b3 + hstep, voffB);
            PG8_WAIT_V(6); PG8_BAR; PG8_MMA(1, 1, At, B1); PG8_BAR;
            }
        }
        if constexpr (ALIGN_EPI) { if (wr == 0) PG8_BAR; }
        if constexpr (!Epi::AFTER_DRAIN) { if constexpr (Epi::PREFETCH) E(acc, cur, wr, wc, fr, fq, lds + STAGE_BYTES + (ui & 1) * 5120); else E(acc, cur, wr, wc, fr, fq); S.done(cur); }
        if (!has_next) break;
        if (!Epi::CHAIN || nxt.ko == 0) {
#pragma unroll
        for (int a = 0; a < 2; ++a)
#pragma unroll
            for (int b = 0; b < 2; ++b)
#pragma unroll
                for (int m = 0; m < 4; ++m)
#pragma unroll
                    for (int n = 0; n < 2; ++n) acc[a][b][m][n] = (f32x4){0.f, 0.f, 0.f, 0.f};
        }
        cur = nxt; cA = nA; cB = nB; ++ui;
        if constexpr (ALIGN_EPI) { if (wr == 1) PG8_BAR; }
    }
    PG8_WAIT_V(0);
    if constexpr (!ALIGN_EPI) { if (wr == 0) PG8_BAR; }
    PG8_BAR;
    if constexpr (Epi::AFTER_DRAIN) { E.fused(acc, cur, wr, wc, fr, fq, lds, wid, lane); S.done(cur); }
#undef PG8_SA
#undef PG8_SB
#undef PG8_STAGE
#undef PG8_LDA
#undef PG8_LDB
#undef PG8_MMA
#undef PG8_WAIT_V
#undef PG8_WAIT_L
#undef PG8_BAR
#undef PG8_SCHED
}
}

#ifndef PG8_SP2
#define PG8_SP2 true
#endif
#ifndef PG8_ALIGN
#define PG8_ALIGN true
#endif
namespace att {
using bf16x8 = __attribute__((ext_vector_type(8))) short;
using s16x4  = __attribute__((ext_vector_type(4))) short;
using f32x16 = __attribute__((ext_vector_type(16))) float;
using u32x4  = __attribute__((ext_vector_type(4))) unsigned;
typedef unsigned short bf16_t;
constexpr int NW = 8, QBLK = 32, KVBLK = 64;
#ifndef ATT_SDEPTH
#define ATT_SDEPTH 1
#endif
#define ATT_SBAR() __builtin_amdgcn_sched_barrier(0)
#define KSWZ64(row, colB) ((row) * 128 + ((colB) ^ ((((row) >> 1) & 7) << 4)))
__device__ __forceinline__ int crow(int r, int hi) { return (r & 3) + 8 * (r >> 2) + 4 * hi; }
__device__ __forceinline__ unsigned cvtpk(float lo, float hi) { unsigned r; asm volatile("v_cvt_pk_bf16_f32 %0, %1, %2" : "=v"(r) : "v"(lo), "v"(hi)); return r; }
__device__ __forceinline__ float bf2f(bf16_t h) { return __uint_as_float((unsigned)h << 16); }
template <int NCB> __device__ __forceinline__ int v_st(int k, int c) { const int kk = k; return ((kk >> 3) * NCB + (c >> 5)) * 512 + ((kk & 7) * 32 + (c & 31)) * 2; }
__device__ __forceinline__ int v_rd_base(int lane) { return ((lane & 3) << 3) | (((lane >> 2) & 3) << 6) | (((lane >> 4) & 1) << 5) | (((lane >> 5) & 1) << 8); }
template <int OFF> __device__ __forceinline__ s16x4 tr_read(int vb) { s16x4 r; asm volatile("ds_read_b64_tr_b16 %0, %1 offset:%2" : "=&v"(r) : "v"(vb), "i"(OFF) : "memory"); return r; }
template <int NCB, int D0> __device__ __forceinline__ void pv_one(f32x16& od, int vb, bf16x8 pa0, bf16x8 pa1, bf16x8 pa2, bf16x8 pa3) {
#define VOFF(ks, half) (D0 * 512 + (2 * (ks) + (half)) * (NCB * 512))
  const s16x4 l0 = tr_read<VOFF(0, 0)>(vb), h0 = tr_read<VOFF(0, 1)>(vb), l1 = tr_read<VOFF(1, 0)>(vb), h1 = tr_read<VOFF(1, 1)>(vb);
  const s16x4 l2 = tr_read<VOFF(2, 0)>(vb), h2 = tr_read<VOFF(2, 1)>(vb), l3 = tr_read<VOFF(3, 0)>(vb), h3 = tr_read<VOFF(3, 1)>(vb);
#undef VOFF
  asm volatile("s_waitcnt lgkmcnt(0)" ::: "memory"); ATT_SBAR();
#define PK(L, H) (bf16x8){L[0], L[1], L[2], L[3], H[0], H[1], H[2], H[3]}
  od = __builtin_amdgcn_mfma_f32_32x32x16_bf16(pa0, PK(l0, h0), od, 0, 0, 0);
  od = __builtin_amdgcn_mfma_f32_32x32x16_bf16(pa1, PK(l1, h1), od, 0, 0, 0);
  od = __builtin_amdgcn_mfma_f32_32x32x16_bf16(pa2, PK(l2, h2), od, 0, 0, 0);
  od = __builtin_amdgcn_mfma_f32_32x32x16_bf16(pa3, PK(l3, h3), od, 0, 0, 0);
#undef PK
}
__device__ __forceinline__ void qkt(f32x16& p0, f32x16& p1, const char* Ks, const bf16x8* qr, const f32x16& negm, int r32, int hi) {
#pragma unroll
  for (int d0 = 0; d0 < 4; ++d0) { const int cb = d0 * 32 + hi * 16;
    const bf16x8 b0 = *reinterpret_cast<const bf16x8*>(Ks + KSWZ64(r32, cb));
    const bf16x8 b1 = *reinterpret_cast<const bf16x8*>(Ks + KSWZ64(32 + r32, cb));
    if (d0 == 0) { p0 = __builtin_amdgcn_mfma_f32_32x32x16_bf16(b0, qr[0], negm, 0, 0, 0); p1 = __builtin_amdgcn_mfma_f32_32x32x16_bf16(b1, qr[0], negm, 0, 0, 0); }
    else { p0 = __builtin_amdgcn_mfma_f32_32x32x16_bf16(b0, qr[d0], p0, 0, 0, 0); p1 = __builtin_amdgcn_mfma_f32_32x32x16_bf16(b1, qr[d0], p1, 0, 0, 0); } }
}
template <bool WIN> __device__ __forceinline__ void wmask(f32x16& p0, f32x16& p1, int qpos, int kbase, int hi) {
  if constexpr (WIN) {
#pragma unroll
    for (int r = 0; r < 16; ++r) { const int k0 = kbase + crow(r, hi) - qpos; if (k0 > 128 || k0 < -128) p0[r] = -INFINITY; if (k0 + 32 > 128 || k0 + 32 < -128) p1[r] = -INFINITY; }
  }
}
__device__ __forceinline__ void exp_half(f32x16& p) {
#pragma unroll
  for (int r = 0; r < 16; ++r) p[r] = __builtin_amdgcn_exp2f(p[r]);
}
__device__ __forceinline__ void finish_sm(f32x16& p0, f32x16& p1, float& l_reg, bf16x8& pa0, bf16x8& pa1, bf16x8& pa2, bf16x8& pa3) {
  exp_half(p1);
  float ps = 0.f;
#pragma unroll
  for (int r = 0; r < 16; ++r) ps += p0[r];
#pragma unroll
  for (int r = 0; r < 16; ++r) ps += p1[r];
  l_reg += ps;
#define PK4(P, BASE, OUT) do { u32x4 w = {cvtpk(P[BASE + 0], P[BASE + 1]), cvtpk(P[BASE + 2], P[BASE + 3]), cvtpk(P[BASE + 4], P[BASE + 5]), cvtpk(P[BASE + 6], P[BASE + 7])}; OUT = *reinterpret_cast<bf16x8*>(&w); } while (0)
  PK4(p0, 0, pa0); PK4(p0, 8, pa1); PK4(p1, 0, pa2); PK4(p1, 8, pa3);
#undef PK4
}
constexpr int NSLOT = 3, LDS_V = 0, LDS_K = NSLOT * KVBLK * 128 * 2, LDS_WS = LDS_K + 4 * KVBLK * 64 * 2, LDS_STG = LDS_WS + NW * 64 * 4, ATT_LDS_BYTES = LDS_STG + NW * 8192;
__device__ __forceinline__ void dma16(unsigned m0v, unsigned voff, __amdgpu_buffer_rsrc_t rs, unsigned soff) {
  unsigned keep;
  asm volatile("s_nop 4\n\ts_mov_b32 %0, m0\n\ts_mov_b32 m0, %1\n\ts_nop 0\n\tbuffer_load_dwordx4 %2, %3, %4 offen lds\n\ts_mov_b32 m0, %0" : "=&s"(keep) : "s"(m0v), "v"(voff), "s"(rs), "s"(soff) : "memory");
}
__device__ __forceinline__ void dma16x2(unsigned m0a, unsigned va, unsigned sa, unsigned m0b, unsigned vb, unsigned sb, __amdgpu_buffer_rsrc_t rs) {
  unsigned keep;
  asm volatile("s_nop 4\n\ts_mov_b32 %0, m0\n\ts_mov_b32 m0, %1\n\ts_nop 0\n\tbuffer_load_dwordx4 %2, %7, %3 offen lds\n\ts_mov_b32 m0, %4\n\ts_nop 0\n\tbuffer_load_dwordx4 %5, %7, %6 offen lds\n\ts_mov_b32 m0, %0"
               : "=&s"(keep) : "s"(m0a), "v"(va), "s"(sa), "s"(m0b), "v"(vb), "s"(sb), "s"(rs) : "memory");
}
__device__ __forceinline__ void dma16x3(unsigned m0a, unsigned va, unsigned sa, unsigned m0b, unsigned vb, unsigned m0c, unsigned vc, unsigned sbc, __amdgpu_buffer_rsrc_t rs) {
  unsigned keep;
  asm volatile("s_nop 4\n\ts_mov_b32 %0, m0\n\ts_mov_b32 m0, %1\n\ts_nop 0\n\tbuffer_load_dwordx4 %2, %9, %3 offen lds\n\ts_mov_b32 m0, %4\n\ts_nop 0\n\tbuffer_load_dwordx4 %5, %9, %8 offen lds\n\ts_mov_b32 m0, %6\n\ts_nop 0\n\tbuffer_load_dwordx4 %7, %9, %8 offen lds\n\ts_mov_b32 m0, %0"
               : "=&s"(keep) : "s"(m0a), "v"(va), "s"(sa), "s"(m0b), "v"(vb), "s"(m0c), "v"(vc), "s"(sbc), "s"(rs) : "memory");
}
template <int NCB, bool WIN>
__device__ __forceinline__ void attn_pass(__amdgpu_buffer_rsrc_t rs, unsigned Qb, unsigned ldq, unsigned Kh, unsigned ldk, unsigned Vh, unsigned ldv, int seq, int qpos0, int kpos0, float negm_s, char* lds, f32x16 (&o)[NCB], float& l_out, const int wid) {
  constexpr int DV = NCB * 32, SLOTV = KVBLK * DV * 2, SLOTK = KVBLK * 64 * 2, NVP = NCB / 2;
  const int lane = MK_LANE(), r32 = lane & 31, hi = lane >> 5;
  const unsigned lds0 = (unsigned)(uintptr_t)lds;
  char* V_lds = lds + LDS_V; char* K_lds = lds + LDS_K;
  bf16x8 qr[4];
  { const unsigned qoff = (unsigned)(wid * QBLK + r32) * ldq + hi * 16;
#pragma unroll
    for (int d0 = 0; d0 < 4; ++d0) { const u32x4 w = __builtin_amdgcn_raw_buffer_load_b128(rs, qoff + d0 * 32, Qb, 0); qr[d0] = __builtin_bit_cast(bf16x8, w); } }
  f32x16 negm; { float ns = negm_s; asm volatile("" : "+v"(ns));
#pragma unroll
  for (int r = 0; r < 16; ++r) negm[r] = ns; }
  asm volatile("" : "+v"(negm));
#pragma unroll
  for (int d = 0; d < NCB; ++d) o[d] = f32x16{};
  float l_reg = 0.f;
  unsigned kvoff, vvoff[NVP];
  { const int ob = wid * 1024 + lane * 16, row = ob >> 7, ch = ((ob >> 4) & 7) ^ ((row >> 1) & 7); kvoff = (unsigned)row * ldk + ch * 16; }
#pragma unroll
  for (int i = 0; i < NVP; ++i) { const int ob = (wid * NVP + i) * 1024 + lane * 16, st = ob >> 9, k = (st / NCB) * 8 + ((ob >> 6) & 7), c = (st % NCB) * 32 + ((ob >> 4) & 3) * 8;
    vvoff[i] = (unsigned)k * ldv + c * 2; }
  const unsigned kdst = lds0 + LDS_K + wid * 1024, vdst = lds0 + LDS_V + wid * NVP * 1024;
#define DMA_K(t, slot) dma16(kdst + (slot) * SLOTK, kvoff, rs, Kh + (unsigned)(t) * (KVBLK * ldk))
#define DMA_V(t, slot) do { _Pragma("unroll") for (int i_ = 0; i_ < NVP; ++i_) dma16(vdst + (slot) * SLOTV + i_ * 1024, vvoff[i_], rs, Vh + (unsigned)(t) * (KVBLK * ldv)); } while (0)
#define WAIT_BAR(N) asm volatile("s_waitcnt vmcnt(" #N ") lgkmcnt(0)\n\ts_barrier" ::: "memory")
#define WAIT_BAR_STEP() do { if (NVP == 2) WAIT_BAR(3); else WAIT_BAR(2); } while (0)
  const int vb0 = (int)(lds0 + LDS_V) + v_rd_base(lane);
  const int qpos = qpos0 + wid * QBLK + r32;
#define PVALL(vb) do { pv_one<NCB, 0>(o[0], vb, pa0, pa1, pa2, pa3); pv_one<NCB, 1>(o[1], vb, pa0, pa1, pa2, pa3); if constexpr (NCB == 4) { pv_one<NCB, 2>(o[2], vb, pa0, pa1, pa2, pa3); pv_one<NCB, 3>(o[3], vb, pa0, pa1, pa2, pa3); } } while (0)
  f32x16 pA0, pA1, pB0, pB1; bf16x8 pa0, pa1, pa2, pa3; const int NT = seq / KVBLK;
  DMA_K(0, 0); DMA_V(0, 0); DMA_K(1, 1);
  if (NVP == 2) WAIT_BAR(3); else WAIT_BAR(2);
  qkt(pA0, pA1, K_lds, qr, negm, r32, hi); wmask<WIN>(pA0, pA1, qpos, kpos0, hi); exp_half(pA0);
  DMA_K(2, 2); DMA_V(1, 1);
  WAIT_BAR_STEP();
  int s0 = 0, s1 = 1, s2 = 2;
#define ROT() do { const int t_ = s0; s0 = s1; s1 = s2; s2 = t_; } while (0)
#define DMA_KV(t) do { if constexpr (NVP == 2) dma16x3(kdst + s0 * SLOTK, kvoff, Kh + (unsigned)((t) + 3) * (KVBLK * ldk), vdst + s2 * SLOTV, vvoff[0], vdst + s2 * SLOTV + 1024, vvoff[NVP - 1], Vh + (unsigned)((t) + 2) * (KVBLK * ldv), rs); \
    else dma16x2(kdst + s0 * SLOTK, kvoff, Kh + (unsigned)((t) + 3) * (KVBLK * ldk), vdst + s2 * SLOTV, vvoff[0], Vh + (unsigned)((t) + 2) * (KVBLK * ldv), rs); } while (0)
  const int wq_lo = qpos0 + wid * QBLK, wq_hi = wq_lo + QBLK - 1;
#define T_NEED(j) (!WIN || ((kpos0 + (j) * KVBLK + KVBLK - 1 >= wq_lo - 128) && (kpos0 + (j) * KVBLK <= wq_hi + 128)))
#define T_FULL(j) ((kpos0 + (j) * KVBLK >= wq_hi - 128) && (kpos0 + (j) * KVBLK + KVBLK - 1 <= wq_lo + 128))
#define STEP(Pc0, Pc1, Pn0, Pn1, t, DOK, DOV, DOQK) do { \
    if (DOK && DOV) DMA_KV(t); else { if (DOK) DMA_K((t) + 3, s0); if (DOV) DMA_V((t) + 2, s2); } \
    const bool nc_ = T_NEED(t), nn_ = DOQK && T_NEED((t) + 1); \
    ATT_SBAR(); if (nn_) { qkt(Pn0, Pn1, K_lds + s1 * SLOTK, qr, negm, r32, hi); if (WIN && !T_FULL((t) + 1)) wmask<WIN>(Pn0, Pn1, qpos, kpos0 + ((t) + 1) * KVBLK, hi); } \
    if (nc_) { finish_sm(Pc0, Pc1, l_reg, pa0, pa1, pa2, pa3); } ATT_SBAR(); \
    if (nc_) { PVALL(vb0 + s0 * SLOTV); } if (nn_) exp_half(Pn0); } while (0)
  int t = 0;
  for (; t + 4 < NT; t += 2) {
    STEP(pA0, pA1, pB0, pB1, t, true, true, true); WAIT_BAR_STEP(); ROT();
    STEP(pB0, pB1, pA0, pA1, t + 1, true, true, true); WAIT_BAR_STEP(); ROT();
  }
  STEP(pA0, pA1, pB0, pB1, t, true, true, true); WAIT_BAR_STEP(); ROT();
  STEP(pB0, pB1, pA0, pA1, t + 1, false, true, true); WAIT_BAR(0); ROT();
  STEP(pA0, pA1, pB0, pB1, t + 2, false, false, true); WAIT_BAR(0); ROT();
  STEP(pB0, pB1, pA0, pA1, t + 3, false, false, false);
  { auto rr = __builtin_amdgcn_permlane32_swap(__float_as_uint(l_reg), __float_as_uint(l_reg), false, false); l_out = __uint_as_float(rr[0]) + __uint_as_float(rr[1]); }
  WAIT_BAR(0);
#undef DMA_K
#undef DMA_V
#undef WAIT_BAR
#undef WAIT_BAR_STEP
#undef PVALL
#undef ROT
#undef STEP
#undef DMA_KV
#undef T_NEED
#undef T_FULL
}
typedef __attribute__((address_space(3))) const char* lds_cptr;
typedef short v4i16_t __attribute__((ext_vector_type(4)));
__device__ __forceinline__ s16x4 vtr(lds_cptr p) { return __builtin_bit_cast(s16x4, __builtin_amdgcn_ds_read_tr16_b64_v4i16((__attribute__((address_space(3))) v4i16_t*)p)); }
__device__ __forceinline__ bf16x8 kld(lds_cptr p) { return *(const __attribute__((address_space(3))) bf16x8*)p; }
__device__ __forceinline__ void attn_pass_d4(__amdgpu_buffer_rsrc_t rs, unsigned Qb, unsigned ldq, unsigned Kh, unsigned ldk, unsigned Vh, unsigned ldv, int seq, float negm_s, char* lds, f32x16 (&o)[4], float& l_out, const int wid) {
  constexpr int SLOTV = KVBLK * 128 * 2, SLOTK = KVBLK * 64 * 2;
  const int lane = MK_LANE(), r32 = lane & 31, hi = lane >> 5;
  const unsigned lds0 = (unsigned)(uintptr_t)lds;
  bf16x8 qr[4];
  { const unsigned qoff = (unsigned)(wid * QBLK + r32) * ldq + hi * 16;
#pragma unroll
    for (int d0 = 0; d0 < 4; ++d0) { const u32x4 w = __builtin_amdgcn_raw_buffer_load_b128(rs, qoff + d0 * 32, Qb, 0); qr[d0] = __builtin_bit_cast(bf16x8, w); } }
  f32x16 negm; { float ns = negm_s; asm volatile("" : "+v"(ns));
#pragma unroll
  for (int r = 0; r < 16; ++r) negm[r] = ns; }
  asm volatile("" : "+v"(negm));
#pragma unroll
  for (int d = 0; d < 4; ++d) o[d] = f32x16{};
  float l_reg = 0.f;
  const unsigned kvoff = (unsigned)lane * ldk + wid * 16;
  unsigned vvoff0, vvoff1;
  { const int ob = (wid * 2 + 0) * 1024 + lane * 16, st = ob >> 9, k = (st / 4) * 8 + ((ob >> 6) & 7), c = (st % 4) * 32 + ((ob >> 4) & 3) * 8; vvoff0 = (unsigned)k * ldv + c * 2; }
  { const int ob = (wid * 2 + 1) * 1024 + lane * 16, st = ob >> 9, k = (st / 4) * 8 + ((ob >> 6) & 7), c = (st % 4) * 32 + ((ob >> 4) & 3) * 8; vvoff1 = (unsigned)k * ldv + c * 2; }
  const unsigned kdst = lds0 + LDS_K + wid * 1024, vdst = lds0 + LDS_V + wid * 2048;
  const lds_cptr kp0 = (lds_cptr)lds + LDS_K + hi * 1024 + r32 * 16;
  const lds_cptr vp0 = (lds_cptr)lds + LDS_V + v_rd_base(lane);
  const int NT = seq / KVBLK;
#define D4_PIN(x) asm volatile("" : "+v"(x))
#define D4_MFMA(a, b, c) __builtin_amdgcn_mfma_f32_32x32x16_bf16(a, b, c, 0, 0, 0)
#define D4_WAIT_BAR(N) asm volatile("s_waitcnt vmcnt(" #N ") lgkmcnt(0)\n\ts_barrier" ::: "memory")
#define D4_KSLOT(t) ((unsigned)((t) & 3) * SLOTK)
#define D4_DMA_K(t) dma16(kdst + D4_KSLOT(t), kvoff, rs, Kh + (unsigned)(t) * (KVBLK * ldk))
#define D4_DMA_V(t, sl) dma16x2(vdst + (sl), vvoff0, Vh + (unsigned)(t) * (KVBLK * ldv), vdst + (sl) + 1024, vvoff1, Vh + (unsigned)(t) * (KVBLK * ldv), rs)
#define D4_DMA_KV(tk, tv, sl) dma16x3(kdst + D4_KSLOT(tk), kvoff, Kh + (unsigned)(tk) * (KVBLK * ldk), vdst + (sl), vvoff0, vdst + (sl) + 1024, vvoff1, Vh + (unsigned)(tv) * (KVBLK * ldv), rs)
  f32x16 pA0, pA1, pB0, pB1; bf16x8 kf[4]; s16x4 vl[5], vh[5]; u32x4 pw0, pw1, pw2, pw3;
#define D4_KRD(buf, kp, j) kf[buf] = kld((kp) + ((j) >> 1) * 2048 + ((j) & 1) * 512)
#define D4_VO(f, half) (((f) & 3) * 512 + (2 * ((f) >> 2) + (half)) * 2048)
#define D4_VRD(f) do { vl[(f) % 5] = vtr(vp_ + D4_VO(f, 0)); vh[(f) % 5] = vtr(vp_ + D4_VO(f, 1)); } while (0)
#define D4_VFR(f) (bf16x8){vl[(f) % 5][0], vl[(f) % 5][1], vl[(f) % 5][2], vl[(f) % 5][3], vh[(f) % 5][0], vh[(f) % 5][1], vh[(f) % 5][2], vh[(f) % 5][3]}
#define D4_PKW(P, i) cvtpk(P[i], P[i + 1])
#define D4_PAF(k) __builtin_bit_cast(bf16x8, pw##k)
  D4_DMA_K(0); D4_DMA_V(0, 0); D4_DMA_K(1); D4_DMA_K(2); D4_DMA_KV(3, 1, SLOTV);
  D4_WAIT_BAR(3);
  { const lds_cptr kp_ = kp0;
    D4_KRD(0, kp_, 0); D4_KRD(1, kp_, 1); D4_KRD(2, kp_, 2); D4_KRD(3, kp_, 3);
    pA0 = D4_MFMA(kf[0], qr[0], negm); pA1 = D4_MFMA(kf[1], qr[0], negm); pA0 = D4_MFMA(kf[2], qr[1], pA0); pA1 = D4_MFMA(kf[3], qr[1], pA1);
    D4_KRD(0, kp_, 4); D4_KRD(1, kp_, 5); D4_KRD(2, kp_, 6); D4_KRD(3, kp_, 7);
    pA0 = D4_MFMA(kf[0], qr[2], pA0); pA1 = D4_MFMA(kf[1], qr[2], pA1); pA0 = D4_MFMA(kf[2], qr[3], pA0); pA1 = D4_MFMA(kf[3], qr[3], pA1);
    exp_half(pA0); exp_half(pA1);
    const lds_cptr kn_ = kp0 + SLOTK;
    D4_KRD(0, kn_, 0); D4_KRD(1, kn_, 1); D4_KRD(2, kn_, 2); D4_KRD(3, kn_, 3); }
  D4_WAIT_BAR(3);
  unsigned sl_prev = 0, sl_cur = SLOTV, sl_next = 2 * SLOTV;
#define D4_ROT() do { sl_prev = sl_cur; sl_cur = sl_next; sl_next = (sl_next == 2u * SLOTV) ? 0u : sl_next + SLOTV; } while (0)
#define D4_EX2(X, i) do { X[i] = __builtin_amdgcn_exp2f(X[i]); X[(i) + 1] = __builtin_amdgcn_exp2f(X[(i) + 1]); } while (0)
#define D4_GAPA(MF, LD, a0, a1, a2, a3, W0, W1, PW) do { MF; LD; sacc += a0; sacc += a1; sacc += a2; sacc += a3; W0; W1; D4_PIN(PW); D4_PIN(sacc); ATT_SBAR(); } while (0)
#define D4_GAPB(i, X, xi, LD) do { o[(i) & 3] = D4_MFMA(D4_PAFI(i), D4_VFR(i), o[(i) & 3]); LD; D4_EX2(X, xi); D4_PIN(X); ATT_SBAR(); } while (0)
#define D4_PAFI(i) (((i) >> 2) == 0 ? D4_PAF(0) : ((i) >> 2) == 1 ? D4_PAF(1) : ((i) >> 2) == 2 ? D4_PAF(2) : D4_PAF(3))
#define D4_PHA(C0, C1, P0, P1, t, VR) do { ATT_SBAR(); \
    const lds_cptr vp_ = vp0 + sl_prev; const lds_cptr kp_ = kp0 + D4_KSLOT(t); \
    float sacc = P0[0] + P0[1]; ATT_SBAR(); \
    D4_GAPA(C0 = D4_MFMA(kf[0], qr[0], negm), D4_KRD(0, kp_, 4), P0[2], P0[3], P0[4], P0[5],     pw0[0] = D4_PKW(P0, 0),  pw0[1] = D4_PKW(P0, 2),  pw0); \
    D4_GAPA(C1 = D4_MFMA(kf[1], qr[0], negm), D4_KRD(1, kp_, 5), P0[6], P0[7], P0[8], P0[9],     pw0[2] = D4_PKW(P0, 4),  pw0[3] = D4_PKW(P0, 6),  pw0); \
    D4_GAPA(C0 = D4_MFMA(kf[2], qr[1], C0),   D4_KRD(2, kp_, 6), P0[10], P0[11], P0[12], P0[13], pw1[0] = D4_PKW(P0, 8),  pw1[1] = D4_PKW(P0, 10), pw1); \
    D4_GAPA(C1 = D4_MFMA(kf[3], qr[1], C1),   D4_KRD(3, kp_, 7), P0[14], P0[15], P1[0], P1[1],   pw1[2] = D4_PKW(P0, 12), pw1[3] = D4_PKW(P0, 14), pw1); \
    D4_GAPA(C0 = D4_MFMA(kf[0], qr[2], C0),   do { if (VR) D4_VRD(0); } while (0), P1[2], P1[3], P1[4], P1[5],     pw2[0] = D4_PKW(P1, 0),  pw2[1] = D4_PKW(P1, 2),  pw2); \
    D4_GAPA(C1 = D4_MFMA(kf[1], qr[2], C1),   do { if (VR) D4_VRD(1); } while (0), P1[6], P1[7], P1[8], P1[9],     pw2[2] = D4_PKW(P1, 4),  pw2[3] = D4_PKW(P1, 6),  pw2); \
    D4_GAPA(C0 = D4_MFMA(kf[2], qr[3], C0),   do { if (VR) D4_VRD(2); } while (0), P1[10], P1[11], P1[12], P1[13], pw3[0] = D4_PKW(P1, 8),  pw3[1] = D4_PKW(P1, 10), pw3); \
    D4_GAPA(C1 = D4_MFMA(kf[3], qr[3], C1),   do { if (VR) { D4_VRD(3); D4_VRD(4); } } while (0), P1[14], P1[15], 0.f, 0.f, pw3[2] = D4_PKW(P1, 12), pw3[3] = D4_PKW(P1, 14), pw3); \
    l_reg += sacc; } while (0)
#define D4_PHB(C0, C1, t, GK, GV, GL, PRE) do { ATT_SBAR(); \
    const lds_cptr vp_ = vp0 + sl_prev; const lds_cptr kn_ = kp0 + D4_KSLOT((t) + 1); \
    if (PRE) { D4_VRD(0); D4_VRD(1); D4_VRD(2); D4_VRD(3); D4_VRD(4); ATT_SBAR(); } \
    D4_GAPB(0, C0, 0, D4_VRD(5));   D4_GAPB(1, C0, 2, D4_VRD(6));   D4_GAPB(2, C0, 4, D4_VRD(7));    D4_GAPB(3, C0, 6, D4_VRD(8)); \
    D4_GAPB(4, C0, 8, D4_VRD(9));   D4_GAPB(5, C0, 10, D4_VRD(10)); D4_GAPB(6, C0, 12, D4_VRD(11));  D4_GAPB(7, C0, 14, do { D4_VRD(12); if (GL) D4_KRD(0, kn_, 0); } while (0)); \
    D4_GAPB(8, C1, 0, do { D4_VRD(13); if ((GK) && (GV)) D4_DMA_KV((t) + 3, (t) + 1, sl_next); else if (GV) D4_DMA_V((t) + 1, sl_next); } while (0)); \
    D4_GAPB(9, C1, 2, do { D4_VRD(14); if (GL) D4_KRD(1, kn_, 1); } while (0));  D4_GAPB(10, C1, 4, do { D4_VRD(15); if (GL) D4_KRD(2, kn_, 2); } while (0));  D4_GAPB(11, C1, 6, do { if (GL) D4_KRD(3, kn_, 3); } while (0)); \
    D4_GAPB(12, C1, 8, (void)0); D4_GAPB(13, C1, 10, (void)0); D4_GAPB(14, C1, 12, (void)0); D4_GAPB(15, C1, 14, (void)0); \
    } while (0)
  if (wid < 4) {
    int t = 1;
    for (; t + 4 < NT; t += 2) {
      D4_PHA(pB0, pB1, pA0, pA1, t, true);     D4_PHB(pB0, pB1, t, true, true, true, false);     D4_WAIT_BAR(3); D4_ROT();
      D4_PHA(pA0, pA1, pB0, pB1, t + 1, true); D4_PHB(pA0, pA1, t + 1, true, true, true, false); D4_WAIT_BAR(3); D4_ROT();
    }
    D4_PHA(pB0, pB1, pA0, pA1, t, true);     D4_PHB(pB0, pB1, t, false, true, true, false);      D4_WAIT_BAR(2); D4_ROT();
    D4_PHA(pA0, pA1, pB0, pB1, t + 1, true); D4_PHB(pA0, pA1, t + 1, false, true, true, false);  D4_WAIT_BAR(0); D4_ROT();
    D4_PHA(pB0, pB1, pA0, pA1, t + 2, true); D4_PHB(pB0, pB1, t + 2, false, false, false, false);
  } else {
    D4_PHA(pB0, pB1, pA0, pA1, 1, false);
    int t = 1;
    for (; t + 4 < NT; t += 2) {
      D4_PHB(pB0, pB1, t, true, true, true, true);     D4_PHA(pA0, pA1, pB0, pB1, t + 1, false); D4_WAIT_BAR(3); D4_ROT();
      D4_PHB(pA0, pA1, t + 1, true, true, true, true); D4_PHA(pB0, pB1, pA0, pA1, t + 2, false); D4_WAIT_BAR(3); D4_ROT();
    }
    D4_PHB(pB0, pB1, t, false, true, true, true);      D4_PHA(pA0, pA1, pB0, pB1, t + 1, false); D4_WAIT_BAR(2); D4_ROT();
    D4_PHB(pA0, pA1, t + 1, false, true, true, true);  D4_PHA(pB0, pB1, pA0, pA1, t + 2, false); D4_WAIT_BAR(0); D4_ROT();
    D4_PHB(pB0, pB1, t + 2, false, false, false, true);
  }
  { float sacc = pB0[0] + pB0[1];
#pragma unroll
    for (int r = 2; r < 16; ++r) sacc += pB0[r];
#pragma unroll
    for (int r = 0; r < 16; ++r) sacc += pB1[r];
    l_reg += sacc;
    pw0 = (u32x4){D4_PKW(pB0, 0), D4_PKW(pB0, 2), D4_PKW(pB0, 4), D4_PKW(pB0, 6)}; pw1 = (u32x4){D4_PKW(pB0, 8), D4_PKW(pB0, 10), D4_PKW(pB0, 12), D4_PKW(pB0, 14)};
    pw2 = (u32x4){D4_PKW(pB1, 0), D4_PKW(pB1, 2), D4_PKW(pB1, 4), D4_PKW(pB1, 6)}; pw3 = (u32x4){D4_PKW(pB1, 8), D4_PKW(pB1, 10), D4_PKW(pB1, 12), D4_PKW(pB1, 14)};
    const lds_cptr vp_ = vp0 + sl_cur;
    D4_VRD(0); D4_VRD(1); D4_VRD(2); D4_VRD(3); D4_VRD(4);
    o[0] = D4_MFMA(D4_PAF(0), D4_VFR(0), o[0]); D4_VRD(5);
    o[1] = D4_MFMA(D4_PAF(0), D4_VFR(1), o[1]); D4_VRD(6);
    o[2] = D4_MFMA(D4_PAF(0), D4_VFR(2), o[2]); D4_VRD(7);
    o[3] = D4_MFMA(D4_PAF(0), D4_VFR(3), o[3]); D4_VRD(8);
    o[0] = D4_MFMA(D4_PAF(1), D4_VFR(4), o[0]); D4_VRD(9);
    o[1] = D4_MFMA(D4_PAF(1), D4_VFR(5), o[1]); D4_VRD(10);
    o[2] = D4_MFMA(D4_PAF(1), D4_VFR(6), o[2]); D4_VRD(11);
    o[3] = D4_MFMA(D4_PAF(1), D4_VFR(7), o[3]); D4_VRD(12);
    o[0] = D4_MFMA(D4_PAF(2), D4_VFR(8), o[0]); D4_VRD(13);
    o[1] = D4_MFMA(D4_PAF(2), D4_VFR(9), o[1]); D4_VRD(14);
    o[2] = D4_MFMA(D4_PAF(2), D4_VFR(10), o[2]); D4_VRD(15);
    o[3] = D4_MFMA(D4_PAF(2), D4_VFR(11), o[3]);
    o[0] = D4_MFMA(D4_PAF(3), D4_VFR(12), o[0]);
    o[1] = D4_MFMA(D4_PAF(3), D4_VFR(13), o[1]);
    o[2] = D4_MFMA(D4_PAF(3), D4_VFR(14), o[2]);
    o[3] = D4_MFMA(D4_PAF(3), D4_VFR(15), o[3]); }
  { auto rr = __builtin_amdgcn_permlane32_swap(__float_as_uint(l_reg), __float_as_uint(l_reg), false, false); l_out = __uint_as_float(rr[0]) + __uint_as_float(rr[1]); }
  D4_WAIT_BAR(0);
#undef D4_PIN
#undef D4_MFMA
#undef D4_WAIT_BAR
#undef D4_KSLOT
#undef D4_DMA_K
#undef D4_DMA_V
#undef D4_DMA_KV
#undef D4_KRD
#undef D4_VO
#undef D4_VRD
#undef D4_VFR
#undef D4_PKW
#undef D4_PAF
#undef D4_PAFI
#undef D4_ROT
#undef D4_EX2
#undef D4_GAPA
#undef D4_GAPB
#undef D4_PHA
#undef D4_PHB
}
__device__ __forceinline__ void row_recips(float l, float extra, float* wsf, int r32, int hi, float (&rli)[16]) {
  if (hi == 0) wsf[r32] = l + extra; asm volatile("s_waitcnt lgkmcnt(0)" ::: "memory");
#pragma unroll
  for (int r = 0; r < 16; ++r) rli[r] = __builtin_amdgcn_rcpf(wsf[crow(r, hi)]);
  asm volatile("s_waitcnt lgkmcnt(0)" ::: "memory");
}

__device__ __forceinline__ void win_unit(__amdgpu_buffer_rsrc_t rs, const char* wsb, int b, int hq, int qb, const bf16_t* QA, const bf16_t* KA, const bf16_t* VA, bf16_t* ACAT, const float* scal, char* lds, const int wid) {
  constexpr int S = 8192;
  const int lane0 = MK_LANE(), kvh = hq >> 2;
  const int q0 = qb * 256; int kbeg = q0 - 128, kend = q0 + 384; if (kbeg < 0) kbeg = 0; if (kend > S) kend = S;
  const size_t rowbase = (size_t)b * S;
  f32x16 o[2]; float l;
  attn_pass<2, true>(rs, (unsigned)((const char*)(QA + (rowbase + q0) * 512 + hq * 64) - wsb), 1024u, (unsigned)((const char*)(KA + (rowbase + kbeg) * 128 + kvh * 64) - wsb), 256u, (unsigned)((const char*)(VA + (rowbase + kbeg) * 128 + kvh * 64) - wsb), 256u, kend - kbeg, q0, kbeg, scal[8 + hq], lds, o, l, wid);
  int r32 = lane0 & 31, hi = lane0 >> 5, lane = lane0; asm volatile("" : "+v"(r32), "+v"(hi), "+v"(lane));
  float* wsf = (float*)(lds + LDS_WS) + wid * 64; float rli[16];
  row_recips(l, scal[16 + hq], wsf, r32, hi, rli);
  bf16_t* stg = (bf16_t*)(lds + LDS_STG) + wid * 4096;
#pragma unroll
  for (int r = 0; r < 16; ++r) { const int orow = crow(r, hi);
#pragma unroll
    for (int d0 = 0; d0 < 2; ++d0) stg[orow * 64 + d0 * 32 + r32] = (bf16_t)(cvtpk(o[d0][r] * rli[r], 0.f) & 0xffffu); }
  asm volatile("s_waitcnt lgkmcnt(0)" ::: "memory");
  const int widl = wid;
  bf16_t* Ow = ACAT + (rowbase + q0) * 1024 + hq * 64 + (unsigned)((widl * QBLK + (lane >> 3)) * 1024 + (lane & 7) * 8);
  const bf16_t* sp = stg + (lane >> 3) * 64 + (lane & 7) * 8;
#pragma unroll
  for (int i = 0; i < 4; ++i) { const u32x4 v = *(const u32x4*)(sp + i * 512); *(u32x4*)(Ow + (size_t)i * 8192) = v; }
  asm volatile("s_waitcnt lgkmcnt(0)" ::: "memory"); __syncthreads();
}

__device__ __forceinline__ void win_unit2(__amdgpu_buffer_rsrc_t rs, const char* wsb, int b, int kvh, int qb, int pair, const bf16_t* QA, const bf16_t* KA, const bf16_t* VA, bf16_t* ACAT, const float* scal, char* lds, const int wid) {
  constexpr int S = 8192, W_K = 65536, W_WS = 131072;
  const int lane = MK_LANE(), r32 = lane & 31, hi = lane >> 5;
  const unsigned lds0 = (unsigned)(uintptr_t)lds;
  const int q0 = qb * 256, kb0 = q0 - 128; const size_t rowbase = (size_t)b * S;
  const unsigned Kb = (unsigned)((const char*)(KA + rowbase * 128 + kvh * 64) - wsb), Vb = (unsigned)((const char*)(VA + rowbase * 128 + kvh * 64) - wsb);
  { const unsigned kvoff = (unsigned)lane * 256u + wid * 16;
    const int ob = wid * 1024 + lane * 16, st = ob >> 9, k = (st / 2) * 8 + ((ob >> 6) & 7), c = (st % 2) * 32 + ((ob >> 4) & 3) * 8; const unsigned vvoff = (unsigned)k * 256u + c * 2;
#pragma unroll
    for (int j = 0; j < 8; ++j) { const int ks = kb0 + 64 * j;
      if (ks >= 0 && ks < S) dma16x2(lds0 + W_K + j * 8192 + wid * 1024, kvoff, Kb + (unsigned)ks * 256u, lds0 + j * 8192 + wid * 1024, vvoff, Vb + (unsigned)ks * 256u, rs); } }
  asm volatile("s_waitcnt vmcnt(0)\n\ts_barrier" ::: "memory");
  const lds_cptr kp0 = (lds_cptr)lds + W_K + hi * 1024 + r32 * 16;
  const lds_cptr vp0 = (lds_cptr)lds + v_rd_base(lane);
  float* wsf = (float*)(lds + W_WS) + wid * 64;
  const int qrow0 = q0 + wid * QBLK, qpos = qrow0 + r32, jlo = wid >> 1;
#pragma unroll 1
  for (int hh = 0; hh < 2; ++hh) {
    const int hq = kvh * 4 + pair * 2 + hh;
    bf16x8 qr[4];
    { const unsigned Qb = (unsigned)((const char*)(QA + (rowbase + q0) * 512 + hq * 64) - wsb), qoff = (unsigned)(wid * QBLK + r32) * 1024u + hi * 16;
#pragma unroll
      for (int d0 = 0; d0 < 4; ++d0) { const u32x4 w = __builtin_amdgcn_raw_buffer_load_b128(rs, qoff + d0 * 32, Qb, 0); qr[d0] = __builtin_bit_cast(bf16x8, w); } }
    f32x16 negm; { float ns = scal[8 + hq]; asm volatile("" : "+v"(ns));
#pragma unroll
    for (int r = 0; r < 16; ++r) negm[r] = ns; }
    f32x16 o0 = f32x16{}, o1 = f32x16{}; float l_reg = 0.f;
#pragma unroll 1
    for (int i = 0; i < 5; ++i) {
      const int j = jlo + i, ks = kb0 + 64 * j;
      if (ks < 0 || ks >= S) continue;
      const lds_cptr kp = kp0 + j * 8192; const lds_cptr vp = vp0 + j * 8192;
      f32x16 p0, p1;
#pragma unroll
      for (int d0 = 0; d0 < 4; ++d0) { const bf16x8 k0 = kld(kp + d0 * 2048), k1 = kld(kp + d0 * 2048 + 512);
        if (d0 == 0) { p0 = __builtin_amdgcn_mfma_f32_32x32x16_bf16(k0, qr[0], negm, 0, 0, 0); p1 = __builtin_amdgcn_mfma_f32_32x32x16_bf16(k1, qr[0], negm, 0, 0, 0); }
        else { p0 = __builtin_amdgcn_mfma_f32_32x32x16_bf16(k0, qr[d0], p0, 0, 0, 0); p1 = __builtin_amdgcn_mfma_f32_32x32x16_bf16(k1, qr[d0], p1, 0, 0, 0); } }
      if (!((ks >= qrow0 + QBLK - 1 - 128) && (ks + 63 <= qrow0 + 128))) wmask<true>(p0, p1, qpos, ks, hi);
      exp_half(p0); exp_half(p1);
      float ps = 0.f;
#pragma unroll
      for (int r = 0; r < 16; ++r) ps += p0[r];
#pragma unroll
      for (int r = 0; r < 16; ++r) ps += p1[r];
      l_reg += ps;
      bf16x8 pa0, pa1, pa2, pa3;
#define W2_PK4(P, BASE, OUT) do { u32x4 w = {cvtpk(P[BASE + 0], P[BASE + 1]), cvtpk(P[BASE + 2], P[BASE + 3]), cvtpk(P[BASE + 4], P[BASE + 5]), cvtpk(P[BASE + 6], P[BASE + 7])}; OUT = *reinterpret_cast<bf16x8*>(&w); } while (0)
      W2_PK4(p0, 0, pa0); W2_PK4(p0, 8, pa1); W2_PK4(p1, 0, pa2); W2_PK4(p1, 8, pa3);
#undef W2_PK4
#define W2_VF(D0, ks_) ({ const s16x4 l_ = vtr(vp + (D0) * 512 + (2 * (ks_)) * 1024), h_ = vtr(vp + (D0) * 512 + (2 * (ks_) + 1) * 1024); (bf16x8){l_[0], l_[1], l_[2], l_[3], h_[0], h_[1], h_[2], h_[3]}; })
      o0 = __builtin_amdgcn_mfma_f32_32x32x16_bf16(pa0, W2_VF(0, 0), o0, 0, 0, 0); o1 = __builtin_amdgcn_mfma_f32_32x32x16_bf16(pa0, W2_VF(1, 0), o1, 0, 0, 0);
      o0 = __builtin_amdgcn_mfma_f32_32x32x16_bf16(pa1, W2_VF(0, 1), o0, 0, 0, 0); o1 = __builtin_amdgcn_mfma_f32_32x32x16_bf16(pa1, W2_VF(1, 1), o1, 0, 0, 0);
      o0 = __builtin_amdgcn_mfma_f32_32x32x16_bf16(pa2, W2_VF(0, 2), o0, 0, 0, 0); o1 = __builtin_amdgcn_mfma_f32_32x32x16_bf16(pa2, W2_VF(1, 2), o1, 0, 0, 0);
      o0 = __builtin_amdgcn_mfma_f32_32x32x16_bf16(pa3, W2_VF(0, 3), o0, 0, 0, 0); o1 = __builtin_amdgcn_mfma_f32_32x32x16_bf16(pa3, W2_VF(1, 3), o1, 0, 0, 0);
#undef W2_VF
    }
    float l; { auto rr = __builtin_amdgcn_permlane32_swap(__float_as_uint(l_reg), __float_as_uint(l_reg), false, false); l = __uint_as_float(rr[0]) + __uint_as_float(rr[1]); }
    float rli[16];
    row_recips(l, scal[16 + hq], wsf, r32, hi, rli);
    bf16_t* stg = (bf16_t*)(lds + W_WS + 2048) + wid * 1024;
    bf16_t* Ow = ACAT + (rowbase + q0 + wid * QBLK) * 1024 + hq * 64;
#pragma unroll
    for (int g = 0; g < 2; ++g) {
#pragma unroll
      for (int rr = 0; rr < 8; ++rr) { const int r = 8 * g + rr, srow = crow(r, hi) - 16 * g;
        stg[srow * 64 + r32] = (bf16_t)(cvtpk(o0[r] * rli[r], 0.f) & 0xffffu); stg[srow * 64 + 32 + r32] = (bf16_t)(cvtpk(o1[r] * rli[r], 0.f) & 0xffffu); }
      asm volatile("s_waitcnt lgkmcnt(0)" ::: "memory");
#pragma unroll
      for (int i = 0; i < 2; ++i) { const int row = i * 8 + (lane >> 3), ch = lane & 7; const u32x4 v = *(const u32x4*)(stg + row * 64 + ch * 8); *(u32x4*)(Ow + (size_t)(16 * g + row) * 1024 + ch * 8) = v; }
      asm volatile("s_waitcnt lgkmcnt(0)" ::: "memory"); }
  }
  asm volatile("s_waitcnt lgkmcnt(0)" ::: "memory"); __syncthreads();
}

__device__ __forceinline__ void diff_unit(__amdgpu_buffer_rsrc_t rs, const char* wsb, int b, int h, int qb, const bf16_t* QB, const bf16_t* KB, const bf16_t* VB, bf16_t* ACAT, const float* scal, const float* subln, char* lds, const int wid) {
  constexpr int S = 8192;
  const size_t rowbase = (size_t)b * S; const int q0 = qb * 256;
  float* wsf = (float*)(lds + LDS_WS) + wid * 64; float rli[16];
  bf16_t* stg = (bf16_t*)(lds + LDS_STG) + wid * 4096;
#pragma unroll 1
  for (int t = 0; t < 2; ++t) {
    f32x16 o[4]; float l; const float negm_s = scal[2];
    attn_pass_d4(rs, (unsigned)((const char*)(QB + (rowbase + q0) * 512 + (2 * h + t) * 64) - wsb), 1024u, (unsigned)((const char*)(KB + rowbase * 512 + (2 * h + t) * 64) - wsb), 1024u, (unsigned)((const char*)(VB + rowbase * 512 + h * 128) - wsb), 1024u, S, negm_s, lds, o, l, wid);
    const int lane1 = MK_LANE(); int r32 = lane1 & 31, hi = lane1 >> 5, lane = lane1; asm volatile("" : "+v"(r32), "+v"(hi), "+v"(lane));
    row_recips(l, 0.f, wsf, r32, hi, rli);
    if (t == 0) {
#pragma unroll
      for (int r = 0; r < 16; ++r) { const int orow = crow(r, hi);
#pragma unroll
        for (int d0 = 0; d0 < 4; ++d0) stg[orow * 128 + d0 * 32 + r32] = (bf16_t)(cvtpk(o[d0][r] * rli[r], 0.f) & 0xffffu); }
    } else {
      const float lam = scal[0], post = 1.0f - scal[1];
      float ss[16];
#pragma unroll
      for (int r = 0; r < 16; ++r) { const int orow = crow(r, hi); float s_ = 0.f;
#pragma unroll
        for (int d0 = 0; d0 < 4; ++d0) { const float v = bf2f(stg[orow * 128 + d0 * 32 + r32]) - lam * (o[d0][r] * rli[r]); o[d0][r] = v; s_ += v * v; }
        ss[r] = s_; }
#pragma unroll
      for (int r = 0; r < 16; ++r) { float s_ = ss[r]; s_ += __shfl_xor(s_, 1); s_ += __shfl_xor(s_, 2); s_ += __shfl_xor(s_, 4); s_ += __shfl_xor(s_, 8); s_ += __shfl_xor(s_, 16); ss[r] = rsqrtf(s_ * (1.0f / 128.0f) + 1e-6f) * post; }
      float sl[4];
#pragma unroll
      for (int d0 = 0; d0 < 4; ++d0) sl[d0] = subln[d0 * 32 + r32];
#pragma unroll
      for (int r = 0; r < 16; ++r) { const int orow = crow(r, hi);
#pragma unroll
        for (int d0 = 0; d0 < 4; ++d0) stg[orow * 128 + d0 * 32 + r32] = (bf16_t)(cvtpk(o[d0][r] * ss[r] * sl[d0], 0.f) & 0xffffu); }
      asm volatile("s_waitcnt lgkmcnt(0)" ::: "memory");
      const int widl = wid;
      bf16_t* Ow = ACAT + (rowbase + q0) * 1024 + 512 + h * 128 + (unsigned)((widl * QBLK + (lane >> 4)) * 1024 + (lane & 15) * 8);
      const bf16_t* sp = stg + (lane >> 4) * 128 + (lane & 15) * 8;
#pragma unroll
      for (int i = 0; i < 8; ++i) { const u32x4 v = *(const u32x4*)(sp + i * 512); *(u32x4*)(Ow + (size_t)i * 4096) = v; }
    }
  }
  asm volatile("s_waitcnt lgkmcnt(0)" ::: "memory"); __syncthreads();
}
#undef ATT_SBAR
#undef KSWZ64
}
constexpr int NWAVES = 8;
#ifndef MK_N_LAUNCHES
#define MK_N_LAUNCHES 1
#endif
constexpr int PER_PHASE = 10;
constexpr int N_LAUNCHES = MK_N_LAUNCHES;

constexpr int BATCH = 2, T = 8192, D = 1024, M = BATCH * T, DFF = 2816, NFF = 2 * DFF, NIN = 4352, NMOD = 9 * D;
constexpr size_t MiB = 1u << 20;
constexpr size_t WS_CTL = 0, CTL_ZERO_BYTES = 1 * MiB;
constexpr size_t WS_MOD = 512 * 1024;
constexpr size_t WS_SCAL = 1 * MiB, WS_CB1 = WS_SCAL + 4096, WS_CBIN = WS_CB1 + 65536, WS_CB2 = WS_CBIN + 65536;
constexpr size_t WS_RSS0 = 2 * MiB, WS_RSS1 = WS_RSS0 + 256 * 1024, WS_RSS2 = WS_RSS1 + 256 * 1024;
constexpr size_t WS_COS = 3 * MiB, WS_SIN = 5 * MiB;
constexpr size_t WS_W1T = 8 * MiB, WS_W1OT = 19 * MiB, WS_WINT = 25 * MiB, WS_WBRT = 34 * MiB, WS_WOT = 38 * MiB, WS_W2T = 40 * MiB, WS_W2OT = 51 * MiB;
constexpr size_t WS_ABUF = 57 * MiB;
constexpr size_t WS_R1 = 89 * MiB;
constexpr size_t WS_QA = WS_R1, WS_KA = WS_QA + 16 * MiB, WS_VA = WS_KA + 4 * MiB, WS_QB = WS_VA + 4 * MiB, WS_KB = WS_QB + 16 * MiB, WS_VB = WS_KB + 16 * MiB;
constexpr size_t WS_MG = WS_R1;
constexpr size_t WS_GA = 177 * MiB, WS_GB = 209 * MiB, WS_END = 241 * MiB;
static_assert(WS_VB + 16 * MiB <= WS_GA && WS_R1 + (size_t)M * DFF * 2 <= WS_GA && WS_W2OT + (size_t)D * DFF * 2 <= WS_ABUF, "d_ws map");
constexpr int CW_TMO = 0, CW_CODE = 1, CW_BAR = 4096;

constexpr int RING_OFF = 0, RING_BYTES = 131072;
constexpr int LDSCTL_OFF = 149504, MISC_OFF = LDSCTL_OFF + 320;
constexpr int LDS_BYTES = 155648;
static_assert(MISC_OFF + 128 <= LDS_BYTES && att::ATT_LDS_BYTES <= LDSCTL_OFF && RING_BYTES <= LDSCTL_OFF, "LDS map");

#define GAS __attribute__((address_space(1)))
#define LAS __attribute__((address_space(3)))
typedef unsigned short bf16;
typedef unsigned v4u __attribute__((ext_vector_type(4)));
typedef float f32x4 __attribute__((ext_vector_type(4)));
typedef short bf16x8 __attribute__((ext_vector_type(8)));
typedef GAS unsigned gu32;
typedef GAS unsigned long long gu64;
#define RLX_AGENT __ATOMIC_RELAXED, __HIP_MEMORY_SCOPE_AGENT
#define LDS_WAIT() asm volatile("s_waitcnt lgkmcnt(0)" ::: "memory")
#define VM_WAIT() asm volatile("s_waitcnt vmcnt(0)" ::: "memory")
__device__ __forceinline__ unsigned long long rt() { return __builtin_amdgcn_s_memrealtime(); }
__device__ __forceinline__ unsigned f2bf(float f) { unsigned u = __builtin_bit_cast(unsigned, f); return (u + 0x7fffu + ((u >> 16) & 1u)) >> 16; }
__device__ __forceinline__ unsigned pk2(float lo, float hi) { return f2bf(lo) | (f2bf(hi) << 16); }

#define XB_TMO      128
#define XB_XCNT(j)  (256  + 64 * (j))
#define XB_XSUB(j)  (1280 + 64 * (j))
#define XB_XGEN(j)  (2304 + 64 * (j))
#define XB_TOP      3328
#define XB_TOPGEN   3392
#define XCD_BAR_WORDS 3456
#define XB_SPIN_CAP (1u << 18)

__device__ __forceinline__ unsigned xb_ld(unsigned* p)              { return __hip_atomic_load(p, __ATOMIC_RELAXED, __HIP_MEMORY_SCOPE_AGENT); }
__device__ __forceinline__ unsigned xb_add(unsigned* p, unsigned v) { return __hip_atomic_fetch_add(p, v, __ATOMIC_RELAXED, __HIP_MEMORY_SCOPE_AGENT); }
__device__ __forceinline__ unsigned xb_xcc_id() { return (unsigned)__builtin_amdgcn_s_getreg((3 << 11) | 20) & 0xFu; }
#define XB_SPIN(cond, bar) do { unsigned _sp = 0; while (cond) { __builtin_amdgcn_s_sleep(1); \
    if ((++_sp & 255u) == 0u) { if (xb_ld(&(bar)[XB_TMO])) break; if (_sp > XB_SPIN_CAP) { atomicAdd(&(bar)[XB_TMO], 1u); break; } } } } while (0)

struct XcdBarrier {
    unsigned* bar; unsigned x;
    volatile LAS unsigned* st;
};

__device__ __forceinline__ XcdBarrier xcd_barrier_post(unsigned* bar, volatile LAS unsigned* st) {
    XcdBarrier b; b.bar = bar; b.x = xb_xcc_id(); b.st = st;
    if (threadIdx.x == 0) (void)xb_add(&bar[XB_XCNT(b.x)], 1u);
    return b;
}
__device__ __forceinline__ void xcd_barrier_complete(unsigned* bar, unsigned x, unsigned& nloc, unsigned& nx) {
    const unsigned G = gridDim.x * gridDim.y * gridDim.z;
    unsigned sum, cnt, mine, sp = 0u;
    for (;;) {
        sum = 0u; cnt = 0u; mine = 0u;
#pragma unroll
        for (unsigned j = 0; j < 16; ++j) { const unsigned c = xb_ld(&bar[XB_XCNT(j)]); sum += c; cnt += (c > 0u) ? 1u : 0u; mine = (j == x) ? c : mine; }
        if (sum == G) break;
        __builtin_amdgcn_s_sleep(1);
        if ((++sp & 255u) == 0u) { if (xb_ld(&bar[XB_TMO])) break; if (sp > XB_SPIN_CAP) { atomicAdd(&bar[XB_TMO], 1u); break; } }
    }
    nloc = mine > 0u ? mine : 1u; nx = cnt > 0u ? cnt : 1u;
}

__device__ __forceinline__ void xcd_barrier(const XcdBarrier& b, const bool leader  ) {
    asm volatile("s_waitcnt vmcnt(0)" ::: "memory");
    __syncthreads();
    if (leader) {
        unsigned* bar = b.bar;
        __builtin_amdgcn_s_waitcnt(0);
        unsigned nloc = b.st[0], nx = b.st[1];
        if (nloc == 0u) { xcd_barrier_complete(bar, b.x, nloc, nx); b.st[0] = nloc; b.st[1] = nx; }
        const unsigned old = xb_add(&bar[XB_XSUB(b.x)], 1u);
        const unsigned gen = old / nloc;
        if (old + 1u == (gen + 1u) * nloc) {
            __builtin_amdgcn_fence(__ATOMIC_RELEASE, "agent");
            asm volatile("s_waitcnt vmcnt(0)" ::: "memory");
            const unsigned og = xb_add(&bar[XB_TOP], 1u);
            const unsigned tg = og / nx;
            asm volatile("buffer_inv sc1" ::: "memory");
            if (og + 1u == (tg + 1u) * nx) xb_add(&bar[XB_TOPGEN], 1u);
            else XB_SPIN(xb_ld(&bar[XB_TOPGEN]) == tg, bar);
            xb_add(&bar[XB_XGEN(b.x)], 1u);
            asm volatile("s_waitcnt vmcnt(0)" ::: "memory");
        } else {
            asm volatile("buffer_inv sc1" ::: "memory");
            XB_SPIN(xb_ld(&bar[XB_XGEN(b.x)]) == gen, bar);
            asm volatile("s_waitcnt vmcnt(0)" ::: "memory");
        }
    }
    __syncthreads();
}

struct Args { const void* in[26]; float* out; unsigned char* ws; int ph_lo, ph_hi, li, pad; };

__device__ __forceinline__ float wave_sum(float v) {
#pragma unroll
    for (int o = 1; o < 64; o <<= 1) v += __shfl_xor(v, o);
    return v;
}
__device__ __forceinline__ int rowmap(int kind, int n0) {
    if (kind == 1) { const int bj = n0 >= DFF ? 1 : 0, jj = n0 - bj * DFF; return (jj >> 7) * 256 + bj * 128 + (jj & 127); }
    if (kind == 2) { if (n0 >= 2304) return n0; const int g32 = n0 >> 5, head = g32 >> 1, bj = g32 & 1; return (head >> 2) * 256 + bj * 128 + (head & 3) * 32; }
    if (kind == 3) return (n0 >> 7) * 256 + (n0 & 127);
    if (kind == 4) return (n0 >> 7) * 256 + 128 + (n0 & 127);
    return n0;
}
struct TItem { const float* src; bf16* dst; int N; int ldk; };
__device__ __forceinline__ TItem p0_item_addr(const float* W, int N, bf16* WT, int ldk, int koff, int kind, int item, int lane) {
    const int nblk = N / 32, kb = item / nblk, nb = item % nblk, k0 = 64 * kb, n0 = 32 * nb, c0 = rowmap(kind, n0), kg = lane & 7, ng = lane >> 3;
    TItem t; t.src = W + (size_t)(k0 + 8 * kg) * N + n0 + 4 * ng; t.dst = WT + (size_t)(c0 + 4 * ng) * ldk + koff + k0 + 8 * kg; t.N = N; t.ldk = ldk; return t;
}
__device__ __forceinline__ void p0_item_load(const TItem& t, f32x4 (&v)[8]) {
#pragma unroll
    for (int j = 0; j < 8; ++j) v[j] = __builtin_nontemporal_load((const f32x4*)(t.src + (size_t)j * t.N));
}
__device__ __forceinline__ void p0_item_store(const TItem& t, const f32x4 (&v)[8]) {
#pragma unroll
    for (int i = 0; i < 4; ++i) { v4u o; o.x = pk2(v[0][i], v[1][i]); o.y = pk2(v[2][i], v[3][i]); o.z = pk2(v[4][i], v[5][i]); o.w = pk2(v[6][i], v[7][i]);
        *(GAS v4u*)(t.dst + (size_t)i * t.ldk) = o; }
}

__device__ __forceinline__ void bias_rows(const bf16* Bt, float* CB, int nrows, const float* sh0, const float* sh1, int gw, int NGW) {
    const int lane = MK_LANE();
    f32x4 s0[2][2], s1[2][2];
#pragma unroll
    for (int hh = 0; hh < 2; ++hh)
#pragma unroll
        for (int q = 0; q < 2; ++q) { s0[hh][q] = *(const f32x4*)(sh0 + hh * 512 + lane * 8 + 4 * q); s1[hh][q] = *(const f32x4*)(sh1 + hh * 512 + lane * 8 + 4 * q); }
    for (int c0 = gw; c0 < nrows; c0 += 3 * NGW) {
        v4u w[3][2];
#pragma unroll
        for (int r = 0; r < 3; ++r) { const int c = c0 + r * NGW;
            if (c < nrows) {
#pragma unroll
                for (int hh = 0; hh < 2; ++hh) w[r][hh] = *(const GAS v4u*)(Bt + (size_t)c * D + hh * 512 + lane * 8); } }
#pragma unroll
        for (int r = 0; r < 3; ++r) { const int c = c0 + r * NGW;
            if (c < nrows) { float a0 = 0.f, a1 = 0.f;
#pragma unroll
                for (int hh = 0; hh < 2; ++hh) { const v4u v = w[r][hh];
                    const float wf[8] = {__uint_as_float(v.x << 16), __uint_as_float(v.x & 0xffff0000u), __uint_as_float(v.y << 16), __uint_as_float(v.y & 0xffff0000u),
                                         __uint_as_float(v.z << 16), __uint_as_float(v.z & 0xffff0000u), __uint_as_float(v.w << 16), __uint_as_float(v.w & 0xffff0000u)};
#pragma unroll
                    for (int e = 0; e < 8; ++e) { a0 += wf[e] * s0[hh][e >> 2][e & 3]; a1 += wf[e] * s1[hh][e >> 2][e & 3]; } }
                a0 = wave_sum(a0); a1 = wave_sum(a1);
                if (lane == 0) { CB[c] = a0; CB[nrows + c] = a1; } } }
    }
}

__global__ void __launch_bounds__(NWAVES * 64, 2) layer_fwd(Args args) {
    extern __shared__ __attribute__((aligned(16))) unsigned char lds[];
    LAS unsigned char* ldsl = (LAS unsigned char*)lds;
    volatile LAS unsigned* MISC = (volatile LAS unsigned*)(ldsl + MISC_OFF);
    const int wave = __builtin_amdgcn_readfirstlane((int)threadIdx.x >> 6), lane = MK_LANE(), tid = wave * 64 + lane;
    const int G = gridDim.x; const int bx = blockIdx.x; const int vcu = (G % 8 == 0) ? (bx % 8) * (G / 8) + bx / 8 : bx;
    unsigned char* ws = args.ws;
    gu32* ctl = (gu32*)(ws + WS_CTL);
    const float* x = (const float*)args.in[0]; const float* cvec = (const float*)args.in[1]; const int* positions = (const int*)args.in[2];
    const float* w_mod = (const float*)args.in[3]; const float* b_mod = (const float*)args.in[4];
    const float* norm_ffn1 = (const float*)args.in[5]; const float* w_ffn1_in = (const float*)args.in[6]; const float* w_ffn1_out = (const float*)args.in[7];
    const float* norm_mix = (const float*)args.in[8]; const float* w_in = (const float*)args.in[9];
    const float* qn_a = (const float*)args.in[10]; const float* kn_a = (const float*)args.in[11]; const float* sink_a = (const float*)args.in[12];
    const float* qn_b = (const float*)args.in[13]; const float* kn_b = (const float*)args.in[14];
    const float* lam_q1 = (const float*)args.in[15]; const float* lam_k1 = (const float*)args.in[16]; const float* lam_q2 = (const float*)args.in[17]; const float* lam_k2 = (const float*)args.in[18];
    const float* subln_b = (const float*)args.in[19]; const float* w_branch_a = (const float*)args.in[20]; const float* w_branch_b = (const float*)args.in[21];
    const float* w_out = (const float*)args.in[22]; const float* norm_ffn2 = (const float*)args.in[23]; const float* w_ffn2_in = (const float*)args.in[24]; const float* w_ffn2_out = (const float*)args.in[25];
    float* out = args.out;
    float* MOD = (float*)(ws + WS_MOD); float* SCAL = (float*)(ws + WS_SCAL); float* CB1 = (float*)(ws + WS_CB1); float* CBIN = (float*)(ws + WS_CBIN); float* CB2 = (float*)(ws + WS_CB2);
    float* RSS0 = (float*)(ws + WS_RSS0); float* RSS1 = (float*)(ws + WS_RSS1); float* RSS2 = (float*)(ws + WS_RSS2); bf16* ROPET = (bf16*)(ws + WS_COS);
    bf16* W1T = (bf16*)(ws + WS_W1T); bf16* W1OT = (bf16*)(ws + WS_W1OT); bf16* WINT = (bf16*)(ws + WS_WINT); bf16* WBRT = (bf16*)(ws + WS_WBRT); bf16* WOT = (bf16*)(ws + WS_WOT);
    bf16* W2T = (bf16*)(ws + WS_W2T); bf16* W2OT = (bf16*)(ws + WS_W2OT);
    bf16* ABUF = (bf16*)(ws + WS_ABUF); bf16* HB = (bf16*)(ws + WS_R1); bf16* MG = (bf16*)(ws + WS_MG);
    bf16* QA = (bf16*)(ws + WS_QA); bf16* KA = (bf16*)(ws + WS_KA); bf16* VA = (bf16*)(ws + WS_VA); bf16* QB = (bf16*)(ws + WS_QB); bf16* KB = (bf16*)(ws + WS_KB); bf16* VB = (bf16*)(ws + WS_VB);
    bf16* GA = (bf16*)(ws + WS_GA); bf16* GB = (bf16*)(ws + WS_GB);
    bf16* X1B = (bf16*)out;
    bf16* X2B = (bf16*)(ws + WS_GA);

    for (int u = tid; u < (LDS_BYTES - LDSCTL_OFF) / 4; u += NWAVES * 64) ((LAS unsigned*)(ldsl + LDSCTL_OFF))[u] = 0u;
    __syncthreads();
    XcdBarrier bar; bar.bar = (unsigned*)(ctl + CW_BAR); bar.x = 0; bar.st = nullptr;
    if (N_LAUNCHES != PER_PHASE) bar = xcd_barrier_post((unsigned*)(ctl + CW_BAR), MISC + 8);
#define GRID_BAR(seam) do { if (N_LAUNCHES == PER_PHASE) { if (tid == 0) __hip_atomic_store(ctl + CW_TMO, 0xBADBA0u | (unsigned)(seam), RLX_AGENT); } else { xcd_barrier(bar, wave == 0 && MK_LANE() == 0); } } while (0)
    const int lo = args.ph_lo, hi = args.ph_hi;
#ifndef PH_MASK
#define PH_MASK 0x3ff
#endif
#define IN(k) (((PH_MASK >> (k)) & 1) && lo <= (k) && (k) < hi)
#define BOTH(k) (IN(k) && IN((k) + 1))
#ifndef REPEAT_MASK
#define REPEAT_MASK 0
#endif
#define REPS(k) for (int rep_ = 0; rep_ <= ((REPEAT_MASK >> (k)) & 1); ++rep_)
    const int gw = vcu * NWAVES + wave, NGW = G * NWAVES;
    constexpr float QSCALE = 0.125f * 1.4426950408889634f;

    if (IN(0)) {
#define MOD_GEMV(IT_BEGIN, IT_END, IT_FIRST, IT_STRIDE, TIDV, LANEV) do { \
            LAS float* ca = (LAS float*)(ldsl + RING_OFF + 73728);              \
            LAS float* red = ca + 2048;                                          \
            for (int i = (TIDV); i < 2 * D; i += NWAVES * 64) { const float v = cvec[i]; ca[i] = v / (1.f + __expf(-v)); } \
            __syncthreads(); \
            for (int it = (IT_BEGIN) + (IT_FIRST); it < (IT_END); it += (IT_STRIDE)) { \
                const int cg = it >> 1, kh = it & 1, j = cg * 64 + (LANEV), kbase = kh * 512 + wave * 64; \
                float wv[64]; \
                _Pragma("unroll") \
                for (int kk = 0; kk < 64; ++kk) wv[kk] = w_mod[(size_t)(kbase + kk) * NMOD + j]; \
                float a0 = 0.f, a1 = 0.f; \
                _Pragma("unroll") \
                for (int kk = 0; kk < 64; ++kk) { a0 += ca[kbase + kk] * wv[kk]; a1 += ca[D + kbase + kk] * wv[kk]; } \
                red[(wave * 2 + 0) * 64 + (LANEV)] = a0; red[(wave * 2 + 1) * 64 + (LANEV)] = a1; \
                __syncthreads(); \
                if ((TIDV) < 128) { const int b = (TIDV) >> 6; float s_ = (kh == 0) ? b_mod[j] : 0.f; \
                    _Pragma("unroll") \
                    for (int w = 0; w < 8; ++w) s_ += red[(w * 2 + b) * 64 + (LANEV)]; \
                    atomicAdd(MOD + b * NMOD + j, s_); } \
                __syncthreads(); \
            } } while (0)
        MOD_GEMV(0, 64, bx, G, tid, lane);
        {
            constexpr int NITEMS = (D / 64) * (NFF / 32);
            auto item_of = [&](int it) -> TItem { return p0_item_addr(w_ffn1_in, NFF, W1T, D, 0, 1, it, lane); };
            for (int it = gw; it < NITEMS; it += 2 * NGW) {
                const int it2 = it + NGW; const bool two = it2 < NITEMS;
                const TItem a = item_of(it), b2 = item_of(two ? it2 : it);
                f32x4 va[8], vb[8];
                p0_item_load(a, va); if (two) p0_item_load(b2, vb);
                p0_item_store(a, va); if (two) p0_item_store(b2, vb);
            }
        }
        if (bx == 0 && wave == 0) {
            const float a = wave_sum(lam_q1[lane] * lam_k1[lane]), b2 = wave_sum(lam_q2[lane] * lam_k2[lane]);
            float mqa = fabsf(qn_a[lane]), mka = fabsf(kn_a[lane]), mqb = fabsf(qn_b[lane]), mkb = fabsf(kn_b[lane]);
#pragma unroll
            for (int o = 1; o < 64; o <<= 1) { mqa = fmaxf(mqa, __shfl_xor(mqa, o)); mka = fmaxf(mka, __shfl_xor(mka, o)); mqb = fmaxf(mqb, __shfl_xor(mqb, o)); mkb = fmaxf(mkb, __shfl_xor(mkb, o)); }
            const float bound_a = 8.0f * mqa * mka * 1.001f, bound_b = 8.0f * mqb * mkb * 1.001f, L2E = 1.4426950408889634f;
            if (lane == 0) { const float lam_init = 0.8f - 0.6f * expf(-0.3f * 0.f); SCAL[0] = expf(a) - expf(b2) + lam_init; SCAL[1] = lam_init; SCAL[2] = -bound_b * L2E; }
            if (lane < 8) { const float sk = sink_a[lane], mh = fmaxf(bound_a, sk); SCAL[8 + lane] = -mh * L2E; SCAL[16 + lane] = exp2f((sk - mh) * L2E); }
        }
        if (BOTH(0)) GRID_BAR(0);
    }

    if (IN(1)) {
        for (int m = gw; m < M; m += NGW) {
            const int b = m >> 13; const GAS f32x4* xr = (const GAS f32x4*)(x + (size_t)m * D) + lane;
            f32x4 v[4]; float s = 0.f;
#pragma unroll
            for (int j = 0; j < 4; ++j) { v[j] = xr[64 * j]; s += (v[j].x * v[j].x + v[j].y * v[j].y) + (v[j].z * v[j].z + v[j].w * v[j].w); }
            s = wave_sum(s);
            if (lane == 0) *(f32x4*)(RSS0 + (size_t)m * 4) = (f32x4){s, 0.f, 0.f, 0.f};
            GAS unsigned long long* o8 = (GAS unsigned long long*)(ABUF + (size_t)m * D) + lane;
#pragma unroll
            for (int j = 0; j < 4; ++j) { const int c = 4 * lane + 256 * j; const f32x4 g = *(const f32x4*)(norm_ffn1 + c) * (*(const f32x4*)(MOD + b * NMOD + 1 * D + c) + 1.0f); const f32x4 a = v[j] * g;
                o8[64 * j] = (unsigned long long)pk2(a.x, a.y) | ((unsigned long long)pk2(a.z, a.w) << 32); }
        }
        bias_rows(W1T, CB1, NFF, MOD + 0 * D, MOD + NMOD + 0 * D, gw, NGW);
        if (BOTH(1)) GRID_BAR(1);
    }

    if (IN(2)) {
        pg8::Gemm g{ABUF, W1T, M, NFF, D}; pg8::StaticOrder S; S.init(M, NFF, G, bx);
        pg8::EpiSwiGLU E{HB, DFF, RSS0, CB1, NFF};
        pg8::gemm_phase<pg8::EpiSwiGLU, pg8::StaticOrder, PG8_ALIGN, PG8_SP2>(ldsl + RING_OFF, g, S, E, wave);
        { pg8::Unit ud; const int nunits = (M / 256) * (NFF / 256), nfull = nunits / G;
          if (!S.next(nfull, ud)) {
            const int nidle = G - (nunits - nfull * G), iw = (bx - (G - nidle)) * NWAVES + wave, NIW = nidle * NWAVES, lane2 = MK_LANE();
            MOD_GEMV(64, 288, bx - (G - nidle), nidle, wave * 64 + lane2, lane2);
            constexpr int I_IN = (D / 64) * (NIN / 32), I_1O = (DFF / 64) * (D / 32), NITEMS = I_IN + I_1O;
            auto item_of = [&](int it) -> TItem { return it < I_IN ? p0_item_addr(w_in, NIN, WINT, D, 0, 2, it, lane2) : p0_item_addr(w_ffn1_out, D, W1OT, DFF, 0, 0, it - I_IN, lane2); };
            for (int it = iw; it < NITEMS; it += 2 * NIW) {
                const int it2 = it + NIW; const bool two = it2 < NITEMS;
                const TItem a = item_of(it), b2 = item_of(two ? it2 : it);
                f32x4 va[8], vb[8];
                p0_item_load(a, va); if (two) p0_item_load(b2, vb);
                p0_item_store(a, va); if (two) p0_item_store(b2, vb);
            }
            { const float invf = (float)pow(10000.0, -(double)(2 * (lane2 & 31)) / 64.0);
              for (int i = iw * 64 + lane2; i < M * 32; i += NIW * 64) { const float ang = (float)positions[i >> 5] * invf; const int row = i >> 5, d = i & 31;
                  ROPET[row * 64 + d] = (bf16)f2bf(cosf(ang)); ROPET[row * 64 + 32 + d] = (bf16)f2bf(sinf(ang)); } }
          } }
        if (BOTH(2)) GRID_BAR(2);
    }
    if (IN(3)) {
        pg8::Gemm g{HB, W1OT, M, D, DFF}; pg8::StaticOrder S; S.init(M, D, G, bx);
        pg8::EpiResid<true, 1, false, true> E{x, X1B, MOD + 2 * D, ABUF, norm_mix, MOD + 4 * D, RSS1};
        pg8::gemm_phase<pg8::EpiResid<true, 1, false, true>, pg8::StaticOrder, false, PG8_SP2>(ldsl + RING_OFF, g, S, E, wave);
        bias_rows(WINT, CBIN, NIN, MOD + 3 * D, MOD + NMOD + 3 * D, gw, NGW);
        if (BOTH(3)) GRID_BAR(3);
    }
    if (IN(4)) {
        pg8::Gemm g{ABUF, WINT, M, NIN, D}; pg8::StaticOrder S; S.init(M, NIN, G, bx);
        pg8::EpiInProj E{QA, KA, VA, QB, KB, VB, GA, GB, RSS1, CBIN, ROPET, qn_a, kn_a, qn_b, kn_b, QSCALE};
        pg8::gemm_phase<pg8::EpiInProj, pg8::StaticOrder, PG8_ALIGN, PG8_SP2>(ldsl + RING_OFF, g, S, E, wave);
        { pg8::Unit ud; const int nunits = (M / 256) * (NIN / 256), nfull = nunits / G;
          if (!S.next(nfull, ud)) {
            const int nidle = G - (nunits - nfull * G), iw = (bx - (G - nidle)) * NWAVES + wave, NIW = nidle * NWAVES, lane2 = MK_LANE();
            constexpr int I_1 = (D / 64) * (NFF / 32), I_1O = (DFF / 64) * (D / 32), I_BR = (512 / 64) * (D / 32), I_O = (D / 64) * (D / 32);
            constexpr int NITEMS = 2 * I_BR + I_O + I_1 + I_1O;
            auto item_of = [&](int it) -> TItem {
                int r = it;
                if (r < I_BR) return p0_item_addr(w_branch_a, D, WBRT, D, 0, 0, r, lane2); r -= I_BR;
                if (r < I_BR) return p0_item_addr(w_branch_b, D, WBRT, D, 512, 0, r, lane2); r -= I_BR;
                if (r < I_O) return p0_item_addr(w_out, D, WOT, D, 0, 0, r, lane2); r -= I_O;
                if (r < I_1) return p0_item_addr(w_ffn2_in, NFF, W2T, D, 0, 1, r, lane2); r -= I_1;
                return p0_item_addr(w_ffn2_out, D, W2OT, DFF, 0, 0, r, lane2);
            };
            for (int it = iw; it < NITEMS; it += 2 * NIW) {
                const int it2 = it + NIW; const bool two = it2 < NITEMS;
                const TItem a = item_of(it), b2 = item_of(two ? it2 : it);
                f32x4 va[8], vb[8];
                p0_item_load(a, va); if (two) p0_item_load(b2, vb);
                p0_item_store(a, va); if (two) p0_item_store(b2, vb);
            }
          } }
        if (BOTH(4)) GRID_BAR(4);
    }
    if (IN(5)) {
        char* alds = (char*)lds + RING_OFF;
        const __amdgpu_buffer_rsrc_t wsrs = __builtin_amdgcn_make_buffer_rsrc((void*)ws, (short)0, 0x10000000, 0x00020000);
#ifndef SKIP_WIN
        for (int id = vcu; id < 256; id += G) att::win_unit2(wsrs, (const char*)ws, id >> 7, (id >> 6) & 1, id & 31, (id >> 5) & 1, QA, KA, VA, ABUF, SCAL, alds, wave);
#endif
#ifndef SKIP_DIFF
        for (int id = vcu; id < 256; id += G) att::diff_unit(wsrs, (const char*)ws, id >> 7, (id >> 5) & 3, id & 31, QB, KB, VB, ABUF, SCAL, subln_b, alds, wave);
#endif
        if (BOTH(5)) GRID_BAR(5);
    }
    if (IN(6)) {
        pg8::Gemm g{ABUF, WBRT, M, D, D, 512}; pg8::PairOrder S; S.init(M, D, G, bx, D);
        pg8::EpiBranch E{GA, GB, MG};
        pg8::gemm_phase<pg8::EpiBranch, pg8::PairOrder, PG8_ALIGN, PG8_SP2>(ldsl + RING_OFF, g, S, E, wave);
        if (BOTH(6)) GRID_BAR(6);
    }
    if (IN(7)) {
        pg8::Gemm g{MG, WOT, M, D, D}; pg8::StaticOrder S; S.init(M, D, G, bx);
        pg8::EpiResid<true, 2, true, true> E{X1B, X2B, MOD + 5 * D, ABUF, norm_ffn2, MOD + 7 * D, RSS2};
        pg8::gemm_phase<pg8::EpiResid<true, 2, true, true>, pg8::StaticOrder, false, PG8_SP2>(ldsl + RING_OFF, g, S, E, wave);
        bias_rows(W2T, CB2, NFF, MOD + 6 * D, MOD + NMOD + 6 * D, gw, NGW);
        if (BOTH(7)) GRID_BAR(7);
    }
    if (IN(8)) {
        pg8::Gemm g{ABUF, W2T, M, NFF, D}; pg8::StaticOrder S; S.init(M, NFF, G, bx);
        pg8::EpiSwiGLU E{HB, DFF, RSS2, CB2, NFF};
        pg8::gemm_phase<pg8::EpiSwiGLU, pg8::StaticOrder, PG8_ALIGN, PG8_SP2>(ldsl + RING_OFF, g, S, E, wave);
        if (BOTH(8)) GRID_BAR(8);
    }
    if (IN(9)) {
        pg8::Gemm g{HB, W2OT, M, D, DFF}; pg8::StaticOrder S; S.init(M, D, G, bx);
        pg8::EpiResid<false, 1, true, false> E{X2B, out, MOD + 8 * D, nullptr, nullptr, nullptr, nullptr};
        pg8::gemm_phase<pg8::EpiResid<false, 1, true, false>, pg8::StaticOrder, false, PG8_SP2>(ldsl + RING_OFF, g, S, E, wave);
    }
#undef IN
#undef BOTH
#undef GRID_BAR
}

extern "C" void kernel_launch(void* const* d_in, const int* in_sizes, int n_in, void* d_out, int out_size, void* d_ws, size_t ws_size, hipStream_t stream) {
    static int grid = 0;
    if (grid == 0) {
        if (n_in != 26 || in_sizes[0] != M * D || out_size != M * D || ws_size < WS_END) { fprintf(stderr, "kernel_launch: unexpected shapes: n_in %d in0 %d out %d ws %zu (need >= %zu)\n", n_in, n_in > 0 ? in_sizes[0] : -1, out_size, ws_size, (size_t)WS_END); grid = -1; return; }
        int dev = 0, cus = 0;
        if (hipGetDevice(&dev) != hipSuccess || hipDeviceGetAttribute(&cus, hipDeviceAttributeMultiprocessorCount, dev) != hipSuccess) { grid = -1; return; }
        if (hipFuncSetAttribute((const void*)layer_fwd, hipFuncAttributeMaxDynamicSharedMemorySize, LDS_BYTES) != hipSuccess) { fprintf(stderr, "kernel_launch: hipFuncSetAttribute failed\n"); grid = -1; return; }
        int per_cu = 0;
        if (hipOccupancyMaxActiveBlocksPerMultiprocessor(&per_cu, (const void*)layer_fwd, NWAVES * 64, LDS_BYTES) != hipSuccess || per_cu < 1) fprintf(stderr, "kernel_launch: occupancy query says %d\n", per_cu);
        (void)hipGetLastError();
        grid = cus;
        if (grid != 256) fprintf(stderr, "kernel_launch: %d CUs; the one-unit-per-workgroup phases need exactly 256\n", grid);
    }
    if (grid < 0) return;
    (void)hipMemsetAsync((char*)d_ws + WS_CTL, 0, CTL_ZERO_BYTES, stream);
    Args a{};
    for (int i = 0; i < 26; ++i) a.in[i] = d_in[i];
    a.out = (float*)d_out; a.ws = (unsigned char*)d_ws;
    for (int li = 0; li < N_LAUNCHES; ++li) {
        a.ph_lo = (N_LAUNCHES == PER_PHASE) ? li : 0; a.ph_hi = (N_LAUNCHES == PER_PHASE) ? li + 1 : PER_PHASE; a.li = li;
        hipLaunchKernelGGL(layer_fwd, dim3(grid), dim3(NWAVES * 64), LDS_BYTES, stream, a);
    }
}
```

```cpp
#include <hip/hip_runtime.h>
#include <cstdio>
#include <cstdint>
#include <cmath>
__device__ __forceinline__ int mk_lane_() { int l; asm volatile("v_mbcnt_lo_u32_b32 %0, -1, 0\n\tv_mbcnt_hi_u32_b32 %0, -1, %0" : "=v"(l)); return l; }
#define MK_LANE() mk_lane_()
namespace pg8 {
#define PG8_LAS __attribute__((address_space(3)))
typedef unsigned short bf16_t;
typedef short bf16x8 __attribute__((ext_vector_type(8)));
typedef float f32x4 __attribute__((ext_vector_type(4)));
typedef unsigned u32x4 __attribute__((ext_vector_type(4)));
constexpr int BM = 256, BK = 64, HALF = 128, HTB = HALF * BK * 2  , STAGE_BYTES = 8 * HTB, NXCD = 8, WGM = 8;

__host__ __device__ __forceinline__ int lds_byte(int r, int c) { const int st = (r >> 4) * 2 + (c >> 5), rr = r & 15, cc = c & 31, ob = rr * 64 + cc * 2; return st * 1024 + (ob ^ (((ob >> 9) & 1) << 5)); }
__host__ __device__ __forceinline__ void stage_rc(int b, int& R, int& C) { const int st = b / 1024, sb = b % 1024, swz = sb ^ (((sb >> 9) & 1) << 5); R = (st >> 1) * 16 + swz / 64; C = (st & 1) * 32 + (swz % 64) / 2; }
__host__ __device__ __forceinline__ int perm32(int rho) { const int n = rho >> 4, i = rho & 15; return 8 * (i >> 2) + 4 * n + (i & 3); }

struct Unit { int pm, pn, ko; };
struct Gemm { const bf16_t* A; const bf16_t* Bt; int M, N, K; int KL = 0; };

struct StaticOrder {
    int nM, nN, nwg, G, c;
    __host__ __device__ void init(int M, int N, int G_, int c_) { nM = M / BM; nN = N / BM; nwg = nM * nN; G = G_; c = c_; }
    __host__ __device__ bool next(int i, Unit& u) const {
        const long L = (long)i * G + c; if (L >= nwg) return false;
        int wgid = (int)L; { const int q = nwg / NXCD, r = nwg % NXCD, xcd = wgid % NXCD, off = wgid / NXCD; wgid = (xcd < r ? xcd * (q + 1) : r * (q + 1) + (xcd - r) * q) + off; }
        const int nig = WGM * nN, gid = wgid / nig, fm = gid * WGM, gsz = (nM - fm) < WGM ? (nM - fm) : WGM;
        u.pm = fm + ((wgid % nig) % gsz); u.pn = (wgid % nig) / gsz; u.ko = 0; return true;
    }
    __device__ __forceinline__ void a_ready(const Unit&) const {}
    __device__ __forceinline__ void done(const Unit&) const {}
};
struct PairOrder {
    StaticOrder S; int khalf_bytes;
    __host__ __device__ void init(int M, int N, int G_, int c_, int K) { S.init(M, N, G_, c_); khalf_bytes = K;   }
    __host__ __device__ bool next(int i, Unit& u) const { if (!S.next(i >> 1, u)) return false; u.ko = (i & 1) * khalf_bytes; return true; }
    __device__ __forceinline__ void a_ready(const Unit&) const {}
    __device__ __forceinline__ void done(const Unit&) const {}
};

__device__ __forceinline__ unsigned cvt_pk_bf16(float lo, float hi) { unsigned r; asm volatile("v_cvt_pk_bf16_f32 %0, %1, %2" : "=v"(r) : "v"(lo), "v"(hi)); return r; }
__device__ __forceinline__ float bf_lo(unsigned w) { return __uint_as_float(w << 16); }
__device__ __forceinline__ float bf_hi(unsigned w) { return __uint_as_float(w & 0xffff0000u); }
constexpr float RMS_EPS = 1e-6f, LOG2E = 1.4426950408889634f;
__device__ __forceinline__ float row_rinv(const float* rss, int row) { const f32x4 s = *(const f32x4*)(rss + (size_t)row * 4); return rsqrtf(((s[0] + s[1]) + (s[2] + s[3])) * (1.0f / 1024.0f) + RMS_EPS); }
__device__ __forceinline__ float fast_sigmoid(float v) { return __builtin_amdgcn_rcpf(1.0f + __builtin_amdgcn_exp2f(-v * LOG2E)); }

struct EpiSwiGLU {
    static constexpr bool PERM = true, AFTER_DRAIN = false, PREFETCH = true, CHAIN = false;
    bf16_t* H; int ldh; const float* rss; const float* cb; int ncb;
    __device__ __forceinline__ void prefetch(const Unit& u, PG8_LAS unsigned char* buf, int wid, int lane) const {
        if (wid < 4) __builtin_amdgcn_global_load_lds((const unsigned*)(rss + (size_t)(u.pm * BM + wid * 64 + lane) * 4), (PG8_LAS unsigned*)(buf + wid * 1024), 16, 0, 0);
        else if (wid == 4) __builtin_amdgcn_global_load_lds((const unsigned*)(cb + (size_t)(u.pm >> 5) * ncb + u.pn * BM + lane * 4), (PG8_LAS unsigned*)(buf + 4096), 16, 0, 0);
    }
    __device__ __forceinline__ void operator()(const f32x4 (&acc)[2][2][4][2], const Unit& u, int wr, int wc, int fr, int fq, const PG8_LAS unsigned char* buf) const {
        const int outcol = u.pn * HALF + wc * 32 + 8 * fq;
        const PG8_LAS float* cbb = (const PG8_LAS float*)(buf + 4096) + wc * 32 + 8 * fq;
        const f32x4 bg0 = *(const PG8_LAS f32x4*)(cbb), bg1 = *(const PG8_LAS f32x4*)(cbb + 4), bu0 = *(const PG8_LAS f32x4*)(cbb + HALF), bu1 = *(const PG8_LAS f32x4*)(cbb + HALF + 4);
#pragma unroll
        for (int ai = 0; ai < 2; ++ai) {
#pragma unroll
            for (int m = 0; m < 4; ++m) {
                const int row = u.pm * BM + ai * HALF + wr * 64 + m * 16 + fr; const f32x4 sv_ = *(const PG8_LAS f32x4*)(buf + (ai * HALF + wr * 64 + m * 16 + fr) * 16); const float ri = rsqrtf(((sv_[0] + sv_[1]) + (sv_[2] + sv_[3])) * (1.0f / 1024.0f) + RMS_EPS);
                const f32x4 g0 = acc[ai][0][m][0] * ri + bg0, g1 = acc[ai][0][m][1] * ri + bg1, u0 = acc[ai][1][m][0] * ri + bu0, u1 = acc[ai][1][m][1] * ri + bu1;
                float o[8];
#pragma unroll
                for (int j = 0; j < 4; ++j) { o[j] = g0[j] * fast_sigmoid(g0[j]) * u0[j]; o[4 + j] = g1[j] * fast_sigmoid(g1[j]) * u1[j]; }
                u32x4 w; w.x = cvt_pk_bf16(o[0], o[1]); w.y = cvt_pk_bf16(o[2], o[3]); w.z = cvt_pk_bf16(o[4], o[5]); w.w = cvt_pk_bf16(o[6], o[7]);
                *(u32x4*)(H + (size_t)row * ldh + outcol) = w; } }
    }
};

struct EpiInProj {
    static constexpr bool PERM = true, AFTER_DRAIN = false, PREFETCH = true, CHAIN = false;
    bf16_t *QA, *KA, *VA, *QB, *KB, *VB, *GA, *GB; const float* rss; const float* cb; const bf16_t* ropet; const float *qn_a, *kn_a, *qn_b, *kn_b; float qscale;
    __device__ __forceinline__ void prefetch(const Unit& u, PG8_LAS unsigned char* buf, int wid, int lane) const {
        if (wid < 4) __builtin_amdgcn_global_load_lds((const unsigned*)(rss + (size_t)(u.pm * BM + wid * 64 + lane) * 4), (PG8_LAS unsigned*)(buf + wid * 1024), 16, 0, 0);
        else if (wid == 4) __builtin_amdgcn_global_load_lds((const unsigned*)(cb + (size_t)(u.pm >> 5) * 4352 + u.pn * BM + lane * 4), (PG8_LAS unsigned*)(buf + 4096), 16, 0, 0);
    }
    __device__ __forceinline__ void operator()(const f32x4 (&acc)[2][2][4][2], const Unit& u, int wr, int wc, int fr, int fq, const PG8_LAS unsigned char* buf) const {
        const int pn = u.pn;
        int mode; bf16_t* dst; int ld; const float* gain = qn_a; float scale = 1.f;
        if (pn < 2) { mode = 0; dst = QA + (4 * pn + wc) * 64; ld = 512; gain = qn_a; scale = qscale; }
        else if (pn == 2) { if (wc < 2) { mode = 0; dst = KA + wc * 64; ld = 128; gain = kn_a; } else { mode = 1; dst = VA + (wc - 2) * 64; ld = 128; } }
        else if (pn < 5) { mode = 0; dst = QB + (4 * (pn - 3) + wc) * 64; ld = 512; gain = qn_b; scale = qscale; }
        else if (pn < 7) { mode = 0; dst = KB + (4 * (pn - 5) + wc) * 64; ld = 512; gain = kn_b; }
        else if (pn < 9) { mode = 1; dst = VB + (4 * (pn - 7) + wc) * 64; ld = 512; }
        else if (pn < 13) { mode = 2; dst = GA + (pn - 9) * BM + wc * 32; ld = 1024; }
        else { mode = 2; dst = GB + (pn - 13) * BM + wc * 32; ld = 1024; }
        const int bjoff = (mode == 2) ? HALF : 32;
        const PG8_LAS float* cbb = (const PG8_LAS float*)(buf + 4096) + wc * 32 + 8 * fq;
        f32x4 bv[2][2];
#pragma unroll
        for (int bj = 0; bj < 2; ++bj)
#pragma unroll
            for (int n = 0; n < 2; ++n) bv[bj][n] = *(const PG8_LAS f32x4*)(cbb + bj * HALF + 4 * n);
        f32x4 gv[2][2];
#pragma unroll
        for (int bj = 0; bj < 2; ++bj)
#pragma unroll
            for (int n = 0; n < 2; ++n) gv[bj][n] = *(const f32x4*)(gain + bj * 32 + 8 * fq + 4 * n);
#pragma unroll
        for (int ai = 0; ai < 2; ++ai) {
            u32x4 csw[4], snw[4];
            if (mode == 0) {
#pragma unroll
              for (int m = 0; m < 4; ++m) { const bf16_t* tp = ropet + (size_t)(u.pm * BM + ai * HALF + wr * 64 + m * 16 + fr) * 64 + 8 * fq; csw[m] = *(const u32x4*)tp; snw[m] = *(const u32x4*)(tp + 32); } }
#pragma unroll
            for (int m = 0; m < 4; ++m) {
                const int row = u.pm * BM + ai * HALF + wr * 64 + m * 16 + fr; const f32x4 sv_ = *(const PG8_LAS f32x4*)(buf + (ai * HALF + wr * 64 + m * 16 + fr) * 16); const float ri = rsqrtf(((sv_[0] + sv_[1]) + (sv_[2] + sv_[3])) * (1.0f / 1024.0f) + RMS_EPS);
                f32x4 v[2][2];
#pragma unroll
                for (int bj = 0; bj < 2; ++bj)
#pragma unroll
                    for (int n = 0; n < 2; ++n) v[bj][n] = acc[ai][bj][m][n] * ri + bv[bj][n];
                if (mode == 0) {
                    float ss = 0.f;
#pragma unroll
                    for (int bj = 0; bj < 2; ++bj)
#pragma unroll
                        for (int n = 0; n < 2; ++n) ss += (v[bj][n][0] * v[bj][n][0] + v[bj][n][1] * v[bj][n][1]) + (v[bj][n][2] * v[bj][n][2] + v[bj][n][3] * v[bj][n][3]);
                    ss += __shfl_xor(ss, 16); ss += __shfl_xor(ss, 32);
                    const float rn = rsqrtf(ss * (1.0f / 64.0f) + RMS_EPS);
#pragma unroll
                    for (int n = 0; n < 2; ++n) {
                        const unsigned c0_ = n ? csw[m].z : csw[m].x, c1_ = n ? csw[m].w : csw[m].y, s0_ = n ? snw[m].z : snw[m].x, s1_ = n ? snw[m].w : snw[m].y;
                        const f32x4 cs = {bf_lo(c0_), bf_hi(c0_), bf_lo(c1_), bf_hi(c1_)}, sn = {bf_lo(s0_), bf_hi(s0_), bf_lo(s1_), bf_hi(s1_)};
                        const f32x4 lo = v[0][n] * rn * gv[0][n], hi = v[1][n] * rn * gv[1][n];
                        v[0][n] = (lo * cs - hi * sn) * scale; v[1][n] = (hi * cs + lo * sn) * scale; }
                } else if (mode == 2) {
#pragma unroll
                    for (int bj = 0; bj < 2; ++bj)
#pragma unroll
                        for (int n = 0; n < 2; ++n)
#pragma unroll
                            for (int j = 0; j < 4; ++j) v[bj][n][j] = fast_sigmoid(v[bj][n][j]);
                }
                bf16_t* rowp = dst + (size_t)row * ld + 8 * fq;
#pragma unroll
                for (int bj = 0; bj < 2; ++bj) { u32x4 w; w.x = cvt_pk_bf16(v[bj][0][0], v[bj][0][1]); w.y = cvt_pk_bf16(v[bj][0][2], v[bj][0][3]); w.z = cvt_pk_bf16(v[bj][1][0], v[bj][1][1]); w.w = cvt_pk_bf16(v[bj][1][2], v[bj][1][3]);
                    *(u32x4*)(rowp + bj * bjoff) = w; } } }
    }
};

struct EpiBranch {
    static constexpr bool PERM = true, AFTER_DRAIN = false, PREFETCH = false, CHAIN = true;
    const bf16_t* GA; const bf16_t* GB; bf16_t* MG;
    __device__ __forceinline__ void operator()(f32x4 (&acc)[2][2][4][2], const Unit& u, int wr, int wc, int fr, int fq) const {
        const bool second = u.ko != 0; constexpr float TINY = 8.67361738e-19f;
        const unsigned rowoff = (unsigned)((u.pm * BM + wr * 64 + fr) * 1024 + u.pn * BM + wc * 32 + 8 * fq);
#define EB_OFF(ai, bj, m) (rowoff + (unsigned)(((ai) * HALF + (m) * 16) * 1024 + (bj) * HALF))
#define EB_UNPACK(dst, src_) const float dst[8] = {bf_lo((src_).x), bf_hi((src_).x), bf_lo((src_).y), bf_hi((src_).y), bf_lo((src_).z), bf_hi((src_).z), bf_lo((src_).w), bf_hi((src_).w)}
        if (!second) {
#pragma unroll
            for (int ai = 0; ai < 2; ++ai)
#pragma unroll
                for (int bj = 0; bj < 2; ++bj) {
                    u32x4 gbv[4], gav[4];
#pragma unroll
                    for (int m = 0; m < 4; ++m) { gbv[m] = *(const u32x4*)(GB + EB_OFF(ai, bj, m)); gav[m] = *(const u32x4*)(GA + EB_OFF(ai, bj, m)); }
#pragma unroll
                    for (int m = 0; m < 4; ++m) { EB_UNPACK(gb, gbv[m]); EB_UNPACK(ga, gav[m]);
#pragma unroll
                        for (int e = 0; e < 4; ++e) { acc[ai][bj][m][0][e] *= ga[e] * __builtin_amdgcn_rcpf(fmaxf(gb[e], TINY)); acc[ai][bj][m][1][e] *= ga[4 + e] * __builtin_amdgcn_rcpf(fmaxf(gb[4 + e], TINY)); } }
                }
        } else {
#pragma unroll
            for (int ai = 0; ai < 2; ++ai) {
                u32x4 gbv[2][4];
#pragma unroll
                for (int bj = 0; bj < 2; ++bj)
#pragma unroll
                    for (int m = 0; m < 4; ++m) gbv[bj][m] = *(const u32x4*)(GB + EB_OFF(ai, bj, m));
#pragma unroll
                for (int bj = 0; bj < 2; ++bj)
#pragma unroll
                    for (int m = 0; m < 4; ++m) { EB_UNPACK(g0, gbv[bj][m]); float gb[8];
#pragma unroll
                        for (int e = 0; e < 8; ++e) gb[e] = fmaxf(g0[e], TINY);
                        const f32x4 y0 = acc[ai][bj][m][0], y1 = acc[ai][bj][m][1];
                        u32x4 w; w.x = cvt_pk_bf16(gb[0] * y0[0], gb[1] * y0[1]); w.y = cvt_pk_bf16(gb[2] * y0[2], gb[3] * y0[3]); w.z = cvt_pk_bf16(gb[4] * y1[0], gb[5] * y1[1]); w.w = cvt_pk_bf16(gb[6] * y1[2], gb[7] * y1[3]);
                        *(u32x4*)(MG + EB_OFF(ai, bj, m)) = w; }
            }
        }
#undef EB_OFF
#undef EB_UNPACK
    }
};

template <bool WRITE_A, int COEF2, bool RIN_BF16, bool ROUT_BF16> struct EpiResid {
    static constexpr bool PERM = true, AFTER_DRAIN = true, PREFETCH = false, CHAIN = false;
    static constexpr float coef = 0.5f * COEF2; static constexpr int modld = 9216;
    const void* xin; void* xout; const float* gate;
    bf16_t* Aout; const float* gnorm; const float* sc; float* rss_out;
    __device__ __forceinline__ void fused(f32x4 (&acc)[2][2][4][2], const Unit& u, int wr, int wc, int fr, int fq, PG8_LAS unsigned char* lds, int wid, int lane) const {
        const int b = u.pm >> 5, col0 = u.pn * BM + wc * 32 + 8 * fq;
        float ss[2][4];
#pragma unroll
        for (int ai = 0; ai < 2; ++ai)
#pragma unroll
            for (int m = 0; m < 4; ++m) ss[ai][m] = 0.f;
#pragma unroll
        for (int bj = 0; bj < 2; ++bj) {
            f32x4 gt[2], gvv[2];
#pragma unroll
            for (int n = 0; n < 2; ++n) { const int c = col0 + bj * HALF + 4 * n; gt[n] = *(const f32x4*)(gate + (size_t)b * modld + c) * coef;
                if (WRITE_A) gvv[n] = *(const f32x4*)(gnorm + c) * (*(const f32x4*)(sc + (size_t)b * modld + c) + 1.0f); }
#pragma unroll
            for (int ai = 0; ai < 2; ++ai) {
                f32x4 xi[4][2];
#pragma unroll
                for (int m = 0; m < 4; ++m) { const size_t off = (size_t)(u.pm * BM + ai * HALF + wr * 64 + m * 16 + fr) * 1024 + col0 + bj * HALF;
                    if constexpr (RIN_BF16) { const u32x4 w = *(const u32x4*)((const bf16_t*)xin + off); xi[m][0] = (f32x4){bf_lo(w.x), bf_hi(w.x), bf_lo(w.y), bf_hi(w.y)}; xi[m][1] = (f32x4){bf_lo(w.z), bf_hi(w.z), bf_lo(w.w), bf_hi(w.w)}; }
                    else {
#pragma unroll
                        for (int n = 0; n < 2; ++n) xi[m][n] = *(const f32x4*)((const float*)xin + off + 4 * n); } }
#pragma unroll
                for (int m = 0; m < 4; ++m) {
                    const int row = u.pm * BM + ai * HALF + wr * 64 + m * 16 + fr; const size_t off = (size_t)row * 1024 + col0 + bj * HALF; float s = 0.f;
                    f32x4 xo[2];
#pragma unroll
                    for (int n = 0; n < 2; ++n) { xo[n] = xi[m][n] + gt[n] * acc[ai][bj][m][n];
                        if constexpr (!ROUT_BF16) *(f32x4*)((float*)xout + off + 4 * n) = xo[n];
                        if (WRITE_A) s += (xo[n][0] * xo[n][0] + xo[n][1] * xo[n][1]) + (xo[n][2] * xo[n][2] + xo[n][3] * xo[n][3]); }
                    if constexpr (ROUT_BF16) { u32x4 w; w.x = cvt_pk_bf16(xo[0][0], xo[0][1]); w.y = cvt_pk_bf16(xo[0][2], xo[0][3]); w.z = cvt_pk_bf16(xo[1][0], xo[1][1]); w.w = cvt_pk_bf16(xo[1][2], xo[1][3]); *(u32x4*)((bf16_t*)xout + off) = w; }
                    if (WRITE_A) { const f32x4 a0 = xo[0] * gvv[0], a1 = xo[1] * gvv[1]; u32x4 w; w.x = cvt_pk_bf16(a0[0], a0[1]); w.y = cvt_pk_bf16(a0[2], a0[3]); w.z = cvt_pk_bf16(a1[0], a1[1]); w.w = cvt_pk_bf16(a1[2], a1[3]);
                        *(u32x4*)(Aout + off) = w; ss[ai][m] += s; } }
                asm volatile("" ::: "memory"); }
        }
        if (WRITE_A) {
            PG8_LAS float* P = (PG8_LAS float*)lds;
#pragma unroll
            for (int ai = 0; ai < 2; ++ai)
#pragma unroll
                for (int m = 0; m < 4; ++m) { float s = ss[ai][m]; s += __shfl_xor(s, 16); s += __shfl_xor(s, 32); if (fq == 0) P[(ai * HALF + wr * 64 + m * 16 + fr) * 4 + wc] = s; }
            asm volatile("s_waitcnt lgkmcnt(0)" ::: "memory"); __builtin_amdgcn_s_barrier(); asm volatile("" ::: "memory");
            const int t = wid * 64 + lane;
            if (t < 256) { const PG8_LAS float* p = P + t * 4; rss_out[(size_t)(u.pm * BM + t) * 4 + u.pn] = (p[0] + p[1]) + (p[2] + p[3]); }
        }
    }
};

template <class Epi, class Sched, bool ALIGN_EPI = false, bool SP2 = false>
__device__ __forceinline__ void gemm_phase(PG8_LAS unsigned char* lds, const Gemm g, const Sched S, const Epi E, const int wid  ) {
    const int lane = MK_LANE(), tid = wid * 64 + lane, wr = wid >> 2, wc = wid & 3, fr = lane & 15, fq = lane >> 4;
    const int K = g.K, nt = (g.KL ? g.KL : K) / BK;
    unsigned voffA[2], voffB[2];
#pragma unroll
    for (int i = 0; i < 2; ++i) { int R, C; stage_rc(tid * 16 + i * 8192, R, C); const int Rb = Epi::PERM ? ((R & ~31) + perm32(R & 31)) : R;
        voffA[i] = (unsigned)(R * K + C) * 2u; voffB[i] = (unsigned)(Rb * K + C) * 2u; }
    const size_t kstep = (size_t)(BK * 2);
    const size_t hstep = (size_t)HALF * K * 2;
    const size_t tstep = 2 * hstep;
    const unsigned ldsw = (unsigned)wid * 1024u;
    const int aoff = lds_byte(wr * 64 + fr, fq * 8), boff = lds_byte(wc * 32 + fr, fq * 8);
#define PG8_SA(b, h) (((b) * 2 + (h)) * HTB)
#define PG8_SB(b, h) ((4 + (b) * 2 + (h)) * HTB)
#define PG8_STAGE(bufoff, gbase, voff) do { _Pragma("unroll") for (int _i = 0; _i < 2; ++_i) \
        __builtin_amdgcn_global_load_lds((const unsigned*)((const char*)(gbase) + (voff)[_i]), (PG8_LAS unsigned*)(lds + (bufoff) + ldsw + _i * 8192), 16, 0, 0); } while (0)
#define PG8_LDA(dst, b, h) do { _Pragma("unroll") for (int m = 0; m < 4; ++m) _Pragma("unroll") for (int k = 0; k < 2; ++k) dst[m][k] = *(const PG8_LAS bf16x8*)(lds + PG8_SA(b, h) + aoff + m * 2048 + k * 1024); } while (0)
#define PG8_LDB(dst, b, h) do { _Pragma("unroll") for (int n = 0; n < 2; ++n) _Pragma("unroll") for (int k = 0; k < 2; ++k) dst[n][k] = *(const PG8_LAS bf16x8*)(lds + PG8_SB(b, h) + boff + n * 2048 + k * 1024); } while (0)
#define PG8_MMA(ai, bj, At, Bt) do { __builtin_amdgcn_s_setprio(1); _Pragma("unroll") for (int m = 0; m < 4; ++m) _Pragma("unroll") for (int n = 0; n < 2; ++n) _Pragma("unroll") for (int k = 0; k < 2; ++k) \
        acc[ai][bj][m][n] = __builtin_amdgcn_mfma_f32_16x16x32_bf16(Bt[n][k], At[m][k], acc[ai][bj][m][n], 0, 0, 0); __builtin_amdgcn_s_setprio(0); } while (0)
#define PG8_WAIT_V(n) asm volatile("s_waitcnt vmcnt(" #n ")" ::: "memory")
#define PG8_WAIT_L(n) asm volatile("s_waitcnt lgkmcnt(" #n ")" ::: "memory")
#define PG8_BAR __builtin_amdgcn_s_barrier()
#define PG8_SCHED __builtin_amdgcn_sched_barrier(0)
    Unit cur, nxt; int ui = 0;
    if (!S.next(0, cur)) return;
    f32x4 acc[2][2][4][2];
#pragma unroll
    for (int a = 0; a < 2; ++a)
#pragma unroll
        for (int b = 0; b < 2; ++b)
#pragma unroll
            for (int m = 0; m < 4; ++m)
#pragma unroll
                for (int n = 0; n < 2; ++n) acc[a][b][m][n] = (f32x4){0.f, 0.f, 0.f, 0.f};
    bf16x8 At[4][2], B0[2][2], B1[2][2];
    const char* cA = (const char*)g.A + (size_t)cur.pm * tstep + cur.ko; const char* cB = (const char*)g.Bt + (size_t)cur.pn * tstep + cur.ko;
    S.a_ready(cur);
    if constexpr (SP2) {
        PG8_STAGE(PG8_SB(0, 0), cB, voffB); PG8_STAGE(PG8_SB(0, 1), cB + hstep, voffB); PG8_STAGE(PG8_SA(0, 0), cA, voffA); PG8_STAGE(PG8_SA(0, 1), cA + hstep, voffA);
        if (wr == 1) PG8_BAR;
        PG8_WAIT_V(2); PG8_BAR;
        PG8_STAGE(PG8_SB(1, 0), cB + kstep, voffB); PG8_STAGE(PG8_SA(1, 0), cA + kstep, voffA); PG8_STAGE(PG8_SB(1, 1), cB + hstep + kstep, voffB);
        PG8_WAIT_V(6); PG8_BAR;
    } else {
        PG8_STAGE(PG8_SB(0, 0), cB, voffB); PG8_STAGE(PG8_SA(0, 0), cA, voffA); PG8_STAGE(PG8_SB(0, 1), cB + hstep, voffB); PG8_STAGE(PG8_SA(0, 1), cA + hstep, voffA);
        if (wr == 1) PG8_BAR;
        PG8_WAIT_V(4); PG8_BAR;
        PG8_STAGE(PG8_SB(1, 0), cB + kstep, voffB); PG8_STAGE(PG8_SA(1, 0), cA + kstep, voffA); PG8_STAGE(PG8_SB(1, 1), cB + hstep + kstep, voffB);
        PG8_WAIT_V(6); PG8_BAR;
    }
    for (;;) {
        if constexpr (Epi::PREFETCH) E.prefetch(cur, lds + STAGE_BYTES + (ui & 1) * 5120, wid, lane);
        const bool has_next = S.next(ui + 1, nxt);
        const char* nA = has_next ? (const char*)g.A + (size_t)nxt.pm * tstep + nxt.ko : cA; const char* nB = has_next ? (const char*)g.Bt + (size_t)nxt.pn * tstep + nxt.ko : cB;
        for (int t = 0; t < nt; t += 2) {
            const bool last = (t == nt - 2);
            const char* a1 = cA + (size_t)(t + 1) * kstep;
            const char* a2 = last ? nA : cA + (size_t)(t + 2) * kstep; const char* b2 = last ? nB : cB + (size_t)(t + 2) * kstep;
            const char* a3 = a2 + kstep; const char* b3 = b2 + kstep;
            if (last && has_next) S.a_ready(nxt);
            if constexpr (SP2) {
            PG8_LDB(B0, 0, 0); PG8_LDB(B1, 0, 1); PG8_SCHED; PG8_LDA(At, 0, 0); PG8_STAGE(PG8_SA(1, 1), a1 + hstep, voffA);
            PG8_WAIT_V(8); PG8_WAIT_L(0); PG8_BAR; PG8_MMA(0, 0, At, B0); PG8_MMA(0, 1, At, B1); PG8_BAR; PG8_SCHED;
            PG8_LDA(At, 0, 1); PG8_STAGE(PG8_SB(0, 0), b2, voffB); PG8_STAGE(PG8_SB(0, 1), b2 + hstep, voffB); PG8_STAGE(PG8_SA(0, 0), a2, voffA);
            PG8_WAIT_V(8); PG8_WAIT_L(0); PG8_BAR; PG8_MMA(1, 0, At, B0); PG8_MMA(1, 1, At, B1); PG8_BAR; PG8_SCHED;
            PG8_LDB(B0, 1, 0); PG8_LDB(B1, 1, 1); PG8_SCHED; PG8_LDA(At, 1, 0); PG8_STAGE(PG8_SA(0, 1), a2 + hstep, voffA);
            PG8_WAIT_V(8); PG8_WAIT_L(0); PG8_BAR; PG8_MMA(0, 0, At, B0); PG8_MMA(0, 1, At, B1); PG8_BAR; PG8_SCHED;
            PG8_LDA(At, 1, 1); PG8_STAGE(PG8_SB(1, 0), b3, voffB); PG8_STAGE(PG8_SB(1, 1), b3 + hstep, voffB); PG8_STAGE(PG8_SA(1, 0), a3, voffA);
            PG8_WAIT_V(8); PG8_WAIT_L(0); PG8_BAR; PG8_MMA(1, 0, At, B0); PG8_MMA(1, 1, At, B1); PG8_BAR; PG8_SCHED;
            } else {
            PG8_LDB(B0, 0, 0); PG8_SCHED; PG8_LDA(At, 0, 0); PG8_STAGE(PG8_SA(1, 1), a1 + hstep, voffA);
            PG8_WAIT_L(8); PG8_BAR; PG8_WAIT_L(0); PG8_MMA(0, 0, At, B0); PG8_BAR; PG8_SCHED;
            PG8_LDB(B1, 0, 1); PG8_STAGE(PG8_SB(0, 0), b2, voffB);
            PG8_BAR; PG8_WAIT_L(0); PG8_MMA(0, 1, At, B1); PG8_BAR;
            PG8_LDA(At, 0, 1); PG8_STAGE(PG8_SA(0, 0), a2, voffA);
            PG8_BAR; PG8_WAIT_L(0); PG8_MMA(1, 0, At, B0); PG8_BAR; PG8_SCHED;
            PG8_STAGE(PG8_SB(0, 1), b2 + hstep, voffB);
            PG8_WAIT_V(6); PG8_BAR; PG8_MMA(1, 1, At, B1); PG8_BAR;
            PG8_LDB(B0, 1, 0); PG8_SCHED; PG8_LDA(At, 1, 0); PG8_STAGE(PG8_SA(0, 1), a2 + hstep, voffA);
            PG8_WAIT_L(8); PG8_BAR; PG8_WAIT_L(0); PG8_MMA(0, 0, At, B0); PG8_BAR; PG8_SCHED;
            PG8_LDB(B1, 1, 1); PG8_STAGE(PG8_SB(1, 0), b3, voffB);
            PG8_BAR; PG8_WAIT_L(0); PG8_MMA(0, 1, At, B1); PG8_BAR;
            PG8_LDA(At, 1, 1); PG8_STAGE(PG8_SA(1, 0), a3, voffA);
            PG8_BAR; PG8_WAIT_L(0); PG8_MMA(1, 0, At, B0); PG8_BAR; PG8_SCHED;
            PG8_STAGE(PG8_SB(1, 1), b3 + hstep, voffB);
            PG8_WAIT_V(6); PG8_BAR; PG8_MMA(1, 1, At, B1); PG8_BAR;
            }
        }
        if constexpr (ALIGN_EPI) { if (wr == 0) PG8_BAR; }
        if constexpr (!Epi::AFTER_DRAIN) { if constexpr (Epi::PREFETCH) E(acc, cur, wr, wc, fr, fq, lds + STAGE_BYTES + (ui & 1) * 5120); else E(acc, cur, wr, wc, fr, fq); S.done(cur); }
        if (!has_next) break;
        if (!Epi::CHAIN || nxt.ko == 0) {
#pragma unroll
        for (int a = 0; a < 2; ++a)
#pragma unroll
            for (int b = 0; b < 2; ++b)
#pragma unroll
                for (int m = 0; m < 4; ++m)
#pragma unroll
                    for (int n = 0; n < 2; ++n) acc[a][b][m][n] = (f32x4){0.f, 0.f, 0.f, 0.f};
        }
        cur = nxt; cA = nA; cB = nB; ++ui;
        if constexpr (ALIGN_EPI) { if (wr == 1) PG8_BAR; }
    }
    PG8_WAIT_V(0);
    if constexpr (!ALIGN_EPI) { if (wr == 0) PG8_BAR; }
    PG8_BAR;
    if constexpr (Epi::AFTER_DRAIN) { E.fused(acc, cur, wr, wc, fr, fq, lds, wid, lane); S.done(cur); }
#undef PG8_SA
#undef PG8_SB
#undef PG8_STAGE
#undef PG8_LDA
#undef PG8_LDB
#undef PG8_MMA
#undef PG8_WAIT_V
#undef PG8_WAIT_L
#undef PG8_BAR
#undef PG8_SCHED
}
}

#ifndef PG8_SP2
#define PG8_SP2 true
#endif
#ifndef PG8_ALIGN
#define PG8_ALIGN true
#endif
namespace att {
using bf16x8 = __attribute__((ext_vector_type(8))) short;
using s16x4  = __attribute__((ext_vector_type(4))) short;
using f32x16 = __attribute__((ext_vector_type(16))) float;
using u32x4  = __attribute__((ext_vector_type(4))) unsigned;
typedef unsigned short bf16_t;
constexpr int NW = 8, QBLK = 32, KVBLK = 64;
#define ATT_SBAR() __builtin_amdgcn_sched_barrier(0)
__device__ __forceinline__ int crow(int r, int hi) { return (r & 3) + 8 * (r >> 2) + 4 * hi; }
__device__ __forceinline__ unsigned cvtpk(float lo, float hi) { unsigned r; asm volatile("v_cvt_pk_bf16_f32 %0, %1, %2" : "=v"(r) : "v"(lo), "v"(hi)); return r; }
__device__ __forceinline__ float bf2f(bf16_t h) { return __uint_as_float((unsigned)h << 16); }
__device__ __forceinline__ int v_rd_base(int lane) { return ((lane & 3) << 3) | (((lane >> 2) & 3) << 6) | (((lane >> 4) & 1) << 5) | (((lane >> 5) & 1) << 8); }
template <bool WIN> __device__ __forceinline__ void wmask(f32x16& p0, f32x16& p1, int qpos, int kbase, int hi) {
  if constexpr (WIN) {
#pragma unroll
    for (int r = 0; r < 16; ++r) { const int k0 = kbase + crow(r, hi) - qpos; if (k0 > 128 || k0 < -128) p0[r] = -INFINITY; if (k0 + 32 > 128 || k0 + 32 < -128) p1[r] = -INFINITY; }
  }
}
__device__ __forceinline__ void exp_half(f32x16& p) {
#pragma unroll
  for (int r = 0; r < 16; ++r) p[r] = __builtin_amdgcn_exp2f(p[r]);
}
constexpr int NSLOT = 3, LDS_V = 0, LDS_K = NSLOT * KVBLK * 128 * 2, LDS_WS = LDS_K + 4 * KVBLK * 64 * 2, LDS_STG = LDS_WS + NW * 64 * 4, ATT_LDS_BYTES = LDS_STG + NW * 8192;
__device__ __forceinline__ void dma16(unsigned m0v, unsigned voff, __amdgpu_buffer_rsrc_t rs, unsigned soff) {
  unsigned keep;
  asm volatile("s_nop 4\n\ts_mov_b32 %0, m0\n\ts_mov_b32 m0, %1\n\ts_nop 0\n\tbuffer_load_dwordx4 %2, %3, %4 offen lds\n\ts_mov_b32 m0, %0" : "=&s"(keep) : "s"(m0v), "v"(voff), "s"(rs), "s"(soff) : "memory");
}
__device__ __forceinline__ void dma16x2(unsigned m0a, unsigned va, unsigned sa, unsigned m0b, unsigned vb, unsigned sb, __amdgpu_buffer_rsrc_t rs) {
  unsigned keep;
  asm volatile("s_nop 4\n\ts_mov_b32 %0, m0\n\ts_mov_b32 m0, %1\n\ts_nop 0\n\tbuffer_load_dwordx4 %2, %7, %3 offen lds\n\ts_mov_b32 m0, %4\n\ts_nop 0\n\tbuffer_load_dwordx4 %5, %7, %6 offen lds\n\ts_mov_b32 m0, %0"
               : "=&s"(keep) : "s"(m0a), "v"(va), "s"(sa), "s"(m0b), "v"(vb), "s"(sb), "s"(rs) : "memory");
}
__device__ __forceinline__ void dma16x3(unsigned m0a, unsigned va, unsigned sa, unsigned m0b, unsigned vb, unsigned m0c, unsigned vc, unsigned sbc, __amdgpu_buffer_rsrc_t rs) {
  unsigned keep;
  asm volatile("s_nop 4\n\ts_mov_b32 %0, m0\n\ts_mov_b32 m0, %1\n\ts_nop 0\n\tbuffer_load_dwordx4 %2, %9, %3 offen lds\n\ts_mov_b32 m0, %4\n\ts_nop 0\n\tbuffer_load_dwordx4 %5, %9, %8 offen lds\n\ts_mov_b32 m0, %6\n\ts_nop 0\n\tbuffer_load_dwordx4 %7, %9, %8 offen lds\n\ts_mov_b32 m0, %0"
               : "=&s"(keep) : "s"(m0a), "v"(va), "s"(sa), "s"(m0b), "v"(vb), "s"(m0c), "v"(vc), "s"(sbc), "s"(rs) : "memory");
}
typedef __attribute__((address_space(3))) const char* lds_cptr;
typedef short v4i16_t __attribute__((ext_vector_type(4)));
__device__ __forceinline__ s16x4 vtr(lds_cptr p) { return __builtin_bit_cast(s16x4, __builtin_amdgcn_ds_read_tr16_b64_v4i16((__attribute__((address_space(3))) v4i16_t*)p)); }
__device__ __forceinline__ bf16x8 kld(lds_cptr p) { return *(const __attribute__((address_space(3))) bf16x8*)p; }
__device__ __forceinline__ void attn_pass_d4(__amdgpu_buffer_rsrc_t rs, unsigned Qb, unsigned ldq, unsigned Kh, unsigned ldk, unsigned Vh, unsigned ldv, int seq, float negm_s, char* lds, f32x16 (&o)[4], float& l_out, const int wid) {
  constexpr int SLOTV = KVBLK * 128 * 2, SLOTK = KVBLK * 64 * 2;
  const int lane = MK_LANE(), r32 = lane & 31, hi = lane >> 5;
  const unsigned lds0 = (unsigned)(uintptr_t)lds;
  bf16x8 qr[4];
  { const unsigned qoff = (unsigned)(wid * QBLK + r32) * ldq + hi * 16;
#pragma unroll
    for (int d0 = 0; d0 < 4; ++d0) { const u32x4 w = __builtin_amdgcn_raw_buffer_load_b128(rs, qoff + d0 * 32, Qb, 0); qr[d0] = __builtin_bit_cast(bf16x8, w); } }
  f32x16 negm; { float ns = negm_s; asm volatile("" : "+v"(ns));
#pragma unroll
  for (int r = 0; r < 16; ++r) negm[r] = ns; }
  asm volatile("" : "+v"(negm));
#pragma unroll
  for (int d = 0; d < 4; ++d) o[d] = f32x16{};
  float l_reg = 0.f;
  const unsigned kvoff = (unsigned)lane * ldk + wid * 16;
  unsigned vvoff0, vvoff1;
  { const int ob = (wid * 2 + 0) * 1024 + lane * 16, st = ob >> 9, k = (st / 4) * 8 + ((ob >> 6) & 7), c = (st % 4) * 32 + ((ob >> 4) & 3) * 8; vvoff0 = (unsigned)k * ldv + c * 2; }
  { const int ob = (wid * 2 + 1) * 1024 + lane * 16, st = ob >> 9, k = (st / 4) * 8 + ((ob >> 6) & 7), c = (st % 4) * 32 + ((ob >> 4) & 3) * 8; vvoff1 = (unsigned)k * ldv + c * 2; }
  const unsigned kdst = lds0 + LDS_K + wid * 1024, vdst = lds0 + LDS_V + wid * 2048;
  const lds_cptr kp0 = (lds_cptr)lds + LDS_K + hi * 1024 + r32 * 16;
  const lds_cptr vp0 = (lds_cptr)lds + LDS_V + v_rd_base(lane);
  const int NT = seq / KVBLK;
#define D4_PIN(x) asm volatile("" : "+v"(x))
#define D4_MFMA(a, b, c) __builtin_amdgcn_mfma_f32_32x32x16_bf16(a, b, c, 0, 0, 0)
#define D4_WAIT_BAR(N) asm volatile("s_waitcnt vmcnt(" #N ") lgkmcnt(0)\n\ts_barrier" ::: "memory")
#define D4_KSLOT(t) ((unsigned)((t) & 3) * SLOTK)
#define D4_DMA_K(t) dma16(kdst + D4_KSLOT(t), kvoff, rs, Kh + (unsigned)(t) * (KVBLK * ldk))
#define D4_DMA_V(t, sl) dma16x2(vdst + (sl), vvoff0, Vh + (unsigned)(t) * (KVBLK * ldv), vdst + (sl) + 1024, vvoff1, Vh + (unsigned)(t) * (KVBLK * ldv), rs)
#define D4_DMA_KV(tk, tv, sl) dma16x3(kdst + D4_KSLOT(tk), kvoff, Kh + (unsigned)(tk) * (KVBLK * ldk), vdst + (sl), vvoff0, vdst + (sl) + 1024, vvoff1, Vh + (unsigned)(tv) * (KVBLK * ldv), rs)
  f32x16 pA0, pA1, pB0, pB1; bf16x8 kf[4]; s16x4 vl[5], vh[5]; u32x4 pw0, pw1, pw2, pw3;
#define D4_KRD(buf, kp, j) kf[buf] = kld((kp) + ((j) >> 1) * 2048 + ((j) & 1) * 512)
#define D4_VO(f, half) (((f) & 3) * 512 + (2 * ((f) >> 2) + (half)) * 2048)
#define D4_VRD(f) do { vl[(f) % 5] = vtr(vp_ + D4_VO(f, 0)); vh[(f) % 5] = vtr(vp_ + D4_VO(f, 1)); } while (0)
#define D4_VFR(f) (bf16x8){vl[(f) % 5][0], vl[(f) % 5][1], vl[(f) % 5][2], vl[(f) % 5][3], vh[(f) % 5][0], vh[(f) % 5][1], vh[(f) % 5][2], vh[(f) % 5][3]}
#define D4_PKW(P, i) cvtpk(P[i], P[i + 1])
#define D4_PAF(k) __builtin_bit_cast(bf16x8, pw##k)
  D4_DMA_K(0); D4_DMA_V(0, 0); D4_DMA_K(1); D4_DMA_K(2); D4_DMA_KV(3, 1, SLOTV);
  D4_WAIT_BAR(3);
  { const lds_cptr kp_ = kp0;
    D4_KRD(0, kp_, 0); D4_KRD(1, kp_, 1); D4_KRD(2, kp_, 2); D4_KRD(3, kp_, 3);
    pA0 = D4_MFMA(kf[0], qr[0], negm); pA1 = D4_MFMA(kf[1], qr[0], negm); pA0 = D4_MFMA(kf[2], qr[1], pA0); pA1 = D4_MFMA(kf[3], qr[1], pA1);
    D4_KRD(0, kp_, 4); D4_KRD(1, kp_, 5); D4_KRD(2, kp_, 6); D4_KRD(3, kp_, 7);
    pA0 = D4_MFMA(kf[0], qr[2], pA0); pA1 = D4_MFMA(kf[1], qr[2], pA1); pA0 = D4_MFMA(kf[2], qr[3], pA0); pA1 = D4_MFMA(kf[3], qr[3], pA1);
    exp_half(pA0); exp_half(pA1);
    const lds_cptr kn_ = kp0 + SLOTK;
    D4_KRD(0, kn_, 0); D4_KRD(1, kn_, 1); D4_KRD(2, kn_, 2); D4_KRD(3, kn_, 3); }
  D4_WAIT_BAR(3);
  unsigned sl_prev = 0, sl_cur = SLOTV, sl_next = 2 * SLOTV;
#define D4_ROT() do { sl_prev = sl_cur; sl_cur = sl_next; sl_next = (sl_next == 2u * SLOTV) ? 0u : sl_next + SLOTV; } while (0)
#define D4_EX2(X, i) do { X[i] = __builtin_amdgcn_exp2f(X[i]); X[(i) + 1] = __builtin_amdgcn_exp2f(X[(i) + 1]); } while (0)
#define D4_GAPA(MF, LD, a0, a1, a2, a3, W0, W1, PW) do { MF; LD; sacc += a0; sacc += a1; sacc += a2; sacc += a3; W0; W1; D4_PIN(PW); D4_PIN(sacc); ATT_SBAR(); } while (0)
#define D4_GAPB(i, X, xi, LD) do { o[(i) & 3] = D4_MFMA(D4_PAFI(i), D4_VFR(i), o[(i) & 3]); LD; D4_EX2(X, xi); D4_PIN(X); ATT_SBAR(); } while (0)
#define D4_PAFI(i) (((i) >> 2) == 0 ? D4_PAF(0) : ((i) >> 2) == 1 ? D4_PAF(1) : ((i) >> 2) == 2 ? D4_PAF(2) : D4_PAF(3))
#define D4_PHA(C0, C1, P0, P1, t, VR) do { ATT_SBAR(); \
    const lds_cptr vp_ = vp0 + sl_prev; const lds_cptr kp_ = kp0 + D4_KSLOT(t); \
    float sacc = P0[0] + P0[1]; ATT_SBAR(); \
    D4_GAPA(C0 = D4_MFMA(kf[0], qr[0], negm), D4_KRD(0, kp_, 4), P0[2], P0[3], P0[4], P0[5],     pw0[0] = D4_PKW(P0, 0),  pw0[1] = D4_PKW(P0, 2),  pw0); \
    D4_GAPA(C1 = D4_MFMA(kf[1], qr[0], negm), D4_KRD(1, kp_, 5), P0[6], P0[7], P0[8], P0[9],     pw0[2] = D4_PKW(P0, 4),  pw0[3] = D4_PKW(P0, 6),  pw0); \
    D4_GAPA(C0 = D4_MFMA(kf[2], qr[1], C0),   D4_KRD(2, kp_, 6), P0[10], P0[11], P0[12], P0[13], pw1[0] = D4_PKW(P0, 8),  pw1[1] = D4_PKW(P0, 10), pw1); \
    D4_GAPA(C1 = D4_MFMA(kf[3], qr[1], C1),   D4_KRD(3, kp_, 7), P0[14], P0[15], P1[0], P1[1],   pw1[2] = D4_PKW(P0, 12), pw1[3] = D4_PKW(P0, 14), pw1); \
    D4_GAPA(C0 = D4_MFMA(kf[0], qr[2], C0),   do { if (VR) D4_VRD(0); } while (0), P1[2], P1[3], P1[4], P1[5],     pw2[0] = D4_PKW(P1, 0),  pw2[1] = D4_PKW(P1, 2),  pw2); \
    D4_GAPA(C1 = D4_MFMA(kf[1], qr[2], C1),   do { if (VR) D4_VRD(1); } while (0), P1[6], P1[7], P1[8], P1[9],     pw2[2] = D4_PKW(P1, 4),  pw2[3] = D4_PKW(P1, 6),  pw2); \
    D4_GAPA(C0 = D4_MFMA(kf[2], qr[3], C0),   do { if (VR) D4_VRD(2); } while (0), P1[10], P1[11], P1[12], P1[13], pw3[0] = D4_PKW(P1, 8),  pw3[1] = D4_PKW(P1, 10), pw3); \
    D4_GAPA(C1 = D4_MFMA(kf[3], qr[3], C1),   do { if (VR) { D4_VRD(3); D4_VRD(4); } } while (0), P1[14], P1[15], 0.f, 0.f, pw3[2] = D4_PKW(P1, 12), pw3[3] = D4_PKW(P1, 14), pw3); \
    l_reg += sacc; } while (0)
#define D4_PHB(C0, C1, t, GK, GV, GL, PRE) do { ATT_SBAR(); \
    const lds_cptr vp_ = vp0 + sl_prev; const lds_cptr kn_ = kp0 + D4_KSLOT((t) + 1); \
    if (PRE) { D4_VRD(0); D4_VRD(1); D4_VRD(2); D4_VRD(3); D4_VRD(4); ATT_SBAR(); } \
    D4_GAPB(0, C0, 0, D4_VRD(5));   D4_GAPB(1, C0, 2, D4_VRD(6));   D4_GAPB(2, C0, 4, D4_VRD(7));    D4_GAPB(3, C0, 6, D4_VRD(8)); \
    D4_GAPB(4, C0, 8, D4_VRD(9));   D4_GAPB(5, C0, 10, D4_VRD(10)); D4_GAPB(6, C0, 12, D4_VRD(11));  D4_GAPB(7, C0, 14, do { D4_VRD(12); if (GL) D4_KRD(0, kn_, 0); } while (0)); \
    D4_GAPB(8, C1, 0, do { D4_VRD(13); if ((GK) && (GV)) D4_DMA_KV((t) + 3, (t) + 1, sl_next); else if (GV) D4_DMA_V((t) + 1, sl_next); } while (0)); \
    D4_GAPB(9, C1, 2, do { D4_VRD(14); if (GL) D4_KRD(1, kn_, 1); } while (0));  D4_GAPB(10, C1, 4, do { D4_VRD(15); if (GL) D4_KRD(2, kn_, 2); } while (0));  D4_GAPB(11, C1, 6, do { if (GL) D4_KRD(3, kn_, 3); } while (0)); \
    D4_GAPB(12, C1, 8, (void)0); D4_GAPB(13, C1, 10, (void)0); D4_GAPB(14, C1, 12, (void)0); D4_GAPB(15, C1, 14, (void)0); \
    } while (0)
  if (wid < 4) {
    int t = 1;
    for (; t + 4 < NT; t += 2) {
      D4_PHA(pB0, pB1, pA0, pA1, t, true);     D4_PHB(pB0, pB1, t, true, true, true, false);     D4_WAIT_BAR(3); D4_ROT();
      D4_PHA(pA0, pA1, pB0, pB1, t + 1, true); D4_PHB(pA0, pA1, t + 1, true, true, true, false); D4_WAIT_BAR(3); D4_ROT();
    }
    D4_PHA(pB0, pB1, pA0, pA1, t, true);     D4_PHB(pB0, pB1, t, false, true, true, false);      D4_WAIT_BAR(2); D4_ROT();
    D4_PHA(pA0, pA1, pB0, pB1, t + 1, true); D4_PHB(pA0, pA1, t + 1, false, true, true, false);  D4_WAIT_BAR(0); D4_ROT();
    D4_PHA(pB0, pB1, pA0, pA1, t + 2, true); D4_PHB(pB0, pB1, t + 2, false, false, false, false);
  } else {
    D4_PHA(pB0, pB1, pA0, pA1, 1, false);
    int t = 1;
    for (; t + 4 < NT; t += 2) {
      D4_PHB(pB0, pB1, t, true, true, true, true);     D4_PHA(pA0, pA1, pB0, pB1, t + 1, false); D4_WAIT_BAR(3); D4_ROT();
      D4_PHB(pA0, pA1, t + 1, true, true, true, true); D4_PHA(pB0, pB1, pA0, pA1, t + 2, false); D4_WAIT_BAR(3); D4_ROT();
    }
    D4_PHB(pB0, pB1, t, false, true, true, true);      D4_PHA(pA0, pA1, pB0, pB1, t + 1, false); D4_WAIT_BAR(2); D4_ROT();
    D4_PHB(pA0, pA1, t + 1, false, true, true, true);  D4_PHA(pB0, pB1, pA0, pA1, t + 2, false); D4_WAIT_BAR(0); D4_ROT();
    D4_PHB(pB0, pB1, t + 2, false, false, false, true);
  }
  { float sacc = pB0[0] + pB0[1];
#pragma unroll
    for (int r = 2; r < 16; ++r) sacc += pB0[r];
#pragma unroll
    for (int r = 0; r < 16; ++r) sacc += pB1[r];
    l_reg += sacc;
    pw0 = (u32x4){D4_PKW(pB0, 0), D4_PKW(pB0, 2), D4_PKW(pB0, 4), D4_PKW(pB0, 6)}; pw1 = (u32x4){D4_PKW(pB0, 8), D4_PKW(pB0, 10), D4_PKW(pB0, 12), D4_PKW(pB0, 14)};
    pw2 = (u32x4){D4_PKW(pB1, 0), D4_PKW(pB1, 2), D4_PKW(pB1, 4), D4_PKW(pB1, 6)}; pw3 = (u32x4){D4_PKW(pB1, 8), D4_PKW(pB1, 10), D4_PKW(pB1, 12), D4_PKW(pB1, 14)};
    const lds_cptr vp_ = vp0 + sl_cur;
    D4_VRD(0); D4_VRD(1); D4_VRD(2); D4_VRD(3); D4_VRD(4);
    o[0] = D4_MFMA(D4_PAF(0), D4_VFR(0), o[0]); D4_VRD(5);
    o[1] = D4_MFMA(D4_PAF(0), D4_VFR(1), o[1]); D4_VRD(6);
    o[2] = D4_MFMA(D4_PAF(0), D4_VFR(2), o[2]); D4_VRD(7);
    o[3] = D4_MFMA(D4_PAF(0), D4_VFR(3), o[3]); D4_VRD(8);
    o[0] = D4_MFMA(D4_PAF(1), D4_VFR(4), o[0]); D4_VRD(9);
    o[1] = D4_MFMA(D4_PAF(1), D4_VFR(5), o[1]); D4_VRD(10);
    o[2] = D4_MFMA(D4_PAF(1), D4_VFR(6), o[2]); D4_VRD(11);
    o[3] = D4_MFMA(D4_PAF(1), D4_VFR(7), o[3]); D4_VRD(12);
    o[0] = D4_MFMA(D4_PAF(2), D4_VFR(8), o[0]); D4_VRD(13);
    o[1] = D4_MFMA(D4_PAF(2), D4_VFR(9), o[1]); D4_VRD(14);
    o[2] = D4_MFMA(D4_PAF(2), D4_VFR(10), o[2]); D4_VRD(15);
    o[3] = D4_MFMA(D4_PAF(2), D4_VFR(11), o[3]);
    o[0] = D4_MFMA(D4_PAF(3), D4_VFR(12), o[0]);
    o[1] = D4_MFMA(D4_PAF(3), D4_VFR(13), o[1]);
    o[2] = D4_MFMA(D4_PAF(3), D4_VFR(14), o[2]);
    o[3] = D4_MFMA(D4_PAF(3), D4_VFR(15), o[3]); }
  { auto rr = __builtin_amdgcn_permlane32_swap(__float_as_uint(l_reg), __float_as_uint(l_reg), false, false); l_out = __uint_as_float(rr[0]) + __uint_as_float(rr[1]); }
  D4_WAIT_BAR(0);
#undef D4_PIN
#undef D4_MFMA
#undef D4_WAIT_BAR
#undef D4_KSLOT
#undef D4_DMA_K
#undef D4_DMA_V
#undef D4_DMA_KV
#undef D4_KRD
#undef D4_VO
#undef D4_VRD
#undef D4_VFR
#undef D4_PKW
#undef D4_PAF
#undef D4_PAFI
#undef D4_ROT
#undef D4_EX2
#undef D4_GAPA
#undef D4_GAPB
#undef D4_PHA
#undef D4_PHB
}
__device__ __forceinline__ void row_recips(float l, float extra, float* wsf, int r32, int hi, float (&rli)[16]) {
  if (hi == 0) wsf[r32] = l + extra; asm volatile("s_waitcnt lgkmcnt(0)" ::: "memory");
#pragma unroll
  for (int r = 0; r < 16; ++r) rli[r] = __builtin_amdgcn_rcpf(wsf[crow(r, hi)]);
  asm volatile("s_waitcnt lgkmcnt(0)" ::: "memory");
}

__device__ __forceinline__ void win_unit2(__amdgpu_buffer_rsrc_t rs, const char* wsb, int b, int kvh, int qb, int pair, const bf16_t* QA, const bf16_t* KA, const bf16_t* VA, bf16_t* ACAT, const float* scal, char* lds, const int wid) {
  constexpr int S = 8192, W_K = 65536, W_WS = 131072;
  const int lane = MK_LANE(), r32 = lane & 31, hi = lane >> 5;
  const unsigned lds0 = (unsigned)(uintptr_t)lds;
  const int q0 = qb * 256, kb0 = q0 - 128; const size_t rowbase = (size_t)b * S;
  const unsigned Kb = (unsigned)((const char*)(KA + rowbase * 128 + kvh * 64) - wsb), Vb = (unsigned)((const char*)(VA + rowbase * 128 + kvh * 64) - wsb);
  { const unsigned kvoff = (unsigned)lane * 256u + wid * 16;
    const int ob = wid * 1024 + lane * 16, st = ob >> 9, k = (st / 2) * 8 + ((ob >> 6) & 7), c = (st % 2) * 32 + ((ob >> 4) & 3) * 8; const unsigned vvoff = (unsigned)k * 256u + c * 2;
#pragma unroll
    for (int j = 0; j < 8; ++j) { const int ks = kb0 + 64 * j;
      if (ks >= 0 && ks < S) dma16x2(lds0 + W_K + j * 8192 + wid * 1024, kvoff, Kb + (unsigned)ks * 256u, lds0 + j * 8192 + wid * 1024, vvoff, Vb + (unsigned)ks * 256u, rs); } }
  asm volatile("s_waitcnt vmcnt(0)\n\ts_barrier" ::: "memory");
  const lds_cptr kp0 = (lds_cptr)lds + W_K + hi * 1024 + r32 * 16;
  const lds_cptr vp0 = (lds_cptr)lds + v_rd_base(lane);
  float* wsf = (float*)(lds + W_WS) + wid * 64;
  const int qrow0 = q0 + wid * QBLK, qpos = qrow0 + r32, jlo = wid >> 1;
#pragma unroll 1
  for (int hh = 0; hh < 2; ++hh) {
    const int hq = kvh * 4 + pair * 2 + hh;
    bf16x8 qr[4];
    { const unsigned Qb = (unsigned)((const char*)(QA + (rowbase + q0) * 512 + hq * 64) - wsb), qoff = (unsigned)(wid * QBLK + r32) * 1024u + hi * 16;
#pragma unroll
      for (int d0 = 0; d0 < 4; ++d0) { const u32x4 w = __builtin_amdgcn_raw_buffer_load_b128(rs, qoff + d0 * 32, Qb, 0); qr[d0] = __builtin_bit_cast(bf16x8, w); } }
    f32x16 negm; { float ns = scal[8 + hq]; asm volatile("" : "+v"(ns));
#pragma unroll
    for (int r = 0; r < 16; ++r) negm[r] = ns; }
    f32x16 o0 = f32x16{}, o1 = f32x16{}; float l_reg = 0.f;
#pragma unroll 1
    for (int i = 0; i < 5; ++i) {
      const int j = jlo + i, ks = kb0 + 64 * j;
      if (ks < 0 || ks >= S) continue;
      const lds_cptr kp = kp0 + j * 8192; const lds_cptr vp = vp0 + j * 8192;
      f32x16 p0, p1;
#pragma unroll
      for (int d0 = 0; d0 < 4; ++d0) { const bf16x8 k0 = kld(kp + d0 * 2048), k1 = kld(kp + d0 * 2048 + 512);
        if (d0 == 0) { p0 = __builtin_amdgcn_mfma_f32_32x32x16_bf16(k0, qr[0], negm, 0, 0, 0); p1 = __builtin_amdgcn_mfma_f32_32x32x16_bf16(k1, qr[0], negm, 0, 0, 0); }
        else { p0 = __builtin_amdgcn_mfma_f32_32x32x16_bf16(k0, qr[d0], p0, 0, 0, 0); p1 = __builtin_amdgcn_mfma_f32_32x32x16_bf16(k1, qr[d0], p1, 0, 0, 0); } }
      if (!((ks >= qrow0 + QBLK - 1 - 128) && (ks + 63 <= qrow0 + 128))) wmask<true>(p0, p1, qpos, ks, hi);
      exp_half(p0); exp_half(p1);
      float ps = 0.f;
#pragma unroll
      for (int r = 0; r < 16; ++r) ps += p0[r];
#pragma unroll
      for (int r = 0; r < 16; ++r) ps += p1[r];
      l_reg += ps;
      bf16x8 pa0, pa1, pa2, pa3;
#define W2_PK4(P, BASE, OUT) do { u32x4 w = {cvtpk(P[BASE + 0], P[BASE + 1]), cvtpk(P[BASE + 2], P[BASE + 3]), cvtpk(P[BASE + 4], P[BASE + 5]), cvtpk(P[BASE + 6], P[BASE + 7])}; OUT = *reinterpret_cast<bf16x8*>(&w); } while (0)
      W2_PK4(p0, 0, pa0); W2_PK4(p0, 8, pa1); W2_PK4(p1, 0, pa2); W2_PK4(p1, 8, pa3);
#undef W2_PK4
#define W2_VF(D0, ks_) ({ const s16x4 l_ = vtr(vp + (D0) * 512 + (2 * (ks_)) * 1024), h_ = vtr(vp + (D0) * 512 + (2 * (ks_) + 1) * 1024); (bf16x8){l_[0], l_[1], l_[2], l_[3], h_[0], h_[1], h_[2], h_[3]}; })
      o0 = __builtin_amdgcn_mfma_f32_32x32x16_bf16(pa0, W2_VF(0, 0), o0, 0, 0, 0); o1 = __builtin_amdgcn_mfma_f32_32x32x16_bf16(pa0, W2_VF(1, 0), o1, 0, 0, 0);
      o0 = __builtin_amdgcn_mfma_f32_32x32x16_bf16(pa1, W2_VF(0, 1), o0, 0, 0, 0); o1 = __builtin_amdgcn_mfma_f32_32x32x16_bf16(pa1, W2_VF(1, 1), o1, 0, 0, 0);
      o0 = __builtin_amdgcn_mfma_f32_32x32x16_bf16(pa2, W2_VF(0, 2), o0, 0, 0, 0); o1 = __builtin_amdgcn_mfma_f32_32x32x16_bf16(pa2, W2_VF(1, 2), o1, 0, 0, 0);
      o0 = __builtin_amdgcn_mfma_f32_32x32x16_bf16(pa3, W2_VF(0, 3), o0, 0, 0, 0); o1 = __builtin_amdgcn_mfma_f32_32x32x16_bf16(pa3, W2_VF(1, 3), o1, 0, 0, 0);
#undef W2_VF
    }
    float l; { auto rr = __builtin_amdgcn_permlane32_swap(__float_as_uint(l_reg), __float_as_uint(l_reg), false, false); l = __uint_as_float(rr[0]) + __uint_as_float(rr[1]); }
    float rli[16];
    row_recips(l, scal[16 + hq], wsf, r32, hi, rli);
    bf16_t* stg = (bf16_t*)(lds + W_WS + 2048) + wid * 1024;
    bf16_t* Ow = ACAT + (rowbase + q0 + wid * QBLK) * 1024 + hq * 64;
#pragma unroll
    for (int g = 0; g < 2; ++g) {
#pragma unroll
      for (int rr = 0; rr < 8; ++rr) { const int r = 8 * g + rr, srow = crow(r, hi) - 16 * g;
        stg[srow * 64 + r32] = (bf16_t)(cvtpk(o0[r] * rli[r], 0.f) & 0xffffu); stg[srow * 64 + 32 + r32] = (bf16_t)(cvtpk(o1[r] * rli[r], 0.f) & 0xffffu); }
      asm volatile("s_waitcnt lgkmcnt(0)" ::: "memory");
#pragma unroll
      for (int i = 0; i < 2; ++i) { const int row = i * 8 + (lane >> 3), ch = lane & 7; const u32x4 v = *(const u32x4*)(stg + row * 64 + ch * 8); *(u32x4*)(Ow + (size_t)(16 * g + row) * 1024 + ch * 8) = v; }
      asm volatile("s_waitcnt lgkmcnt(0)" ::: "memory"); }
  }
  asm volatile("s_waitcnt lgkmcnt(0)" ::: "memory"); __syncthreads();
}

__device__ __forceinline__ void diff_unit(__amdgpu_buffer_rsrc_t rs, const char* wsb, int b, int h, int qb, const bf16_t* QB, const bf16_t* KB, const bf16_t* VB, bf16_t* ACAT, const float* scal, const float* subln, char* lds, const int wid) {
  constexpr int S = 8192;
  const size_t rowbase = (size_t)b * S; const int q0 = qb * 256;
  float* wsf = (float*)(lds + LDS_WS) + wid * 64; float rli[16];
  bf16_t* stg = (bf16_t*)(lds + LDS_STG) + wid * 4096;
#pragma unroll 1
  for (int t = 0; t < 2; ++t) {
    f32x16 o[4]; float l; const float negm_s = scal[2];
    attn_pass_d4(rs, (unsigned)((const char*)(QB + (rowbase + q0) * 512 + (2 * h + t) * 64) - wsb), 1024u, (unsigned)((const char*)(KB + rowbase * 512 + (2 * h + t) * 64) - wsb), 1024u, (unsigned)((const char*)(VB + rowbase * 512 + h * 128) - wsb), 1024u, S, negm_s, lds, o, l, wid);
    const int lane1 = MK_LANE(); int r32 = lane1 & 31, hi = lane1 >> 5, lane = lane1; asm volatile("" : "+v"(r32), "+v"(hi), "+v"(lane));
    row_recips(l, 0.f, wsf, r32, hi, rli);
    if (t == 0) {
#pragma unroll
      for (int r = 0; r < 16; ++r) { const int orow = crow(r, hi);
#pragma unroll
        for (int d0 = 0; d0 < 4; ++d0) stg[orow * 128 + d0 * 32 + r32] = (bf16_t)(cvtpk(o[d0][r] * rli[r], 0.f) & 0xffffu); }
    } else {
      const float lam = scal[0], post = 1.0f - scal[1];
      float ss[16];
#pragma unroll
      for (int r = 0; r < 16; ++r) { const int orow = crow(r, hi); float s_ = 0.f;
#pragma unroll
        for (int d0 = 0; d0 < 4; ++d0) { const float v = bf2f(stg[orow * 128 + d0 * 32 + r32]) - lam * (o[d0][r] * rli[r]); o[d0][r] = v; s_ += v * v; }
        ss[r] = s_; }
#pragma unroll
      for (int r = 0; r < 16; ++r) { float s_ = ss[r]; s_ += __shfl_xor(s_, 1); s_ += __shfl_xor(s_, 2); s_ += __shfl_xor(s_, 4); s_ += __shfl_xor(s_, 8); s_ += __shfl_xor(s_, 16); ss[r] = rsqrtf(s_ * (1.0f / 128.0f) + 1e-6f) * post; }
      float sl[4];
#pragma unroll
      for (int d0 = 0; d0 < 4; ++d0) sl[d0] = subln[d0 * 32 + r32];
#pragma unroll
      for (int r = 0; r < 16; ++r) { const int orow = crow(r, hi);
#pragma unroll
        for (int d0 = 0; d0 < 4; ++d0) stg[orow * 128 + d0 * 32 + r32] = (bf16_t)(cvtpk(o[d0][r] * ss[r] * sl[d0], 0.f) & 0xffffu); }
      asm volatile("s_waitcnt lgkmcnt(0)" ::: "memory");
      const int widl = wid;
      bf16_t* Ow = ACAT + (rowbase + q0) * 1024 + 512 + h * 128 + (unsigned)((widl * QBLK + (lane >> 4)) * 1024 + (lane & 15) * 8);
      const bf16_t* sp = stg + (lane >> 4) * 128 + (lane & 15) * 8;
#pragma unroll
      for (int i = 0; i < 8; ++i) { const u32x4 v = *(const u32x4*)(sp + i * 512); *(u32x4*)(Ow + (size_t)i * 4096) = v; }
    }
  }
  asm volatile("s_waitcnt lgkmcnt(0)" ::: "memory"); __syncthreads();
}
#undef ATT_SBAR
}
constexpr int NWAVES = 8;
#ifndef MK_N_LAUNCHES
#define MK_N_LAUNCHES 1
#endif
constexpr int PER_PHASE = 10;
constexpr int N_LAUNCHES = MK_N_LAUNCHES;

constexpr int BATCH = 2, T = 8192, D = 1024, M = BATCH * T, DFF = 2816, NFF = 2 * DFF, NIN = 4352, NMOD = 9 * D;
constexpr size_t MiB = 1u << 20;
constexpr size_t WS_CTL = 0, CTL_ZERO_BYTES = 1 * MiB;
constexpr size_t WS_MOD = 512 * 1024;
constexpr size_t WS_SCAL = 1 * MiB, WS_CB1 = WS_SCAL + 4096, WS_CBIN = WS_CB1 + 65536, WS_CB2 = WS_CBIN + 65536;
constexpr size_t WS_RSS0 = 2 * MiB, WS_RSS1 = WS_RSS0 + 256 * 1024, WS_RSS2 = WS_RSS1 + 256 * 1024;
constexpr size_t WS_COS = 3 * MiB, WS_SIN = 5 * MiB;
constexpr size_t WS_W1T = 8 * MiB, WS_W1OT = 19 * MiB, WS_WINT = 25 * MiB, WS_WBRT = 34 * MiB, WS_WOT = 38 * MiB, WS_W2T = 40 * MiB, WS_W2OT = 51 * MiB;
constexpr size_t WS_ABUF = 57 * MiB;
constexpr size_t WS_R1 = 89 * MiB;
constexpr size_t WS_QA = WS_R1, WS_KA = WS_QA + 16 * MiB, WS_VA = WS_KA + 4 * MiB, WS_QB = WS_VA + 4 * MiB, WS_KB = WS_QB + 16 * MiB, WS_VB = WS_KB + 16 * MiB;
constexpr size_t WS_MG = WS_R1;
constexpr size_t WS_GA = 177 * MiB, WS_GB = 209 * MiB, WS_END = 241 * MiB;
static_assert(WS_VB + 16 * MiB <= WS_GA && WS_R1 + (size_t)M * DFF * 2 <= WS_GA && WS_W2OT + (size_t)D * DFF * 2 <= WS_ABUF, "d_ws map");
constexpr int CW_TMO = 0, CW_CODE = 1, CW_BAR = 4096;

constexpr int RING_OFF = 0, RING_BYTES = 131072;
constexpr int LDSCTL_OFF = 149504, MISC_OFF = LDSCTL_OFF + 320;
constexpr int LDS_BYTES = 155648;
static_assert(MISC_OFF + 128 <= LDS_BYTES && att::ATT_LDS_BYTES <= LDSCTL_OFF && RING_BYTES <= LDSCTL_OFF, "LDS map");

#define GAS __attribute__((address_space(1)))
#define LAS __attribute__((address_space(3)))
typedef unsigned short bf16;
typedef unsigned v4u __attribute__((ext_vector_type(4)));
typedef float f32x4 __attribute__((ext_vector_type(4)));
typedef short bf16x8 __attribute__((ext_vector_type(8)));
typedef GAS unsigned gu32;
typedef GAS unsigned long long gu64;
#define RLX_AGENT __ATOMIC_RELAXED, __HIP_MEMORY_SCOPE_AGENT
#define LDS_WAIT() asm volatile("s_waitcnt lgkmcnt(0)" ::: "memory")
#define VM_WAIT() asm volatile("s_waitcnt vmcnt(0)" ::: "memory")
__device__ __forceinline__ unsigned long long rt() { return __builtin_amdgcn_s_memrealtime(); }
__device__ __forceinline__ unsigned f2bf(float f) { unsigned u = __builtin_bit_cast(unsigned, f); return (u + 0x7fffu + ((u >> 16) & 1u)) >> 16; }
__device__ __forceinline__ unsigned pk2(float lo, float hi) { return f2bf(lo) | (f2bf(hi) << 16); }

#define XB_TMO      128
#define XB_XCNT(j)  (256  + 64 * (j))
#define XB_XSUB(j)  (1280 + 64 * (j))
#define XB_XGEN(j)  (2304 + 64 * (j))
#define XB_TOP      3328
#define XB_TOPGEN   3392
#define XCD_BAR_WORDS 3456
#define XB_SPIN_CAP (1u << 18)

__device__ __forceinline__ unsigned xb_ld(unsigned* p)              { return __hip_atomic_load(p, __ATOMIC_RELAXED, __HIP_MEMORY_SCOPE_AGENT); }
__device__ __forceinline__ unsigned xb_add(unsigned* p, unsigned v) { return __hip_atomic_fetch_add(p, v, __ATOMIC_RELAXED, __HIP_MEMORY_SCOPE_AGENT); }
__device__ __forceinline__ unsigned xb_xcc_id() { return (unsigned)__builtin_amdgcn_s_getreg((3 << 11) | 20) & 0xFu; }
#define XB_SPIN(cond, bar) do { unsigned _sp = 0; while (cond) { __builtin_amdgcn_s_sleep(1); \
    if ((++_sp & 255u) == 0u) { if (xb_ld(&(bar)[XB_TMO])) break; if (_sp > XB_SPIN_CAP) { atomicAdd(&(bar)[XB_TMO], 1u); break; } } } } while (0)

struct XcdBarrier {
    unsigned* bar; unsigned x;
    volatile LAS unsigned* st;
};

__device__ __forceinline__ XcdBarrier xcd_barrier_post(unsigned* bar, volatile LAS unsigned* st) {
    XcdBarrier b; b.bar = bar; b.x = xb_xcc_id(); b.st = st;
    if (threadIdx.x == 0) (void)xb_add(&bar[XB_XCNT(b.x)], 1u);
    return b;
}
__device__ __forceinline__ void xcd_barrier_complete(unsigned* bar, unsigned x, unsigned& nloc, unsigned& nx) {
    const unsigned G = gridDim.x * gridDim.y * gridDim.z;
    unsigned sum, cnt, mine, sp = 0u;
    for (;;) {
        sum = 0u; cnt = 0u; mine = 0u;
#pragma unroll
        for (unsigned j = 0; j < 16; ++j) { const unsigned c = xb_ld(&bar[XB_XCNT(j)]); sum += c; cnt += (c > 0u) ? 1u : 0u; mine = (j == x) ? c : mine; }
        if (sum == G) break;
        __builtin_amdgcn_s_sleep(1);
        if ((++sp & 255u) == 0u) { if (xb_ld(&bar[XB_TMO])) break; if (sp > XB_SPIN_CAP) { atomicAdd(&bar[XB_TMO], 1u); break; } }
    }
    nloc = mine > 0u ? mine : 1u; nx = cnt > 0u ? cnt : 1u;
}

__device__ __forceinline__ void xcd_barrier(const XcdBarrier& b, const bool leader  ) {
    asm volatile("s_waitcnt vmcnt(0)" ::: "memory");
    __syncthreads();
    if (leader) {
        unsigned* bar = b.bar;
        __builtin_amdgcn_s_waitcnt(0);
        unsigned nloc = b.st[0], nx = b.st[1];
        if (nloc == 0u) { xcd_barrier_complete(bar, b.x, nloc, nx); b.st[0] = nloc; b.st[1] = nx; }
        const unsigned old = xb_add(&bar[XB_XSUB(b.x)], 1u);
        const unsigned gen = old / nloc;
        if (old + 1u == (gen + 1u) * nloc) {
            __builtin_amdgcn_fence(__ATOMIC_RELEASE, "agent");
            asm volatile("s_waitcnt vmcnt(0)" ::: "memory");
            const unsigned og = xb_add(&bar[XB_TOP], 1u);
            const unsigned tg = og / nx;
            asm volatile("buffer_inv sc1" ::: "memory");
            if (og + 1u == (tg + 1u) * nx) xb_add(&bar[XB_TOPGEN], 1u);
            else XB_SPIN(xb_ld(&bar[XB_TOPGEN]) == tg, bar);
            xb_add(&bar[XB_XGEN(b.x)], 1u);
            asm volatile("s_waitcnt vmcnt(0)" ::: "memory");
        } else {
            asm volatile("buffer_inv sc1" ::: "memory");
            XB_SPIN(xb_ld(&bar[XB_XGEN(b.x)]) == gen, bar);
            asm volatile("s_waitcnt vmcnt(0)" ::: "memory");
        }
    }
    __syncthreads();
}

struct Args { const void* in[26]; float* out; unsigned char* ws; int ph_lo, ph_hi, li, pad; };

__device__ __forceinline__ float wave_sum(float v) {
#pragma unroll
    for (int o = 1; o < 64; o <<= 1) v += __shfl_xor(v, o);
    return v;
}
__device__ __forceinline__ int rowmap(int kind, int n0) {
    if (kind == 1) { const int bj = n0 >= DFF ? 1 : 0, jj = n0 - bj * DFF; return (jj >> 7) * 256 + bj * 128 + (jj & 127); }
    if (kind == 2) { if (n0 >= 2304) return n0; const int g32 = n0 >> 5, head = g32 >> 1, bj = g32 & 1; return (head >> 2) * 256 + bj * 128 + (head & 3) * 32; }
    if (kind == 3) return (n0 >> 7) * 256 + (n0 & 127);
    if (kind == 4) return (n0 >> 7) * 256 + 128 + (n0 & 127);
    return n0;
}
struct TItem { const float* src; bf16* dst; int N; int ldk; };
__device__ __forceinline__ TItem p0_item_addr(const float* W, int N, bf16* WT, int ldk, int koff, int kind, int item, int lane) {
    const int nblk = N / 32, kb = item / nblk, nb = item % nblk, k0 = 64 * kb, n0 = 32 * nb, c0 = rowmap(kind, n0), kg = lane & 7, ng = lane >> 3;
    TItem t; t.src = W + (size_t)(k0 + 8 * kg) * N + n0 + 4 * ng; t.dst = WT + (size_t)(c0 + 4 * ng) * ldk + koff + k0 + 8 * kg; t.N = N; t.ldk = ldk; return t;
}
__device__ __forceinline__ void p0_item_load(const TItem& t, f32x4 (&v)[8]) {
#pragma unroll
    for (int j = 0; j < 8; ++j) v[j] = __builtin_nontemporal_load((const f32x4*)(t.src + (size_t)j * t.N));
}
__device__ __forceinline__ void p0_item_store(const TItem& t, const f32x4 (&v)[8]) {
#pragma unroll
    for (int i = 0; i < 4; ++i) { v4u o; o.x = pk2(v[0][i], v[1][i]); o.y = pk2(v[2][i], v[3][i]); o.z = pk2(v[4][i], v[5][i]); o.w = pk2(v[6][i], v[7][i]);
        *(GAS v4u*)(t.dst + (size_t)i * t.ldk) = o; }
}

__device__ __forceinline__ void bias_rows(const bf16* Bt, float* CB, int nrows, const float* sh0, const float* sh1, int gw, int NGW) {
    const int lane = MK_LANE();
    f32x4 s0[2][2], s1[2][2];
#pragma unroll
    for (int hh = 0; hh < 2; ++hh)
#pragma unroll
        for (int q = 0; q < 2; ++q) { s0[hh][q] = *(const f32x4*)(sh0 + hh * 512 + lane * 8 + 4 * q); s1[hh][q] = *(const f32x4*)(sh1 + hh * 512 + lane * 8 + 4 * q); }
    for (int c0 = gw; c0 < nrows; c0 += 3 * NGW) {
        v4u w[3][2];
#pragma unroll
        for (int r = 0; r < 3; ++r) { const int c = c0 + r * NGW;
            if (c < nrows) {
#pragma unroll
                for (int hh = 0; hh < 2; ++hh) w[r][hh] = *(const GAS v4u*)(Bt + (size_t)c * D + hh * 512 + lane * 8); } }
#pragma unroll
        for (int r = 0; r < 3; ++r) { const int c = c0 + r * NGW;
            if (c < nrows) { float a0 = 0.f, a1 = 0.f;
#pragma unroll
                for (int hh = 0; hh < 2; ++hh) { const v4u v = w[r][hh];
                    const float wf[8] = {__uint_as_float(v.x << 16), __uint_as_float(v.x & 0xffff0000u), __uint_as_float(v.y << 16), __uint_as_float(v.y & 0xffff0000u),
                                         __uint_as_float(v.z << 16), __uint_as_float(v.z & 0xffff0000u), __uint_as_float(v.w << 16), __uint_as_float(v.w & 0xffff0000u)};
#pragma unroll
                    for (int e = 0; e < 8; ++e) { a0 += wf[e] * s0[hh][e >> 2][e & 3]; a1 += wf[e] * s1[hh][e >> 2][e & 3]; } }
                a0 = wave_sum(a0); a1 = wave_sum(a1);
                if (lane == 0) { CB[c] = a0; CB[nrows + c] = a1; } } }
    }
}

__global__ void __launch_bounds__(NWAVES * 64, 2) layer_fwd(Args args) {
    extern __shared__ __attribute__((aligned(16))) unsigned char lds[];
    LAS unsigned char* ldsl = (LAS unsigned char*)lds;
    volatile LAS unsigned* MISC = (volatile LAS unsigned*)(ldsl + MISC_OFF);
    const int wave = __builtin_amdgcn_readfirstlane((int)threadIdx.x >> 6), lane = MK_LANE(), tid = wave * 64 + lane;
    const int G = gridDim.x; const int bx = blockIdx.x; const int vcu = (G % 8 == 0) ? (bx % 8) * (G / 8) + bx / 8 : bx;
    unsigned char* ws = args.ws;
    gu32* ctl = (gu32*)(ws + WS_CTL);
    const float* x = (const float*)args.in[0]; const float* cvec = (const float*)args.in[1]; const int* positions = (const int*)args.in[2];
    const float* w_mod = (const float*)args.in[3]; const float* b_mod = (const float*)args.in[4];
    const float* norm_ffn1 = (const float*)args.in[5]; const float* w_ffn1_in = (const float*)args.in[6]; const float* w_ffn1_out = (const float*)args.in[7];
    const float* norm_mix = (const float*)args.in[8]; const float* w_in = (const float*)args.in[9];
    const float* qn_a = (const float*)args.in[10]; const float* kn_a = (const float*)args.in[11]; const float* sink_a = (const float*)args.in[12];
    const float* qn_b = (const float*)args.in[13]; const float* kn_b = (const float*)args.in[14];
    const float* lam_q1 = (const float*)args.in[15]; const float* lam_k1 = (const float*)args.in[16]; const float* lam_q2 = (const float*)args.in[17]; const float* lam_k2 = (const float*)args.in[18];
    const float* subln_b = (const float*)args.in[19]; const float* w_branch_a = (const float*)args.in[20]; const float* w_branch_b = (const float*)args.in[21];
    const float* w_out = (const float*)args.in[22]; const float* norm_ffn2 = (const float*)args.in[23]; const float* w_ffn2_in = (const float*)args.in[24]; const float* w_ffn2_out = (const float*)args.in[25];
    float* out = args.out;
    float* MOD = (float*)(ws + WS_MOD); float* SCAL = (float*)(ws + WS_SCAL); float* CB1 = (float*)(ws + WS_CB1); float* CBIN = (float*)(ws + WS_CBIN); float* CB2 = (float*)(ws + WS_CB2);
    float* RSS0 = (float*)(ws + WS_RSS0); float* RSS1 = (float*)(ws + WS_RSS1); float* RSS2 = (float*)(ws + WS_RSS2); bf16* ROPET = (bf16*)(ws + WS_COS);
    bf16* W1T = (bf16*)(ws + WS_W1T); bf16* W1OT = (bf16*)(ws + WS_W1OT); bf16* WINT = (bf16*)(ws + WS_WINT); bf16* WBRT = (bf16*)(ws + WS_WBRT); bf16* WOT = (bf16*)(ws + WS_WOT);
    bf16* W2T = (bf16*)(ws + WS_W2T); bf16* W2OT = (bf16*)(ws + WS_W2OT);
    bf16* ABUF = (bf16*)(ws + WS_ABUF); bf16* HB = (bf16*)(ws + WS_R1); bf16* MG = (bf16*)(ws + WS_MG);
    bf16* QA = (bf16*)(ws + WS_QA); bf16* KA = (bf16*)(ws + WS_KA); bf16* VA = (bf16*)(ws + WS_VA); bf16* QB = (bf16*)(ws + WS_QB); bf16* KB = (bf16*)(ws + WS_KB); bf16* VB = (bf16*)(ws + WS_VB);
    bf16* GA = (bf16*)(ws + WS_GA); bf16* GB = (bf16*)(ws + WS_GB);
    bf16* X1B = (bf16*)out;
    bf16* X2B = (bf16*)(ws + WS_GA);

    for (int u = tid; u < (LDS_BYTES - LDSCTL_OFF) / 4; u += NWAVES * 64) ((LAS unsigned*)(ldsl + LDSCTL_OFF))[u] = 0u;
    __syncthreads();
    XcdBarrier bar; bar.bar = (unsigned*)(ctl + CW_BAR); bar.x = 0; bar.st = nullptr;
    if (N_LAUNCHES != PER_PHASE) bar = xcd_barrier_post((unsigned*)(ctl + CW_BAR), MISC + 8);
#define GRID_BAR(seam) do { if (N_LAUNCHES == PER_PHASE) { if (tid == 0) __hip_atomic_store(ctl + CW_TMO, 0xBADBA0u | (unsigned)(seam), RLX_AGENT); } else { xcd_barrier(bar, wave == 0 && MK_LANE() == 0); } } while (0)
    const int lo = args.ph_lo, hi = args.ph_hi;
#ifndef PH_MASK
#define PH_MASK 0x3ff
#endif
#define IN(k) (((PH_MASK >> (k)) & 1) && lo <= (k) && (k) < hi)
#define BOTH(k) (IN(k) && IN((k) + 1))
#ifndef REPEAT_MASK
#define REPEAT_MASK 0
#endif
#define REPS(k) for (int rep_ = 0; rep_ <= ((REPEAT_MASK >> (k)) & 1); ++rep_)
    const int gw = vcu * NWAVES + wave, NGW = G * NWAVES;
    constexpr float QSCALE = 0.125f * 1.4426950408889634f;

    if (IN(0)) {
#define MOD_GEMV(IT_BEGIN, IT_END, IT_FIRST, IT_STRIDE, TIDV, LANEV) do { \
            LAS float* ca = (LAS float*)(ldsl + RING_OFF + 73728);              \
            LAS float* red = ca + 2048;                                          \
            for (int i = (TIDV); i < 2 * D; i += NWAVES * 64) { const float v = cvec[i]; ca[i] = v / (1.f + __expf(-v)); } \
            __syncthreads(); \
            for (int it = (IT_BEGIN) + (IT_FIRST); it < (IT_END); it += (IT_STRIDE)) { \
                const int cg = it >> 1, kh = it & 1, j = cg * 64 + (LANEV), kbase = kh * 512 + wave * 64; \
                float wv[64]; \
                _Pragma("unroll") \
                for (int kk = 0; kk < 64; ++kk) wv[kk] = w_mod[(size_t)(kbase + kk) * NMOD + j]; \
                float a0 = 0.f, a1 = 0.f; \
                _Pragma("unroll") \
                for (int kk = 0; kk < 64; ++kk) { a0 += ca[kbase + kk] * wv[kk]; a1 += ca[D + kbase + kk] * wv[kk]; } \
                red[(wave * 2 + 0) * 64 + (LANEV)] = a0; red[(wave * 2 + 1) * 64 + (LANEV)] = a1; \
                __syncthreads(); \
                if ((TIDV) < 128) { const int b = (TIDV) >> 6; float s_ = (kh == 0) ? b_mod[j] : 0.f; \
                    _Pragma("unroll") \
                    for (int w = 0; w < 8; ++w) s_ += red[(w * 2 + b) * 64 + (LANEV)]; \
                    atomicAdd(MOD + b * NMOD + j, s_); } \
                __syncthreads(); \
            } } while (0)
        MOD_GEMV(0, 64, bx, G, tid, lane);
        {
            constexpr int NITEMS = (D / 64) * (NFF / 32);
            auto item_of = [&](int it) -> TItem { return p0_item_addr(w_ffn1_in, NFF, W1T, D, 0, 1, it, lane); };
            for (int it = gw; it < NITEMS; it += 2 * NGW) {
                const int it2 = it + NGW; const bool two = it2 < NITEMS;
                const TItem a = item_of(it), b2 = item_of(two ? it2 : it);
                f32x4 va[8], vb[8];
                p0_item_load(a, va); if (two) p0_item_load(b2, vb);
                p0_item_store(a, va); if (two) p0_item_store(b2, vb);
            }
        }
        if (bx == 0 && wave == 0) {
            const float a = wave_sum(lam_q1[lane] * lam_k1[lane]), b2 = wave_sum(lam_q2[lane] * lam_k2[lane]);
            float mqa = fabsf(qn_a[lane]), mka = fabsf(kn_a[lane]), mqb = fabsf(qn_b[lane]), mkb = fabsf(kn_b[lane]);
#pragma unroll
            for (int o = 1; o < 64; o <<= 1) { mqa = fmaxf(mqa, __shfl_xor(mqa, o)); mka = fmaxf(mka, __shfl_xor(mka, o)); mqb = fmaxf(mqb, __shfl_xor(mqb, o)); mkb = fmaxf(mkb, __shfl_xor(mkb, o)); }
            const float bound_a = 8.0f * mqa * mka * 1.001f, bound_b = 8.0f * mqb * mkb * 1.001f, L2E = 1.4426950408889634f;
            if (lane == 0) { const float lam_init = 0.8f - 0.6f * expf(-0.3f * 0.f); SCAL[0] = expf(a) - expf(b2) + lam_init; SCAL[1] = lam_init; SCAL[2] = -bound_b * L2E; }
            if (lane < 8) { const float sk = sink_a[lane], mh = fmaxf(bound_a, sk); SCAL[8 + lane] = -mh * L2E; SCAL[16 + lane] = exp2f((sk - mh) * L2E); }
        }
        if (BOTH(0)) GRID_BAR(0);
    }

    if (IN(1)) {
        for (int m = gw; m < M; m += NGW) {
            const int b = m >> 13; const GAS f32x4* xr = (const GAS f32x4*)(x + (size_t)m * D) + lane;
            f32x4 v[4]; float s = 0.f;
#pragma unroll
            for (int j = 0; j < 4; ++j) { v[j] = xr[64 * j]; s += (v[j].x * v[j].x + v[j].y * v[j].y) + (v[j].z * v[j].z + v[j].w * v[j].w); }
            s = wave_sum(s);
            if (lane == 0) *(f32x4*)(RSS0 + (size_t)m * 4) = (f32x4){s, 0.f, 0.f, 0.f};
            GAS unsigned long long* o8 = (GAS unsigned long long*)(ABUF + (size_t)m * D) + lane;
#pragma unroll
            for (int j = 0; j < 4; ++j) { const int c = 4 * lane + 256 * j; const f32x4 g = *(const f32x4*)(norm_ffn1 + c) * (*(const f32x4*)(MOD + b * NMOD + 1 * D + c) + 1.0f); const f32x4 a = v[j] * g;
                o8[64 * j] = (unsigned long long)pk2(a.x, a.y) | ((unsigned long long)pk2(a.z, a.w) << 32); }
        }
        bias_rows(W1T, CB1, NFF, MOD + 0 * D, MOD + NMOD + 0 * D, gw, NGW);
        if (BOTH(1)) GRID_BAR(1);
    }

    if (IN(2)) {
        pg8::Gemm g{ABUF, W1T, M, NFF, D}; pg8::StaticOrder S; S.init(M, NFF, G, bx);
        pg8::EpiSwiGLU E{HB, DFF, RSS0, CB1, NFF};
        pg8::gemm_phase<pg8::EpiSwiGLU, pg8::StaticOrder, PG8_ALIGN, PG8_SP2>(ldsl + RING_OFF, g, S, E, wave);
        { pg8::Unit ud; const int nunits = (M / 256) * (NFF / 256), nfull = nunits / G;
          if (!S.next(nfull, ud)) {
            const int nidle = G - (nunits - nfull * G), iw = (bx - (G - nidle)) * NWAVES + wave, NIW = nidle * NWAVES, lane2 = MK_LANE();
            MOD_GEMV(64, 288, bx - (G - nidle), nidle, wave * 64 + lane2, lane2);
            constexpr int I_IN = (D / 64) * (NIN / 32), I_1O = (DFF / 64) * (D / 32), NITEMS = I_IN + I_1O;
            auto item_of = [&](int it) -> TItem { return it < I_IN ? p0_item_addr(w_in, NIN, WINT, D, 0, 2, it, lane2) : p0_item_addr(w_ffn1_out, D, W1OT, DFF, 0, 0, it - I_IN, lane2); };
            for (int it = iw; it < NITEMS; it += 2 * NIW) {
                const int it2 = it + NIW; const bool two = it2 < NITEMS;
                const TItem a = item_of(it), b2 = item_of(two ? it2 : it);
                f32x4 va[8], vb[8];
                p0_item_load(a, va); if (two) p0_item_load(b2, vb);
                p0_item_store(a, va); if (two) p0_item_store(b2, vb);
            }
            { const float invf = (float)pow(10000.0, -(double)(2 * (lane2 & 31)) / 64.0);
              for (int i = iw * 64 + lane2; i < M * 32; i += NIW * 64) { const float ang = (float)positions[i >> 5] * invf; const int row = i >> 5, d = i & 31;
                  ROPET[row * 64 + d] = (bf16)f2bf(cosf(ang)); ROPET[row * 64 + 32 + d] = (bf16)f2bf(sinf(ang)); } }
          } }
        if (BOTH(2)) GRID_BAR(2);
    }
    if (IN(3)) {
        pg8::Gemm g{HB, W1OT, M, D, DFF}; pg8::StaticOrder S; S.init(M, D, G, bx);
        pg8::EpiResid<true, 1, false, true> E{x, X1B, MOD + 2 * D, ABUF, norm_mix, MOD + 4 * D, RSS1};
        pg8::gemm_phase<pg8::EpiResid<true, 1, false, true>, pg8::StaticOrder, false, PG8_SP2>(ldsl + RING_OFF, g, S, E, wave);
        bias_rows(WINT, CBIN, NIN, MOD + 3 * D, MOD + NMOD + 3 * D, gw, NGW);
        if (BOTH(3)) GRID_BAR(3);
    }
    if (IN(4)) {
        pg8::Gemm g{ABUF, WINT, M, NIN, D}; pg8::StaticOrder S; S.init(M, NIN, G, bx);
        pg8::EpiInProj E{QA, KA, VA, QB, KB, VB, GA, GB, RSS1, CBIN, ROPET, qn_a, kn_a, qn_b, kn_b, QSCALE};
        pg8::gemm_phase<pg8::EpiInProj, pg8::StaticOrder, PG8_ALIGN, PG8_SP2>(ldsl + RING_OFF, g, S, E, wave);
        { pg8::Unit ud; const int nunits = (M / 256) * (NIN / 256), nfull = nunits / G;
          if (!S.next(nfull, ud)) {
            const int nidle = G - (nunits - nfull * G), iw = (bx - (G - nidle)) * NWAVES + wave, NIW = nidle * NWAVES, lane2 = MK_LANE();
            constexpr int I_1 = (D / 64) * (NFF / 32), I_1O = (DFF / 64) * (D / 32), I_BR = (512 / 64) * (D / 32), I_O = (D / 64) * (D / 32);
            constexpr int NITEMS = 2 * I_BR + I_O + I_1 + I_1O;
            auto item_of = [&](int it) -> TItem {
                int r = it;
                if (r < I_BR) return p0_item_addr(w_branch_a, D, WBRT, D, 0, 0, r, lane2); r -= I_BR;
                if (r < I_BR) return p0_item_addr(w_branch_b, D, WBRT, D, 512, 0, r, lane2); r -= I_BR;
                if (r < I_O) return p0_item_addr(w_out, D, WOT, D, 0, 0, r, lane2); r -= I_O;
                if (r < I_1) return p0_item_addr(w_ffn2_in, NFF, W2T, D, 0, 1, r, lane2); r -= I_1;
                return p0_item_addr(w_ffn2_out, D, W2OT, DFF, 0, 0, r, lane2);
            };
            for (int it = iw; it < NITEMS; it += 2 * NIW) {
                const int it2 = it + NIW; const bool two = it2 < NITEMS;
                const TItem a = item_of(it), b2 = item_of(two ? it2 : it);
                f32x4 va[8], vb[8];
                p0_item_load(a, va); if (two) p0_item_load(b2, vb);
                p0_item_store(a, va); if (two) p0_item_store(b2, vb);
            }
          } }
        if (BOTH(4)) GRID_BAR(4);
    }
    if (IN(5)) {
        char* alds = (char*)lds + RING_OFF;
        const __amdgpu_buffer_rsrc_t wsrs = __builtin_amdgcn_make_buffer_rsrc((void*)ws, (short)0, 0x10000000, 0x00020000);
#ifndef SKIP_WIN
        for (int id = vcu; id < 256; id += G) att::win_unit2(wsrs, (const char*)ws, id >> 7, (id >> 6) & 1, id & 31, (id >> 5) & 1, QA, KA, VA, ABUF, SCAL, alds, wave);
#endif
#ifndef SKIP_DIFF
        for (int id = vcu; id < 256; id += G) att::diff_unit(wsrs, (const char*)ws, id >> 7, (id >> 5) & 3, id & 31, QB, KB, VB, ABUF, SCAL, subln_b, alds, wave);
#endif
        if (BOTH(5)) GRID_BAR(5);
    }
    if (IN(6)) {
        pg8::Gemm g{ABUF, WBRT, M, D, D, 512}; pg8::PairOrder S; S.init(M, D, G, bx, D);
        pg8::EpiBranch E{GA, GB, MG};
        pg8::gemm_phase<pg8::EpiBranch, pg8::PairOrder, PG8_ALIGN, PG8_SP2>(ldsl + RING_OFF, g, S, E, wave);
        if (BOTH(6)) GRID_BAR(6);
    }
    if (IN(7)) {
        pg8::Gemm g{MG, WOT, M, D, D}; pg8::StaticOrder S; S.init(M, D, G, bx);
        pg8::EpiResid<true, 2, true, true> E{X1B, X2B, MOD + 5 * D, ABUF, norm_ffn2, MOD + 7 * D, RSS2};
        pg8::gemm_phase<pg8::EpiResid<true, 2, true, true>, pg8::StaticOrder, false, PG8_SP2>(ldsl + RING_OFF, g, S, E, wave);
        bias_rows(W2T, CB2, NFF, MOD + 6 * D, MOD + NMOD + 6 * D, gw, NGW);
        if (BOTH(7)) GRID_BAR(7);
    }
    if (IN(8)) {
        pg8::Gemm g{ABUF, W2T, M, NFF, D}; pg8::StaticOrder S; S.init(M, NFF, G, bx);
        pg8::EpiSwiGLU E{HB, DFF, RSS2, CB2, NFF};
        pg8::gemm_phase<pg8::EpiSwiGLU, pg8::StaticOrder, PG8_ALIGN, PG8_SP2>(ldsl + RING_OFF, g, S, E, wave);
        if (BOTH(8)) GRID_BAR(8);
    }
    if (IN(9)) {
        pg8::Gemm g{HB, W2OT, M, D, DFF}; pg8::StaticOrder S; S.init(M, D, G, bx);
        pg8::EpiResid<false, 1, true, false> E{X2B, out, MOD + 8 * D, nullptr, nullptr, nullptr, nullptr};
        pg8::gemm_phase<pg8::EpiResid<false, 1, true, false>, pg8::StaticOrder, false, PG8_SP2>(ldsl + RING_OFF, g, S, E, wave);
    }
#undef IN
#undef BOTH
#undef GRID_BAR
}

extern "C" void kernel_launch(void* const* d_in, const int* in_sizes, int n_in, void* d_out, int out_size, void* d_ws, size_t ws_size, hipStream_t stream) {
    static int grid = 0;
    if (grid == 0) {
        if (n_in != 26 || in_sizes[0] != M * D || out_size != M * D || ws_size < WS_END) { fprintf(stderr, "kernel_launch: unexpected shapes: n_in %d in0 %d out %d ws %zu (need >= %zu)\n", n_in, n_in > 0 ? in_sizes[0] : -1, out_size, ws_size, (size_t)WS_END); grid = -1; return; }
        int dev = 0, cus = 0;
        if (hipGetDevice(&dev) != hipSuccess || hipDeviceGetAttribute(&cus, hipDeviceAttributeMultiprocessorCount, dev) != hipSuccess) { grid = -1; return; }
        if (hipFuncSetAttribute((const void*)layer_fwd, hipFuncAttributeMaxDynamicSharedMemorySize, LDS_BYTES) != hipSuccess) { fprintf(stderr, "kernel_launch: hipFuncSetAttribute failed\n"); grid = -1; return; }
        int per_cu = 0;
        if (hipOccupancyMaxActiveBlocksPerMultiprocessor(&per_cu, (const void*)layer_fwd, NWAVES * 64, LDS_BYTES) != hipSuccess || per_cu < 1) fprintf(stderr, "kernel_launch: occupancy query says %d\n", per_cu);
        (void)hipGetLastError();
        grid = cus;
        if (grid != 256) fprintf(stderr, "kernel_launch: %d CUs; the one-unit-per-workgroup phases need exactly 256\n", grid);
    }
    if (grid < 0) return;
    (void)hipMemsetAsync((char*)d_ws + WS_CTL, 0, CTL_ZERO_BYTES, stream);
    Args a{};
    for (int i = 0; i < 26; ++i) a.in[i] = d_in[i];
    a.out = (float*)d_out; a.ws = (unsigned char*)d_ws;
    for (int li = 0; li < N_LAUNCHES; ++li) {
        a.ph_lo = (N_LAUNCHES == PER_PHASE) ? li : 0; a.ph_hi = (N_LAUNCHES == PER_PHASE) ? li + 1 : PER_PHASE; a.li = li;
        hipLaunchKernelGGL(layer_fwd, dim3(grid), dim3(NWAVES * 64), LDS_BYTES, stream, a);
    }
}
```

```cpp
#include <hip/hip_runtime.h>
#include <cstdio>
#include <cstdint>
#include <cmath>
__device__ __forceinline__ int mk_lane_() { int l; asm volatile("v_mbcnt_lo_u32_b32 %0, -1, 0\n\tv_mbcnt_hi_u32_b32 %0, -1, %0" : "=v"(l)); return l; }
#define MK_LANE() mk_lane_()
namespace pg8 {
#define PG8_LAS __attribute__((address_space(3)))
typedef unsigned short bf16_t;
typedef short bf16x8 __attribute__((ext_vector_type(8)));
typedef float f32x4 __attribute__((ext_vector_type(4)));
typedef unsigned u32x4 __attribute__((ext_vector_type(4)));
constexpr int BM = 256, BK = 64, HALF = 128, HTB = HALF * BK * 2  , STAGE_BYTES = 8 * HTB, NXCD = 8, WGM = 8;

__host__ __device__ __forceinline__ int lds_byte(int r, int c) { const int st = (r >> 4) * 2 + (c >> 5), rr = r & 15, cc = c & 31, ob = rr * 64 + cc * 2; return st * 1024 + (ob ^ (((ob >> 9) & 1) << 5)); }
__host__ __device__ __forceinline__ void stage_rc(int b, int& R, int& C) { const int st = b / 1024, sb = b % 1024, swz = sb ^ (((sb >> 9) & 1) << 5); R = (st >> 1) * 16 + swz / 64; C = (st & 1) * 32 + (swz % 64) / 2; }
__host__ __device__ __forceinline__ int perm32(int rho) { const int n = rho >> 4, i = rho & 15; return 8 * (i >> 2) + 4 * n + (i & 3); }

struct Unit { int pm, pn, ko; };
struct Gemm { const bf16_t* A; const bf16_t* Bt; int M, N, K; int KL = 0; };

struct StaticOrder {
    int nM, nN, nwg, G, c;
    __host__ __device__ void init(int M, int N, int G_, int c_) { nM = M / BM; nN = N / BM; nwg = nM * nN; G = G_; c = c_; }
    __host__ __device__ bool next(int i, Unit& u) const {
        const long L = (long)i * G + c; if (L >= nwg) return false;
        int wgid = (int)L; { const int q = nwg / NXCD, r = nwg % NXCD, xcd = wgid % NXCD, off = wgid / NXCD; wgid = (xcd < r ? xcd * (q + 1) : r * (q + 1) + (xcd - r) * q) + off; }
        const int nig = WGM * nN, gid = wgid / nig, fm = gid * WGM, gsz = (nM - fm) < WGM ? (nM - fm) : WGM;
        u.pm = fm + ((wgid % nig) % gsz); u.pn = (wgid % nig) / gsz; u.ko = 0; return true;
    }
    __device__ __forceinline__ void a_ready(const Unit&) const {}
    __device__ __forceinline__ void done(const Unit&) const {}
};
struct PairOrder {
    StaticOrder S; int khalf_bytes;
    __host__ __device__ void init(int M, int N, int G_, int c_, int K) { S.init(M, N, G_, c_); khalf_bytes = K;   }
    __host__ __device__ bool next(int i, Unit& u) const { if (!S.next(i >> 1, u)) return false; u.ko = (i & 1) * khalf_bytes; return true; }
    __device__ __forceinline__ void a_ready(const Unit&) const {}
    __device__ __forceinline__ void done(const Unit&) const {}
};

__device__ __forceinline__ unsigned cvt_pk_bf16(float lo, float hi) { unsigned r; asm volatile("v_cvt_pk_bf16_f32 %0, %1, %2" : "=v"(r) : "v"(lo), "v"(hi)); return r; }
__device__ __forceinline__ float bf_lo(unsigned w) { return __uint_as_float(w << 16); }
__device__ __forceinline__ float bf_hi(unsigned w) { return __uint_as_float(w & 0xffff0000u); }
constexpr float RMS_EPS = 1e-6f, LOG2E = 1.4426950408889634f;
__device__ __forceinline__ float row_rinv(const float* rss, int row) { const f32x4 s = *(const f32x4*)(rss + (size_t)row * 4); return rsqrtf(((s[0] + s[1]) + (s[2] + s[3])) * (1.0f / 1024.0f) + RMS_EPS); }
__device__ __forceinline__ float fast_sigmoid(float v) { return __builtin_amdgcn_rcpf(1.0f + __builtin_amdgcn_exp2f(-v * LOG2E)); }

struct EpiSwiGLU {
    static constexpr bool PERM = true, AFTER_DRAIN = false, PREFETCH = true, CHAIN = false;
    bf16_t* H; int ldh; const float* rss; const float* cb; int ncb;
    __device__ __forceinline__ void prefetch(const Unit& u, PG8_LAS unsigned char* buf, int wid, int lane) const {
        if (wid < 4) __builtin_amdgcn_global_load_lds((const unsigned*)(rss + (size_t)(u.pm * BM + wid * 64 + lane) * 4), (PG8_LAS unsigned*)(buf + wid * 1024), 16, 0, 0);
        else if (wid == 4) __builtin_amdgcn_global_load_lds((const unsigned*)(cb + (size_t)(u.pm >> 5) * ncb + u.pn * BM + lane * 4), (PG8_LAS unsigned*)(buf + 4096), 16, 0, 0);
    }
    __device__ __forceinline__ void operator()(const f32x4 (&acc)[2][2][4][2], const Unit& u, int wr, int wc, int fr, int fq, const PG8_LAS unsigned char* buf) const {
        const int outcol = u.pn * HALF + wc * 32 + 8 * fq;
        const PG8_LAS float* cbb = (const PG8_LAS float*)(buf + 4096) + wc * 32 + 8 * fq;
        const f32x4 bg0 = *(const PG8_LAS f32x4*)(cbb), bg1 = *(const PG8_LAS f32x4*)(cbb + 4), bu0 = *(const PG8_LAS f32x4*)(cbb + HALF), bu1 = *(const PG8_LAS f32x4*)(cbb + HALF + 4);
#pragma unroll
        for (int ai = 0; ai < 2; ++ai) {
#pragma unroll
            for (int m = 0; m < 4; ++m) {
                const int row = u.pm * BM + ai * HALF + wr * 64 + m * 16 + fr; const f32x4 sv_ = *(const PG8_LAS f32x4*)(buf + (ai * HALF + wr * 64 + m * 16 + fr) * 16); const float ri = rsqrtf(((sv_[0] + sv_[1]) + (sv_[2] + sv_[3])) * (1.0f / 1024.0f) + RMS_EPS);
                const f32x4 g0 = acc[ai][0][m][0] * ri + bg0, g1 = acc[ai][0][m][1] * ri + bg1, u0 = acc[ai][1][m][0] * ri + bu0, u1 = acc[ai][1][m][1] * ri + bu1;
                float o[8];
#pragma unroll
                for (int j = 0; j < 4; ++j) { o[j] = g0[j] * fast_sigmoid(g0[j]) * u0[j]; o[4 + j] = g1[j] * fast_sigmoid(g1[j]) * u1[j]; }
                u32x4 w; w.x = cvt_pk_bf16(o[0], o[1]); w.y = cvt_pk_bf16(o[2], o[3]); w.z = cvt_pk_bf16(o[4], o[5]); w.w = cvt_pk_bf16(o[6], o[7]);
                *(u32x4*)(H + (size_t)row * ldh + outcol) = w; } }
    }
};

struct EpiInProj {
    static constexpr bool PERM = true, AFTER_DRAIN = false, PREFETCH = true, CHAIN = false;
    bf16_t *QA, *KA, *VA, *QB, *KB, *VB, *GA, *GB; const float* rss; const float* cb; const bf16_t* ropet; const float *qn_a, *kn_a, *qn_b, *kn_b; float qscale;
    __device__ __forceinline__ void prefetch(const Unit& u, PG8_LAS unsigned char* buf, int wid, int lane) const {
        if (wid < 4) __builtin_amdgcn_global_load_lds((const unsigned*)(rss + (size_t)(u.pm * BM + wid * 64 + lane) * 4), (PG8_LAS unsigned*)(buf + wid * 1024), 16, 0, 0);
        else if (wid == 4) __builtin_amdgcn_global_load_lds((const unsigned*)(cb + (size_t)(u.pm >> 5) * 4352 + u.pn * BM + lane * 4), (PG8_LAS unsigned*)(buf + 4096), 16, 0, 0);
    }
    __device__ __forceinline__ void operator()(const f32x4 (&acc)[2][2][4][2], const Unit& u, int wr, int wc, int fr, int fq, const PG8_LAS unsigned char* buf) const {
        const int pn = u.pn;
        int mode; bf16_t* dst; int ld; const float* gain = qn_a; float scale = 1.f;
        if (pn < 2) { mode = 0; dst = QA + (4 * pn + wc) * 64; ld = 512; gain = qn_a; scale = qscale; }
        else if (pn == 2) { if (wc < 2) { mode = 0; dst = KA + wc * 64; ld = 128; gain = kn_a; } else { mode = 1; dst = VA + (wc - 2) * 64; ld = 128; } }
        else if (pn < 5) { mode = 0; dst = QB + (4 * (pn - 3) + wc) * 64; ld = 512; gain = qn_b; scale = qscale; }
        else if (pn < 7) { mode = 0; dst = KB + (4 * (pn - 5) + wc) * 64; ld = 512; gain = kn_b; }
        else if (pn < 9) { mode = 1; dst = VB + (4 * (pn - 7) + wc) * 64; ld = 512; }
        else if (pn < 13) { mode = 2; dst = GA + (pn - 9) * BM + wc * 32; ld = 1024; }
        else { mode = 2; dst = GB + (pn - 13) * BM + wc * 32; ld = 1024; }
        const int bjoff = (mode == 2) ? HALF : 32;
        const PG8_LAS float* cbb = (const PG8_LAS float*)(buf + 4096) + wc * 32 + 8 * fq;
        f32x4 bv[2][2];
#pragma unroll
        for (int bj = 0; bj < 2; ++bj)
#pragma unroll
            for (int n = 0; n < 2; ++n) bv[bj][n] = *(const PG8_LAS f32x4*)(cbb + bj * HALF + 4 * n);
        f32x4 gv[2][2];
#pragma unroll
        for (int bj = 0; bj < 2; ++bj)
#pragma unroll
            for (int n = 0; n < 2; ++n) gv[bj][n] = *(const f32x4*)(gain + bj * 32 + 8 * fq + 4 * n);
#pragma unroll
        for (int ai = 0; ai < 2; ++ai) {
            u32x4 csw[4], snw[4];
            if (mode == 0) {
#pragma unroll
              for (int m = 0; m < 4; ++m) { const bf16_t* tp = ropet + (size_t)(u.pm * BM + ai * HALF + wr * 64 + m * 16 + fr) * 64 + 8 * fq; csw[m] = *(const u32x4*)tp; snw[m] = *(const u32x4*)(tp + 32); } }
#pragma unroll
            for (int m = 0; m < 4; ++m) {
                const int row = u.pm * BM + ai * HALF + wr * 64 + m * 16 + fr; const f32x4 sv_ = *(const PG8_LAS f32x4*)(buf + (ai * HALF + wr * 64 + m * 16 + fr) * 16); const float ri = rsqrtf(((sv_[0] + sv_[1]) + (sv_[2] + sv_[3])) * (1.0f / 1024.0f) + RMS_EPS);
                f32x4 v[2][2];
#pragma unroll
                for (int bj = 0; bj < 2; ++bj)
#pragma unroll
                    for (int n = 0; n < 2; ++n) v[bj][n] = acc[ai][bj][m][n] * ri + bv[bj][n];
                if (mode == 0) {
                    float ss = 0.f;
#pragma unroll
                    for (int bj = 0; bj < 2; ++bj)
#pragma unroll
                        for (int n = 0; n < 2; ++n) ss += (v[bj][n][0] * v[bj][n][0] + v[bj][n][1] * v[bj][n][1]) + (v[bj][n][2] * v[bj][n][2] + v[bj][n][3] * v[bj][n][3]);
                    ss += __shfl_xor(ss, 16); ss += __shfl_xor(ss, 32);
                    const float rn = rsqrtf(ss * (1.0f / 64.0f) + RMS_EPS);
#pragma unroll
                    for (int n = 0; n < 2; ++n) {
                        const unsigned c0_ = n ? csw[m].z : csw[m].x, c1_ = n ? csw[m].w : csw[m].y, s0_ = n ? snw[m].z : snw[m].x, s1_ = n ? snw[m].w : snw[m].y;
                        const f32x4 cs = {bf_lo(c0_), bf_hi(c0_), bf_lo(c1_), bf_hi(c1_)}, sn = {bf_lo(s0_), bf_hi(s0_), bf_lo(s1_), bf_hi(s1_)};
                        const f32x4 lo = v[0][n] * rn * gv[0][n], hi = v[1][n] * rn * gv[1][n];
                        v[0][n] = (lo * cs - hi * sn) * scale; v[1][n] = (hi * cs + lo * sn) * scale; }
                } else if (mode == 2) {
#pragma unroll
                    for (int bj = 0; bj < 2; ++bj)
#pragma unroll
                        for (int n = 0; n < 2; ++n)
#pragma unroll
                            for (int j = 0; j < 4; ++j) v[bj][n][j] = fast_sigmoid(v[bj][n][j]);
                }
                bf16_t* rowp = dst + (size_t)row * ld + 8 * fq;
#pragma unroll
                for (int bj = 0; bj < 2; ++bj) { u32x4 w; w.x = cvt_pk_bf16(v[bj][0][0], v[bj][0][1]); w.y = cvt_pk_bf16(v[bj][0][2], v[bj][0][3]); w.z = cvt_pk_bf16(v[bj][1][0], v[bj][1][1]); w.w = cvt_pk_bf16(v[bj][1][2], v[bj][1][3]);
                    *(u32x4*)(rowp + bj * bjoff) = w; } } }
    }
};

struct EpiBranch {
    static constexpr bool PERM = true, AFTER_DRAIN = false, PREFETCH = false, CHAIN = true;
    const bf16_t* GA; const bf16_t* GB; bf16_t* MG;
    __device__ __forceinline__ void operator()(f32x4 (&acc)[2][2][4][2], const Unit& u, int wr, int wc, int fr, int fq) const {
        const bool second = u.ko != 0; constexpr float TINY = 8.67361738e-19f;
        const unsigned rowoff = (unsigned)((u.pm * BM + wr * 64 + fr) * 1024 + u.pn * BM + wc * 32 + 8 * fq);
#define EB_OFF(ai, bj, m) (rowoff + (unsigned)(((ai) * HALF + (m) * 16) * 1024 + (bj) * HALF))
#define EB_UNPACK(dst, src_) const float dst[8] = {bf_lo((src_).x), bf_hi((src_).x), bf_lo((src_).y), bf_hi((src_).y), bf_lo((src_).z), bf_hi((src_).z), bf_lo((src_).w), bf_hi((src_).w)}
        if (!second) {
#pragma unroll
            for (int ai = 0; ai < 2; ++ai)
#pragma unroll
                for (int bj = 0; bj < 2; ++bj) {
                    u32x4 gbv[4], gav[4];
#pragma unroll
                    for (int m = 0; m < 4; ++m) { gbv[m] = *(const u32x4*)(GB + EB_OFF(ai, bj, m)); gav[m] = *(const u32x4*)(GA + EB_OFF(ai, bj, m)); }
#pragma unroll
                    for (int m = 0; m < 4; ++m) { EB_UNPACK(gb, gbv[m]); EB_UNPACK(ga, gav[m]);
#pragma unroll
                        for (int e = 0; e < 4; ++e) { acc[ai][bj][m][0][e] *= ga[e] * __builtin_amdgcn_rcpf(fmaxf(gb[e], TINY)); acc[ai][bj][m][1][e] *= ga[4 + e] * __builtin_amdgcn_rcpf(fmaxf(gb[4 + e], TINY)); } }
                }
        } else {
#pragma unroll
            for (int ai = 0; ai < 2; ++ai) {
                u32x4 gbv[2][4];
#pragma unroll
                for (int bj = 0; bj < 2; ++bj)
#pragma unroll
                    for (int m = 0; m < 4; ++m) gbv[bj][m] = *(const u32x4*)(GB + EB_OFF(ai, bj, m));
#pragma unroll
                for (int bj = 0; bj < 2; ++bj)
#pragma unroll
                    for (int m = 0; m < 4; ++m) { EB_UNPACK(g0, gbv[bj][m]); float gb[8];
#pragma unroll
                        for (int e = 0; e < 8; ++e) gb[e] = fmaxf(g0[e], TINY);
                        const f32x4 y0 = acc[ai][bj][m][0], y1 = acc[ai][bj][m][1];
                        u32x4 w; w.x = cvt_pk_bf16(gb[0] * y0[0], gb[1] * y0[1]); w.y = cvt_pk_bf16(gb[2] * y0[2], gb[3] * y0[3]); w.z = cvt_pk_bf16(gb[4] * y1[0], gb[5] * y1[1]); w.w = cvt_pk_bf16(gb[6] * y1[2], gb[7] * y1[3]);
                        *(u32x4*)(MG + EB_OFF(ai, bj, m)) = w; }
            }
        }
#undef EB_OFF
#undef EB_UNPACK
    }
};

template <bool WRITE_A, int COEF2, bool RIN_BF16, bool ROUT_BF16> struct EpiResid {
    static constexpr bool PERM = true, AFTER_DRAIN = true, PREFETCH = false, CHAIN = false;
    static constexpr float coef = 0.5f * COEF2; static constexpr int modld = 9216;
    const void* xin; void* xout; const float* gate;
    bf16_t* Aout; const float* gnorm; const float* sc; float* rss_out;
    __device__ __forceinline__ void fused(f32x4 (&acc)[2][2][4][2], const Unit& u, int wr, int wc, int fr, int fq, PG8_LAS unsigned char* lds, int wid, int lane) const {
        const int b = u.pm >> 5, col0 = u.pn * BM + wc * 32 + 8 * fq;
        float ss[2][4];
#pragma unroll
        for (int ai = 0; ai < 2; ++ai)
#pragma unroll
            for (int m = 0; m < 4; ++m) ss[ai][m] = 0.f;
#pragma unroll
        for (int bj = 0; bj < 2; ++bj) {
            f32x4 gt[2], gvv[2];
#pragma unroll
            for (int n = 0; n < 2; ++n) { const int c = col0 + bj * HALF + 4 * n; gt[n] = *(const f32x4*)(gate + (size_t)b * modld + c) * coef;
                if (WRITE_A) gvv[n] = *(const f32x4*)(gnorm + c) * (*(const f32x4*)(sc + (size_t)b * modld + c) + 1.0f); }
#pragma unroll
            for (int ai = 0; ai < 2; ++ai) {
                f32x4 xi[4][2];
#pragma unroll
                for (int m = 0; m < 4; ++m) { const size_t off = (size_t)(u.pm * BM + ai * HALF + wr * 64 + m * 16 + fr) * 1024 + col0 + bj * HALF;
                    if constexpr (RIN_BF16) { const u32x4 w = *(const u32x4*)((const bf16_t*)xin + off); xi[m][0] = (f32x4){bf_lo(w.x), bf_hi(w.x), bf_lo(w.y), bf_hi(w.y)}; xi[m][1] = (f32x4){bf_lo(w.z), bf_hi(w.z), bf_lo(w.w), bf_hi(w.w)}; }
                    else {
#pragma unroll
                        for (int n = 0; n < 2; ++n) xi[m][n] = *(const f32x4*)((const float*)xin + off + 4 * n); } }
#pragma unroll
                for (int m = 0; m < 4; ++m) {
                    const int row = u.pm * BM + ai * HALF + wr * 64 + m * 16 + fr; const size_t off = (size_t)row * 1024 + col0 + bj * HALF; float s = 0.f;
                    f32x4 xo[2];
#pragma unroll
                    for (int n = 0; n < 2; ++n) { xo[n] = xi[m][n] + gt[n] * acc[ai][bj][m][n];
                        if constexpr (!ROUT_BF16) *(f32x4*)((float*)xout + off + 4 * n) = xo[n];
                        if (WRITE_A) s += (xo[n][0] * xo[n][0] + xo[n][1] * xo[n][1]) + (xo[n][2] * xo[n][2] + xo[n][3] * xo[n][3]); }
                    if constexpr (ROUT_BF16) { u32x4 w; w.x = cvt_pk_bf16(xo[0][0], xo[0][1]); w.y = cvt_pk_bf16(xo[0][2], xo[0][3]); w.z = cvt_pk_bf16(xo[1][0], xo[1][1]); w.w = cvt_pk_bf16(xo[1][2], xo[1][3]); *(u32x4*)((bf16_t*)xout + off) = w; }
                    if (WRITE_A) { const f32x4 a0 = xo[0] * gvv[0], a1 = xo[1] * gvv[1]; u32x4 w; w.x = cvt_pk_bf16(a0[0], a0[1]); w.y = cvt_pk_bf16(a0[2], a0[3]); w.z = cvt_pk_bf16(a1[0], a1[1]); w.w = cvt_pk_bf16(a1[2], a1[3]);
                        *(u32x4*)(Aout + off) = w; ss[ai][m] += s; } }
                asm volatile("" ::: "memory"); }
        }
        if (WRITE_A) {
            PG8_LAS float* P = (PG8_LAS float*)lds;
#pragma unroll
            for (int ai = 0; ai < 2; ++ai)
#pragma unroll
                for (int m = 0; m < 4; ++m) { float s = ss[ai][m]; s += __shfl_xor(s, 16); s += __shfl_xor(s, 32); if (fq == 0) P[(ai * HALF + wr * 64 + m * 16 + fr) * 4 + wc] = s; }
            asm volatile("s_waitcnt lgkmcnt(0)" ::: "memory"); __builtin_amdgcn_s_barrier(); asm volatile("" ::: "memory");
            const int t = wid * 64 + lane;
            if (t < 256) { const PG8_LAS float* p = P + t * 4; rss_out[(size_t)(u.pm * BM + t) * 4 + u.pn] = (p[0] + p[1]) + (p[2] + p[3]); }
        }
    }
};

template <class Epi, class Sched, bool ALIGN_EPI = false, bool SP2 = false>
__device__ __forceinline__ void gemm_phase(PG8_LAS unsigned char* lds, const Gemm g, const Sched S, const Epi E, const int wid  ) {
    const int lane = MK_LANE(), tid = wid * 64 + lane, wr = wid >> 2, wc = wid & 3, fr = lane & 15, fq = lane >> 4;
    const int K = g.K, nt = (g.KL ? g.KL : K) / BK;
    unsigned voffA[2], voffB[2];
#pragma unroll
    for (int i = 0; i < 2; ++i) { int R, C; stage_rc(tid * 16 + i * 8192, R, C); const int Rb = Epi::PERM ? ((R & ~31) + perm32(R & 31)) : R;
        voffA[i] = (unsigned)(R * K + C) * 2u; voffB[i] = (unsigned)(Rb * K + C) * 2u; }
    const size_t kstep = (size_t)(BK * 2);
    const size_t hstep = (size_t)HALF * K * 2;
    const size_t tstep = 2 * hstep;
    const unsigned ldsw = (unsigned)wid * 1024u;
    const int aoff = lds_byte(wr * 64 + fr, fq * 8), boff = lds_byte(wc * 32 + fr, fq * 8);
#define PG8_SA(b, h) (((b) * 2 + (h)) * HTB)
#define PG8_SB(b, h) ((4 + (b) * 2 + (h)) * HTB)
#define PG8_STAGE(bufoff, gbase, voff) do { _Pragma("unroll") for (int _i = 0; _i < 2; ++_i) \
        __builtin_amdgcn_global_load_lds((const unsigned*)((const char*)(gbase) + (voff)[_i]), (PG8_LAS unsigned*)(lds + (bufoff) + ldsw + _i * 8192), 16, 0, 0); } while (0)
#define PG8_LDA(dst, b, h) do { _Pragma("unroll") for (int m = 0; m < 4; ++m) _Pragma("unroll") for (int k = 0; k < 2; ++k) dst[m][k] = *(const PG8_LAS bf16x8*)(lds + PG8_SA(b, h) + aoff + m * 2048 + k * 1024); } while (0)
#define PG8_LDB(dst, b, h) do { _Pragma("unroll") for (int n = 0; n < 2; ++n) _Pragma("unroll") for (int k = 0; k < 2; ++k) dst[n][k] = *(const PG8_LAS bf16x8*)(lds + PG8_SB(b, h) + boff + n * 2048 + k * 1024); } while (0)
#define PG8_MMA(ai, bj, At, Bt) do { __builtin_amdgcn_s_setprio(1); _Pragma("unroll") for (int m = 0; m < 4; ++m) _Pragma("unroll") for (int n = 0; n < 2; ++n) _Pragma("unroll") for (int k = 0; k < 2; ++k) \
        acc[ai][bj][m][n] = __builtin_amdgcn_mfma_f32_16x16x32_bf16(Bt[n][k], At[m][k], acc[ai][bj][m][n], 0, 0, 0); __builtin_amdgcn_s_setprio(0); } while (0)
#define PG8_WAIT_V(n) asm volatile("s_waitcnt vmcnt(" #n ")" ::: "memory")
#define PG8_WAIT_L(n) asm volatile("s_waitcnt lgkmcnt(" #n ")" ::: "memory")
#define PG8_BAR __builtin_amdgcn_s_barrier()
#define PG8_SCHED __builtin_amdgcn_sched_barrier(0)
    Unit cur, nxt; int ui = 0;
    if (!S.next(0, cur)) return;
    f32x4 acc[2][2][4][2];
#pragma unroll
    for (int a = 0; a < 2; ++a)
#pragma unroll
        for (int b = 0; b < 2; ++b)
#pragma unroll
            for (int m = 0; m < 4; ++m)
#pragma unroll
                for (int n = 0; n < 2; ++n) acc[a][b][m][n] = (f32x4){0.f, 0.f, 0.f, 0.f};
    bf16x8 At[4][2], B0[2][2], B1[2][2];
    const char* cA = (const char*)g.A + (size_t)cur.pm * tstep + cur.ko; const char* cB = (const char*)g.Bt + (size_t)cur.pn * tstep + cur.ko;
    S.a_ready(cur);
    if constexpr (SP2) {
        PG8_STAGE(PG8_SB(0, 0), cB, voffB); PG8_STAGE(PG8_SB(0, 1), cB + hstep, voffB); PG8_STAGE(PG8_SA(0, 0), cA, voffA); PG8_STAGE(PG8_SA(0, 1), cA + hstep, voffA);
        if (wr == 1) PG8_BAR;
        PG8_WAIT_V(2); PG8_BAR;
        PG8_STAGE(PG8_SB(1, 0), cB + kstep, voffB); PG8_STAGE(PG8_SA(1, 0), cA + kstep, voffA); PG8_STAGE(PG8_SB(1, 1), cB + hstep + kstep, voffB);
        PG8_WAIT_V(6); PG8_BAR;
    } else {
        PG8_STAGE(PG8_SB(0, 0), cB, voffB); PG8_STAGE(PG8_SA(0, 0), cA, voffA); PG8_STAGE(PG8_SB(0, 1), cB + hstep, voffB); PG8_STAGE(PG8_SA(0, 1), cA + hstep, voffA);
        if (wr == 1) PG8_BAR;
        PG8_WAIT_V(4); PG8_BAR;
        PG8_STAGE(PG8_SB(1, 0), cB + kstep, voffB); PG8_STAGE(PG8_SA(1, 0), cA + kstep, voffA); PG8_STAGE(PG8_SB(1, 1), cB + hstep + kstep, voffB);
        PG8_WAIT_V(6); PG8_BAR;
    }
    for (;;) {
        if constexpr (Epi::PREFETCH) E.prefetch(cur, lds + STAGE_BYTES + (ui & 1) * 5120, wid, lane);
        const bool has_next = S.next(ui + 1, nxt);
        const char* nA = has_next ? (const char*)g.A + (size_t)nxt.pm * tstep + nxt.ko : cA; const char* nB = has_next ? (const char*)g.Bt + (size_t)nxt.pn * tstep + nxt.ko : cB;
        for (int t = 0; t < nt; t += 2) {
            const bool last = (t == nt - 2);
            const char* a1 = cA + (size_t)(t + 1) * kstep;
            const char* a2 = last ? nA : cA + (size_t)(t + 2) * kstep; const char* b2 = last ? nB : cB + (size_t)(t + 2) * kstep;
            const char* a3 = a2 + kstep; const char* b3 = b2 + kstep;
            if (last && has_next) S.a_ready(nxt);
            if constexpr (SP2) {
            PG8_LDB(B0, 0, 0); PG8_LDB(B1, 0, 1); PG8_SCHED; PG8_LDA(At, 0, 0); PG8_STAGE(PG8_SA(1, 1), a1 + hstep, voffA);
            PG8_WAIT_V(8); PG8_WAIT_L(0); PG8_BAR; PG8_MMA(0, 0, At, B0); PG8_MMA(0, 1, At, B1); PG8_BAR; PG8_SCHED;
            PG8_LDA(At, 0, 1); PG8_STAGE(PG8_SB(0, 0), b2, voffB); PG8_STAGE(PG8_SB(0, 1), b2 + hstep, voffB); PG8_STAGE(PG8_SA(0, 0), a2, voffA);
            PG8_WAIT_V(8); PG8_WAIT_L(0); PG8_BAR; PG8_MMA(1, 0, At, B0); PG8_MMA(1, 1, At, B1); PG8_BAR; PG8_SCHED;
            PG8_LDB(B0, 1, 0); PG8_LDB(B1, 1, 1); PG8_SCHED; PG8_LDA(At, 1, 0); PG8_STAGE(PG8_SA(0, 1), a2 + hstep, voffA);
            PG8_WAIT_V(8); PG8_WAIT_L(0); PG8_BAR; PG8_MMA(0, 0, At, B0); PG8_MMA(0, 1, At, B1); PG8_BAR; PG8_SCHED;
            PG8_LDA(At, 1, 1); PG8_STAGE(PG8_SB(1, 0), b3, voffB); PG8_STAGE(PG8_SB(1, 1), b3 + hstep, voffB); PG8_STAGE(PG8_SA(1, 0), a3, voffA);
            PG8_WAIT_V(8); PG8_WAIT_L(0); PG8_BAR; PG8_MMA(1, 0, At, B0); PG8_MMA(1, 1, At, B1); PG8_BAR; PG8_SCHED;
            } else {
            PG8_LDB(B0, 0, 0); PG8_SCHED; PG8_LDA(At, 0, 0); PG8_STAGE(PG8_SA(1, 1), a1 + hstep, voffA);
            PG8_WAIT_L(8); PG8_BAR; PG8_WAIT_L(0); PG8_MMA(0, 0, At, B0); PG8_BAR; PG8_SCHED;
            PG8_LDB(B1, 0, 1); PG8_STAGE(PG8_SB(0, 0), b2, voffB);
            PG8_BAR; PG8_WAIT_L(0); PG8_MMA(0, 1, At, B1); PG8_BAR;
            PG8_LDA(At, 0, 1); PG8_STAGE(PG8_SA(0, 0), a2, voffA);
            PG8_BAR; PG8_WAIT_L(0); PG8_MMA(1, 0, At, B0); PG8_BAR; PG8_SCHED;
            PG8_STAGE(PG8_SB(0, 1), b2 + hstep, voffB);
            PG8_WAIT_V(6); PG8_BAR; PG8_MMA(1, 1, At, B1); PG8_BAR;
            PG8_LDB(B0, 1, 0); PG8_SCHED; PG8_LDA(At, 1, 0); PG8_STAGE(PG8_SA(0, 1), a2 + hstep, voffA);
            PG8_WAIT_L(8); PG8_BAR; PG8_WAIT_L(0); PG8_MMA(0, 0, At, B0); PG8_BAR; PG8_SCHED;
            PG8_LDB(B1, 1, 1); PG8_STAGE(PG8_SB(1, 0), b3, voffB);
            PG8_BAR; PG8_WAIT_L(0); PG8_MMA(0, 1, At, B1); PG8_BAR;
            PG8_LDA(At, 1, 1); PG8_STAGE(PG8_SA(1, 0), a3, voffA);
            PG8_BAR; PG8_WAIT_L(0); PG8_MMA(1, 0, At, B0); PG8_BAR; PG8_SCHED;
            PG8_STAGE(PG8_SB(1, 1), b3 + hstep, voffB);
            PG8_WAIT_V(6); PG8_BAR; PG8_MMA(1, 1, At, B1); PG8_BAR;
            }
        }
        if constexpr (ALIGN_EPI) { if (wr == 0) PG8_BAR; }
        if constexpr (!Epi::AFTER_DRAIN) { if constexpr (Epi::PREFETCH) E(acc, cur, wr, wc, fr, fq, lds + STAGE_BYTES + (ui & 1) * 5120); else E(acc, cur, wr, wc, fr, fq); S.done(cur); }
        if (!has_next) break;
        if (!Epi::CHAIN || nxt.ko == 0) {
#pragma unroll
        for (int a = 0; a < 2; ++a)
#pragma unroll
            for (int b = 0; b < 2; ++b)
#pragma unroll
                for (int m = 0; m < 4; ++m)
#pragma unroll
                    for (int n = 0; n < 2; ++n) acc[a][b][m][n] = (f32x4){0.f, 0.f, 0.f, 0.f};
        }
        cur = nxt; cA = nA; cB = nB; ++ui;
        if constexpr (ALIGN_EPI) { if (wr == 1) PG8_BAR; }
    }
    PG8_WAIT_V(0);
    if constexpr (!ALIGN_EPI) { if (wr == 0) PG8_BAR; }
    PG8_BAR;
    if constexpr (Epi::AFTER_DRAIN) { E.fused(acc, cur, wr, wc, fr, fq, lds, wid, lane); S.done(cur); }
#undef PG8_SA
#undef PG8_SB
#undef PG8_STAGE
#undef PG8_LDA
#undef PG8_LDB
#undef PG8_MMA
#undef PG8_WAIT_V
#undef PG8_WAIT_L
#undef PG8_BAR
#undef PG8_SCHED
}
}

#ifndef PG8_SP2
#define PG8_SP2 true
#endif
#ifndef PG8_ALIGN
#define PG8_ALIGN true
#endif
namespace att {
using bf16x8 = __attribute__((ext_vector_type(8))) short;
using s16x4  = __attribute__((ext_vector_type(4))) short;
using f32x16 = __attribute__((ext_vector_type(16))) float;
using u32x4  = __attribute__((ext_vector_type(4))) unsigned;
typedef unsigned short bf16_t;
constexpr int NW = 8, QBLK = 32, KVBLK = 64;
#define ATT_SBAR() __builtin_amdgcn_sched_barrier(0)
__device__ __forceinline__ int crow(int r, int hi) { return (r & 3) + 8 * (r >> 2) + 4 * hi; }
__device__ __forceinline__ unsigned cvtpk(float lo, float hi) { unsigned r; asm volatile("v_cvt_pk_bf16_f32 %0, %1, %2" : "=v"(r) : "v"(lo), "v"(hi)); return r; }
__device__ __forceinline__ float bf2f(bf16_t h) { return __uint_as_float((unsigned)h << 16); }
__device__ __forceinline__ int v_rd_base(int lane) { return ((lane & 3) << 3) | (((lane >> 2) & 3) << 6) | (((lane >> 4) & 1) << 5) | (((lane >> 5) & 1) << 8); }
template <bool WIN> __device__ __forceinline__ void wmask(f32x16& p0, f32x16& p1, int qpos, int kbase, int hi) {
  if constexpr (WIN) {
#pragma unroll
    for (int r = 0; r < 16; ++r) { const int k0 = kbase + crow(r, hi) - qpos; if (k0 > 128 || k0 < -128) p0[r] = -INFINITY; if (k0 + 32 > 128 || k0 + 32 < -128) p1[r] = -INFINITY; }
  }
}
__device__ __forceinline__ void exp_half(f32x16& p) {
#pragma unroll
  for (int r = 0; r < 16; ++r) p[r] = __builtin_amdgcn_exp2f(p[r]);
}
constexpr int NSLOT = 3, LDS_V = 0, LDS_K = NSLOT * KVBLK * 128 * 2, LDS_WS = LDS_K + 4 * KVBLK * 64 * 2, LDS_STG = LDS_WS + NW * 64 * 4, ATT_LDS_BYTES = LDS_STG + NW * 8192;
__device__ __forceinline__ void dma16(unsigned m0v, unsigned voff, __amdgpu_buffer_rsrc_t rs, unsigned soff) {
  unsigned keep;
  asm volatile("s_nop 4\n\ts_mov_b32 %0, m0\n\ts_mov_b32 m0, %1\n\ts_nop 0\n\tbuffer_load_dwordx4 %2, %3, %4 offen lds\n\ts_mov_b32 m0, %0" : "=&s"(keep) : "s"(m0v), "v"(voff), "s"(rs), "s"(soff) : "memory");
}
__device__ __forceinline__ void dma16x2(unsigned m0a, unsigned va, unsigned sa, unsigned m0b, unsigned vb, unsigned sb, __amdgpu_buffer_rsrc_t rs) {
  unsigned keep;
  asm volatile("s_nop 4\n\ts_mov_b32 %0, m0\n\ts_mov_b32 m0, %1\n\ts_nop 0\n\tbuffer_load_dwordx4 %2, %7, %3 offen lds\n\ts_mov_b32 m0, %4\n\ts_nop 0\n\tbuffer_load_dwordx4 %5, %7, %6 offen lds\n\ts_mov_b32 m0, %0"
               : "=&s"(keep) : "s"(m0a), "v"(va), "s"(sa), "s"(m0b), "v"(vb), "s"(sb), "s"(rs) : "memory");
}
__device__ __forceinline__ void dma16x3(unsigned m0a, unsigned va, unsigned sa, unsigned m0b, unsigned vb, unsigned m0c, unsigned vc, unsigned sbc, __amdgpu_buffer_rsrc_t rs) {
  unsigned keep;
  asm volatile("s_nop 4\n\ts_mov_b32 %0, m0\n\ts_mov_b32 m0, %1\n\ts_nop 0\n\tbuffer_load_dwordx4 %2, %9, %3 offen lds\n\ts_mov_b32 m0, %4\n\ts_nop 0\n\tbuffer_load_dwordx4 %5, %9, %8 offen lds\n\ts_mov_b32 m0, %6\n\ts_nop 0\n\tbuffer_load_dwordx4 %7, %9, %8 offen lds\n\ts_mov_b32 m0, %0"
               : "=&s"(keep) : "s"(m0a), "v"(va), "s"(sa), "s"(m0b), "v"(vb), "s"(m0c), "v"(vc), "s"(sbc), "s"(rs) : "memory");
}
typedef __attribute__((address_space(3))) const char* lds_cptr;
typedef short v4i16_t __attribute__((ext_vector_type(4)));
__device__ __forceinline__ s16x4 vtr(lds_cptr p) { return __builtin_bit_cast(s16x4, __builtin_amdgcn_ds_read_tr16_b64_v4i16((__attribute__((address_space(3))) v4i16_t*)p)); }
__device__ __forceinline__ bf16x8 kld(lds_cptr p) { return *(const __attribute__((address_space(3))) bf16x8*)p; }
__device__ __forceinline__ void attn_pass_d4(__amdgpu_buffer_rsrc_t rs, unsigned Qb, unsigned ldq, unsigned Kh, unsigned ldk, unsigned Vh, unsigned ldv, int seq, float negm_s, char* lds, f32x16 (&o)[4], float& l_out, const int wid) {
  constexpr int SLOTV = KVBLK * 128 * 2, SLOTK = KVBLK * 64 * 2;
  const int lane = MK_LANE(), r32 = lane & 31, hi = lane >> 5;
  const unsigned lds0 = (unsigned)(uintptr_t)lds;
  bf16x8 qr[4];
  { const unsigned qoff = (unsigned)(wid * QBLK + r32) * ldq + hi * 16;
#pragma unroll
    for (int d0 = 0; d0 < 4; ++d0) { const u32x4 w = __builtin_amdgcn_raw_buffer_load_b128(rs, qoff + d0 * 32, Qb, 0); qr[d0] = __builtin_bit_cast(bf16x8, w); } }
  f32x16 negm; { float ns = negm_s; asm volatile("" : "+v"(ns));
#pragma unroll
  for (int r = 0; r < 16; ++r) negm[r] = ns; }
  asm volatile("" : "+v"(negm));
#pragma unroll
  for (int d = 0; d < 4; ++d) o[d] = f32x16{};
  float l_reg = 0.f;
  const unsigned kvoff = (unsigned)lane * ldk + wid * 16;
  unsigned vvoff0, vvoff1;
  { const int ob = (wid * 2 + 0) * 1024 + lane * 16, st = ob >> 9, k = (st / 4) * 8 + ((ob >> 6) & 7), c = (st % 4) * 32 + ((ob >> 4) & 3) * 8; vvoff0 = (unsigned)k * ldv + c * 2; }
  { const int ob = (wid * 2 + 1) * 1024 + lane * 16, st = ob >> 9, k = (st / 4) * 8 + ((ob >> 6) & 7), c = (st % 4) * 32 + ((ob >> 4) & 3) * 8; vvoff1 = (unsigned)k * ldv + c * 2; }
  const unsigned kdst = lds0 + LDS_K + wid * 1024, vdst = lds0 + LDS_V + wid * 2048;
  const lds_cptr kp0 = (lds_cptr)lds + LDS_K + hi * 1024 + r32 * 16;
  const lds_cptr vp0 = (lds_cptr)lds + LDS_V + v_rd_base(lane);
  const int NT = seq / KVBLK;
#define D4_PIN(x) asm volatile("" : "+v"(x))
#define D4_MFMA(a, b, c) __builtin_amdgcn_mfma_f32_32x32x16_bf16(a, b, c, 0, 0, 0)
#define D4_WAIT_BAR(N) asm volatile("s_waitcnt vmcnt(" #N ") lgkmcnt(0)\n\ts_barrier" ::: "memory")
#define D4_KSLOT(t) ((unsigned)((t) & 3) * SLOTK)
#define D4_DMA_K(t) dma16(kdst + D4_KSLOT(t), kvoff, rs, Kh + (unsigned)(t) * (KVBLK * ldk))
#define D4_DMA_V(t, sl) dma16x2(vdst + (sl), vvoff0, Vh + (unsigned)(t) * (KVBLK * ldv), vdst + (sl) + 1024, vvoff1, Vh + (unsigned)(t) * (KVBLK * ldv), rs)
#define D4_DMA_KV(tk, tv, sl) dma16x3(kdst + D4_KSLOT(tk), kvoff, Kh + (unsigned)(tk) * (KVBLK * ldk), vdst + (sl), vvoff0, vdst + (sl) + 1024, vvoff1, Vh + (unsigned)(tv) * (KVBLK * ldv), rs)
  f32x16 pA0, pA1, pB0, pB1; bf16x8 kf[4]; s16x4 vl[5], vh[5]; u32x4 pw0, pw1, pw2, pw3;
#define D4_KRD(buf, kp, j) kf[buf] = kld((kp) + ((j) >> 1) * 2048 + ((j) & 1) * 512)
#define D4_VO(f, half) (((f) & 3) * 512 + (2 * ((f) >> 2) + (half)) * 2048)
#define D4_VRD(f) do { vl[(f) % 5] = vtr(vp_ + D4_VO(f, 0)); vh[(f) % 5] = vtr(vp_ + D4_VO(f, 1)); } while (0)
#define D4_VFR(f) (bf16x8){vl[(f) % 5][0], vl[(f) % 5][1], vl[(f) % 5][2], vl[(f) % 5][3], vh[(f) % 5][0], vh[(f) % 5][1], vh[(f) % 5][2], vh[(f) % 5][3]}
#define D4_PKW(P, i) cvtpk(P[i], P[i + 1])
#define D4_PAF(k) __builtin_bit_cast(bf16x8, pw##k)
  D4_DMA_K(0); D4_DMA_V(0, 0); D4_DMA_K(1); D4_DMA_K(2); D4_DMA_KV(3, 1, SLOTV);
  D4_WAIT_BAR(3);
  { const lds_cptr kp_ = kp0;
    D4_KRD(0, kp_, 0); D4_KRD(1, kp_, 1); D4_KRD(2, kp_, 2); D4_KRD(3, kp_, 3);
    pA0 = D4_MFMA(kf[0], qr[0], negm); pA1 = D4_MFMA(kf[1], qr[0], negm); pA0 = D4_MFMA(kf[2], qr[1], pA0); pA1 = D4_MFMA(kf[3], qr[1], pA1);
    D4_KRD(0, kp_, 4); D4_KRD(1, kp_, 5); D4_KRD(2, kp_, 6); D4_KRD(3, kp_, 7);
    pA0 = D4_MFMA(kf[0], qr[2], pA0); pA1 = D4_MFMA(kf[1], qr[2], pA1); pA0 = D4_MFMA(kf[2], qr[3], pA0); pA1 = D4_MFMA(kf[3], qr[3], pA1);
    exp_half(pA0); exp_half(pA1);
    const lds_cptr kn_ = kp0 + SLOTK;
    D4_KRD(0, kn_, 0); D4_KRD(1, kn_, 1); D4_KRD(2, kn_, 2); D4_KRD(3, kn_, 3); }
  D4_WAIT_BAR(3);
  unsigned sl_prev = 0, sl_cur = SLOTV, sl_next = 2 * SLOTV;
#define D4_ROT() do { sl_prev = sl_cur; sl_cur = sl_next; sl_next = (sl_next == 2u * SLOTV) ? 0u : sl_next + SLOTV; } while (0)
#define D4_EX2(X, i) do { X[i] = __builtin_amdgcn_exp2f(X[i]); X[(i) + 1] = __builtin_amdgcn_exp2f(X[(i) + 1]); } while (0)
#define D4_GAPA(MF, LD, a0, a1, a2, a3, W0, W1, PW) do { MF; LD; sacc += a0; sacc += a1; sacc += a2; sacc += a3; W0; W1; D4_PIN(PW); D4_PIN(sacc); ATT_SBAR(); } while (0)
#define D4_GAPB(i, X, xi, LD) do { o[(i) & 3] = D4_MFMA(D4_PAFI(i), D4_VFR(i), o[(i) & 3]); LD; D4_EX2(X, xi); D4_PIN(X); ATT_SBAR(); } while (0)
#define D4_PAFI(i) (((i) >> 2) == 0 ? D4_PAF(0) : ((i) >> 2) == 1 ? D4_PAF(1) : ((i) >> 2) == 2 ? D4_PAF(2) : D4_PAF(3))
#define D4_PHA(C0, C1, P0, P1, t, VR) do { ATT_SBAR(); \
    const lds_cptr vp_ = vp0 + sl_prev; const lds_cptr kp_ = kp0 + D4_KSLOT(t); \
    float sacc = P0[0] + P0[1]; ATT_SBAR(); \
    D4_GAPA(C0 = D4_MFMA(kf[0], qr[0], negm), D4_KRD(0, kp_, 4), P0[2], P0[3], P0[4], P0[5],     pw0[0] = D4_PKW(P0, 0),  pw0[1] = D4_PKW(P0, 2),  pw0); \
    D4_GAPA(C1 = D4_MFMA(kf[1], qr[0], negm), D4_KRD(1, kp_, 5), P0[6], P0[7], P0[8], P0[9],     pw0[2] = D4_PKW(P0, 4),  pw0[3] = D4_PKW(P0, 6),  pw0); \
    D4_GAPA(C0 = D4_MFMA(kf[2], qr[1], C0),   D4_KRD(2, kp_, 6), P0[10], P0[11], P0[12], P0[13], pw1[0] = D4_PKW(P0, 8),  pw1[1] = D4_PKW(P0, 10), pw1); \
    D4_GAPA(C1 = D4_MFMA(kf[3], qr[1], C1),   D4_KRD(3, kp_, 7), P0[14], P0[15], P1[0], P1[1],   pw1[2] = D4_PKW(P0, 12), pw1[3] = D4_PKW(P0, 14), pw1); \
    D4_GAPA(C0 = D4_MFMA(kf[0], qr[2], C0),   do { if (VR) D4_VRD(0); } while (0), P1[2], P1[3], P1[4], P1[5],     pw2[0] = D4_PKW(P1, 0),  pw2[1] = D4_PKW(P1, 2),  pw2); \
    D4_GAPA(C1 = D4_MFMA(kf[1], qr[2], C1),   do { if (VR) D4_VRD(1); } while (0), P1[6], P1[7], P1[8], P1[9],     pw2[2] = D4_PKW(P1, 4),  pw2[3] = D4_PKW(P1, 6),  pw2); \
    D4_GAPA(C0 = D4_MFMA(kf[2], qr[3], C0),   do { if (VR) D4_VRD(2); } while (0), P1[10], P1[11], P1[12], P1[13], pw3[0] = D4_PKW(P1, 8),  pw3[1] = D4_PKW(P1, 10), pw3); \
    D4_GAPA(C1 = D4_MFMA(kf[3], qr[3], C1),   do { if (VR) { D4_VRD(3); D4_VRD(4); } } while (0), P1[14], P1[15], 0.f, 0.f, pw3[2] = D4_PKW(P1, 12), pw3[3] = D4_PKW(P1, 14), pw3); \
    l_reg += sacc; } while (0)
#define D4_PHB(C0, C1, t, GK, GV, GL, PRE) do { ATT_SBAR(); \
    const lds_cptr vp_ = vp0 + sl_prev; const lds_cptr kn_ = kp0 + D4_KSLOT((t) + 1); \
    if (PRE) { D4_VRD(0); D4_VRD(1); D4_VRD(2); D4_VRD(3); D4_VRD(4); ATT_SBAR(); } \
    D4_GAPB(0, C0, 0, D4_VRD(5));   D4_GAPB(1, C0, 2, D4_VRD(6));   D4_GAPB(2, C0, 4, D4_VRD(7));    D4_GAPB(3, C0, 6, D4_VRD(8)); \
    D4_GAPB(4, C0, 8, D4_VRD(9));   D4_GAPB(5, C0, 10, D4_VRD(10)); D4_GAPB(6, C0, 12, D4_VRD(11));  D4_GAPB(7, C0, 14, do { D4_VRD(12); if (GL) D4_KRD(0, kn_, 0); } while (0)); \
    D4_GAPB(8, C1, 0, do { D4_VRD(13); if ((GK) && (GV)) D4_DMA_KV((t) + 3, (t) + 1, sl_next); else if (GV) D4_DMA_V((t) + 1, sl_next); } while (0)); \
    D4_GAPB(9, C1, 2, do { D4_VRD(14); if (GL) D4_KRD(1, kn_, 1); } while (0));  D4_GAPB(10, C1, 4, do { D4_VRD(15); if (GL) D4_KRD(2, kn_, 2); } while (0));  D4_GAPB(11, C1, 6, do { if (GL) D4_KRD(3, kn_, 3); } while (0)); \
    D4_GAPB(12, C1, 8, (void)0); D4_GAPB(13, C1, 10, (void)0); D4_GAPB(14, C1, 12, (void)0); D4_GAPB(15, C1, 14, (void)0); \
    } while (0)
  if (wid < 4) {
    int t = 1;
    for (; t + 4 < NT; t += 2) {
      D4_PHA(pB0, pB1, pA0, pA1, t, true);     D4_PHB(pB0, pB1, t, true, true, true, false);     D4_WAIT_BAR(3); D4_ROT();
      D4_PHA(pA0, pA1, pB0, pB1, t + 1, true); D4_PHB(pA0, pA1, t + 1, true, true, true, false); D4_WAIT_BAR(3); D4_ROT();
    }
    D4_PHA(pB0, pB1, pA0, pA1, t, true);     D4_PHB(pB0, pB1, t, false, true, true, false);      D4_WAIT_BAR(2); D4_ROT();
    D4_PHA(pA0, pA1, pB0, pB1, t + 1, true); D4_PHB(pA0, pA1, t + 1, false, true, true, false);  D4_WAIT_BAR(0); D4_ROT();
    D4_PHA(pB0, pB1, pA0, pA1, t + 2, true); D4_PHB(pB0, pB1, t + 2, false, false, false, false);
  } else {
    D4_PHA(pB0, pB1, pA0, pA1, 1, false);
    int t = 1;
    for (; t + 4 < NT; t += 2) {
      D4_PHB(pB0, pB1, t, true, true, true, true);     D4_PHA(pA0, pA1, pB0, pB1, t + 1, false); D4_WAIT_BAR(3); D4_ROT();
      D4_PHB(pA0, pA1, t + 1, true, true, true, true); D4_PHA(pB0, pB1, pA0, pA1, t + 2, false); D4_WAIT_BAR(3); D4_ROT();
    }
    D4_PHB(pB0, pB1, t, false, true, true, true);      D4_PHA(pA0, pA1, pB0, pB1, t + 1, false); D4_WAIT_BAR(2); D4_ROT();
    D4_PHB(pA0, pA1, t + 1, false, true, true, true);  D4_PHA(pB0, pB1, pA0, pA1, t + 2, false); D4_WAIT_BAR(0); D4_ROT();
    D4_PHB(pB0, pB1, t + 2, false, false, false, true);
  }
  { float sacc = pB0[0] + pB0[1];
#pragma unroll
    for (int r = 2; r < 16; ++r) sacc += pB0[r];
#pragma unroll
    for (int r = 0; r < 16; ++r) sacc += pB1[r];
    l_reg += sacc;
    pw0 = (u32x4){D4_PKW(pB0, 0), D4_PKW(pB0, 2), D4_PKW(pB0, 4), D4_PKW(pB0, 6)}; pw1 = (u32x4){D4_PKW(pB0, 8), D4_PKW(pB0, 10), D4_PKW(pB0, 12), D4_PKW(pB0, 14)};
    pw2 = (u32x4){D4_PKW(pB1, 0), D4_PKW(pB1, 2), D4_PKW(pB1, 4), D4_PKW(pB1, 6)}; pw3 = (u32x4){D4_PKW(pB1, 8), D4_PKW(pB1, 10), D4_PKW(pB1, 12), D4_PKW(pB1, 14)};
    const lds_cptr vp_ = vp0 + sl_cur;
    D4_VRD(0); D4_VRD(1); D4_VRD(2); D4_VRD(3); D4_VRD(4);
    o[0] = D4_MFMA(D4_PAF(0), D4_VFR(0), o[0]); D4_VRD(5);
    o[1] = D4_MFMA(D4_PAF(0), D4_VFR(1), o[1]); D4_VRD(6);
    o[2] = D4_MFMA(D4_PAF(0), D4_VFR(2), o[2]); D4_VRD(7);
    o[3] = D4_MFMA(D4_PAF(0), D4_VFR(3), o[3]); D4_VRD(8);
    o[0] = D4_MFMA(D4_PAF(1), D4_VFR(4), o[0]); D4_VRD(9);
    o[1] = D4_MFMA(D4_PAF(1), D4_VFR(5), o[1]); D4_VRD(10);
    o[2] = D4_MFMA(D4_PAF(1), D4_VFR(6), o[2]); D4_VRD(11);
    o[3] = D4_MFMA(D4_PAF(1), D4_VFR(7), o[3]); D4_VRD(12);
    o[0] = D4_MFMA(D4_PAF(2), D4_VFR(8), o[0]); D4_VRD(13);
    o[1] = D4_MFMA(D4_PAF(2), D4_VFR(9), o[1]); D4_VRD(14);
    o[2] = D4_MFMA(D4_PAF(2), D4_VFR(10), o[2]); D4_VRD(15);
    o[3] = D4_MFMA(D4_PAF(2), D4_VFR(11), o[3]);
    o[0] = D4_MFMA(D4_PAF(3), D4_VFR(12), o[0]);
    o[1] = D4_MFMA(D4_PAF(3), D4_VFR(13), o[1]);
    o[2] = D4_MFMA(D4_PAF(3), D4_VFR(14), o[2]);
    o[3] = D4_MFMA(D4_PAF(3), D4_VFR(15), o[3]); }
  { auto rr = __builtin_amdgcn_permlane32_swap(__float_as_uint(l_reg), __float_as_uint(l_reg), false, false); l_out = __uint_as_float(rr[0]) + __uint_as_float(rr[1]); }
  D4_WAIT_BAR(0);
#undef D4_PIN
#undef D4_MFMA
#undef D4_WAIT_BAR
#undef D4_KSLOT
#undef D4_DMA_K
#undef D4_DMA_V
#undef D4_DMA_KV
#undef D4_KRD
#undef D4_VO
#undef D4_VRD
#undef D4_VFR
#undef D4_PKW
#undef D4_PAF
#undef D4_PAFI
#undef D4_ROT
#undef D4_EX2
#undef D4_GAPA
#undef D4_GAPB
#undef D4_PHA
#undef D4_PHB
}
__device__ __forceinline__ void row_recips(float l, float extra, float* wsf, int r32, int hi, float (&rli)[16]) {
  if (hi == 0) wsf[r32] = l + extra; asm volatile("s_waitcnt lgkmcnt(0)" ::: "memory");
#pragma unroll
  for (int r = 0; r < 16; ++r) rli[r] = __builtin_amdgcn_rcpf(wsf[crow(r, hi)]);
  asm volatile("s_waitcnt lgkmcnt(0)" ::: "memory");
}

__device__ __forceinline__ void win_unit2(__amdgpu_buffer_rsrc_t rs, const char* wsb, int b, int kvh, int qb, int pair, const bf16_t* QA, const bf16_t* KA, const bf16_t* VA, bf16_t* ACAT, const float* scal, char* lds, const int wid) {
  constexpr int S = 8192, W_K = 65536, W_WS = 131072;
  const int lane = MK_LANE(), r32 = lane & 31, hi = lane >> 5;
  const unsigned lds0 = (unsigned)(uintptr_t)lds;
  const int q0 = qb * 256, kb0 = q0 - 128; const size_t rowbase = (size_t)b * S;
  const unsigned Kb = (unsigned)((const char*)(KA + rowbase * 128 + kvh * 64) - wsb), Vb = (unsigned)((const char*)(VA + rowbase * 128 + kvh * 64) - wsb);
  { const unsigned kvoff = (unsigned)lane * 256u + wid * 16;
    const int ob = wid * 1024 + lane * 16, st = ob >> 9, k = (st / 2) * 8 + ((ob >> 6) & 7), c = (st % 2) * 32 + ((ob >> 4) & 3) * 8; const unsigned vvoff = (unsigned)k * 256u + c * 2;
#pragma unroll
    for (int j = 0; j < 8; ++j) { const int ks = kb0 + 64 * j;
      if (ks >= 0 && ks < S) dma16x2(lds0 + W_K + j * 8192 + wid * 1024, kvoff, Kb + (unsigned)ks * 256u, lds0 + j * 8192 + wid * 1024, vvoff, Vb + (unsigned)ks * 256u, rs); } }
  asm volatile("s_waitcnt vmcnt(0)\n\ts_barrier" ::: "memory");
  const lds_cptr kp0 = (lds_cptr)lds + W_K + hi * 1024 + r32 * 16;
  const lds_cptr vp0 = (lds_cptr)lds + v_rd_base(lane);
  float* wsf = (float*)(lds + W_WS) + wid * 64;
  const int qrow0 = q0 + wid * QBLK, qpos = qrow0 + r32, jlo = wid >> 1;
#pragma unroll 1
  for (int hh = 0; hh < 2; ++hh) {
    const int hq = kvh * 4 + pair * 2 + hh;
    bf16x8 qr[4];
    { const unsigned Qb = (unsigned)((const char*)(QA + (rowbase + q0) * 512 + hq * 64) - wsb), qoff = (unsigned)(wid * QBLK + r32) * 1024u + hi * 16;
#pragma unroll
      for (int d0 = 0; d0 < 4; ++d0) { const u32x4 w = __builtin_amdgcn_raw_buffer_load_b128(rs, qoff + d0 * 32, Qb, 0); qr[d0] = __builtin_bit_cast(bf16x8, w); } }
    f32x16 negm; { float ns = scal[8 + hq]; asm volatile("" : "+v"(ns));
#pragma unroll
    for (int r = 0; r < 16; ++r) negm[r] = ns; }
    f32x16 o0 = f32x16{}, o1 = f32x16{}; float l_reg = 0.f;
#pragma unroll 1
    for (int i = 0; i < 5; ++i) {
      const int j = jlo + i, ks = kb0 + 64 * j;
      if (ks < 0 || ks >= S) continue;
      const lds_cptr kp = kp0 + j * 8192; const lds_cptr vp = vp0 + j * 8192;
      f32x16 p0, p1;
#pragma unroll
      for (int d0 = 0; d0 < 4; ++d0) { const bf16x8 k0 = kld(kp + d0 * 2048), k1 = kld(kp + d0 * 2048 + 512);
        if (d0 == 0) { p0 = __builtin_amdgcn_mfma_f32_32x32x16_bf16(k0, qr[0], negm, 0, 0, 0); p1 = __builtin_amdgcn_mfma_f32_32x32x16_bf16(k1, qr[0], negm, 0, 0, 0); }
        else { p0 = __builtin_amdgcn_mfma_f32_32x32x16_bf16(k0, qr[d0], p0, 0, 0, 0); p1 = __builtin_amdgcn_mfma_f32_32x32x16_bf16(k1, qr[d0], p1, 0, 0, 0); } }
      if (!((ks >= qrow0 + QBLK - 1 - 128) && (ks + 63 <= qrow0 + 128))) wmask<true>(p0, p1, qpos, ks, hi);
      exp_half(p0); exp_half(p1);
      float ps = 0.f;
#pragma unroll
      for (int r = 0; r < 16; ++r) ps += p0[r];
#pragma unroll
      for (int r = 0; r < 16; ++r) ps += p1[r];
      l_reg += ps;
      bf16x8 pa0, pa1, pa2, pa3;
#define W2_PK4(P, BASE, OUT) do { u32x4 w = {cvtpk(P[BASE + 0], P[BASE + 1]), cvtpk(P[BASE + 2], P[BASE + 3]), cvtpk(P[BASE + 4], P[BASE + 5]), cvtpk(P[BASE + 6], P[BASE + 7])}; OUT = *reinterpret_cast<bf16x8*>(&w); } while (0)
      W2_PK4(p0, 0, pa0); W2_PK4(p0, 8, pa1); W2_PK4(p1, 0, pa2); W2_PK4(p1, 8, pa3);
#undef W2_PK4
#define W2_VF(D0, ks_) ({ const s16x4 l_ = vtr(vp + (D0) * 512 + (2 * (ks_)) * 1024), h_ = vtr(vp + (D0) * 512 + (2 * (ks_) + 1) * 1024); (bf16x8){l_[0], l_[1], l_[2], l_[3], h_[0], h_[1], h_[2], h_[3]}; })
      o0 = __builtin_amdgcn_mfma_f32_32x32x16_bf16(pa0, W2_VF(0, 0), o0, 0, 0, 0); o1 = __builtin_amdgcn_mfma_f32_32x32x16_bf16(pa0, W2_VF(1, 0), o1, 0, 0, 0);
      o0 = __builtin_amdgcn_mfma_f32_32x32x16_bf16(pa1, W2_VF(0, 1), o0, 0, 0, 0); o1 = __builtin_amdgcn_mfma_f32_32x32x16_bf16(pa1, W2_VF(1, 1), o1, 0, 0, 0);
      o0 = __builtin_amdgcn_mfma_f32_32x32x16_bf16(pa2, W2_VF(0, 2), o0, 0, 0, 0); o1 = __builtin_amdgcn_mfma_f32_32x32x16_bf16(pa2, W2_VF(1, 2), o1, 0, 0, 0);
      o0 = __builtin_amdgcn_mfma_f32_32x32x16_bf16(pa3, W2_VF(0, 3), o0, 0, 0, 0); o1 = __builtin_amdgcn_mfma_f32_32x32x16_bf16(pa3, W2_VF(1, 3), o1, 0, 0, 0);
#undef W2_VF
    }
    float l; { auto rr = __builtin_amdgcn_permlane32_swap(__float_as_uint(l_reg), __float_as_uint(l_reg), false, false); l = __uint_as_float(rr[0]) + __uint_as_float(rr[1]); }
    float rli[16];
    row_recips(l, scal[16 + hq], wsf, r32, hi, rli);
    bf16_t* stg = (bf16_t*)(lds + W_WS + 2048) + wid * 1024;
    bf16_t* Ow = ACAT + (rowbase + q0 + wid * QBLK) * 1024 + hq * 64;
#pragma unroll
    for (int g = 0; g < 2; ++g) {
#pragma unroll
      for (int rr = 0; rr < 8; ++rr) { const int r = 8 * g + rr, srow = crow(r, hi) - 16 * g;
        stg[srow * 64 + r32] = (bf16_t)(cvtpk(o0[r] * rli[r], 0.f) & 0xffffu); stg[srow * 64 + 32 + r32] = (bf16_t)(cvtpk(o1[r] * rli[r], 0.f) & 0xffffu); }
      asm volatile("s_waitcnt lgkmcnt(0)" ::: "memory");
#pragma unroll
      for (int i = 0; i < 2; ++i) { const int row = i * 8 + (lane >> 3), ch = lane & 7; const u32x4 v = *(const u32x4*)(stg + row * 64 + ch * 8); *(u32x4*)(Ow + (size_t)(16 * g + row) * 1024 + ch * 8) = v; }
      asm volatile("s_waitcnt lgkmcnt(0)" ::: "memory"); }
  }
  asm volatile("s_waitcnt lgkmcnt(0)" ::: "memory"); __syncthreads();
}

__device__ __forceinline__ void diff_unit(__amdgpu_buffer_rsrc_t rs, const char* wsb, int b, int h, int qb, const bf16_t* QB, const bf16_t* KB, const bf16_t* VB, bf16_t* ACAT, const float* scal, const float* subln, char* lds, const int wid) {
  constexpr int S = 8192;
  const size_t rowbase = (size_t)b * S; const int q0 = qb * 256;
  float* wsf = (float*)(lds + LDS_WS) + wid * 64; float rli[16];
  bf16_t* stg = (bf16_t*)(lds + LDS_STG) + wid * 4096;
#pragma unroll 1
  for (int t = 0; t < 2; ++t) {
    f32x16 o[4]; float l; const float negm_s = scal[2];
    attn_pass_d4(rs, (unsigned)((const char*)(QB + (rowbase + q0) * 512 + (2 * h + t) * 64) - wsb), 1024u, (unsigned)((const char*)(KB + rowbase * 512 + (2 * h + t) * 64) - wsb), 1024u, (unsigned)((const char*)(VB + rowbase * 512 + h * 128) - wsb), 1024u, S, negm_s, lds, o, l, wid);
    const int lane1 = MK_LANE(); int r32 = lane1 & 31, hi = lane1 >> 5, lane = lane1; asm volatile("" : "+v"(r32), "+v"(hi), "+v"(lane));
    row_recips(l, 0.f, wsf, r32, hi, rli);
    if (t == 0) {
#pragma unroll
      for (int r = 0; r < 16; ++r) { const int orow = crow(r, hi);
#pragma unroll
        for (int d0 = 0; d0 < 4; ++d0) stg[orow * 128 + d0 * 32 + r32] = (bf16_t)(cvtpk(o[d0][r] * rli[r], 0.f) & 0xffffu); }
    } else {
      const float lam = scal[0], post = 1.0f - scal[1];
      float ss[16];
#pragma unroll
      for (int r = 0; r < 16; ++r) { const int orow = crow(r, hi); float s_ = 0.f;
#pragma unroll
        for (int d0 = 0; d0 < 4; ++d0) { const float v = bf2f(stg[orow * 128 + d0 * 32 + r32]) - lam * (o[d0][r] * rli[r]); o[d0][r] = v; s_ += v * v; }
        ss[r] = s_; }
#pragma unroll
      for (int r = 0; r < 16; ++r) { float s_ = ss[r]; s_ += __shfl_xor(s_, 1); s_ += __shfl_xor(s_, 2); s_ += __shfl_xor(s_, 4); s_ += __shfl_xor(s_, 8); s_ += __shfl_xor(s_, 16); ss[r] = rsqrtf(s_ * (1.0f / 128.0f) + 1e-6f) * post; }
      float sl[4];
#pragma unroll
      for (int d0 = 0; d0 < 4; ++d0) sl[d0] = subln[d0 * 32 + r32];
#pragma unroll
      for (int r = 0; r < 16; ++r) { const int orow = crow(r, hi);
#pragma unroll
        for (int d0 = 0; d0 < 4; ++d0) stg[orow * 128 + d0 * 32 + r32] = (bf16_t)(cvtpk(o[d0][r] * ss[r] * sl[d0], 0.f) & 0xffffu); }
      asm volatile("s_waitcnt lgkmcnt(0)" ::: "memory");
      const int widl = wid;
      bf16_t* Ow = ACAT + (rowbase + q0) * 1024 + 512 + h * 128 + (unsigned)((widl * QBLK + (lane >> 4)) * 1024 + (lane & 15) * 8);
      const bf16_t* sp = stg + (lane >> 4) * 128 + (lane & 15) * 8;
#pragma unroll
      for (int i = 0; i < 8; ++i) { const u32x4 v = *(const u32x4*)(sp + i * 512); *(u32x4*)(Ow + (size_t)i * 4096) = v; }
    }
  }
  asm volatile("s_waitcnt lgkmcnt(0)" ::: "memory"); __syncthreads();
}
#undef ATT_SBAR
}
constexpr int NWAVES = 8;
#ifndef MK_N_LAUNCHES
#define MK_N_LAUNCHES 1
#endif
constexpr int PER_PHASE = 10;
constexpr int N_LAUNCHES = MK_N_LAUNCHES;

constexpr int BATCH = 2, T = 8192, D = 1024, M = BATCH * T, DFF = 2816, NFF = 2 * DFF, NIN = 4352, NMOD = 9 * D;
constexpr size_t MiB = 1u << 20;
constexpr size_t WS_CTL = 0, CTL_ZERO_BYTES = 1 * MiB;
constexpr size_t WS_MOD = 512 * 1024;
constexpr size_t WS_SCAL = 1 * MiB, WS_CB1 = WS_SCAL + 4096, WS_CBIN = WS_CB1 + 65536, WS_CB2 = WS_CBIN + 65536;
constexpr size_t WS_RSS0 = 2 * MiB, WS_RSS1 = WS_RSS0 + 256 * 1024, WS_RSS2 = WS_RSS1 + 256 * 1024;
constexpr size_t WS_COS = 3 * MiB, WS_SIN = 5 * MiB;
constexpr size_t WS_W1T = 8 * MiB, WS_W1OT = 19 * MiB, WS_WINT = 25 * MiB, WS_WBRT = 34 * MiB, WS_WOT = 38 * MiB, WS_W2T = 40 * MiB, WS_W2OT = 51 * MiB;
constexpr size_t WS_ABUF = 57 * MiB;
constexpr size_t WS_R1 = 89 * MiB;
constexpr size_t WS_QA = WS_R1, WS_KA = WS_QA + 16 * MiB, WS_VA = WS_KA + 4 * MiB, WS_QB = WS_VA + 4 * MiB, WS_KB = WS_QB + 16 * MiB, WS_VB = WS_KB + 16 * MiB;
constexpr size_t WS_MG = WS_R1;
constexpr size_t WS_GA = 177 * MiB, WS_GB = 209 * MiB, WS_END = 241 * MiB;
static_assert(WS_VB + 16 * MiB <= WS_GA && WS_R1 + (size_t)M * DFF * 2 <= WS_GA && WS_W2OT + (size_t)D * DFF * 2 <= WS_ABUF, "d_ws map");
constexpr int CW_TMO = 0, CW_CODE = 1, CW_BAR = 4096;

constexpr int RING_OFF = 0, RING_BYTES = 131072;
constexpr int LDSCTL_OFF = 149504, MISC_OFF = LDSCTL_OFF + 320;
constexpr int LDS_BYTES = 155648;
static_assert(MISC_OFF + 128 <= LDS_BYTES && att::ATT_LDS_BYTES <= LDSCTL_OFF && RING_BYTES <= LDSCTL_OFF, "LDS map");

#define GAS __attribute__((address_space(1)))
#define LAS __attribute__((address_space(3)))
typedef unsigned short bf16;
typedef unsigned v4u __attribute__((ext_vector_type(4)));
typedef float f32x4 __attribute__((ext_vector_type(4)));
typedef short bf16x8 __attribute__((ext_vector_type(8)));
typedef GAS unsigned gu32;
typedef GAS unsigned long long gu64;
#define RLX_AGENT __ATOMIC_RELAXED, __HIP_MEMORY_SCOPE_AGENT
#define LDS_WAIT() asm volatile("s_waitcnt lgkmcnt(0)" ::: "memory")
#define VM_WAIT() asm volatile("s_waitcnt vmcnt(0)" ::: "memory")
__device__ __forceinline__ unsigned long long rt() { return __builtin_amdgcn_s_memrealtime(); }
__device__ __forceinline__ unsigned f2bf(float f) { unsigned u = __builtin_bit_cast(unsigned, f); return (u + 0x7fffu + ((u >> 16) & 1u)) >> 16; }
__device__ __forceinline__ unsigned pk2(float lo, float hi) { return f2bf(lo) | (f2bf(hi) << 16); }

#define XB_TMO      128
#define XB_XCNT(j)  (256  + 64 * (j))
#define XB_XSUB(j)  (1280 + 64 * (j))
#define XB_XGEN(j)  (2304 + 64 * (j))
#define XB_TOP      3328
#define XB_TOPGEN   3392
#define XCD_BAR_WORDS 3456
#define XB_SPIN_CAP (1u << 18)

__device__ __forceinline__ unsigned xb_ld(unsigned* p)              { return __hip_atomic_load(p, __ATOMIC_RELAXED, __HIP_MEMORY_SCOPE_AGENT); }
__device__ __forceinline__ unsigned xb_add(unsigned* p, unsigned v) { return __hip_atomic_fetch_add(p, v, __ATOMIC_RELAXED, __HIP_MEMORY_SCOPE_AGENT); }
__device__ __forceinline__ unsigned xb_xcc_id() { return (unsigned)__builtin_amdgcn_s_getreg((3 << 11) | 20) & 0xFu; }
#define XB_SPIN(cond, bar) do { unsigned _sp = 0; while (cond) { __builtin_amdgcn_s_sleep(1); \
    if ((++_sp & 255u) == 0u) { if (xb_ld(&(bar)[XB_TMO])) break; if (_sp > XB_SPIN_CAP) { atomicAdd(&(bar)[XB_TMO], 1u); break; } } } } while (0)

struct XcdBarrier {
    unsigned* bar; unsigned x;
    volatile LAS unsigned* st;
};

__device__ __forceinline__ XcdBarrier xcd_barrier_post(unsigned* bar, volatile LAS unsigned* st) {
    XcdBarrier b; b.bar = bar; b.x = xb_xcc_id(); b.st = st;
    if (threadIdx.x == 0) (void)xb_add(&bar[XB_XCNT(b.x)], 1u);
    return b;
}
__device__ __forceinline__ void xcd_barrier_complete(unsigned* bar, unsigned x, unsigned& nloc, unsigned& nx) {
    const unsigned G = gridDim.x * gridDim.y * gridDim.z;
    unsigned sum, cnt, mine, sp = 0u;
    for (;;) {
        sum = 0u; cnt = 0u; mine = 0u;
#pragma unroll
        for (unsigned j = 0; j < 16; ++j) { const unsigned c = xb_ld(&bar[XB_XCNT(j)]); sum += c; cnt += (c > 0u) ? 1u : 0u; mine = (j == x) ? c : mine; }
        if (sum == G) break;
        __builtin_amdgcn_s_sleep(1);
        if ((++sp & 255u) == 0u) { if (xb_ld(&bar[XB_TMO])) break; if (sp > XB_SPIN_CAP) { atomicAdd(&bar[XB_TMO], 1u); break; } }
    }
    nloc = mine > 0u ? mine : 1u; nx = cnt > 0u ? cnt : 1u;
}

__device__ __forceinline__ void xcd_barrier(const XcdBarrier& b, const bool leader  ) {
    asm volatile("s_waitcnt vmcnt(0)" ::: "memory");
    __syncthreads();
    if (leader) {
        unsigned* bar = b.bar;
        __builtin_amdgcn_s_waitcnt(0);
        unsigned nloc = b.st[0], nx = b.st[1];
        if (nloc == 0u) { xcd_barrier_complete(bar, b.x, nloc, nx); b.st[0] = nloc; b.st[1] = nx; }
        const unsigned old = xb_add(&bar[XB_XSUB(b.x)], 1u);
        const unsigned gen = old / nloc;
        if (old + 1u == (gen + 1u) * nloc) {
            __builtin_amdgcn_fence(__ATOMIC_RELEASE, "agent");
            asm volatile("s_waitcnt vmcnt(0)" ::: "memory");
            const unsigned og = xb_add(&bar[XB_TOP], 1u);
            const unsigned tg = og / nx;
            asm volatile("buffer_inv sc1" ::: "memory");
            if (og + 1u == (tg + 1u) * nx) xb_add(&bar[XB_TOPGEN], 1u);
            else XB_SPIN(xb_ld(&bar[XB_TOPGEN]) == tg, bar);
            xb_add(&bar[XB_XGEN(b.x)], 1u);
            asm volatile("s_waitcnt vmcnt(0)" ::: "memory");
        } else {
            asm volatile("buffer_inv sc1" ::: "memory");
            XB_SPIN(xb_ld(&bar[XB_XGEN(b.x)]) == gen, bar);
            asm volatile("s_waitcnt vmcnt(0)" ::: "memory");
        }
    }
    __syncthreads();
}

struct Args { const void* in[26]; float* out; unsigned char* ws; int ph_lo, ph_hi, li, pad; };

__device__ __forceinline__ float wave_sum(float v) {
#pragma unroll
    for (int o = 1; o < 64; o <<= 1) v += __shfl_xor(v, o);
    return v;
}
__device__ __forceinline__ int rowmap(int kind, int n0) {
    if (kind == 1) { const int bj = n0 >= DFF ? 1 : 0, jj = n0 - bj * DFF; return (jj >> 7) * 256 + bj * 128 + (jj & 127); }
    if (kind == 2) { if (n0 >= 2304) return n0; const int g32 = n0 >> 5, head = g32 >> 1, bj = g32 & 1; return (head >> 2) * 256 + bj * 128 + (head & 3) * 32; }
    if (kind == 3) return (n0 >> 7) * 256 + (n0 & 127);
    if (kind == 4) return (n0 >> 7) * 256 + 128 + (n0 & 127);
    return n0;
}
struct TItem { const float* src; bf16* dst; int N; int ldk; };
__device__ __forceinline__ TItem p0_item_addr(const float* W, int N, bf16* WT, int ldk, int koff, int kind, int item, int lane) {
    const int nblk = N / 32, kb = item / nblk, nb = item % nblk, k0 = 64 * kb, n0 = 32 * nb, c0 = rowmap(kind, n0), kg = lane & 7, ng = lane >> 3;
    TItem t; t.src = W + (size_t)(k0 + 8 * kg) * N + n0 + 4 * ng; t.dst = WT + (size_t)(c0 + 4 * ng) * ldk + koff + k0 + 8 * kg; t.N = N; t.ldk = ldk; return t;
}
__device__ __forceinline__ void p0_item_load(const TItem& t, f32x4 (&v)[8]) {
#pragma unroll
    for (int j = 0; j < 8; ++j) v[j] = __builtin_nontemporal_load((const f32x4*)(t.src + (size_t)j * t.N));
}
__device__ __forceinline__ void p0_item_store(const TItem& t, const f32x4 (&v)[8]) {
#pragma unroll
    for (int i = 0; i < 4; ++i) { v4u o; o.x = pk2(v[0][i], v[1][i]); o.y = pk2(v[2][i], v[3][i]); o.z = pk2(v[4][i], v[5][i]); o.w = pk2(v[6][i], v[7][i]);
        *(GAS v4u*)(t.dst + (size_t)i * t.ldk) = o; }
}

__device__ __forceinline__ void bias_rows(const bf16* Bt, float* CB, int nrows, const float* sh0, const float* sh1, int gw, int NGW) {
    const int lane = MK_LANE();
    f32x4 s0[2][2], s1[2][2];
#pragma unroll
    for (int hh = 0; hh < 2; ++hh)
#pragma unroll
        for (int q = 0; q < 2; ++q) { s0[hh][q] = *(const f32x4*)(sh0 + hh * 512 + lane * 8 + 4 * q); s1[hh][q] = *(const f32x4*)(sh1 + hh * 512 + lane * 8 + 4 * q); }
    for (int c0 = gw; c0 < nrows; c0 += 3 * NGW) {
        v4u w[3][2];
#pragma unroll
        for (int r = 0; r < 3; ++r) { const int c = c0 + r * NGW;
            if (c < nrows) {
#pragma unroll
                for (int hh = 0; hh < 2; ++hh) w[r][hh] = *(const GAS v4u*)(Bt + (size_t)c * D + hh * 512 + lane * 8); } }
#pragma unroll
        for (int r = 0; r < 3; ++r) { const int c = c0 + r * NGW;
            if (c < nrows) { float a0 = 0.f, a1 = 0.f;
#pragma unroll
                for (int hh = 0; hh < 2; ++hh) { const v4u v = w[r][hh];
                    const float wf[8] = {__uint_as_float(v.x << 16), __uint_as_float(v.x & 0xffff0000u), __uint_as_float(v.y << 16), __uint_as_float(v.y & 0xffff0000u),
                                         __uint_as_float(v.z << 16), __uint_as_float(v.z & 0xffff0000u), __uint_as_float(v.w << 16), __uint_as_float(v.w & 0xffff0000u)};
#pragma unroll
                    for (int e = 0; e < 8; ++e) { a0 += wf[e] * s0[hh][e >> 2][e & 3]; a1 += wf[e] * s1[hh][e >> 2][e & 3]; } }
                a0 = wave_sum(a0); a1 = wave_sum(a1);
                if (lane == 0) { CB[c] = a0; CB[nrows + c] = a1; } } }
    }
}

__global__ void __launch_bounds__(NWAVES * 64, 2) layer_fwd(Args args) {
    extern __shared__ __attribute__((aligned(16))) unsigned char lds[];
    LAS unsigned char* ldsl = (LAS unsigned char*)lds;
    volatile LAS unsigned* MISC = (volatile LAS unsigned*)(ldsl + MISC_OFF);
    const int wave = __builtin_amdgcn_readfirstlane((int)threadIdx.x >> 6), lane = MK_LANE(), tid = wave * 64 + lane;
    const int G = gridDim.x; const int bx = blockIdx.x; const int vcu = (G % 8 == 0) ? (bx % 8) * (G / 8) + bx / 8 : bx;
    unsigned char* ws = args.ws;
    gu32* ctl = (gu32*)(ws + WS_CTL);
    const float* x = (const float*)args.in[0]; const float* cvec = (const float*)args.in[1]; const int* positions = (const int*)args.in[2];
    const float* w_mod = (const float*)args.in[3]; const float* b_mod = (const float*)args.in[4];
    const float* norm_ffn1 = (const float*)args.in[5]; const float* w_ffn1_in = (const float*)args.in[6]; const float* w_ffn1_out = (const float*)args.in[7];
    const float* norm_mix = (const float*)args.in[8]; const float* w_in = (const float*)args.in[9];
    const float* qn_a = (const float*)args.in[10]; const float* kn_a = (const float*)args.in[11]; const float* sink_a = (const float*)args.in[12];
    const float* qn_b = (const float*)args.in[13]; const float* kn_b = (const float*)args.in[14];
    const float* lam_q1 = (const float*)args.in[15]; const float* lam_k1 = (const float*)args.in[16]; const float* lam_q2 = (const float*)args.in[17]; const float* lam_k2 = (const float*)args.in[18];
    const float* subln_b = (const float*)args.in[19]; const float* w_branch_a = (const float*)args.in[20]; const float* w_branch_b = (const float*)args.in[21];
    const float* w_out = (const float*)args.in[22]; const float* norm_ffn2 = (const float*)args.in[23]; const float* w_ffn2_in = (const float*)args.in[24]; const float* w_ffn2_out = (const float*)args.in[25];
    float* out = args.out;
    float* MOD = (float*)(ws + WS_MOD); float* SCAL = (float*)(ws + WS_SCAL); float* CB1 = (float*)(ws + WS_CB1); float* CBIN = (float*)(ws + WS_CBIN); float* CB2 = (float*)(ws + WS_CB2);
    float* RSS0 = (float*)(ws + WS_RSS0); float* RSS1 = (float*)(ws + WS_RSS1); float* RSS2 = (float*)(ws + WS_RSS2); bf16* ROPET = (bf16*)(ws + WS_COS);
    bf16* W1T = (bf16*)(ws + WS_W1T); bf16* W1OT = (bf16*)(ws + WS_W1OT); bf16* WINT = (bf16*)(ws + WS_WINT); bf16* WBRT = (bf16*)(ws + WS_WBRT); bf16* WOT = (bf16*)(ws + WS_WOT);
    bf16* W2T = (bf16*)(ws + WS_W2T); bf16* W2OT = (bf16*)(ws + WS_W2OT);
    bf16* ABUF = (bf16*)(ws + WS_ABUF); bf16* HB = (bf16*)(ws + WS_R1); bf16* MG = (bf16*)(ws + WS_MG);
    bf16* QA = (bf16*)(ws + WS_QA); bf16* KA = (bf16*)(ws + WS_KA); bf16* VA = (bf16*)(ws + WS_VA); bf16* QB = (bf16*)(ws + WS_QB); bf16* KB = (bf16*)(ws + WS_KB); bf16* VB = (bf16*)(ws + WS_VB);
    bf16* GA = (bf16*)(ws + WS_GA); bf16* GB = (bf16*)(ws + WS_GB);
    bf16* X1B = (bf16*)out;
    bf16* X2B = (bf16*)(ws + WS_GA);

    for (int u = tid; u < (LDS_BYTES - LDSCTL_OFF) / 4; u += NWAVES * 64) ((LAS unsigned*)(ldsl + LDSCTL_OFF))[u] = 0u;
    __syncthreads();
    XcdBarrier bar; bar.bar = (unsigned*)(ctl + CW_BAR); bar.x = 0; bar.st = nullptr;
    if (N_LAUNCHES != PER_PHASE) bar = xcd_barrier_post((unsigned*)(ctl + CW_BAR), MISC + 8);
#define GRID_BAR(seam) do { if (N_LAUNCHES == PER_PHASE) { if (tid == 0) __hip_atomic_store(ctl + CW_TMO, 0xBADBA0u | (unsigned)(seam), RLX_AGENT); } else { xcd_barrier(bar, wave == 0 && MK_LANE() == 0); } } while (0)
    const int lo = args.ph_lo, hi = args.ph_hi;
#ifndef PH_MASK
#define PH_MASK 0x3ff
#endif
#define IN(k) (((PH_MASK >> (k)) & 1) && lo <= (k) && (k) < hi)
#define BOTH(k) (IN(k) && IN((k) + 1))
#ifndef REPEAT_MASK
#define REPEAT_MASK 0
#endif
#define REPS(k) for (int rep_ = 0; rep_ <= ((REPEAT_MASK >> (k)) & 1); ++rep_)
    const int gw = vcu * NWAVES + wave, NGW = G * NWAVES;
    constexpr float QSCALE = 0.125f * 1.4426950408889634f;

    if (IN(0)) {
#define MOD_GEMV(IT_BEGIN, IT_END, IT_FIRST, IT_STRIDE, TIDV, LANEV) do { \
            LAS float* ca = (LAS float*)(ldsl + RING_OFF + 73728);              \
            LAS float* red = ca + 2048;                                          \
            for (int i = (TIDV); i < 2 * D; i += NWAVES * 64) { const float v = cvec[i]; ca[i] = v / (1.f + __expf(-v)); } \
            __syncthreads(); \
            for (int it = (IT_BEGIN) + (IT_FIRST); it < (IT_END); it += (IT_STRIDE)) { \
                const int cg = it >> 1, kh = it & 1, j = cg * 64 + (LANEV), kbase = kh * 512 + wave * 64; \
                float wv[64]; \
                _Pragma("unroll") \
                for (int kk = 0; kk < 64; ++kk) wv[kk] = w_mod[(size_t)(kbase + kk) * NMOD + j]; \
                float a0 = 0.f, a1 = 0.f; \
                _Pragma("unroll") \
                for (int kk = 0; kk < 64; ++kk) { a0 += ca[kbase + kk] * wv[kk]; a1 += ca[D + kbase + kk] * wv[kk]; } \
                red[(wave * 2 + 0) * 64 + (LANEV)] = a0; red[(wave * 2 + 1) * 64 + (LANEV)] = a1; \
                __syncthreads(); \
                if ((TIDV) < 128) { const int b = (TIDV) >> 6; float s_ = (kh == 0) ? b_mod[j] : 0.f; \
                    _Pragma("unroll") \
                    for (int w = 0; w < 8; ++w) s_ += red[(w * 2 + b) * 64 + (LANEV)]; \
                    atomicAdd(MOD + b * NMOD + j, s_); } \
                __syncthreads(); \
            } } while (0)
        MOD_GEMV(0, 64, bx, G, tid, lane);
        {
            constexpr int NITEMS = (D / 64) * (NFF / 32);
            auto item_of = [&](int it) -> TItem { return p0_item_addr(w_ffn1_in, NFF, W1T, D, 0, 1, it, lane); };
            for (int it = gw; it < NITEMS; it += 2 * NGW) {
                const int it2 = it + NGW; const bool two = it2 < NITEMS;
                const TItem a = item_of(it), b2 = item_of(two ? it2 : it);
                f32x4 va[8], vb[8];
                p0_item_load(a, va); if (two) p0_item_load(b2, vb);
                p0_item_store(a, va); if (two) p0_item_store(b2, vb);
            }
        }
        if (bx == 0 && wave == 0) {
            const float a = wave_sum(lam_q1[lane] * lam_k1[lane]), b2 = wave_sum(lam_q2[lane] * lam_k2[lane]);
            float mqa = fabsf(qn_a[lane]), mka = fabsf(kn_a[lane]), mqb = fabsf(qn_b[lane]), mkb = fabsf(kn_b[lane]);
#pragma unroll
            for (int o = 1; o < 64; o <<= 1) { mqa = fmaxf(mqa, __shfl_xor(mqa, o)); mka = fmaxf(mka, __shfl_xor(mka, o)); mqb = fmaxf(mqb, __shfl_xor(mqb, o)); mkb = fmaxf(mkb, __shfl_xor(mkb, o)); }
            const float bound_a = 8.0f * mqa * mka * 1.001f, bound_b = 8.0f * mqb * mkb * 1.001f, L2E = 1.4426950408889634f;
            if (lane == 0) { const float lam_init = 0.8f - 0.6f * expf(-0.3f * 0.f); SCAL[0] = expf(a) - expf(b2) + lam_init; SCAL[1] = lam_init; SCAL[2] = -bound_b * L2E; }
            if (lane < 8) { const float sk = sink_a[lane], mh = fmaxf(bound_a, sk); SCAL[8 + lane] = -mh * L2E; SCAL[16 + lane] = exp2f((sk - mh) * L2E); }
        }
        if (BOTH(0)) GRID_BAR(0);
    }

    if (IN(1)) {
        for (int m = gw; m < M; m += NGW) {
            const int b = m >> 13; const GAS f32x4* xr = (const GAS f32x4*)(x + (size_t)m * D) + lane;
            f32x4 v[4]; float s = 0.f;
#pragma unroll
            for (int j = 0; j < 4; ++j) { v[j] = xr[64 * j]; s += (v[j].x * v[j].x + v[j].y * v[j].y) + (v[j].z * v[j].z + v[j].w * v[j].w); }
            s = wave_sum(s);
            if (lane == 0) *(f32x4*)(RSS0 + (size_t)m * 4) = (f32x4){s, 0.f, 0.f, 0.f};
            GAS unsigned long long* o8 = (GAS unsigned long long*)(ABUF + (size_t)m * D) + lane;
#pragma unroll
            for (int j = 0; j < 4; ++j) { const int c = 4 * lane + 256 * j; const f32x4 g = *(const f32x4*)(norm_ffn1 + c) * (*(const f32x4*)(MOD + b * NMOD + 1 * D + c) + 1.0f); const f32x4 a = v[j] * g;
                o8[64 * j] = (unsigned long long)pk2(a.x, a.y) | ((unsigned long long)pk2(a.z, a.w) << 32); }
        }
        bias_rows(W1T, CB1, NFF, MOD + 0 * D, MOD + NMOD + 0 * D, gw, NGW);
        if (BOTH(1)) GRID_BAR(1);
    }

    if (IN(2)) {
        pg8::Gemm g{ABUF, W1T, M, NFF, D}; pg8::StaticOrder S; S.init(M, NFF, G, bx);
        pg8::EpiSwiGLU E{HB, DFF, RSS0, CB1, NFF};
        pg8::gemm_phase<pg8::EpiSwiGLU, pg8::StaticOrder, PG8_ALIGN, PG8_SP2>(ldsl + RING_OFF, g, S, E, wave);
        { pg8::Unit ud; const int nunits = (M / 256) * (NFF / 256), nfull = nunits / G;
          if (!S.next(nfull, ud)) {
            const int nidle = G - (nunits - nfull * G), iw = (bx - (G - nidle)) * NWAVES + wave, NIW = nidle * NWAVES, lane2 = MK_LANE();
            MOD_GEMV(64, 288, bx - (G - nidle), nidle, wave * 64 + lane2, lane2);
            constexpr int I_IN = (D / 64) * (NIN / 32), I_1O = (DFF / 64) * (D / 32), NITEMS = I_IN + I_1O;
            auto item_of = [&](int it) -> TItem { return it < I_IN ? p0_item_addr(w_in, NIN, WINT, D, 0, 2, it, lane2) : p0_item_addr(w_ffn1_out, D, W1OT, DFF, 0, 0, it - I_IN, lane2); };
            for (int it = iw; it < NITEMS; it += 2 * NIW) {
                const int it2 = it + NIW; const bool two = it2 < NITEMS;
                const TItem a = item_of(it), b2 = item_of(two ? it2 : it);
                f32x4 va[8], vb[8];
                p0_item_load(a, va); if (two) p0_item_load(b2, vb);
                p0_item_store(a, va); if (two) p0_item_store(b2, vb);
            }
            { const float invf = (float)pow(10000.0, -(double)(2 * (lane2 & 31)) / 64.0);
              for (int i = iw * 64 + lane2; i < M * 32; i += NIW * 64) { const float ang = (float)positions[i >> 5] * invf; const int row = i >> 5, d = i & 31;
                  ROPET[row * 64 + d] = (bf16)f2bf(cosf(ang)); ROPET[row * 64 + 32 + d] = (bf16)f2bf(sinf(ang)); } }
          } }
        if (BOTH(2)) GRID_BAR(2);
    }
    if (IN(3)) {
        pg8::Gemm g{HB, W1OT, M, D, DFF}; pg8::StaticOrder S; S.init(M, D, G, bx);
        pg8::EpiResid<true, 1, false, true> E{x, X1B, MOD + 2 * D, ABUF, norm_mix, MOD + 4 * D, RSS1};
        pg8::gemm_phase<pg8::EpiResid<true, 1, false, true>, pg8::StaticOrder, false, PG8_SP2>(ldsl + RING_OFF, g, S, E, wave);
        bias_rows(WINT, CBIN, NIN, MOD + 3 * D, MOD + NMOD + 3 * D, gw, NGW);
        if (BOTH(3)) GRID_BAR(3);
    }
    if (IN(4)) {
        pg8::Gemm g{ABUF, WINT, M, NIN, D}; pg8::StaticOrder S; S.init(M, NIN, G, bx);
        pg8::EpiInProj E{QA, KA, VA, QB, KB, VB, GA, GB, RSS1, CBIN, ROPET, qn_a, kn_a, qn_b, kn_b, QSCALE};
        pg8::gemm_phase<pg8::EpiInProj, pg8::StaticOrder, PG8_ALIGN, PG8_SP2>(ldsl + RING_OFF, g, S, E, wave);
        { pg8::Unit ud; const int nunits = (M / 256) * (NIN / 256), nfull = nunits / G;
          if (!S.next(nfull, ud)) {
            const int nidle = G - (nunits - nfull * G), iw = (bx - (G - nidle)) * NWAVES + wave, NIW = nidle * NWAVES, lane2 = MK_LANE();
            constexpr int I_1 = (D / 64) * (NFF / 32), I_1O = (DFF / 64) * (D / 32), I_BR = (512 / 64) * (D / 32), I_O = (D / 64) * (D / 32);
            constexpr int NITEMS = 2 * I_BR + I_O + I_1 + I_1O;
            auto item_of = [&](int it) -> TItem {
                int r = it;
                if (r < I_BR) return p0_item_addr(w_branch_a, D, WBRT, D, 0, 0, r, lane2); r -= I_BR;
                if (r < I_BR) return p0_item_addr(w_branch_b, D, WBRT, D, 512, 0, r, lane2); r -= I_BR;
                if (r < I_O) return p0_item_addr(w_out, D, WOT, D, 0, 0, r, lane2); r -= I_O;
                if (r < I_1) return p0_item_addr(w_ffn2_in, NFF, W2T, D, 0, 1, r, lane2); r -= I_1;
                return p0_item_addr(w_ffn2_out, D, W2OT, DFF, 0, 0, r, lane2);
            };
            for (int it = iw; it < NITEMS; it += 2 * NIW) {
                const int it2 = it + NIW; const bool two = it2 < NITEMS;
                const TItem a = item_of(it), b2 = item_of(two ? it2 : it);
                f32x4 va[8], vb[8];
                p0_item_load(a, va); if (two) p0_item_load(b2, vb);
                p0_item_store(a, va); if (two) p0_item_store(b2, vb);
            }
          } }
        if (BOTH(4)) GRID_BAR(4);
    }
    if (IN(5)) {
        char* alds = (char*)lds + RING_OFF;
        const __amdgpu_buffer_rsrc_t wsrs = __builtin_amdgcn_make_buffer_rsrc((void*)ws, (short)0, 0x10000000, 0x00020000);
#ifndef SKIP_WIN
        for (int id = vcu; id < 256; id += G) att::win_unit2(wsrs, (const char*)ws, id >> 7, (id >> 6) & 1, id & 31, (id >> 5) & 1, QA, KA, VA, ABUF, SCAL, alds, wave);
#endif
#ifndef SKIP_DIFF
        for (int id = vcu; id < 256; id += G) att::diff_unit(wsrs, (const char*)ws, id >> 7, (id >> 5) & 3, id & 31, QB, KB, VB, ABUF, SCAL, subln_b, alds, wave);
#endif
        if (BOTH(5)) GRID_BAR(5);
    }
    if (IN(6)) {
        pg8::Gemm g{ABUF, WBRT, M, D, D, 512}; pg8::PairOrder S; S.init(M, D, G, bx, D);
        pg8::EpiBranch E{GA, GB, MG};
        pg8::gemm_phase<pg8::EpiBranch, pg8::PairOrder, false, PG8_SP2>(ldsl + RING_OFF, g, S, E, wave);
        if (BOTH(6)) GRID_BAR(6);
    }
    if (IN(7)) {
        pg8::Gemm g{MG, WOT, M, D, D}; pg8::StaticOrder S; S.init(M, D, G, bx);
        pg8::EpiResid<true, 2, true, true> E{X1B, X2B, MOD + 5 * D, ABUF, norm_ffn2, MOD + 7 * D, RSS2};
        pg8::gemm_phase<pg8::EpiResid<true, 2, true, true>, pg8::StaticOrder, false, PG8_SP2>(ldsl + RING_OFF, g, S, E, wave);
        bias_rows(W2T, CB2, NFF, MOD + 6 * D, MOD + NMOD + 6 * D, gw, NGW);
        if (BOTH(7)) GRID_BAR(7);
    }
    if (IN(8)) {
        pg8::Gemm g{ABUF, W2T, M, NFF, D}; pg8::StaticOrder S; S.init(M, NFF, G, bx);
        pg8::EpiSwiGLU E{HB, DFF, RSS2, CB2, NFF};
        pg8::gemm_phase<pg8::EpiSwiGLU, pg8::StaticOrder, PG8_ALIGN, PG8_SP2>(ldsl + RING_OFF, g, S, E, wave);
        if (BOTH(8)) GRID_BAR(8);
    }
    if (IN(9)) {
        pg8::Gemm g{HB, W2OT, M, D, DFF}; pg8::StaticOrder S; S.init(M, D, G, bx);
        pg8::EpiResid<false, 1, true, false> E{X2B, out, MOD + 8 * D, nullptr, nullptr, nullptr, nullptr};
        pg8::gemm_phase<pg8::EpiResid<false, 1, true, false>, pg8::StaticOrder, false, PG8_SP2>(ldsl + RING_OFF, g, S, E, wave);
    }
#undef IN
#undef BOTH
#undef GRID_BAR
}

extern "C" void kernel_launch(void* const* d_in, const int* in_sizes, int n_in, void* d_out, int out_size, void* d_ws, size_t ws_size, hipStream_t stream) {
    static int grid = 0;
    if (grid == 0) {
        if (n_in != 26 || in_sizes[0] != M * D || out_size != M * D || ws_size < WS_END) { fprintf(stderr, "kernel_launch: unexpected shapes: n_in %d in0 %d out %d ws %zu (need >= %zu)\n", n_in, n_in > 0 ? in_sizes[0] : -1, out_size, ws_size, (size_t)WS_END); grid = -1; return; }
        int dev = 0, cus = 0;
        if (hipGetDevice(&dev) != hipSuccess || hipDeviceGetAttribute(&cus, hipDeviceAttributeMultiprocessorCount, dev) != hipSuccess) { grid = -1; return; }
        if (hipFuncSetAttribute((const void*)layer_fwd, hipFuncAttributeMaxDynamicSharedMemorySize, LDS_BYTES) != hipSuccess) { fprintf(stderr, "kernel_launch: hipFuncSetAttribute failed\n"); grid = -1; return; }
        int per_cu = 0;
        if (hipOccupancyMaxActiveBlocksPerMultiprocessor(&per_cu, (const void*)layer_fwd, NWAVES * 64, LDS_BYTES) != hipSuccess || per_cu < 1) fprintf(stderr, "kernel_launch: occupancy query says %d\n", per_cu);
        (void)hipGetLastError();
        grid = cus;
        if (grid != 256) fprintf(stderr, "kernel_launch: %d CUs; the one-unit-per-workgroup phases need exactly 256\n", grid);
    }
    if (grid < 0) return;
    (void)hipMemsetAsync((char*)d_ws + WS_CTL, 0, CTL_ZERO_BYTES, stream);
    Args a{};
    for (int i = 0; i < 26; ++i) a.in[i] = d_in[i];
    a.out = (float*)d_out; a.ws = (unsigned char*)d_ws;
    for (int li = 0; li < N_LAUNCHES; ++li) {
        a.ph_lo = (N_LAUNCHES == PER_PHASE) ? li : 0; a.ph_hi = (N_LAUNCHES == PER_PHASE) ? li + 1 : PER_PHASE; a.li = li;
        hipLaunchKernelGGL(layer_fwd, dim3(grid), dim3(NWAVES * 64), LDS_BYTES, stream, a);
    }
}
```

```cpp
#include <hip/hip_runtime.h>
#include <cstdio>
#include <cstdint>
#include <cmath>
__device__ __forceinline__ int mk_lane_() { int l; asm volatile("v_mbcnt_lo_u32_b32 %0, -1, 0\n\tv_mbcnt_hi_u32_b32 %0, -1, %0" : "=v"(l)); return l; }
#define MK_LANE() mk_lane_()
namespace pg8 {
#define PG8_LAS __attribute__((address_space(3)))
typedef unsigned short bf16_t;
typedef short bf16x8 __attribute__((ext_vector_type(8)));
typedef float f32x4 __attribute__((ext_vector_type(4)));
typedef unsigned u32x4 __attribute__((ext_vector_type(4)));
constexpr int BM = 256, BK = 64, HALF = 128, HTB = HALF * BK * 2  , STAGE_BYTES = 8 * HTB, NXCD = 8, WGM = 8;

__host__ __device__ __forceinline__ int lds_byte(int r, int c) { const int st = (r >> 4) * 2 + (c >> 5), rr = r & 15, cc = c & 31, ob = rr * 64 + cc * 2; return st * 1024 + (ob ^ (((ob >> 9) & 1) << 5)); }
__host__ __device__ __forceinline__ void stage_rc(int b, int& R, int& C) { const int st = b / 1024, sb = b % 1024, swz = sb ^ (((sb >> 9) & 1) << 5); R = (st >> 1) * 16 + swz / 64; C = (st & 1) * 32 + (swz % 64) / 2; }
__host__ __device__ __forceinline__ int perm32(int rho) { const int n = rho >> 4, i = rho & 15; return 8 * (i >> 2) + 4 * n + (i & 3); }

struct Unit { int pm, pn, ko; };
struct Gemm { const bf16_t* A; const bf16_t* Bt; int M, N, K; int KL = 0; };

struct StaticOrder {
    int nM, nN, nwg, G, c;
    __host__ __device__ void init(int M, int N, int G_, int c_) { nM = M / BM; nN = N / BM; nwg = nM * nN; G = G_; c = c_; }
    __host__ __device__ bool next(int i, Unit& u) const {
        const long L = (long)i * G + c; if (L >= nwg) return false;
        int wgid = (int)L; { const int q = nwg / NXCD, r = nwg % NXCD, xcd = wgid % NXCD, off = wgid / NXCD; wgid = (xcd < r ? xcd * (q + 1) : r * (q + 1) + (xcd - r) * q) + off; }
        const int nig = WGM * nN, gid = wgid / nig, fm = gid * WGM, gsz = (nM - fm) < WGM ? (nM - fm) : WGM;
        u.pm = fm + ((wgid % nig) % gsz); u.pn = (wgid % nig) / gsz; u.ko = 0; return true;
    }
    __device__ __forceinline__ void a_ready(const Unit&) const {}
    __device__ __forceinline__ void done(const Unit&) const {}
};
struct PairOrder {
    StaticOrder S; int khalf_bytes;
    __host__ __device__ void init(int M, int N, int G_, int c_, int K) { S.init(M, N, G_, c_); khalf_bytes = K;   }
    __host__ __device__ bool next(int i, Unit& u) const { if (!S.next(i >> 1, u)) return false; u.ko = (i & 1) * khalf_bytes; return true; }
    __device__ __forceinline__ void a_ready(const Unit&) const {}
    __device__ __forceinline__ void done(const Unit&) const {}
};

__device__ __forceinline__ unsigned cvt_pk_bf16(float lo, float hi) { unsigned r; asm volatile("v_cvt_pk_bf16_f32 %0, %1, %2" : "=v"(r) : "v"(lo), "v"(hi)); return r; }
__device__ __forceinline__ float bf_lo(unsigned w) { return __uint_as_float(w << 16); }
__device__ __forceinline__ float bf_hi(unsigned w) { return __uint_as_float(w & 0xffff0000u); }
constexpr float RMS_EPS = 1e-6f, LOG2E = 1.4426950408889634f;
__device__ __forceinline__ float row_rinv(const float* rss, int row) { const f32x4 s = *(const f32x4*)(rss + (size_t)row * 4); return rsqrtf(((s[0] + s[1]) + (s[2] + s[3])) * (1.0f / 1024.0f) + RMS_EPS); }
__device__ __forceinline__ float fast_sigmoid(float v) { return __builtin_amdgcn_rcpf(1.0f + __builtin_amdgcn_exp2f(-v * LOG2E)); }

struct EpiSwiGLU {
    static constexpr bool PERM = true, AFTER_DRAIN = false, PREFETCH = true, CHAIN = false;
    bf16_t* H; int ldh; const float* rss; const float* cb; int ncb;
    __device__ __forceinline__ void prefetch(const Unit& u, PG8_LAS unsigned char* buf, int wid, int lane) const {
        if (wid < 4) __builtin_amdgcn_global_load_lds((const unsigned*)(rss + (size_t)(u.pm * BM + wid * 64 + lane) * 4), (PG8_LAS unsigned*)(buf + wid * 1024), 16, 0, 0);
        else if (wid == 4) __builtin_amdgcn_global_load_lds((const unsigned*)(cb + (size_t)(u.pm >> 5) * ncb + u.pn * BM + lane * 4), (PG8_LAS unsigned*)(buf + 4096), 16, 0, 0);
    }
    __device__ __forceinline__ void operator()(const f32x4 (&acc)[2][2][4][2], const Unit& u, int wr, int wc, int fr, int fq, const PG8_LAS unsigned char* buf) const {
        const int outcol = u.pn * HALF + wc * 32 + 8 * fq;
        const PG8_LAS float* cbb = (const PG8_LAS float*)(buf + 4096) + wc * 32 + 8 * fq;
        const f32x4 bg0 = *(const PG8_LAS f32x4*)(cbb), bg1 = *(const PG8_LAS f32x4*)(cbb + 4), bu0 = *(const PG8_LAS f32x4*)(cbb + HALF), bu1 = *(const PG8_LAS f32x4*)(cbb + HALF + 4);
#pragma unroll
        for (int ai = 0; ai < 2; ++ai) {
#pragma unroll
            for (int m = 0; m < 4; ++m) {
                const int row = u.pm * BM + ai * HALF + wr * 64 + m * 16 + fr; const f32x4 sv_ = *(const PG8_LAS f32x4*)(buf + (ai * HALF + wr * 64 + m * 16 + fr) * 16); const float ri = rsqrtf(((sv_[0] + sv_[1]) + (sv_[2] + sv_[3])) * (1.0f / 1024.0f) + RMS_EPS);
                const f32x4 g0 = acc[ai][0][m][0] * ri + bg0, g1 = acc[ai][0][m][1] * ri + bg1, u0 = acc[ai][1][m][0] * ri + bu0, u1 = acc[ai][1][m][1] * ri + bu1;
                float o[8];
#pragma unroll
                for (int j = 0; j < 4; ++j) { o[j] = g0[j] * fast_sigmoid(g0[j]) * u0[j]; o[4 + j] = g1[j] * fast_sigmoid(g1[j]) * u1[j]; }
                u32x4 w; w.x = cvt_pk_bf16(o[0], o[1]); w.y = cvt_pk_bf16(o[2], o[3]); w.z = cvt_pk_bf16(o[4], o[5]); w.w = cvt_pk_bf16(o[6], o[7]);
                *(u32x4*)(H + (size_t)row * ldh + outcol) = w; } }
    }
};

struct EpiInProj {
    static constexpr bool PERM = true, AFTER_DRAIN = false, PREFETCH = true, CHAIN = false;
    bf16_t *QA, *KA, *VA, *QB, *KB, *VB, *GA, *GB; const float* rss; const float* cb; const bf16_t* ropet; const float *qn_a, *kn_a, *qn_b, *kn_b; float qscale;
    __device__ __forceinline__ void prefetch(const Unit& u, PG8_LAS unsigned char* buf, int wid, int lane) const {
        if (wid < 4) __builtin_amdgcn_global_load_lds((const unsigned*)(rss + (size_t)(u.pm * BM + wid * 64 + lane) * 4), (PG8_LAS unsigned*)(buf + wid * 1024), 16, 0, 0);
        else if (wid == 4) __builtin_amdgcn_global_load_lds((const unsigned*)(cb + (size_t)(u.pm >> 5) * 4352 + u.pn * BM + lane * 4), (PG8_LAS unsigned*)(buf + 4096), 16, 0, 0);
    }
    __device__ __forceinline__ void operator()(const f32x4 (&acc)[2][2][4][2], const Unit& u, int wr, int wc, int fr, int fq, const PG8_LAS unsigned char* buf) const {
        const int pn = u.pn;
        int mode; bf16_t* dst; int ld; const float* gain = qn_a; float scale = 1.f;
        if (pn < 2) { mode = 0; dst = QA + (4 * pn + wc) * 64; ld = 512; gain = qn_a; scale = qscale; }
        else if (pn == 2) { if (wc < 2) { mode = 0; dst = KA + wc * 64; ld = 128; gain = kn_a; } else { mode = 1; dst = VA + (wc - 2) * 64; ld = 128; } }
        else if (pn < 5) { mode = 0; dst = QB + (4 * (pn - 3) + wc) * 64; ld = 512; gain = qn_b; scale = qscale; }
        else if (pn < 7) { mode = 0; dst = KB + (4 * (pn - 5) + wc) * 64; ld = 512; gain = kn_b; }
        else if (pn < 9) { mode = 1; dst = VB + (4 * (pn - 7) + wc) * 64; ld = 512; }
        else if (pn < 13) { mode = 2; dst = GA + (pn - 9) * BM + wc * 32; ld = 1024; }
        else { mode = 2; dst = GB + (pn - 13) * BM + wc * 32; ld = 1024; }
        const int bjoff = (mode == 2) ? HALF : 32;
        const PG8_LAS float* cbb = (const PG8_LAS float*)(buf + 4096) + wc * 32 + 8 * fq;
        f32x4 bv[2][2];
#pragma unroll
        for (int bj = 0; bj < 2; ++bj)
#pragma unroll
            for (int n = 0; n < 2; ++n) bv[bj][n] = *(const PG8_LAS f32x4*)(cbb + bj * HALF + 4 * n);
        f32x4 gv[2][2];
#pragma unroll
        for (int bj = 0; bj < 2; ++bj)
#pragma unroll
            for (int n = 0; n < 2; ++n) gv[bj][n] = *(const f32x4*)(gain + bj * 32 + 8 * fq + 4 * n);
#pragma unroll
        for (int ai = 0; ai < 2; ++ai) {
            u32x4 csw[4], snw[4];
            if (mode == 0) {
#pragma unroll
              for (int m = 0; m < 4; ++m) { const bf16_t* tp = ropet + (size_t)(u.pm * BM + ai * HALF + wr * 64 + m * 16 + fr) * 64 + 8 * fq; csw[m] = *(const u32x4*)tp; snw[m] = *(const u32x4*)(tp + 32); } }
#pragma unroll
            for (int m = 0; m < 4; ++m) {
                const int row = u.pm * BM + ai * HALF + wr * 64 + m * 16 + fr; const f32x4 sv_ = *(const PG8_LAS f32x4*)(buf + (ai * HALF + wr * 64 + m * 16 + fr) * 16); const float ri = rsqrtf(((sv_[0] + sv_[1]) + (sv_[2] + sv_[3])) * (1.0f / 1024.0f) + RMS_EPS);
                f32x4 v[2][2];
#pragma unroll
                for (int bj = 0; bj < 2; ++bj)
#pragma unroll
                    for (int n = 0; n < 2; ++n) v[bj][n] = acc[ai][bj][m][n] * ri + bv[bj][n];
                if (mode == 0) {
                    float ss = 0.f;
#pragma unroll
                    for (int bj = 0; bj < 2; ++bj)
#pragma unroll
                        for (int n = 0; n < 2; ++n) ss += (v[bj][n][0] * v[bj][n][0] + v[bj][n][1] * v[bj][n][1]) + (v[bj][n][2] * v[bj][n][2] + v[bj][n][3] * v[bj][n][3]);
                    ss += __shfl_xor(ss, 16); ss += __shfl_xor(ss, 32);
                    const float rn = rsqrtf(ss * (1.0f / 64.0f) + RMS_EPS);
#pragma unroll
                    for (int n = 0; n < 2; ++n) {
                        const unsigned c0_ = n ? csw[m].z : csw[m].x, c1_ = n ? csw[m].w : csw[m].y, s0_ = n ? snw[m].z : snw[m].x, s1_ = n ? snw[m].w : snw[m].y;
                        const f32x4 cs = {bf_lo(c0_), bf_hi(c0_), bf_lo(c1_), bf_hi(c1_)}, sn = {bf_lo(s0_), bf_hi(s0_), bf_lo(s1_), bf_hi(s1_)};
                        const f32x4 lo = v[0][n] * rn * gv[0][n], hi = v[1][n] * rn * gv[1][n];
                        v[0][n] = (lo * cs - hi * sn) * scale; v[1][n] = (hi * cs + lo * sn) * scale; }
                } else if (mode == 2) {
#pragma unroll
                    for (int bj = 0; bj < 2; ++bj)
#pragma unroll
                        for (int n = 0; n < 2; ++n)
#pragma unroll
                            for (int j = 0; j < 4; ++j) v[bj][n][j] = fast_sigmoid(v[bj][n][j]);
                }
                bf16_t* rowp = dst + (size_t)row * ld + 8 * fq;
#pragma unroll
                for (int bj = 0; bj < 2; ++bj) { u32x4 w; w.x = cvt_pk_bf16(v[bj][0][0], v[bj][0][1]); w.y = cvt_pk_bf16(v[bj][0][2], v[bj][0][3]); w.z = cvt_pk_bf16(v[bj][1][0], v[bj][1][1]); w.w = cvt_pk_bf16(v[bj][1][2], v[bj][1][3]);
                    *(u32x4*)(rowp + bj * bjoff) = w; } } }
    }
};

struct EpiBranch {
    static constexpr bool PERM = true, AFTER_DRAIN = false, PREFETCH = false, CHAIN = true;
    const bf16_t* GA; const bf16_t* GB; bf16_t* MG;
    __device__ __forceinline__ void operator()(f32x4 (&acc)[2][2][4][2], const Unit& u, int wr, int wc, int fr, int fq) const {
        const bool second = u.ko != 0; constexpr float TINY = 8.67361738e-19f;
        const unsigned rowoff = (unsigned)((u.pm * BM + wr * 64 + fr) * 1024 + u.pn * BM + wc * 32 + 8 * fq);
#define EB_OFF(ai, bj, m) (rowoff + (unsigned)(((ai) * HALF + (m) * 16) * 1024 + (bj) * HALF))
#define EB_UNPACK(dst, src_) const float dst[8] = {bf_lo((src_).x), bf_hi((src_).x), bf_lo((src_).y), bf_hi((src_).y), bf_lo((src_).z), bf_hi((src_).z), bf_lo((src_).w), bf_hi((src_).w)}
        if (!second) {
#pragma unroll
            for (int ai = 0; ai < 2; ++ai)
#pragma unroll
                for (int bj = 0; bj < 2; ++bj) {
                    u32x4 gbv[4], gav[4];
#pragma unroll
                    for (int m = 0; m < 4; ++m) { gbv[m] = *(const u32x4*)(GB + EB_OFF(ai, bj, m)); gav[m] = *(const u32x4*)(GA + EB_OFF(ai, bj, m)); }
#pragma unroll
                    for (int m = 0; m < 4; ++m) { EB_UNPACK(gb, gbv[m]); EB_UNPACK(ga, gav[m]);
#pragma unroll
                        for (int e = 0; e < 4; ++e) { acc[ai][bj][m][0][e] *= ga[e] * __builtin_amdgcn_rcpf(fmaxf(gb[e], TINY)); acc[ai][bj][m][1][e] *= ga[4 + e] * __builtin_amdgcn_rcpf(fmaxf(gb[4 + e], TINY)); } }
                }
        } else {
#pragma unroll
            for (int ai = 0; ai < 2; ++ai) {
                u32x4 gbv[2][4];
#pragma unroll
                for (int bj = 0; bj < 2; ++bj)
#pragma unroll
                    for (int m = 0; m < 4; ++m) gbv[bj][m] = *(const u32x4*)(GB + EB_OFF(ai, bj, m));
#pragma unroll
                for (int bj = 0; bj < 2; ++bj)
#pragma unroll
                    for (int m = 0; m < 4; ++m) { EB_UNPACK(g0, gbv[bj][m]); float gb[8];
#pragma unroll
                        for (int e = 0; e < 8; ++e) gb[e] = fmaxf(g0[e], TINY);
                        const f32x4 y0 = acc[ai][bj][m][0], y1 = acc[ai][bj][m][1];
                        u32x4 w; w.x = cvt_pk_bf16(gb[0] * y0[0], gb[1] * y0[1]); w.y = cvt_pk_bf16(gb[2] * y0[2], gb[3] * y0[3]); w.z = cvt_pk_bf16(gb[4] * y1[0], gb[5] * y1[1]); w.w = cvt_pk_bf16(gb[6] * y1[2], gb[7] * y1[3]);
                        *(u32x4*)(MG + EB_OFF(ai, bj, m)) = w; }
            }
        }
#undef EB_OFF
#undef EB_UNPACK
    }
};

template <bool WRITE_A, int COEF2, bool RIN_BF16, bool ROUT_BF16> struct EpiResid {
    static constexpr bool PERM = true, AFTER_DRAIN = true, PREFETCH = false, CHAIN = false;
    static constexpr float coef = 0.5f * COEF2; static constexpr int modld = 9216;
    const void* xin; void* xout; const float* gate;
    bf16_t* Aout; const float* gnorm; const float* sc; float* rss_out;
    __device__ __forceinline__ void fused(f32x4 (&acc)[2][2][4][2], const Unit& u, int wr, int wc, int fr, int fq, PG8_LAS unsigned char* lds, int wid, int lane) const {
        const int b = u.pm >> 5, col0 = u.pn * BM + wc * 32 + 8 * fq;
        float ss[2][4];
#pragma unroll
        for (int ai = 0; ai < 2; ++ai)
#pragma unroll
            for (int m = 0; m < 4; ++m) ss[ai][m] = 0.f;
        auto stage = [&](int bjsel) {
#pragma unroll 1
            for (int i = 0; i < 16; ++i) { const int rr = wid * 32 + 2 * i + (lane >> 5), g = (lane & 31) ^ (rr & 31);
                const char* src = RIN_BF16 ? (const char*)xin + ((size_t)(u.pm * BM + rr) * 1024 + u.pn * BM) * 2 + g * 16
                                           : (const char*)xin + ((size_t)(u.pm * BM + rr) * 1024 + u.pn * BM + bjsel * HALF) * 4 + g * 16;
                __builtin_amdgcn_global_load_lds((const unsigned*)src, (PG8_LAS unsigned*)(lds + (wid * 32 + 2 * i) * 512), 16, 0, 0); }
        };
        if constexpr (RIN_BF16) { stage(0); asm volatile("s_waitcnt vmcnt(0)" ::: "memory"); __builtin_amdgcn_s_barrier(); asm volatile("" ::: "memory"); }
#pragma unroll
        for (int bj = 0; bj < 2; ++bj) {
            if constexpr (!RIN_BF16) { if (bj) { asm volatile("s_waitcnt lgkmcnt(0)" ::: "memory"); __builtin_amdgcn_s_barrier(); }
                stage(bj); asm volatile("s_waitcnt vmcnt(0)" ::: "memory"); __builtin_amdgcn_s_barrier(); asm volatile("" ::: "memory"); }
            f32x4 gt[2], gvv[2];
#pragma unroll
            for (int n = 0; n < 2; ++n) { const int c = col0 + bj * HALF + 4 * n; gt[n] = *(const f32x4*)(gate + (size_t)b * modld + c) * coef;
                if (WRITE_A) gvv[n] = *(const f32x4*)(gnorm + c) * (*(const f32x4*)(sc + (size_t)b * modld + c) + 1.0f); }
#pragma unroll
            for (int ai = 0; ai < 2; ++ai) {
                f32x4 xi[4][2];
#pragma unroll
                for (int m = 0; m < 4; ++m) { const int rr = ai * HALF + wr * 64 + m * 16 + fr;
                    if constexpr (RIN_BF16) { const u32x4 w = *(const PG8_LAS u32x4*)(lds + rr * 512 + (((bj * 16 + wc * 4 + fq) ^ (rr & 31)) << 4));
                        xi[m][0] = (f32x4){bf_lo(w.x), bf_hi(w.x), bf_lo(w.y), bf_hi(w.y)}; xi[m][1] = (f32x4){bf_lo(w.z), bf_hi(w.z), bf_lo(w.w), bf_hi(w.w)}; }
                    else {
#pragma unroll
                        for (int n = 0; n < 2; ++n) xi[m][n] = *(const PG8_LAS f32x4*)(lds + rr * 512 + (((wc * 8 + fq * 2 + n) ^ (rr & 31)) << 4)); } }
#pragma unroll
                for (int m = 0; m < 4; ++m) {
                    const int row = u.pm * BM + ai * HALF + wr * 64 + m * 16 + fr; const size_t off = (size_t)row * 1024 + col0 + bj * HALF; float s = 0.f;
                    f32x4 xo[2];
#pragma unroll
                    for (int n = 0; n < 2; ++n) { xo[n] = xi[m][n] + gt[n] * acc[ai][bj][m][n];
                        if constexpr (!ROUT_BF16) *(f32x4*)((float*)xout + off + 4 * n) = xo[n];
                        if (WRITE_A) s += (xo[n][0] * xo[n][0] + xo[n][1] * xo[n][1]) + (xo[n][2] * xo[n][2] + xo[n][3] * xo[n][3]); }
                    if constexpr (ROUT_BF16) { u32x4 w; w.x = cvt_pk_bf16(xo[0][0], xo[0][1]); w.y = cvt_pk_bf16(xo[0][2], xo[0][3]); w.z = cvt_pk_bf16(xo[1][0], xo[1][1]); w.w = cvt_pk_bf16(xo[1][2], xo[1][3]); *(u32x4*)((bf16_t*)xout + off) = w; }
                    if (WRITE_A) { const f32x4 a0 = xo[0] * gvv[0], a1 = xo[1] * gvv[1]; u32x4 w; w.x = cvt_pk_bf16(a0[0], a0[1]); w.y = cvt_pk_bf16(a0[2], a0[3]); w.z = cvt_pk_bf16(a1[0], a1[1]); w.w = cvt_pk_bf16(a1[2], a1[3]);
                        *(u32x4*)(Aout + off) = w; ss[ai][m] += s; } }
                asm volatile("" ::: "memory"); }
        }
        if (WRITE_A) {
            asm volatile("s_waitcnt lgkmcnt(0)" ::: "memory"); __builtin_amdgcn_s_barrier(); asm volatile("" ::: "memory");
            PG8_LAS float* P = (PG8_LAS float*)lds;
#pragma unroll
            for (int ai = 0; ai < 2; ++ai)
#pragma unroll
                for (int m = 0; m < 4; ++m) { float s = ss[ai][m]; s += __shfl_xor(s, 16); s += __shfl_xor(s, 32); if (fq == 0) P[(ai * HALF + wr * 64 + m * 16 + fr) * 4 + wc] = s; }
            asm volatile("s_waitcnt lgkmcnt(0)" ::: "memory"); __builtin_amdgcn_s_barrier(); asm volatile("" ::: "memory");
            const int t = wid * 64 + lane;
            if (t < 256) { const PG8_LAS float* p = P + t * 4; rss_out[(size_t)(u.pm * BM + t) * 4 + u.pn] = (p[0] + p[1]) + (p[2] + p[3]); }
        }
    }
};

template <class Epi, class Sched, bool ALIGN_EPI = false, bool SP2 = false>
__device__ __forceinline__ void gemm_phase(PG8_LAS unsigned char* lds, const Gemm g, const Sched S, const Epi E, const int wid  ) {
    const int lane = MK_LANE(), tid = wid * 64 + lane, wr = wid >> 2, wc = wid & 3, fr = lane & 15, fq = lane >> 4;
    const int K = g.K, nt = (g.KL ? g.KL : K) / BK;
    unsigned voffA[2], voffB[2];
#pragma unroll
    for (int i = 0; i < 2; ++i) { int R, C; stage_rc(tid * 16 + i * 8192, R, C); const int Rb = Epi::PERM ? ((R & ~31) + perm32(R & 31)) : R;
        voffA[i] = (unsigned)(R * K + C) * 2u; voffB[i] = (unsigned)(Rb * K + C) * 2u; }
    const size_t kstep = (size_t)(BK * 2);
    const size_t hstep = (size_t)HALF * K * 2;
    const size_t tstep = 2 * hstep;
    const unsigned ldsw = (unsigned)wid * 1024u;
    const int aoff = lds_byte(wr * 64 + fr, fq * 8), boff = lds_byte(wc * 32 + fr, fq * 8);
#define PG8_SA(b, h) (((b) * 2 + (h)) * HTB)
#define PG8_SB(b, h) ((4 + (b) * 2 + (h)) * HTB)
#define PG8_STAGE(bufoff, gbase, voff) do { _Pragma("unroll") for (int _i = 0; _i < 2; ++_i) \
        __builtin_amdgcn_global_load_lds((const unsigned*)((const char*)(gbase) + (voff)[_i]), (PG8_LAS unsigned*)(lds + (bufoff) + ldsw + _i * 8192), 16, 0, 0); } while (0)
#define PG8_LDA(dst, b, h) do { _Pragma("unroll") for (int m = 0; m < 4; ++m) _Pragma("unroll") for (int k = 0; k < 2; ++k) dst[m][k] = *(const PG8_LAS bf16x8*)(lds + PG8_SA(b, h) + aoff + m * 2048 + k * 1024); } while (0)
#define PG8_LDB(dst, b, h) do { _Pragma("unroll") for (int n = 0; n < 2; ++n) _Pragma("unroll") for (int k = 0; k < 2; ++k) dst[n][k] = *(const PG8_LAS bf16x8*)(lds + PG8_SB(b, h) + boff + n * 2048 + k * 1024); } while (0)
#define PG8_MMA(ai, bj, At, Bt) do { __builtin_amdgcn_s_setprio(1); _Pragma("unroll") for (int m = 0; m < 4; ++m) _Pragma("unroll") for (int n = 0; n < 2; ++n) _Pragma("unroll") for (int k = 0; k < 2; ++k) \
        acc[ai][bj][m][n] = __builtin_amdgcn_mfma_f32_16x16x32_bf16(Bt[n][k], At[m][k], acc[ai][bj][m][n], 0, 0, 0); __builtin_amdgcn_s_setprio(0); } while (0)
#define PG8_WAIT_V(n) asm volatile("s_waitcnt vmcnt(" #n ")" ::: "memory")
#define PG8_WAIT_L(n) asm volatile("s_waitcnt lgkmcnt(" #n ")" ::: "memory")
#define PG8_BAR __builtin_amdgcn_s_barrier()
#define PG8_SCHED __builtin_amdgcn_sched_barrier(0)
    Unit cur, nxt; int ui = 0;
    if (!S.next(0, cur)) return;
    f32x4 acc[2][2][4][2];
#pragma unroll
    for (int a = 0; a < 2; ++a)
#pragma unroll
        for (int b = 0; b < 2; ++b)
#pragma unroll
            for (int m = 0; m < 4; ++m)
#pragma unroll
                for (int n = 0; n < 2; ++n) acc[a][b][m][n] = (f32x4){0.f, 0.f, 0.f, 0.f};
    bf16x8 At[4][2], B0[2][2], B1[2][2];
    const char* cA = (const char*)g.A + (size_t)cur.pm * tstep + cur.ko; const char* cB = (const char*)g.Bt + (size_t)cur.pn * tstep + cur.ko;
    S.a_ready(cur);
    if constexpr (SP2) {
        PG8_STAGE(PG8_SB(0, 0), cB, voffB); PG8_STAGE(PG8_SB(0, 1), cB + hstep, voffB); PG8_STAGE(PG8_SA(0, 0), cA, voffA); PG8_STAGE(PG8_SA(0, 1), cA + hstep, voffA);
        if (wr == 1) PG8_BAR;
        PG8_WAIT_V(2); PG8_BAR;
        PG8_STAGE(PG8_SB(1, 0), cB + kstep, voffB); PG8_STAGE(PG8_SA(1, 0), cA + kstep, voffA); PG8_STAGE(PG8_SB(1, 1), cB + hstep + kstep, voffB);
        PG8_WAIT_V(6); PG8_BAR;
    } else {
        PG8_STAGE(PG8_SB(0, 0), cB, voffB); PG8_STAGE(PG8_SA(0, 0), cA, voffA); PG8_STAGE(PG8_SB(0, 1), cB + hstep, voffB); PG8_STAGE(PG8_SA(0, 1), cA + hstep, voffA);
        if (wr == 1) PG8_BAR;
        PG8_WAIT_V(4); PG8_BAR;
        PG8_STAGE(PG8_SB(1, 0), cB + kstep, voffB); PG8_STAGE(PG8_SA(1, 0), cA + kstep, voffA); PG8_STAGE(PG8_SB(1, 1), cB + hstep + kstep, voffB);
        PG8_WAIT_V(6); PG8_BAR;
    }
    for (;;) {
        if constexpr (Epi::PREFETCH) E.prefetch(cur, lds + STAGE_BYTES + (ui & 1) * 5120, wid, lane);
        const bool has_next = S.next(ui + 1, nxt);
        const char* nA = has_next ? (const char*)g.A + (size_t)nxt.pm * tstep + nxt.ko : cA; const char* nB = has_next ? (const char*)g.Bt + (size_t)nxt.pn * tstep + nxt.ko : cB;
        for (int t = 0; t < nt; t += 2) {
            const bool last = (t == nt - 2);
            const char* a1 = cA + (size_t)(t + 1) * kstep;
            const char* a2 = last ? nA : cA + (size_t)(t + 2) * kstep; const char* b2 = last ? nB : cB + (size_t)(t + 2) * kstep;
            const char* a3 = a2 + kstep; const char* b3 = b2 + kstep;
            if (last && has_next) S.a_ready(nxt);
            if constexpr (SP2) {
            PG8_LDB(B0, 0, 0); PG8_LDB(B1, 0, 1); PG8_SCHED; PG8_LDA(At, 0, 0); PG8_STAGE(PG8_SA(1, 1), a1 + hstep, voffA);
            PG8_WAIT_V(8); PG8_WAIT_L(0); PG8_BAR; PG8_MMA(0, 0, At, B0); PG8_MMA(0, 1, At, B1); PG8_BAR; PG8_SCHED;
            PG8_LDA(At, 0, 1); PG8_STAGE(PG8_SB(0, 0), b2, voffB); PG8_STAGE(PG8_SB(0, 1), b2 + hstep, voffB); PG8_STAGE(PG8_SA(0, 0), a2, voffA);
            PG8_WAIT_V(8); PG8_WAIT_L(0); PG8_BAR; PG8_MMA(1, 0, At, B0); PG8_MMA(1, 1, At, B1); PG8_BAR; PG8_SCHED;
            PG8_LDB(B0, 1, 0); PG8_LDB(B1, 1, 1); PG8_SCHED; PG8_LDA(At, 1, 0); PG8_STAGE(PG8_SA(0, 1), a2 + hstep, voffA);
            PG8_WAIT_V(8); PG8_WAIT_L(0); PG8_BAR; PG8_MMA(0, 0, At, B0); PG8_MMA(0, 1, At, B1); PG8_BAR; PG8_SCHED;
            PG8_LDA(At, 1, 1); PG8_STAGE(PG8_SB(1, 0), b3, voffB); PG8_STAGE(PG8_SB(1, 1), b3 + hstep, voffB); PG8_STAGE(PG8_SA(1, 0), a3, voffA);
            PG8_WAIT_V(8); PG8_WAIT_L(0); PG8_BAR; PG8_MMA(1, 0, At, B0); PG8_MMA(1, 1, At, B1); PG8_BAR; PG8_SCHED;
            } else {
            PG8_LDB(B0, 0, 0); PG8_SCHED; PG8_LDA(At, 0, 0); PG8_STAGE(PG8_SA(1, 1), a1 + hstep, voffA);
            PG8_WAIT_L(8); PG8_BAR; PG8_WAIT_L(0); PG8_MMA(0, 0, At, B0); PG8_BAR; PG8_SCHED;
            PG8_LDB(B1, 0, 1); PG8_STAGE(PG8_SB(0, 0), b2, voffB);
            PG8_BAR; PG8_WAIT_L(0); PG8_MMA(0, 1, At, B1); PG8_BAR;
            PG8_LDA(At, 0, 1); PG8_STAGE(PG8_SA(0, 0), a2, voffA);
            PG8_BAR; PG8_WAIT_L(0); PG8_MMA(1, 0, At, B0); PG8_BAR; PG8_SCHED;
            PG8_STAGE(PG8_SB(0, 1), b2 + hstep, voffB);
            PG8_WAIT_V(6); PG8_BAR; PG8_MMA(1, 1, At, B1); PG8_BAR;
            PG8_LDB(B0, 1, 0); PG8_SCHED; PG8_LDA(At, 1, 0); PG8_STAGE(PG8_SA(0, 1), a2 + hstep, voffA);
            PG8_WAIT_L(8); PG8_BAR; PG8_WAIT_L(0); PG8_MMA(0, 0, At, B0); PG8_BAR; PG8_SCHED;
            PG8_LDB(B1, 1, 1); PG8_STAGE(PG8_SB(1, 0), b3, voffB);
            PG8_BAR; PG8_WAIT_L(0); PG8_MMA(0, 1, At, B1); PG8_BAR;
            PG8_LDA(At, 1, 1); PG8_STAGE(PG8_SA(1, 0), a3, voffA);
            PG8_BAR; PG8_WAIT_L(0); PG8_MMA(1, 0, At, B0); PG8_BAR; PG8_SCHED;
            PG8_STAGE(PG8_SB(1, 1), b3 + hstep, voffB);
            PG8_WAIT_V(6); PG8_BAR; PG8_MMA(1, 1, At, B1); PG8_BAR;
            }
        }
        if constexpr (ALIGN_EPI) { if (wr == 0) PG8_BAR; }
        if constexpr (!Epi::AFTER_DRAIN) { if constexpr (Epi::PREFETCH) E(acc, cur, wr, wc, fr, fq, lds + STAGE_BYTES + (ui & 1) * 5120); else E(acc, cur, wr, wc, fr, fq); S.done(cur); }
        if (!has_next) break;
        if (!Epi::CHAIN || nxt.ko == 0) {
#pragma unroll
        for (int a = 0; a < 2; ++a)
#pragma unroll
            for (int b = 0; b < 2; ++b)
#pragma unroll
                for (int m = 0; m < 4; ++m)
#pragma unroll
                    for (int n = 0; n < 2; ++n) acc[a][b][m][n] = (f32x4){0.f, 0.f, 0.f, 0.f};
        }
        cur = nxt; cA = nA; cB = nB; ++ui;
        if constexpr (ALIGN_EPI) { if (wr == 1) PG8_BAR; }
    }
    PG8_WAIT_V(0);
    if constexpr (!ALIGN_EPI) { if (wr == 0) PG8_BAR; }
    PG8_BAR;
    if constexpr (Epi::AFTER_DRAIN) { E.fused(acc, cur, wr, wc, fr, fq, lds, wid, lane); S.done(cur); }
#undef PG8_SA
#undef PG8_SB
#undef PG8_STAGE
#undef PG8_LDA
#undef PG8_LDB
#undef PG8_MMA
#undef PG8_WAIT_V
#undef PG8_WAIT_L
#undef PG8_BAR
#undef PG8_SCHED
}
}

#ifndef PG8_SP2
#define PG8_SP2 true
#endif
#ifndef PG8_ALIGN
#define PG8_ALIGN true
#endif
namespace att {
using bf16x8 = __attribute__((ext_vector_type(8))) short;
using s16x4  = __attribute__((ext_vector_type(4))) short;
using f32x16 = __attribute__((ext_vector_type(16))) float;
using u32x4  = __attribute__((ext_vector_type(4))) unsigned;
typedef unsigned short bf16_t;
constexpr int NW = 8, QBLK = 32, KVBLK = 64;
#define ATT_SBAR() __builtin_amdgcn_sched_barrier(0)
__device__ __forceinline__ int crow(int r, int hi) { return (r & 3) + 8 * (r >> 2) + 4 * hi; }
__device__ __forceinline__ unsigned cvtpk(float lo, float hi) { unsigned r; asm volatile("v_cvt_pk_bf16_f32 %0, %1, %2" : "=v"(r) : "v"(lo), "v"(hi)); return r; }
__device__ __forceinline__ float bf2f(bf16_t h) { return __uint_as_float((unsigned)h << 16); }
__device__ __forceinline__ int v_rd_base(int lane) { return ((lane & 3) << 3) | (((lane >> 2) & 3) << 6) | (((lane >> 4) & 1) << 5) | (((lane >> 5) & 1) << 8); }
template <bool WIN> __device__ __forceinline__ void wmask(f32x16& p0, f32x16& p1, int qpos, int kbase, int hi) {
  if constexpr (WIN) {
#pragma unroll
    for (int r = 0; r < 16; ++r) { const int k0 = kbase + crow(r, hi) - qpos; if (k0 > 128 || k0 < -128) p0[r] = -INFINITY; if (k0 + 32 > 128 || k0 + 32 < -128) p1[r] = -INFINITY; }
  }
}
__device__ __forceinline__ void exp_half(f32x16& p) {
#pragma unroll
  for (int r = 0; r < 16; ++r) p[r] = __builtin_amdgcn_exp2f(p[r]);
}
constexpr int NSLOT = 3, LDS_V = 0, LDS_K = NSLOT * KVBLK * 128 * 2, LDS_WS = LDS_K + 4 * KVBLK * 64 * 2, LDS_STG = LDS_WS + NW * 64 * 4, ATT_LDS_BYTES = LDS_STG + NW * 8192;
__device__ __forceinline__ void dma16(unsigned m0v, unsigned voff, __amdgpu_buffer_rsrc_t rs, unsigned soff) {
  unsigned keep;
  asm volatile("s_nop 4\n\ts_mov_b32 %0, m0\n\ts_mov_b32 m0, %1\n\ts_nop 0\n\tbuffer_load_dwordx4 %2, %3, %4 offen lds\n\ts_mov_b32 m0, %0" : "=&s"(keep) : "s"(m0v), "v"(voff), "s"(rs), "s"(soff) : "memory");
}
__device__ __forceinline__ void dma16x2(unsigned m0a, unsigned va, unsigned sa, unsigned m0b, unsigned vb, unsigned sb, __amdgpu_buffer_rsrc_t rs) {
  unsigned keep;
  asm volatile("s_nop 4\n\ts_mov_b32 %0, m0\n\ts_mov_b32 m0, %1\n\ts_nop 0\n\tbuffer_load_dwordx4 %2, %7, %3 offen lds\n\ts_mov_b32 m0, %4\n\ts_nop 0\n\tbuffer_load_dwordx4 %5, %7, %6 offen lds\n\ts_mov_b32 m0, %0"
               : "=&s"(keep) : "s"(m0a), "v"(va), "s"(sa), "s"(m0b), "v"(vb), "s"(sb), "s"(rs) : "memory");
}
__device__ __forceinline__ void dma16x3(unsigned m0a, unsigned va, unsigned sa, unsigned m0b, unsigned vb, unsigned m0c, unsigned vc, unsigned sbc, __amdgpu_buffer_rsrc_t rs) {
  unsigned keep;
  asm volatile("s_nop 4\n\ts_mov_b32 %0, m0\n\ts_mov_b32 m0, %1\n\ts_nop 0\n\tbuffer_load_dwordx4 %2, %9, %3 offen lds\n\ts_mov_b32 m0, %4\n\ts_nop 0\n\tbuffer_load_dwordx4 %5, %9, %8 offen lds\n\ts_mov_b32 m0, %6\n\ts_nop 0\n\tbuffer_load_dwordx4 %7, %9, %8 offen lds\n\ts_mov_b32 m0, %0"
               : "=&s"(keep) : "s"(m0a), "v"(va), "s"(sa), "s"(m0b), "v"(vb), "s"(m0c), "v"(vc), "s"(sbc), "s"(rs) : "memory");
}
typedef __attribute__((address_space(3))) const char* lds_cptr;
typedef short v4i16_t __attribute__((ext_vector_type(4)));
__device__ __forceinline__ s16x4 vtr(lds_cptr p) { return __builtin_bit_cast(s16x4, __builtin_amdgcn_ds_read_tr16_b64_v4i16((__attribute__((address_space(3))) v4i16_t*)p)); }
__device__ __forceinline__ bf16x8 kld(lds_cptr p) { return *(const __attribute__((address_space(3))) bf16x8*)p; }
__device__ __forceinline__ void attn_pass_d4(__amdgpu_buffer_rsrc_t rs, unsigned Qb, unsigned ldq, unsigned Kh, unsigned ldk, unsigned Vh, unsigned ldv, int seq, float negm_s, char* lds, f32x16 (&o)[4], float& l_out, const int wid) {
  constexpr int SLOTV = KVBLK * 128 * 2, SLOTK = KVBLK * 64 * 2;
  const int lane = MK_LANE(), r32 = lane & 31, hi = lane >> 5;
  const unsigned lds0 = (unsigned)(uintptr_t)lds;
  bf16x8 qr[4];
  { const unsigned qoff = (unsigned)(wid * QBLK + r32) * ldq + hi * 16;
#pragma unroll
    for (int d0 = 0; d0 < 4; ++d0) { const u32x4 w = __builtin_amdgcn_raw_buffer_load_b128(rs, qoff + d0 * 32, Qb, 0); qr[d0] = __builtin_bit_cast(bf16x8, w); } }
  f32x16 negm; { float ns = negm_s; asm volatile("" : "+v"(ns));
#pragma unroll
  for (int r = 0; r < 16; ++r) negm[r] = ns; }
  asm volatile("" : "+v"(negm));
#pragma unroll
  for (int d = 0; d < 4; ++d) o[d] = f32x16{};
  float l_reg = 0.f;
  const unsigned kvoff = (unsigned)lane * ldk + wid * 16;
  unsigned vvoff0, vvoff1;
  { const int ob = (wid * 2 + 0) * 1024 + lane * 16, st = ob >> 9, k = (st / 4) * 8 + ((ob >> 6) & 7), c = (st % 4) * 32 + ((ob >> 4) & 3) * 8; vvoff0 = (unsigned)k * ldv + c * 2; }
  { const int ob = (wid * 2 + 1) * 1024 + lane * 16, st = ob >> 9, k = (st / 4) * 8 + ((ob >> 6) & 7), c = (st % 4) * 32 + ((ob >> 4) & 3) * 8; vvoff1 = (unsigned)k * ldv + c * 2; }
  const unsigned kdst = lds0 + LDS_K + wid * 1024, vdst = lds0 + LDS_V + wid * 2048;
  const lds_cptr kp0 = (lds_cptr)lds + LDS_K + hi * 1024 + r32 * 16;
  const lds_cptr vp0 = (lds_cptr)lds + LDS_V + v_rd_base(lane);
  const int NT = seq / KVBLK;
#define D4_PIN(x) asm volatile("" : "+v"(x))
#define D4_MFMA(a, b, c) __builtin_amdgcn_mfma_f32_32x32x16_bf16(a, b, c, 0, 0, 0)
#define D4_WAIT_BAR(N) asm volatile("s_waitcnt vmcnt(" #N ") lgkmcnt(0)\n\ts_barrier" ::: "memory")
#define D4_KSLOT(t) ((unsigned)((t) & 3) * SLOTK)
#define D4_DMA_K(t) dma16(kdst + D4_KSLOT(t), kvoff, rs, Kh + (unsigned)(t) * (KVBLK * ldk))
#define D4_DMA_V(t, sl) dma16x2(vdst + (sl), vvoff0, Vh + (unsigned)(t) * (KVBLK * ldv), vdst + (sl) + 1024, vvoff1, Vh + (unsigned)(t) * (KVBLK * ldv), rs)
#define D4_DMA_KV(tk, tv, sl) dma16x3(kdst + D4_KSLOT(tk), kvoff, Kh + (unsigned)(tk) * (KVBLK * ldk), vdst + (sl), vvoff0, vdst + (sl) + 1024, vvoff1, Vh + (unsigned)(tv) * (KVBLK * ldv), rs)
  f32x16 pA0, pA1, pB0, pB1; bf16x8 kf[4]; s16x4 vl[5], vh[5]; u32x4 pw0, pw1, pw2, pw3;
#define D4_KRD(buf, kp, j) kf[buf] = kld((kp) + ((j) >> 1) * 2048 + ((j) & 1) * 512)
#define D4_VO(f, half) (((f) & 3) * 512 + (2 * ((f) >> 2) + (half)) * 2048)
#define D4_VRD(f) do { vl[(f) % 5] = vtr(vp_ + D4_VO(f, 0)); vh[(f) % 5] = vtr(vp_ + D4_VO(f, 1)); } while (0)
#define D4_VFR(f) (bf16x8){vl[(f) % 5][0], vl[(f) % 5][1], vl[(f) % 5][2], vl[(f) % 5][3], vh[(f) % 5][0], vh[(f) % 5][1], vh[(f) % 5][2], vh[(f) % 5][3]}
#define D4_PKW(P, i) cvtpk(P[i], P[i + 1])
#define D4_PAF(k) __builtin_bit_cast(bf16x8, pw##k)
  D4_DMA_K(0); D4_DMA_V(0, 0); D4_DMA_K(1); D4_DMA_K(2); D4_DMA_KV(3, 1, SLOTV);
  D4_WAIT_BAR(3);
  { const lds_cptr kp_ = kp0;
    D4_KRD(0, kp_, 0); D4_KRD(1, kp_, 1); D4_KRD(2, kp_, 2); D4_KRD(3, kp_, 3);
    pA0 = D4_MFMA(kf[0], qr[0], negm); pA1 = D4_MFMA(kf[1], qr[0], negm); pA0 = D4_MFMA(kf[2], qr[1], pA0); pA1 = D4_MFMA(kf[3], qr[1], pA1);
    D4_KRD(0, kp_, 4); D4_KRD(1, kp_, 5); D4_KRD(2, kp_, 6); D4_KRD(3, kp_, 7);
    pA0 = D4_MFMA(kf[0], qr[2], pA0); pA1 = D4_MFMA(kf[1], qr[2], pA1); pA0 = D4_MFMA(kf[2], qr[3], pA0); pA1 = D4_MFMA(kf[3], qr[3], pA1);
    exp_half(pA0); exp_half(pA1);
    const lds_cptr kn_ = kp0 + SLOTK;
    D4_KRD(0, kn_, 0); D4_KRD(1, kn_, 1); D4_KRD(2, kn_, 2); D4_KRD(3, kn_, 3); }
  D4_WAIT_BAR(3);
  unsigned sl_prev = 0, sl_cur = SLOTV, sl_next = 2 * SLOTV;
#define D4_ROT() do { sl_prev = sl_cur; sl_cur = sl_next; sl_next = (sl_next == 2u * SLOTV) ? 0u : sl_next + SLOTV; } while (0)
#define D4_EX2(X, i) do { X[i] = __builtin_amdgcn_exp2f(X[i]); X[(i) + 1] = __builtin_amdgcn_exp2f(X[(i) + 1]); } while (0)
#define D4_GAPA(MF, LD, a0, a1, a2, a3, W0, W1, PW) do { MF; LD; sacc += a0; sacc += a1; sacc += a2; sacc += a3; W0; W1; D4_PIN(PW); D4_PIN(sacc); ATT_SBAR(); } while (0)
#define D4_GAPB(i, X, xi, LD) do { o[(i) & 3] = D4_MFMA(D4_PAFI(i), D4_VFR(i), o[(i) & 3]); LD; D4_EX2(X, xi); D4_PIN(X); ATT_SBAR(); } while (0)
#define D4_PAFI(i) (((i) >> 2) == 0 ? D4_PAF(0) : ((i) >> 2) == 1 ? D4_PAF(1) : ((i) >> 2) == 2 ? D4_PAF(2) : D4_PAF(3))
#define D4_PHA(C0, C1, P0, P1, t, VR) do { ATT_SBAR(); \
    const lds_cptr vp_ = vp0 + sl_prev; const lds_cptr kp_ = kp0 + D4_KSLOT(t); \
    float sacc = P0[0] + P0[1]; ATT_SBAR(); \
    D4_GAPA(C0 = D4_MFMA(kf[0], qr[0], negm), D4_KRD(0, kp_, 4), P0[2], P0[3], P0[4], P0[5],     pw0[0] = D4_PKW(P0, 0),  pw0[1] = D4_PKW(P0, 2),  pw0); \
    D4_GAPA(C1 = D4_MFMA(kf[1], qr[0], negm), D4_KRD(1, kp_, 5), P0[6], P0[7], P0[8], P0[9],     pw0[2] = D4_PKW(P0, 4),  pw0[3] = D4_PKW(P0, 6),  pw0); \
    D4_GAPA(C0 = D4_MFMA(kf[2], qr[1], C0),   D4_KRD(2, kp_, 6), P0[10], P0[11], P0[12], P0[13], pw1[0] = D4_PKW(P0, 8),  pw1[1] = D4_PKW(P0, 10), pw1); \
    D4_GAPA(C1 = D4_MFMA(kf[3], qr[1], C1),   D4_KRD(3, kp_, 7), P0[14], P0[15], P1[0], P1[1],   pw1[2] = D4_PKW(P0, 12), pw1[3] = D4_PKW(P0, 14), pw1); \
    D4_GAPA(C0 = D4_MFMA(kf[0], qr[2], C0),   do { if (VR) D4_VRD(0); } while (0), P1[2], P1[3], P1[4], P1[5],     pw2[0] = D4_PKW(P1, 0),  pw2[1] = D4_PKW(P1, 2),  pw2); \
    D4_GAPA(C1 = D4_MFMA(kf[1], qr[2], C1),   do { if (VR) D4_VRD(1); } while (0), P1[6], P1[7], P1[8], P1[9],     pw2[2] = D4_PKW(P1, 4),  pw2[3] = D4_PKW(P1, 6),  pw2); \
    D4_GAPA(C0 = D4_MFMA(kf[2], qr[3], C0),   do { if (VR) D4_VRD(2); } while (0), P1[10], P1[11], P1[12], P1[13], pw3[0] = D4_PKW(P1, 8),  pw3[1] = D4_PKW(P1, 10), pw3); \
    D4_GAPA(C1 = D4_MFMA(kf[3], qr[3], C1),   do { if (VR) { D4_VRD(3); D4_VRD(4); } } while (0), P1[14], P1[15], 0.f, 0.f, pw3[2] = D4_PKW(P1, 12), pw3[3] = D4_PKW(P1, 14), pw3); \
    l_reg += sacc; } while (0)
#define D4_PHB(C0, C1, t, GK, GV, GL, PRE) do { ATT_SBAR(); \
    const lds_cptr vp_ = vp0 + sl_prev; const lds_cptr kn_ = kp0 + D4_KSLOT((t) + 1); \
    if (PRE) { D4_VRD(0); D4_VRD(1); D4_VRD(2); D4_VRD(3); D4_VRD(4); ATT_SBAR(); } \
    D4_GAPB(0, C0, 0, D4_VRD(5));   D4_GAPB(1, C0, 2, D4_VRD(6));   D4_GAPB(2, C0, 4, D4_VRD(7));    D4_GAPB(3, C0, 6, D4_VRD(8)); \
    D4_GAPB(4, C0, 8, D4_VRD(9));   D4_GAPB(5, C0, 10, D4_VRD(10)); D4_GAPB(6, C0, 12, D4_VRD(11));  D4_GAPB(7, C0, 14, do { D4_VRD(12); if (GL) D4_KRD(0, kn_, 0); } while (0)); \
    D4_GAPB(8, C1, 0, do { D4_VRD(13); if ((GK) && (GV)) D4_DMA_KV((t) + 3, (t) + 1, sl_next); else if (GV) D4_DMA_V((t) + 1, sl_next); } while (0)); \
    D4_GAPB(9, C1, 2, do { D4_VRD(14); if (GL) D4_KRD(1, kn_, 1); } while (0));  D4_GAPB(10, C1, 4, do { D4_VRD(15); if (GL) D4_KRD(2, kn_, 2); } while (0));  D4_GAPB(11, C1, 6, do { if (GL) D4_KRD(3, kn_, 3); } while (0)); \
    D4_GAPB(12, C1, 8, (void)0); D4_GAPB(13, C1, 10, (void)0); D4_GAPB(14, C1, 12, (void)0); D4_GAPB(15, C1, 14, (void)0); \
    } while (0)
  if (wid < 4) {
    int t = 1;
    for (; t + 4 < NT; t += 2) {
      D4_PHA(pB0, pB1, pA0, pA1, t, true);     D4_PHB(pB0, pB1, t, true, true, true, false);     D4_WAIT_BAR(3); D4_ROT();
      D4_PHA(pA0, pA1, pB0, pB1, t + 1, true); D4_PHB(pA0, pA1, t + 1, true, true, true, false); D4_WAIT_BAR(3); D4_ROT();
    }
    D4_PHA(pB0, pB1, pA0, pA1, t, true);     D4_PHB(pB0, pB1, t, false, true, true, false);      D4_WAIT_BAR(2); D4_ROT();
    D4_PHA(pA0, pA1, pB0, pB1, t + 1, true); D4_PHB(pA0, pA1, t + 1, false, true, true, false);  D4_WAIT_BAR(0); D4_ROT();
    D4_PHA(pB0, pB1, pA0, pA1, t + 2, true); D4_PHB(pB0, pB1, t + 2, false, false, false, false);
  } else {
    D4_PHA(pB0, pB1, pA0, pA1, 1, false);
    int t = 1;
    for (; t + 4 < NT; t += 2) {
      D4_PHB(pB0, pB1, t, true, true, true, true);     D4_PHA(pA0, pA1, pB0, pB1, t + 1, false); D4_WAIT_BAR(3); D4_ROT();
      D4_PHB(pA0, pA1, t + 1, true, true, true, true); D4_PHA(pB0, pB1, pA0, pA1, t + 2, false); D4_WAIT_BAR(3); D4_ROT();
    }
    D4_PHB(pB0, pB1, t, false, true, true, true);      D4_PHA(pA0, pA1, pB0, pB1, t + 1, false); D4_WAIT_BAR(2); D4_ROT();
    D4_PHB(pA0, pA1, t + 1, false, true, true, true);  D4_PHA(pB0, pB1, pA0, pA1, t + 2, false); D4_WAIT_BAR(0); D4_ROT();
    D4_PHB(pB0, pB1, t + 2, false, false, false, true);
  }
  { float sacc = pB0[0] + pB0[1];
#pragma unroll
    for (int r = 2; r < 16; ++r) sacc += pB0[r];
#pragma unroll
    for (int r = 0; r < 16; ++r) sacc += pB1[r];
    l_reg += sacc;
    pw0 = (u32x4){D4_PKW(pB0, 0), D4_PKW(pB0, 2), D4_PKW(pB0, 4), D4_PKW(pB0, 6)}; pw1 = (u32x4){D4_PKW(pB0, 8), D4_PKW(pB0, 10), D4_PKW(pB0, 12), D4_PKW(pB0, 14)};
    pw2 = (u32x4){D4_PKW(pB1, 0), D4_PKW(pB1, 2), D4_PKW(pB1, 4), D4_PKW(pB1, 6)}; pw3 = (u32x4){D4_PKW(pB1, 8), D4_PKW(pB1, 10), D4_PKW(pB1, 12), D4_PKW(pB1, 14)};
    const lds_cptr vp_ = vp0 + sl_cur;
    D4_VRD(0); D4_VRD(1); D4_VRD(2); D4_VRD(3); D4_VRD(4);
    o[0] = D4_MFMA(D4_PAF(0), D4_VFR(0), o[0]); D4_VRD(5);
    o[1] = D4_MFMA(D4_PAF(0), D4_VFR(1), o[1]); D4_VRD(6);
    o[2] = D4_MFMA(D4_PAF(0), D4_VFR(2), o[2]); D4_VRD(7);
    o[3] = D4_MFMA(D4_PAF(0), D4_VFR(3), o[3]); D4_VRD(8);
    o[0] = D4_MFMA(D4_PAF(1), D4_VFR(4), o[0]); D4_VRD(9);
    o[1] = D4_MFMA(D4_PAF(1), D4_VFR(5), o[1]); D4_VRD(10);
    o[2] = D4_MFMA(D4_PAF(1), D4_VFR(6), o[2]); D4_VRD(11);
    o[3] = D4_MFMA(D4_PAF(1), D4_VFR(7), o[3]); D4_VRD(12);
    o[0] = D4_MFMA(D4_PAF(2), D4_VFR(8), o[0]); D4_VRD(13);
    o[1] = D4_MFMA(D4_PAF(2), D4_VFR(9), o[1]); D4_VRD(14);
    o[2] = D4_MFMA(D4_PAF(2), D4_VFR(10), o[2]); D4_VRD(15);
    o[3] = D4_MFMA(D4_PAF(2), D4_VFR(11), o[3]);
    o[0] = D4_MFMA(D4_PAF(3), D4_VFR(12), o[0]);
    o[1] = D4_MFMA(D4_PAF(3), D4_VFR(13), o[1]);
    o[2] = D4_MFMA(D4_PAF(3), D4_VFR(14), o[2]);
    o[3] = D4_MFMA(D4_PAF(3), D4_VFR(15), o[3]); }
  { auto rr = __builtin_amdgcn_permlane32_swap(__float_as_uint(l_reg), __float_as_uint(l_reg), false, false); l_out = __uint_as_float(rr[0]) + __uint_as_float(rr[1]); }
  D4_WAIT_BAR(0);
#undef D4_PIN
#undef D4_MFMA
#undef D4_WAIT_BAR
#undef D4_KSLOT
#undef D4_DMA_K
#undef D4_DMA_V
#undef D4_DMA_KV
#undef D4_KRD
#undef D4_VO
#undef D4_VRD
#undef D4_VFR
#undef D4_PKW
#undef D4_PAF
#undef D4_PAFI
#undef D4_ROT
#undef D4_EX2
#undef D4_GAPA
#undef D4_GAPB
#undef D4_PHA
#undef D4_PHB
}
__device__ __forceinline__ void row_recips(float l, float extra, float* wsf, int r32, int hi, float (&rli)[16]) {
  if (hi == 0) wsf[r32] = l + extra; asm volatile("s_waitcnt lgkmcnt(0)" ::: "memory");
#pragma unroll
  for (int r = 0; r < 16; ++r) rli[r] = __builtin_amdgcn_rcpf(wsf[crow(r, hi)]);
  asm volatile("s_waitcnt lgkmcnt(0)" ::: "memory");
}

__device__ __forceinline__ void win_unit2(__amdgpu_buffer_rsrc_t rs, const char* wsb, int b, int kvh, int qb, int pair, const bf16_t* QA, const bf16_t* KA, const bf16_t* VA, bf16_t* ACAT, const float* scal, char* lds, const int wid) {
  constexpr int S = 8192, W_K = 65536, W_WS = 131072;
  const int lane = MK_LANE(), r32 = lane & 31, hi = lane >> 5;
  const unsigned lds0 = (unsigned)(uintptr_t)lds;
  const int q0 = qb * 256, kb0 = q0 - 128; const size_t rowbase = (size_t)b * S;
  const unsigned Kb = (unsigned)((const char*)(KA + rowbase * 128 + kvh * 64) - wsb), Vb = (unsigned)((const char*)(VA + rowbase * 128 + kvh * 64) - wsb);
  { const unsigned kvoff = (unsigned)lane * 256u + wid * 16;
    const int ob = wid * 1024 + lane * 16, st = ob >> 9, k = (st / 2) * 8 + ((ob >> 6) & 7), c = (st % 2) * 32 + ((ob >> 4) & 3) * 8; const unsigned vvoff = (unsigned)k * 256u + c * 2;
#pragma unroll
    for (int j = 0; j < 8; ++j) { const int ks = kb0 + 64 * j;
      if (ks >= 0 && ks < S) dma16x2(lds0 + W_K + j * 8192 + wid * 1024, kvoff, Kb + (unsigned)ks * 256u, lds0 + j * 8192 + wid * 1024, vvoff, Vb + (unsigned)ks * 256u, rs); } }
  asm volatile("s_waitcnt vmcnt(0)\n\ts_barrier" ::: "memory");
  const lds_cptr kp0 = (lds_cptr)lds + W_K + hi * 1024 + r32 * 16;
  const lds_cptr vp0 = (lds_cptr)lds + v_rd_base(lane);
  float* wsf = (float*)(lds + W_WS) + wid * 64;
  const int qrow0 = q0 + wid * QBLK, qpos = qrow0 + r32, jlo = wid >> 1;
#pragma unroll 1
  for (int hh = 0; hh < 2; ++hh) {
    const int hq = kvh * 4 + pair * 2 + hh;
    bf16x8 qr[4];
    { const unsigned Qb = (unsigned)((const char*)(QA + (rowbase + q0) * 512 + hq * 64) - wsb), qoff = (unsigned)(wid * QBLK + r32) * 1024u + hi * 16;
#pragma unroll
      for (int d0 = 0; d0 < 4; ++d0) { const u32x4 w = __builtin_amdgcn_raw_buffer_load_b128(rs, qoff + d0 * 32, Qb, 0); qr[d0] = __builtin_bit_cast(bf16x8, w); } }
    f32x16 negm; { float ns = scal[8 + hq]; asm volatile("" : "+v"(ns));
#pragma unroll
    for (int r = 0; r < 16; ++r) negm[r] = ns; }
    f32x16 o0 = f32x16{}, o1 = f32x16{}; float l_reg = 0.f;
#pragma unroll 1
    for (int i = 0; i < 5; ++i) {
      const int j = jlo + i, ks = kb0 + 64 * j;
      if (ks < 0 || ks >= S) continue;
      const lds_cptr kp = kp0 + j * 8192; const lds_cptr vp = vp0 + j * 8192;
      f32x16 p0, p1;
#pragma unroll
      for (int d0 = 0; d0 < 4; ++d0) { const bf16x8 k0 = kld(kp + d0 * 2048), k1 = kld(kp + d0 * 2048 + 512);
        if (d0 == 0) { p0 = __builtin_amdgcn_mfma_f32_32x32x16_bf16(k0, qr[0], negm, 0, 0, 0); p1 = __builtin_amdgcn_mfma_f32_32x32x16_bf16(k1, qr[0], negm, 0, 0, 0); }
        else { p0 = __builtin_amdgcn_mfma_f32_32x32x16_bf16(k0, qr[d0], p0, 0, 0, 0); p1 = __builtin_amdgcn_mfma_f32_32x32x16_bf16(k1, qr[d0], p1, 0, 0, 0); } }
      if (!((ks >= qrow0 + QBLK - 1 - 128) && (ks + 63 <= qrow0 + 128))) wmask<true>(p0, p1, qpos, ks, hi);
      exp_half(p0); exp_half(p1);
      float ps = 0.f;
#pragma unroll
      for (int r = 0; r < 16; ++r) ps += p0[r];
#pragma unroll
      for (int r = 0; r < 16; ++r) ps += p1[r];
      l_reg += ps;
      bf16x8 pa0, pa1, pa2, pa3;
#define W2_PK4(P, BASE, OUT) do { u32x4 w = {cvtpk(P[BASE + 0], P[BASE + 1]), cvtpk(P[BASE + 2], P[BASE + 3]), cvtpk(P[BASE + 4], P[BASE + 5]), cvtpk(P[BASE + 6], P[BASE + 7])}; OUT = *reinterpret_cast<bf16x8*>(&w); } while (0)
      W2_PK4(p0, 0, pa0); W2_PK4(p0, 8, pa1); W2_PK4(p1, 0, pa2); W2_PK4(p1, 8, pa3);
#undef W2_PK4
#define W2_VF(D0, ks_) ({ const s16x4 l_ = vtr(vp + (D0) * 512 + (2 * (ks_)) * 1024), h_ = vtr(vp + (D0) * 512 + (2 * (ks_) + 1) * 1024); (bf16x8){l_[0], l_[1], l_[2], l_[3], h_[0], h_[1], h_[2], h_[3]}; })
      o0 = __builtin_amdgcn_mfma_f32_32x32x16_bf16(pa0, W2_VF(0, 0), o0, 0, 0, 0); o1 = __builtin_amdgcn_mfma_f32_32x32x16_bf16(pa0, W2_VF(1, 0), o1, 0, 0, 0);
      o0 = __builtin_amdgcn_mfma_f32_32x32x16_bf16(pa1, W2_VF(0, 1), o0, 0, 0, 0); o1 = __builtin_amdgcn_mfma_f32_32x32x16_bf16(pa1, W2_VF(1, 1), o1, 0, 0, 0);
      o0 = __builtin_amdgcn_mfma_f32_32x32x16_bf16(pa2, W2_VF(0, 2), o0, 0, 0, 0); o1 = __builtin_amdgcn_mfma_f32_32x32x16_bf16(pa2, W2_VF(1, 2), o1, 0, 0, 0);
      o0 = __builtin_amdgcn_mfma_f32_32x32x16_bf16(pa3, W2_VF(0, 3), o0, 0, 0, 0); o1 = __builtin_amdgcn_mfma_f32_32x32x16_bf16(pa3, W2_VF(1, 3), o1, 0, 0, 0);
#undef W2_VF
    }
    float l; { auto rr = __builtin_amdgcn_permlane32_swap(__float_as_uint(l_reg), __float_as_uint(l_reg), false, false); l = __uint_as_float(rr[0]) + __uint_as_float(rr[1]); }
    float rli[16];
    row_recips(l, scal[16 + hq], wsf, r32, hi, rli);
    bf16_t* stg = (bf16_t*)(lds + W_WS + 2048) + wid * 1024;
    bf16_t* Ow = ACAT + (rowbase + q0 + wid * QBLK) * 1024 + hq * 64;
#pragma unroll
    for (int g = 0; g < 2; ++g) {
#pragma unroll
      for (int rr = 0; rr < 8; ++rr) { const int r = 8 * g + rr, srow = crow(r, hi) - 16 * g;
        stg[srow * 64 + r32] = (bf16_t)(cvtpk(o0[r] * rli[r], 0.f) & 0xffffu); stg[srow * 64 + 32 + r32] = (bf16_t)(cvtpk(o1[r] * rli[r], 0.f) & 0xffffu); }
      asm volatile("s_waitcnt lgkmcnt(0)" ::: "memory");
#pragma unroll
      for (int i = 0; i < 2; ++i) { const int row = i * 8 + (lane >> 3), ch = lane & 7; const u32x4 v = *(const u32x4*)(stg + row * 64 + ch * 8); *(u32x4*)(Ow + (size_t)(16 * g + row) * 1024 + ch * 8) = v; }
      asm volatile("s_waitcnt lgkmcnt(0)" ::: "memory"); }
  }
  asm volatile("s_waitcnt lgkmcnt(0)" ::: "memory"); __syncthreads();
}

__device__ __forceinline__ void diff_unit(__amdgpu_buffer_rsrc_t rs, const char* wsb, int b, int h, int qb, const bf16_t* QB, const bf16_t* KB, const bf16_t* VB, bf16_t* ACAT, const float* scal, const float* subln, char* lds, const int wid) {
  constexpr int S = 8192;
  const size_t rowbase = (size_t)b * S; const int q0 = qb * 256;
  float* wsf = (float*)(lds + LDS_WS) + wid * 64; float rli[16];
  bf16_t* stg = (bf16_t*)(lds + LDS_STG) + wid * 4096;
#pragma unroll 1
  for (int t = 0; t < 2; ++t) {
    f32x16 o[4]; float l; const float negm_s = scal[2];
    attn_pass_d4(rs, (unsigned)((const char*)(QB + (rowbase + q0) * 512 + (2 * h + t) * 64) - wsb), 1024u, (unsigned)((const char*)(KB + rowbase * 512 + (2 * h + t) * 64) - wsb), 1024u, (unsigned)((const char*)(VB + rowbase * 512 + h * 128) - wsb), 1024u, S, negm_s, lds, o, l, wid);
    const int lane1 = MK_LANE(); int r32 = lane1 & 31, hi = lane1 >> 5, lane = lane1; asm volatile("" : "+v"(r32), "+v"(hi), "+v"(lane));
    row_recips(l, 0.f, wsf, r32, hi, rli);
    if (t == 0) {
#pragma unroll
      for (int r = 0; r < 16; ++r) { const int orow = crow(r, hi);
#pragma unroll
        for (int d0 = 0; d0 < 4; ++d0) stg[orow * 128 + d0 * 32 + r32] = (bf16_t)(cvtpk(o[d0][r] * rli[r], 0.f) & 0xffffu); }
    } else {
      const float lam = scal[0], post = 1.0f - scal[1];
      float ss[16];
#pragma unroll
      for (int r = 0; r < 16; ++r) { const int orow = crow(r, hi); float s_ = 0.f;
#pragma unroll
        for (int d0 = 0; d0 < 4; ++d0) { const float v = bf2f(stg[orow * 128 + d0 * 32 + r32]) - lam * (o[d0][r] * rli[r]); o[d0][r] = v; s_ += v * v; }
        ss[r] = s_; }
#pragma unroll
      for (int r = 0; r < 16; ++r) { float s_ = ss[r]; s_ += __shfl_xor(s_, 1); s_ += __shfl_xor(s_, 2); s_ += __shfl_xor(s_, 4); s_ += __shfl_xor(s_, 8); s_ += __shfl_xor(s_, 16); ss[r] = rsqrtf(s_ * (1.0f / 128.0f) + 1e-6f) * post; }
      float sl[4];
#pragma unroll
      for (int d0 = 0; d0 < 4; ++d0) sl[d0] = subln[d0 * 32 + r32];
#pragma unroll
      for (int r = 0; r < 16; ++r) { const int orow = crow(r, hi);
#pragma unroll
        for (int d0 = 0; d0 < 4; ++d0) stg[orow * 128 + d0 * 32 + r32] = (bf16_t)(cvtpk(o[d0][r] * ss[r] * sl[d0], 0.f) & 0xffffu); }
      asm volatile("s_waitcnt lgkmcnt(0)" ::: "memory");
      const int widl = wid;
      bf16_t* Ow = ACAT + (rowbase + q0) * 1024 + 512 + h * 128 + (unsigned)((widl * QBLK + (lane >> 4)) * 1024 + (lane & 15) * 8);
      const bf16_t* sp = stg + (lane >> 4) * 128 + (lane & 15) * 8;
#pragma unroll
      for (int i = 0; i < 8; ++i) { const u32x4 v = *(const u32x4*)(sp + i * 512); *(u32x4*)(Ow + (size_t)i * 4096) = v; }
    }
  }
  asm volatile("s_waitcnt lgkmcnt(0)" ::: "memory"); __syncthreads();
}
#undef ATT_SBAR
}
constexpr int NWAVES = 8;
#ifndef MK_N_LAUNCHES
#define MK_N_LAUNCHES 1
#endif
constexpr int PER_PHASE = 10;
constexpr int N_LAUNCHES = MK_N_LAUNCHES;

constexpr int BATCH = 2, T = 8192, D = 1024, M = BATCH * T, DFF = 2816, NFF = 2 * DFF, NIN = 4352, NMOD = 9 * D;
constexpr size_t MiB = 1u << 20;
constexpr size_t WS_CTL = 0, CTL_ZERO_BYTES = 1 * MiB;
constexpr size_t WS_MOD = 512 * 1024;
constexpr size_t WS_SCAL = 1 * MiB, WS_CB1 = WS_SCAL + 4096, WS_CBIN = WS_CB1 + 65536, WS_CB2 = WS_CBIN + 65536;
constexpr size_t WS_RSS0 = 2 * MiB, WS_RSS1 = WS_RSS0 + 256 * 1024, WS_RSS2 = WS_RSS1 + 256 * 1024;
constexpr size_t WS_COS = 3 * MiB, WS_SIN = 5 * MiB;
constexpr size_t WS_W1T = 8 * MiB, WS_W1OT = 19 * MiB, WS_WINT = 25 * MiB, WS_WBRT = 34 * MiB, WS_WOT = 38 * MiB, WS_W2T = 40 * MiB, WS_W2OT = 51 * MiB;
constexpr size_t WS_ABUF = 57 * MiB;
constexpr size_t WS_R1 = 89 * MiB;
constexpr size_t WS_QA = WS_R1, WS_KA = WS_QA + 16 * MiB, WS_VA = WS_KA + 4 * MiB, WS_QB = WS_VA + 4 * MiB, WS_KB = WS_QB + 16 * MiB, WS_VB = WS_KB + 16 * MiB;
constexpr size_t WS_MG = WS_R1;
constexpr size_t WS_GA = 177 * MiB, WS_GB = 209 * MiB, WS_END = 241 * MiB;
static_assert(WS_VB + 16 * MiB <= WS_GA && WS_R1 + (size_t)M * DFF * 2 <= WS_GA && WS_W2OT + (size_t)D * DFF * 2 <= WS_ABUF, "d_ws map");
constexpr int CW_TMO = 0, CW_CODE = 1, CW_BAR = 4096;

constexpr int RING_OFF = 0, RING_BYTES = 131072;
constexpr int LDSCTL_OFF = 149504, MISC_OFF = LDSCTL_OFF + 320;
constexpr int LDS_BYTES = 155648;
static_assert(MISC_OFF + 128 <= LDS_BYTES && att::ATT_LDS_BYTES <= LDSCTL_OFF && RING_BYTES <= LDSCTL_OFF, "LDS map");

#define GAS __attribute__((address_space(1)))
#define LAS __attribute__((address_space(3)))
typedef unsigned short bf16;
typedef unsigned v4u __attribute__((ext_vector_type(4)));
typedef float f32x4 __attribute__((ext_vector_type(4)));
typedef short bf16x8 __attribute__((ext_vector_type(8)));
typedef GAS unsigned gu32;
typedef GAS unsigned long long gu64;
#define RLX_AGENT __ATOMIC_RELAXED, __HIP_MEMORY_SCOPE_AGENT
#define LDS_WAIT() asm volatile("s_waitcnt lgkmcnt(0)" ::: "memory")
#define VM_WAIT() asm volatile("s_waitcnt vmcnt(0)" ::: "memory")
__device__ __forceinline__ unsigned long long rt() { return __builtin_amdgcn_s_memrealtime(); }
__device__ __forceinline__ unsigned f2bf(float f) { unsigned u = __builtin_bit_cast(unsigned, f); return (u + 0x7fffu + ((u >> 16) & 1u)) >> 16; }
__device__ __forceinline__ unsigned pk2(float lo, float hi) { return f2bf(lo) | (f2bf(hi) << 16); }

#define XB_TMO      128
#define XB_XCNT(j)  (256  + 64 * (j))
#define XB_XSUB(j)  (1280 + 64 * (j))
#define XB_XGEN(j)  (2304 + 64 * (j))
#define XB_TOP      3328
#define XB_TOPGEN   3392
#define XCD_BAR_WORDS 3456
#define XB_SPIN_CAP (1u << 18)

__device__ __forceinline__ unsigned xb_ld(unsigned* p)              { return __hip_atomic_load(p, __ATOMIC_RELAXED, __HIP_MEMORY_SCOPE_AGENT); }
__device__ __forceinline__ unsigned xb_add(unsigned* p, unsigned v) { return __hip_atomic_fetch_add(p, v, __ATOMIC_RELAXED, __HIP_MEMORY_SCOPE_AGENT); }
__device__ __forceinline__ unsigned xb_xcc_id() { return (unsigned)__builtin_amdgcn_s_getreg((3 << 11) | 20) & 0xFu; }
#define XB_SPIN(cond, bar) do { unsigned _sp = 0; while (cond) { __builtin_amdgcn_s_sleep(1); \
    if ((++_sp & 255u) == 0u) { if (xb_ld(&(bar)[XB_TMO])) break; if (_sp > XB_SPIN_CAP) { atomicAdd(&(bar)[XB_TMO], 1u); break; } } } } while (0)

struct XcdBarrier {
    unsigned* bar; unsigned x;
    volatile LAS unsigned* st;
};

__device__ __forceinline__ XcdBarrier xcd_barrier_post(unsigned* bar, volatile LAS unsigned* st) {
    XcdBarrier b; b.bar = bar; b.x = xb_xcc_id(); b.st = st;
    if (threadIdx.x == 0) (void)xb_add(&bar[XB_XCNT(b.x)], 1u);
    return b;
}
__device__ __forceinline__ void xcd_barrier_complete(unsigned* bar, unsigned x, unsigned& nloc, unsigned& nx) {
    const unsigned G = gridDim.x * gridDim.y * gridDim.z;
    unsigned sum, cnt, mine, sp = 0u;
    for (;;) {
        sum = 0u; cnt = 0u; mine = 0u;
#pragma unroll
        for (unsigned j = 0; j < 16; ++j) { const unsigned c = xb_ld(&bar[XB_XCNT(j)]); sum += c; cnt += (c > 0u) ? 1u : 0u; mine = (j == x) ? c : mine; }
        if (sum == G) break;
        __builtin_amdgcn_s_sleep(1);
        if ((++sp & 255u) == 0u) { if (xb_ld(&bar[XB_TMO])) break; if (sp > XB_SPIN_CAP) { atomicAdd(&bar[XB_TMO], 1u); break; } }
    }
    nloc = mine > 0u ? mine : 1u; nx = cnt > 0u ? cnt : 1u;
}

__device__ __forceinline__ void xcd_barrier(const XcdBarrier& b, const bool leader  ) {
    asm volatile("s_waitcnt vmcnt(0)" ::: "memory");
    __syncthreads();
    if (leader) {
        unsigned* bar = b.bar;
        __builtin_amdgcn_s_waitcnt(0);
        unsigned nloc = b.st[0], nx = b.st[1];
        if (nloc == 0u) { xcd_barrier_complete(bar, b.x, nloc, nx); b.st[0] = nloc; b.st[1] = nx; }
        const unsigned old = xb_add(&bar[XB_XSUB(b.x)], 1u);
        const unsigned gen = old / nloc;
        if (old + 1u == (gen + 1u) * nloc) {
            __builtin_amdgcn_fence(__ATOMIC_RELEASE, "agent");
            asm volatile("s_waitcnt vmcnt(0)" ::: "memory");
            const unsigned og = xb_add(&bar[XB_TOP], 1u);
            const unsigned tg = og / nx;
            asm volatile("buffer_inv sc1" ::: "memory");
            if (og + 1u == (tg + 1u) * nx) xb_add(&bar[XB_TOPGEN], 1u);
            else XB_SPIN(xb_ld(&bar[XB_TOPGEN]) == tg, bar);
            xb_add(&bar[XB_XGEN(b.x)], 1u);
            asm volatile("s_waitcnt vmcnt(0)" ::: "memory");
        } else {
            asm volatile("buffer_inv sc1" ::: "memory");
            XB_SPIN(xb_ld(&bar[XB_XGEN(b.x)]) == gen, bar);
            asm volatile("s_waitcnt vmcnt(0)" ::: "memory");
        }
    }
    __syncthreads();
}

struct Args { const void* in[26]; float* out; unsigned char* ws; int ph_lo, ph_hi, li, pad; };

__device__ __forceinline__ float wave_sum(float v) {
#pragma unroll
    for (int o = 1; o < 64; o <<= 1) v += __shfl_xor(v, o);
    return v;
}
__device__ __forceinline__ int rowmap(int kind, int n0) {
    if (kind == 1) { const int bj = n0 >= DFF ? 1 : 0, jj = n0 - bj * DFF; return (jj >> 7) * 256 + bj * 128 + (jj & 127); }
    if (kind == 2) { if (n0 >= 2304) return n0; const int g32 = n0 >> 5, head = g32 >> 1, bj = g32 & 1; return (head >> 2) * 256 + bj * 128 + (head & 3) * 32; }
    if (kind == 3) return (n0 >> 7) * 256 + (n0 & 127);
    if (kind == 4) return (n0 >> 7) * 256 + 128 + (n0 & 127);
    return n0;
}
struct TItem { const float* src; bf16* dst; int N; int ldk; };
__device__ __forceinline__ TItem p0_item_addr(const float* W, int N, bf16* WT, int ldk, int koff, int kind, int item, int lane) {
    const int nblk = N / 32, kb = item / nblk, nb = item % nblk, k0 = 64 * kb, n0 = 32 * nb, c0 = rowmap(kind, n0), kg = lane & 7, ng = lane >> 3;
    TItem t; t.src = W + (size_t)(k0 + 8 * kg) * N + n0 + 4 * ng; t.dst = WT + (size_t)(c0 + 4 * ng) * ldk + koff + k0 + 8 * kg; t.N = N; t.ldk = ldk; return t;
}
__device__ __forceinline__ void p0_item_load(const TItem& t, f32x4 (&v)[8]) {
#pragma unroll
    for (int j = 0; j < 8; ++j) v[j] = __builtin_nontemporal_load((const f32x4*)(t.src + (size_t)j * t.N));
}
__device__ __forceinline__ void p0_item_store(const TItem& t, const f32x4 (&v)[8]) {
#pragma unroll
    for (int i = 0; i < 4; ++i) { v4u o; o.x = pk2(v[0][i], v[1][i]); o.y = pk2(v[2][i], v[3][i]); o.z = pk2(v[4][i], v[5][i]); o.w = pk2(v[6][i], v[7][i]);
        *(GAS v4u*)(t.dst + (size_t)i * t.ldk) = o; }
}

__device__ __forceinline__ void bias_rows(const bf16* Bt, float* CB, int nrows, const float* sh0, const float* sh1, int gw, int NGW) {
    const int lane = MK_LANE();
    f32x4 s0[2][2], s1[2][2];
#pragma unroll
    for (int hh = 0; hh < 2; ++hh)
#pragma unroll
        for (int q = 0; q < 2; ++q) { s0[hh][q] = *(const f32x4*)(sh0 + hh * 512 + lane * 8 + 4 * q); s1[hh][q] = *(const f32x4*)(sh1 + hh * 512 + lane * 8 + 4 * q); }
    for (int c0 = gw; c0 < nrows; c0 += 3 * NGW) {
        v4u w[3][2];
#pragma unroll
        for (int r = 0; r < 3; ++r) { const int c = c0 + r * NGW;
            if (c < nrows) {
#pragma unroll
                for (int hh = 0; hh < 2; ++hh) w[r][hh] = *(const GAS v4u*)(Bt + (size_t)c * D + hh * 512 + lane * 8); } }
#pragma unroll
        for (int r = 0; r < 3; ++r) { const int c = c0 + r * NGW;
            if (c < nrows) { float a0 = 0.f, a1 = 0.f;
#pragma unroll
                for (int hh = 0; hh < 2; ++hh) { const v4u v = w[r][hh];
                    const float wf[8] = {__uint_as_float(v.x << 16), __uint_as_float(v.x & 0xffff0000u), __uint_as_float(v.y << 16), __uint_as_float(v.y & 0xffff0000u),
                                         __uint_as_float(v.z << 16), __uint_as_float(v.z & 0xffff0000u), __uint_as_float(v.w << 16), __uint_as_float(v.w & 0xffff0000u)};
#pragma unroll
                    for (int e = 0; e < 8; ++e) { a0 += wf[e] * s0[hh][e >> 2][e & 3]; a1 += wf[e] * s1[hh][e >> 2][e & 3]; } }
                a0 = wave_sum(a0); a1 = wave_sum(a1);
                if (lane == 0) { CB[c] = a0; CB[nrows + c] = a1; } } }
    }
}

__global__ void __launch_bounds__(NWAVES * 64, 2) layer_fwd(Args args) {
    extern __shared__ __attribute__((aligned(16))) unsigned char lds[];
    LAS unsigned char* ldsl = (LAS unsigned char*)lds;
    volatile LAS unsigned* MISC = (volatile LAS unsigned*)(ldsl + MISC_OFF);
    const int wave = __builtin_amdgcn_readfirstlane((int)threadIdx.x >> 6), lane = MK_LANE(), tid = wave * 64 + lane;
    const int G = gridDim.x; const int bx = blockIdx.x; const int vcu = (G % 8 == 0) ? (bx % 8) * (G / 8) + bx / 8 : bx;
    unsigned char* ws = args.ws;
    gu32* ctl = (gu32*)(ws + WS_CTL);
    const float* x = (const float*)args.in[0]; const float* cvec = (const float*)args.in[1]; const int* positions = (const int*)args.in[2];
    const float* w_mod = (const float*)args.in[3]; const float* b_mod = (const float*)args.in[4];
    const float* norm_ffn1 = (const float*)args.in[5]; const float* w_ffn1_in = (const float*)args.in[6]; const float* w_ffn1_out = (const float*)args.in[7];
    const float* norm_mix = (const float*)args.in[8]; const float* w_in = (const float*)args.in[9];
    const float* qn_a = (const float*)args.in[10]; const float* kn_a = (const float*)args.in[11]; const float* sink_a = (const float*)args.in[12];
    const float* qn_b = (const float*)args.in[13]; const float* kn_b = (const float*)args.in[14];
    const float* lam_q1 = (const float*)args.in[15]; const float* lam_k1 = (const float*)args.in[16]; const float* lam_q2 = (const float*)args.in[17]; const float* lam_k2 = (const float*)args.in[18];
    const float* subln_b = (const float*)args.in[19]; const float* w_branch_a = (const float*)args.in[20]; const float* w_branch_b = (const float*)args.in[21];
    const float* w_out = (const float*)args.in[22]; const float* norm_ffn2 = (const float*)args.in[23]; const float* w_ffn2_in = (const float*)args.in[24]; const float* w_ffn2_out = (const float*)args.in[25];
    float* out = args.out;
    float* MOD = (float*)(ws + WS_MOD); float* SCAL = (float*)(ws + WS_SCAL); float* CB1 = (float*)(ws + WS_CB1); float* CBIN = (float*)(ws + WS_CBIN); float* CB2 = (float*)(ws + WS_CB2);
    float* RSS0 = (float*)(ws + WS_RSS0); float* RSS1 = (float*)(ws + WS_RSS1); float* RSS2 = (float*)(ws + WS_RSS2); bf16* ROPET = (bf16*)(ws + WS_COS);
    bf16* W1T = (bf16*)(ws + WS_W1T); bf16* W1OT = (bf16*)(ws + WS_W1OT); bf16* WINT = (bf16*)(ws + WS_WINT); bf16* WBRT = (bf16*)(ws + WS_WBRT); bf16* WOT = (bf16*)(ws + WS_WOT);
    bf16* W2T = (bf16*)(ws + WS_W2T); bf16* W2OT = (bf16*)(ws + WS_W2OT);
    bf16* ABUF = (bf16*)(ws + WS_ABUF); bf16* HB = (bf16*)(ws + WS_R1); bf16* MG = (bf16*)(ws + WS_MG);
    bf16* QA = (bf16*)(ws + WS_QA); bf16* KA = (bf16*)(ws + WS_KA); bf16* VA = (bf16*)(ws + WS_VA); bf16* QB = (bf16*)(ws + WS_QB); bf16* KB = (bf16*)(ws + WS_KB); bf16* VB = (bf16*)(ws + WS_VB);
    bf16* GA = (bf16*)(ws + WS_GA); bf16* GB = (bf16*)(ws + WS_GB);
    bf16* X1B = (bf16*)out;
    bf16* X2B = (bf16*)(ws + WS_GA);

    for (int u = tid; u < (LDS_BYTES - LDSCTL_OFF) / 4; u += NWAVES * 64) ((LAS unsigned*)(ldsl + LDSCTL_OFF))[u] = 0u;
    __syncthreads();
    XcdBarrier bar; bar.bar = (unsigned*)(ctl + CW_BAR); bar.x = 0; bar.st = nullptr;
    if (N_LAUNCHES != PER_PHASE) bar = xcd_barrier_post((unsigned*)(ctl + CW_BAR), MISC + 8);
#define GRID_BAR(seam) do { if (N_LAUNCHES == PER_PHASE) { if (tid == 0) __hip_atomic_store(ctl + CW_TMO, 0xBADBA0u | (unsigned)(seam), RLX_AGENT); } else { xcd_barrier(bar, wave == 0 && MK_LANE() == 0); } } while (0)
    const int lo = args.ph_lo, hi = args.ph_hi;
#ifndef PH_MASK
#define PH_MASK 0x3ff
#endif
#define IN(k) (((PH_MASK >> (k)) & 1) && lo <= (k) && (k) < hi)
#define BOTH(k) (IN(k) && IN((k) + 1))
#ifndef REPEAT_MASK
#define REPEAT_MASK 0
#endif
#define REPS(k) for (int rep_ = 0; rep_ <= ((REPEAT_MASK >> (k)) & 1); ++rep_)
    const int gw = vcu * NWAVES + wave, NGW = G * NWAVES;
    constexpr float QSCALE = 0.125f * 1.4426950408889634f;

    if (IN(0)) {
#define MOD_GEMV(IT_BEGIN, IT_END, IT_FIRST, IT_STRIDE, TIDV, LANEV) do { \
            LAS float* ca = (LAS float*)(ldsl + RING_OFF + 73728);              \
            LAS float* red = ca + 2048;                                          \
            for (int i = (TIDV); i < 2 * D; i += NWAVES * 64) { const float v = cvec[i]; ca[i] = v / (1.f + __expf(-v)); } \
            __syncthreads(); \
            for (int it = (IT_BEGIN) + (IT_FIRST); it < (IT_END); it += (IT_STRIDE)) { \
                const int cg = it >> 1, kh = it & 1, j = cg * 64 + (LANEV), kbase = kh * 512 + wave * 64; \
                float wv[64]; \
                _Pragma("unroll") \
                for (int kk = 0; kk < 64; ++kk) wv[kk] = w_mod[(size_t)(kbase + kk) * NMOD + j]; \
                float a0 = 0.f, a1 = 0.f; \
                _Pragma("unroll") \
                for (int kk = 0; kk < 64; ++kk) { a0 += ca[kbase + kk] * wv[kk]; a1 += ca[D + kbase + kk] * wv[kk]; } \
                red[(wave * 2 + 0) * 64 + (LANEV)] = a0; red[(wave * 2 + 1) * 64 + (LANEV)] = a1; \
                __syncthreads(); \
                if ((TIDV) < 128) { const int b = (TIDV) >> 6; float s_ = (kh == 0) ? b_mod[j] : 0.f; \
                    _Pragma("unroll") \
                    for (int w = 0; w < 8; ++w) s_ += red[(w * 2 + b) * 64 + (LANEV)]; \
                    atomicAdd(MOD + b * NMOD + j, s_); } \
                __syncthreads(); \
            } } while (0)
        MOD_GEMV(0, 64, bx, G, tid, lane);
        {
            constexpr int NITEMS = (D / 64) * (NFF / 32);
            auto item_of = [&](int it) -> TItem { return p0_item_addr(w_ffn1_in, NFF, W1T, D, 0, 1, it, lane); };
            for (int it = gw; it < NITEMS; it += 2 * NGW) {
                const int it2 = it + NGW; const bool two = it2 < NITEMS;
                const TItem a = item_of(it), b2 = item_of(two ? it2 : it);
                f32x4 va[8], vb[8];
                p0_item_load(a, va); if (two) p0_item_load(b2, vb);
                p0_item_store(a, va); if (two) p0_item_store(b2, vb);
            }
        }
        if (bx == 0 && wave == 0) {
            const float a = wave_sum(lam_q1[lane] * lam_k1[lane]), b2 = wave_sum(lam_q2[lane] * lam_k2[lane]);
            float mqa = fabsf(qn_a[lane]), mka = fabsf(kn_a[lane]), mqb = fabsf(qn_b[lane]), mkb = fabsf(kn_b[lane]);
#pragma unroll
            for (int o = 1; o < 64; o <<= 1) { mqa = fmaxf(mqa, __shfl_xor(mqa, o)); mka = fmaxf(mka, __shfl_xor(mka, o)); mqb = fmaxf(mqb, __shfl_xor(mqb, o)); mkb = fmaxf(mkb, __shfl_xor(mkb, o)); }
            const float bound_a = 8.0f * mqa * mka * 1.001f, bound_b = 8.0f * mqb * mkb * 1.001f, L2E = 1.4426950408889634f;
            if (lane == 0) { const float lam_init = 0.8f - 0.6f * expf(-0.3f * 0.f); SCAL[0] = expf(a) - expf(b2) + lam_init; SCAL[1] = lam_init; SCAL[2] = -bound_b * L2E; }
            if (lane < 8) { const float sk = sink_a[lane], mh = fmaxf(bound_a, sk); SCAL[8 + lane] = -mh * L2E; SCAL[16 + lane] = exp2f((sk - mh) * L2E); }
        }
        if (BOTH(0)) GRID_BAR(0);
    }

    if (IN(1)) {
        for (int m = gw; m < M; m += NGW) {
            const int b = m >> 13; const GAS f32x4* xr = (const GAS f32x4*)(x + (size_t)m * D) + lane;
            f32x4 v[4]; float s = 0.f;
#pragma unroll
            for (int j = 0; j < 4; ++j) { v[j] = xr[64 * j]; s += (v[j].x * v[j].x + v[j].y * v[j].y) + (v[j].z * v[j].z + v[j].w * v[j].w); }
            s = wave_sum(s);
            if (lane == 0) *(f32x4*)(RSS0 + (size_t)m * 4) = (f32x4){s, 0.f, 0.f, 0.f};
            GAS unsigned long long* o8 = (GAS unsigned long long*)(ABUF + (size_t)m * D) + lane;
#pragma unroll
            for (int j = 0; j < 4; ++j) { const int c = 4 * lane + 256 * j; const f32x4 g = *(const f32x4*)(norm_ffn1 + c) * (*(const f32x4*)(MOD + b * NMOD + 1 * D + c) + 1.0f); const f32x4 a = v[j] * g;
                o8[64 * j] = (unsigned long long)pk2(a.x, a.y) | ((unsigned long long)pk2(a.z, a.w) << 32); }
        }
        bias_rows(W1T, CB1, NFF, MOD + 0 * D, MOD + NMOD + 0 * D, gw, NGW);
        if (BOTH(1)) GRID_BAR(1);
    }

    if (IN(2)) {
        pg8::Gemm g{ABUF, W1T, M, NFF, D}; pg8::StaticOrder S; S.init(M, NFF, G, bx);
        pg8::EpiSwiGLU E{HB, DFF, RSS0, CB1, NFF};
        pg8::gemm_phase<pg8::EpiSwiGLU, pg8::StaticOrder, PG8_ALIGN, PG8_SP2>(ldsl + RING_OFF, g, S, E, wave);
        { pg8::Unit ud; const int nunits = (M / 256) * (NFF / 256), nfull = nunits / G;
          if (!S.next(nfull, ud)) {
            const int nidle = G - (nunits - nfull * G), iw = (bx - (G - nidle)) * NWAVES + wave, NIW = nidle * NWAVES, lane2 = MK_LANE();
            MOD_GEMV(64, 288, bx - (G - nidle), nidle, wave * 64 + lane2, lane2);
            constexpr int I_IN = (D / 64) * (NIN / 32), I_1O = (DFF / 64) * (D / 32), NITEMS = I_IN + I_1O;
            auto item_of = [&](int it) -> TItem { return it < I_IN ? p0_item_addr(w_in, NIN, WINT, D, 0, 2, it, lane2) : p0_item_addr(w_ffn1_out, D, W1OT, DFF, 0, 0, it - I_IN, lane2); };
            for (int it = iw; it < NITEMS; it += 2 * NIW) {
                const int it2 = it + NIW; const bool two = it2 < NITEMS;
                const TItem a = item_of(it), b2 = item_of(two ? it2 : it);
                f32x4 va[8], vb[8];
                p0_item_load(a, va); if (two) p0_item_load(b2, vb);
                p0_item_store(a, va); if (two) p0_item_store(b2, vb);
            }
            { const float invf = (float)pow(10000.0, -(double)(2 * (lane2 & 31)) / 64.0);
              for (int i = iw * 64 + lane2; i < M * 32; i += NIW * 64) { const float ang = (float)positions[i >> 5] * invf; const int row = i >> 5, d = i & 31;
                  ROPET[row * 64 + d] = (bf16)f2bf(cosf(ang)); ROPET[row * 64 + 32 + d] = (bf16)f2bf(sinf(ang)); } }
          } }
        if (BOTH(2)) GRID_BAR(2);
    }
    if (IN(3)) {
        pg8::Gemm g{HB, W1OT, M, D, DFF}; pg8::StaticOrder S; S.init(M, D, G, bx);
        pg8::EpiResid<true, 1, false, true> E{x, X1B, MOD + 2 * D, ABUF, norm_mix, MOD + 4 * D, RSS1};
        pg8::gemm_phase<pg8::EpiResid<true, 1, false, true>, pg8::StaticOrder, false, PG8_SP2>(ldsl + RING_OFF, g, S, E, wave);
        bias_rows(WINT, CBIN, NIN, MOD + 3 * D, MOD + NMOD + 3 * D, gw, NGW);
        if (BOTH(3)) GRID_BAR(3);
    }
    if (IN(4)) {
        pg8::Gemm g{ABUF, WINT, M, NIN, D}; pg8::StaticOrder S; S.init(M, NIN, G, bx);
        pg8::EpiInProj E{QA, KA, VA, QB, KB, VB, GA, GB, RSS1, CBIN, ROPET, qn_a, kn_a, qn_b, kn_b, QSCALE};
        pg8::gemm_phase<pg8::EpiInProj, pg8::StaticOrder, PG8_ALIGN, PG8_SP2>(ldsl + RING_OFF, g, S, E, wave);
        { pg8::Unit ud; const int nunits = (M / 256) * (NIN / 256), nfull = nunits / G;
          if (!S.next(nfull, ud)) {
            const int nidle = G - (nunits - nfull * G), iw = (bx - (G - nidle)) * NWAVES + wave, NIW = nidle * NWAVES, lane2 = MK_LANE();
            constexpr int I_1 = (D / 64) * (NFF / 32), I_1O = (DFF / 64) * (D / 32), I_BR = (512 / 64) * (D / 32), I_O = (D / 64) * (D / 32);
            constexpr int NITEMS = 2 * I_BR + I_O + I_1 + I_1O;
            auto item_of = [&](int it) -> TItem {
                int r = it;
                if (r < I_BR) return p0_item_addr(w_branch_a, D, WBRT, D, 0, 0, r, lane2); r -= I_BR;
                if (r < I_BR) return p0_item_addr(w_branch_b, D, WBRT, D, 512, 0, r, lane2); r -= I_BR;
                if (r < I_O) return p0_item_addr(w_out, D, WOT, D, 0, 0, r, lane2); r -= I_O;
                if (r < I_1) return p0_item_addr(w_ffn2_in, NFF, W2T, D, 0, 1, r, lane2); r -= I_1;
                return p0_item_addr(w_ffn2_out, D, W2OT, DFF, 0, 0, r, lane2);
            };
            for (int it = iw; it < NITEMS; it += 2 * NIW) {
                const int it2 = it + NIW; const bool two = it2 < NITEMS;
                const TItem a = item_of(it), b2 = item_of(two ? it2 : it);
                f32x4 va[8], vb[8];
                p0_item_load(a, va); if (two) p0_item_load(b2, vb);
                p0_item_store(a, va); if (two) p0_item_store(b2, vb);
            }
          } }
        if (BOTH(4)) GRID_BAR(4);
    }
    if (IN(5)) {
        char* alds = (char*)lds + RING_OFF;
        const __amdgpu_buffer_rsrc_t wsrs = __builtin_amdgcn_make_buffer_rsrc((void*)ws, (short)0, 0x10000000, 0x00020000);
#ifndef SKIP_WIN
        for (int id = vcu; id < 256; id += G) att::win_unit2(wsrs, (const char*)ws, id >> 7, (id >> 6) & 1, id & 31, (id >> 5) & 1, QA, KA, VA, ABUF, SCAL, alds, wave);
#endif
#ifndef SKIP_DIFF
        for (int id = vcu; id < 256; id += G) att::diff_unit(wsrs, (const char*)ws, id >> 7, (id >> 5) & 3, id & 31, QB, KB, VB, ABUF, SCAL, subln_b, alds, wave);
#endif
        if (BOTH(5)) GRID_BAR(5);
    }
    if (IN(6)) {
        pg8::Gemm g{ABUF, WBRT, M, D, D, 512}; pg8::PairOrder S; S.init(M, D, G, bx, D);
        pg8::EpiBranch E{GA, GB, MG};
        pg8::gemm_phase<pg8::EpiBranch, pg8::PairOrder, false, PG8_SP2>(ldsl + RING_OFF, g, S, E, wave);
        if (BOTH(6)) GRID_BAR(6);
    }
    if (IN(7)) {
        pg8::Gemm g{MG, WOT, M, D, D}; pg8::StaticOrder S; S.init(M, D, G, bx);
        pg8::EpiResid<true, 2, true, true> E{X1B, X2B, MOD + 5 * D, ABUF, norm_ffn2, MOD + 7 * D, RSS2};
        pg8::gemm_phase<pg8::EpiResid<true, 2, true, true>, pg8::StaticOrder, false, PG8_SP2>(ldsl + RING_OFF, g, S, E, wave);
        bias_rows(W2T, CB2, NFF, MOD + 6 * D, MOD + NMOD + 6 * D, gw, NGW);
        if (BOTH(7)) GRID_BAR(7);
    }
    if (IN(8)) {
        pg8::Gemm g{ABUF, W2T, M, NFF, D}; pg8::StaticOrder S; S.init(M, NFF, G, bx);
        pg8::EpiSwiGLU E{HB, DFF, RSS2, CB2, NFF};
        pg8::gemm_phase<pg8::EpiSwiGLU, pg8::StaticOrder, PG8_ALIGN, PG8_SP2>(ldsl + RING_OFF, g, S, E, wave);
        if (BOTH(8)) GRID_BAR(8);
    }
    if (IN(9)) {
        pg8::Gemm g{HB, W2OT, M, D, DFF}; pg8::StaticOrder S; S.init(M, D, G, bx);
        pg8::EpiResid<false, 1, true, false> E{X2B, out, MOD + 8 * D, nullptr, nullptr, nullptr, nullptr};
        pg8::gemm_phase<pg8::EpiResid<false, 1, true, false>, pg8::StaticOrder, false, PG8_SP2>(ldsl + RING_OFF, g, S, E, wave);
    }
#undef IN
#undef BOTH
#undef GRID_BAR
}

extern "C" void kernel_launch(void* const* d_in, const int* in_sizes, int n_in, void* d_out, int out_size, void* d_ws, size_t ws_size, hipStream_t stream) {
    static int grid = 0;
    if (grid == 0) {
        if (n_in != 26 || in_sizes[0] != M * D || out_size != M * D || ws_size < WS_END) { fprintf(stderr, "kernel_launch: unexpected shapes: n_in %d in0 %d out %d ws %zu (need >= %zu)\n", n_in, n_in > 0 ? in_sizes[0] : -1, out_size, ws_size, (size_t)WS_END); grid = -1; return; }
        int dev = 0, cus = 0;
        if (hipGetDevice(&dev) != hipSuccess || hipDeviceGetAttribute(&cus, hipDeviceAttributeMultiprocessorCount, dev) != hipSuccess) { grid = -1; return; }
        if (hipFuncSetAttribute((const void*)layer_fwd, hipFuncAttributeMaxDynamicSharedMemorySize, LDS_BYTES) != hipSuccess) { fprintf(stderr, "kernel_launch: hipFuncSetAttribute failed\n"); grid = -1; return; }
        int per_cu = 0;
        if (hipOccupancyMaxActiveBlocksPerMultiprocessor(&per_cu, (const void*)layer_fwd, NWAVES * 64, LDS_BYTES) != hipSuccess || per_cu < 1) fprintf(stderr, "kernel_launch: occupancy query says %d\n", per_cu);
        (void)hipGetLastError();
        grid = cus;
        if (grid != 256) fprintf(stderr, "kernel_launch: %d CUs; the one-unit-per-workgroup phases need exactly 256\n", grid);
    }
    if (grid < 0) return;
    (void)hipMemsetAsync((char*)d_ws + WS_CTL, 0, CTL_ZERO_BYTES, stream);
    Args a{};
    for (int i = 0; i < 26; ++i) a.in[i] = d_in[i];
    a.out = (float*)d_out; a.ws = (unsigned char*)d_ws;
    for (int li = 0; li < N_LAUNCHES; ++li) {
        a.ph_lo = (N_LAUNCHES == PER_PHASE) ? li : 0; a.ph_hi = (N_LAUNCHES == PER_PHASE) ? li + 1 : PER_PHASE; a.li = li;
        hipLaunchKernelGGL(layer_fwd, dim3(grid), dim3(NWAVES * 64), LDS_BYTES, stream, a);
    }
}
```

```cpp
#include <hip/hip_runtime.h>
#include <cstdio>
#include <cstdint>
#include <cmath>
__device__ __forceinline__ int mk_lane_() { int l; asm volatile("v_mbcnt_lo_u32_b32 %0, -1, 0\n\tv_mbcnt_hi_u32_b32 %0, -1, %0" : "=v"(l)); return l; }
#define MK_LANE() mk_lane_()
namespace pg8 {
#define PG8_LAS __attribute__((address_space(3)))
typedef unsigned short bf16_t;
typedef short bf16x8 __attribute__((ext_vector_type(8)));
typedef float f32x4 __attribute__((ext_vector_type(4)));
typedef unsigned u32x4 __attribute__((ext_vector_type(4)));
constexpr int BM = 256, BK = 64, HALF = 128, HTB = HALF * BK * 2  , STAGE_BYTES = 8 * HTB, NXCD = 8, WGM = 8;

__host__ __device__ __forceinline__ int lds_byte(int r, int c) { const int st = (r >> 4) * 2 + (c >> 5), rr = r & 15, cc = c & 31, ob = rr * 64 + cc * 2; return st * 1024 + (ob ^ (((ob >> 9) & 1) << 5)); }
__host__ __device__ __forceinline__ void stage_rc(int b, int& R, int& C) { const int st = b / 1024, sb = b % 1024, swz = sb ^ (((sb >> 9) & 1) << 5); R = (st >> 1) * 16 + swz / 64; C = (st & 1) * 32 + (swz % 64) / 2; }
__host__ __device__ __forceinline__ int perm32(int rho) { const int n = rho >> 4, i = rho & 15; return 8 * (i >> 2) + 4 * n + (i & 3); }

struct Unit { int pm, pn, ko; };
struct Gemm { const bf16_t* A; const bf16_t* Bt; int M, N, K; int KL = 0; };

struct StaticOrder {
    int nM, nN, nwg, G, c;
    __host__ __device__ void init(int M, int N, int G_, int c_) { nM = M / BM; nN = N / BM; nwg = nM * nN; G = G_; c = c_; }
    __host__ __device__ bool next(int i, Unit& u) const {
        const long L = (long)i * G + c; if (L >= nwg) return false;
        int wgid = (int)L; { const int q = nwg / NXCD, r = nwg % NXCD, xcd = wgid % NXCD, off = wgid / NXCD; wgid = (xcd < r ? xcd * (q + 1) : r * (q + 1) + (xcd - r) * q) + off; }
        const int nig = WGM * nN, gid = wgid / nig, fm = gid * WGM, gsz = (nM - fm) < WGM ? (nM - fm) : WGM;
        u.pm = fm + ((wgid % nig) % gsz); u.pn = (wgid % nig) / gsz; u.ko = 0; return true;
    }
    __device__ __forceinline__ void a_ready(const Unit&) const {}
    __device__ __forceinline__ void done(const Unit&) const {}
};
struct PairOrder {
    StaticOrder S; int khalf_bytes;
    __host__ __device__ void init(int M, int N, int G_, int c_, int K) { S.init(M, N, G_, c_); khalf_bytes = K;   }
    __host__ __device__ bool next(int i, Unit& u) const { if (!S.next(i >> 1, u)) return false; u.ko = (i & 1) * khalf_bytes; return true; }
    __device__ __forceinline__ void a_ready(const Unit&) const {}
    __device__ __forceinline__ void done(const Unit&) const {}
};

__device__ __forceinline__ unsigned cvt_pk_bf16(float lo, float hi) { unsigned r; asm volatile("v_cvt_pk_bf16_f32 %0, %1, %2" : "=v"(r) : "v"(lo), "v"(hi)); return r; }
__device__ __forceinline__ float bf_lo(unsigned w) { return __uint_as_float(w << 16); }
__device__ __forceinline__ float bf_hi(unsigned w) { return __uint_as_float(w & 0xffff0000u); }
constexpr float RMS_EPS = 1e-6f, LOG2E = 1.4426950408889634f;
__device__ __forceinline__ float row_rinv(const float* rss, int row) { const f32x4 s = *(const f32x4*)(rss + (size_t)row * 4); return rsqrtf(((s[0] + s[1]) + (s[2] + s[3])) * (1.0f / 1024.0f) + RMS_EPS); }
__device__ __forceinline__ float fast_sigmoid(float v) { return __builtin_amdgcn_rcpf(1.0f + __builtin_amdgcn_exp2f(-v * LOG2E)); }

struct EpiSwiGLU {
    static constexpr bool PERM = true, AFTER_DRAIN = false, PREFETCH = true, CHAIN = false;
    bf16_t* H; int ldh; const float* rss; const float* cb; int ncb;
    __device__ __forceinline__ void prefetch(const Unit& u, PG8_LAS unsigned char* buf, int wid, int lane) const {
        if (wid < 4) __builtin_amdgcn_global_load_lds((const unsigned*)(rss + (size_t)(u.pm * BM + wid * 64 + lane) * 4), (PG8_LAS unsigned*)(buf + wid * 1024), 16, 0, 0);
        else if (wid == 4) __builtin_amdgcn_global_load_lds((const unsigned*)(cb + (size_t)(u.pm >> 5) * ncb + u.pn * BM + lane * 4), (PG8_LAS unsigned*)(buf + 4096), 16, 0, 0);
    }
    __device__ __forceinline__ void operator()(const f32x4 (&acc)[2][2][4][2], const Unit& u, int wr, int wc, int fr, int fq, const PG8_LAS unsigned char* buf) const {
        const int outcol = u.pn * HALF + wc * 32 + 8 * fq;
        const PG8_LAS float* cbb = (const PG8_LAS float*)(buf + 4096) + wc * 32 + 8 * fq;
        const f32x4 bg0 = *(const PG8_LAS f32x4*)(cbb), bg1 = *(const PG8_LAS f32x4*)(cbb + 4), bu0 = *(const PG8_LAS f32x4*)(cbb + HALF), bu1 = *(const PG8_LAS f32x4*)(cbb + HALF + 4);
#pragma unroll
        for (int ai = 0; ai < 2; ++ai) {
#pragma unroll
            for (int m = 0; m < 4; ++m) {
                const int row = u.pm * BM + ai * HALF + wr * 64 + m * 16 + fr; const f32x4 sv_ = *(const PG8_LAS f32x4*)(buf + (ai * HALF + wr * 64 + m * 16 + fr) * 16); const float ri = rsqrtf(((sv_[0] + sv_[1]) + (sv_[2] + sv_[3])) * (1.0f / 1024.0f) + RMS_EPS);
                const f32x4 g0 = acc[ai][0][m][0] * ri + bg0, g1 = acc[ai][0][m][1] * ri + bg1, u0 = acc[ai][1][m][0] * ri + bu0, u1 = acc[ai][1][m][1] * ri + bu1;
                float o[8];
#pragma unroll
                for (int j = 0; j < 4; ++j) { o[j] = g0[j] * fast_sigmoid(g0[j]) * u0[j]; o[4 + j] = g1[j] * fast_sigmoid(g1[j]) * u1[j]; }
                u32x4 w; w.x = cvt_pk_bf16(o[0], o[1]); w.y = cvt_pk_bf16(o[2], o[3]); w.z = cvt_pk_bf16(o[4], o[5]); w.w = cvt_pk_bf16(o[6], o[7]);
                *(u32x4*)(H + (size_t)row * ldh + outcol) = w; } }
    }
};

struct EpiInProj {
    static constexpr bool PERM = true, AFTER_DRAIN = false, PREFETCH = true, CHAIN = false;
    bf16_t *QA, *KA, *VA, *QB, *KB, *VB, *GA, *GB; const float* rss; const float* cb; const bf16_t* ropet; const float *qn_a, *kn_a, *qn_b, *kn_b; float qscale;
    __device__ __forceinline__ void prefetch(const Unit& u, PG8_LAS unsigned char* buf, int wid, int lane) const {
        if (wid < 4) __builtin_amdgcn_global_load_lds((const unsigned*)(rss + (size_t)(u.pm * BM + wid * 64 + lane) * 4), (PG8_LAS unsigned*)(buf + wid * 1024), 16, 0, 0);
        else if (wid == 4) __builtin_amdgcn_global_load_lds((const unsigned*)(cb + (size_t)(u.pm >> 5) * 4352 + u.pn * BM + lane * 4), (PG8_LAS unsigned*)(buf + 4096), 16, 0, 0);
    }
    __device__ __forceinline__ void operator()(const f32x4 (&acc)[2][2][4][2], const Unit& u, int wr, int wc, int fr, int fq, const PG8_LAS unsigned char* buf) const {
        const int pn = u.pn;
        int mode; bf16_t* dst; int ld; const float* gain = qn_a; float scale = 1.f;
        if (pn < 2) { mode = 0; dst = QA + (4 * pn + wc) * 64; ld = 512; gain = qn_a; scale = qscale; }
        else if (pn == 2) { if (wc < 2) { mode = 0; dst = KA + wc * 64; ld = 128; gain = kn_a; } else { mode = 1; dst = VA + (wc - 2) * 64; ld = 128; } }
        else if (pn < 5) { mode = 0; dst = QB + (4 * (pn - 3) + wc) * 64; ld = 512; gain = qn_b; scale = qscale; }
        else if (pn < 7) { mode = 0; dst = KB + (4 * (pn - 5) + wc) * 64; ld = 512; gain = kn_b; }
        else if (pn < 9) { mode = 1; dst = VB + (4 * (pn - 7) + wc) * 64; ld = 512; }
        else if (pn < 13) { mode = 2; dst = GA + (pn - 9) * BM + wc * 32; ld = 1024; }
        else { mode = 2; dst = GB + (pn - 13) * BM + wc * 32; ld = 1024; }
        const int bjoff = (mode == 2) ? HALF : 32;
        const PG8_LAS float* cbb = (const PG8_LAS float*)(buf + 4096) + wc * 32 + 8 * fq;
        f32x4 bv[2][2];
#pragma unroll
        for (int bj = 0; bj < 2; ++bj)
#pragma unroll
            for (int n = 0; n < 2; ++n) bv[bj][n] = *(const PG8_LAS f32x4*)(cbb + bj * HALF + 4 * n);
        f32x4 gv[2][2];
#pragma unroll
        for (int bj = 0; bj < 2; ++bj)
#pragma unroll
            for (int n = 0; n < 2; ++n) gv[bj][n] = *(const f32x4*)(gain + bj * 32 + 8 * fq + 4 * n);
#pragma unroll
        for (int ai = 0; ai < 2; ++ai) {
            u32x4 csw[4], snw[4];
            if (mode == 0) {
#pragma unroll
              for (int m = 0; m < 4; ++m) { const bf16_t* tp = ropet + (size_t)(u.pm * BM + ai * HALF + wr * 64 + m * 16 + fr) * 64 + 8 * fq; csw[m] = *(const u32x4*)tp; snw[m] = *(const u32x4*)(tp + 32); } }
#pragma unroll
            for (int m = 0; m < 4; ++m) {
                const int row = u.pm * BM + ai * HALF + wr * 64 + m * 16 + fr; const f32x4 sv_ = *(const PG8_LAS f32x4*)(buf + (ai * HALF + wr * 64 + m * 16 + fr) * 16); const float ri = rsqrtf(((sv_[0] + sv_[1]) + (sv_[2] + sv_[3])) * (1.0f / 1024.0f) + RMS_EPS);
                f32x4 v[2][2];
#pragma unroll
                for (int bj = 0; bj < 2; ++bj)
#pragma unroll
                    for (int n = 0; n < 2; ++n) v[bj][n] = acc[ai][bj][m][n] * ri + bv[bj][n];
                if (mode == 0) {
                    float ss = 0.f;
#pragma unroll
                    for (int bj = 0; bj < 2; ++bj)
#pragma unroll
                        for (int n = 0; n < 2; ++n) ss += (v[bj][n][0] * v[bj][n][0] + v[bj][n][1] * v[bj][n][1]) + (v[bj][n][2] * v[bj][n][2] + v[bj][n][3] * v[bj][n][3]);
                    ss += __shfl_xor(ss, 16); ss += __shfl_xor(ss, 32);
                    const float rn = rsqrtf(ss * (1.0f / 64.0f) + RMS_EPS);
#pragma unroll
                    for (int n = 0; n < 2; ++n) {
                        const unsigned c0_ = n ? csw[m].z : csw[m].x, c1_ = n ? csw[m].w : csw[m].y, s0_ = n ? snw[m].z : snw[m].x, s1_ = n ? snw[m].w : snw[m].y;
                        const f32x4 cs = {bf_lo(c0_), bf_hi(c0_), bf_lo(c1_), bf_hi(c1_)}, sn = {bf_lo(s0_), bf_hi(s0_), bf_lo(s1_), bf_hi(s1_)};
                        const f32x4 lo = v[0][n] * rn * gv[0][n], hi = v[1][n] * rn * gv[1][n];
                        v[0][n] = (lo * cs - hi * sn) * scale; v[1][n] = (hi * cs + lo * sn) * scale; }
                } else if (mode == 2) {
#pragma unroll
                    for (int bj = 0; bj < 2; ++bj)
#pragma unroll
                        for (int n = 0; n < 2; ++n)
#pragma unroll
                            for (int j = 0; j < 4; ++j) v[bj][n][j] = fast_sigmoid(v[bj][n][j]);
                }
                bf16_t* rowp = dst + (size_t)row * ld + 8 * fq;
#pragma unroll
                for (int bj = 0; bj < 2; ++bj) { u32x4 w; w.x = cvt_pk_bf16(v[bj][0][0], v[bj][0][1]); w.y = cvt_pk_bf16(v[bj][0][2], v[bj][0][3]); w.z = cvt_pk_bf16(v[bj][1][0], v[bj][1][1]); w.w = cvt_pk_bf16(v[bj][1][2], v[bj][1][3]);
                    *(u32x4*)(rowp + bj * bjoff) = w; } } }
    }
};

struct EpiBranch {
    static constexpr bool PERM = true, AFTER_DRAIN = false, PREFETCH = false, CHAIN = true;
    const bf16_t* GA; const bf16_t* GB; bf16_t* MG;
    __device__ __forceinline__ void operator()(f32x4 (&acc)[2][2][4][2], const Unit& u, int wr, int wc, int fr, int fq) const {
        const bool second = u.ko != 0; constexpr float TINY = 8.67361738e-19f;
        const unsigned rowoff = (unsigned)((u.pm * BM + wr * 64 + fr) * 1024 + u.pn * BM + wc * 32 + 8 * fq);
#define EB_OFF(ai, bj, m) (rowoff + (unsigned)(((ai) * HALF + (m) * 16) * 1024 + (bj) * HALF))
#define EB_UNPACK(dst, src_) const float dst[8] = {bf_lo((src_).x), bf_hi((src_).x), bf_lo((src_).y), bf_hi((src_).y), bf_lo((src_).z), bf_hi((src_).z), bf_lo((src_).w), bf_hi((src_).w)}
        if (!second) {
#pragma unroll
            for (int ai = 0; ai < 2; ++ai)
#pragma unroll
                for (int bj = 0; bj < 2; ++bj) {
                    u32x4 gbv[4], gav[4];
#pragma unroll
                    for (int m = 0; m < 4; ++m) { gbv[m] = *(const u32x4*)(GB + EB_OFF(ai, bj, m)); gav[m] = *(const u32x4*)(GA + EB_OFF(ai, bj, m)); }
#pragma unroll
                    for (int m = 0; m < 4; ++m) { EB_UNPACK(gb, gbv[m]); EB_UNPACK(ga, gav[m]);
#pragma unroll
                        for (int e = 0; e < 4; ++e) { acc[ai][bj][m][0][e] *= ga[e] * __builtin_amdgcn_rcpf(fmaxf(gb[e], TINY)); acc[ai][bj][m][1][e] *= ga[4 + e] * __builtin_amdgcn_rcpf(fmaxf(gb[4 + e], TINY)); } }
                }
        } else {
#pragma unroll
            for (int ai = 0; ai < 2; ++ai) {
                u32x4 gbv[2][4];
#pragma unroll
                for (int bj = 0; bj < 2; ++bj)
#pragma unroll
                    for (int m = 0; m < 4; ++m) gbv[bj][m] = *(const u32x4*)(GB + EB_OFF(ai, bj, m));
#pragma unroll
                for (int bj = 0; bj < 2; ++bj)
#pragma unroll
                    for (int m = 0; m < 4; ++m) { EB_UNPACK(g0, gbv[bj][m]); float gb[8];
#pragma unroll
                        for (int e = 0; e < 8; ++e) gb[e] = fmaxf(g0[e], TINY);
                        const f32x4 y0 = acc[ai][bj][m][0], y1 = acc[ai][bj][m][1];
                        u32x4 w; w.x = cvt_pk_bf16(gb[0] * y0[0], gb[1] * y0[1]); w.y = cvt_pk_bf16(gb[2] * y0[2], gb[3] * y0[3]); w.z = cvt_pk_bf16(gb[4] * y1[0], gb[5] * y1[1]); w.w = cvt_pk_bf16(gb[6] * y1[2], gb[7] * y1[3]);
                        *(u32x4*)(MG + EB_OFF(ai, bj, m)) = w; }
            }
        }
#undef EB_OFF
#undef EB_UNPACK
    }
};

template <bool WRITE_A, int COEF2, bool RIN_BF16, bool ROUT_BF16> struct EpiResid {
    static constexpr bool PERM = true, AFTER_DRAIN = true, PREFETCH = false, CHAIN = false;
    static constexpr float coef = 0.5f * COEF2; static constexpr int modld = 9216;
    const void* xin; void* xout; const float* gate;
    bf16_t* Aout; const float* gnorm; const float* sc; float* rss_out;
    __device__ __forceinline__ void fused(f32x4 (&acc)[2][2][4][2], const Unit& u, int wr, int wc, int fr, int fq, PG8_LAS unsigned char* lds, int wid, int lane) const {
        const int b = u.pm >> 5, col0 = u.pn * BM + wc * 32 + 8 * fq;
        float ss[2][4];
#pragma unroll
        for (int ai = 0; ai < 2; ++ai)
#pragma unroll
            for (int m = 0; m < 4; ++m) ss[ai][m] = 0.f;
        auto stage = [&](int bjsel) {
#pragma unroll 1
            for (int i = 0; i < 16; ++i) { const int rr = wid * 32 + 2 * i + (lane >> 5), g = (lane & 31) ^ (rr & 31);
                const char* src = RIN_BF16 ? (const char*)xin + ((size_t)(u.pm * BM + rr) * 1024 + u.pn * BM) * 2 + g * 16
                                           : (const char*)xin + ((size_t)(u.pm * BM + rr) * 1024 + u.pn * BM + bjsel * HALF) * 4 + g * 16;
                __builtin_amdgcn_global_load_lds((const unsigned*)src, (PG8_LAS unsigned*)(lds + (wid * 32 + 2 * i) * 512), 16, 0, 0); }
        };
        if constexpr (RIN_BF16) stage(0); else stage(0);
        f32x4 gtA[2][2], gvA[2][2];
#pragma unroll
        for (int bj = 0; bj < 2; ++bj)
#pragma unroll
            for (int n = 0; n < 2; ++n) { const int c = col0 + bj * HALF + 4 * n; gtA[bj][n] = *(const f32x4*)(gate + (size_t)b * modld + c) * coef;
                if (WRITE_A) gvA[bj][n] = *(const f32x4*)(gnorm + c) * (*(const f32x4*)(sc + (size_t)b * modld + c) + 1.0f); }
        asm volatile("s_waitcnt vmcnt(0)" ::: "memory"); __builtin_amdgcn_s_barrier(); asm volatile("" ::: "memory");
#pragma unroll
        for (int bj = 0; bj < 2; ++bj) {
            if constexpr (!RIN_BF16) { if (bj) { asm volatile("s_waitcnt lgkmcnt(0)" ::: "memory"); __builtin_amdgcn_s_barrier();
                stage(bj); asm volatile("s_waitcnt vmcnt(0)" ::: "memory"); __builtin_amdgcn_s_barrier(); asm volatile("" ::: "memory"); } }
            f32x4 gt[2], gvv[2];
#pragma unroll
            for (int n = 0; n < 2; ++n) { gt[n] = gtA[bj][n]; if (WRITE_A) gvv[n] = gvA[bj][n]; }
#pragma unroll
            for (int ai = 0; ai < 2; ++ai) {
                f32x4 xi[4][2];
#pragma unroll
                for (int m = 0; m < 4; ++m) { const int rr = ai * HALF + wr * 64 + m * 16 + fr;
                    if constexpr (RIN_BF16) { const u32x4 w = *(const PG8_LAS u32x4*)(lds + rr * 512 + (((bj * 16 + wc * 4 + fq) ^ (rr & 31)) << 4));
                        xi[m][0] = (f32x4){bf_lo(w.x), bf_hi(w.x), bf_lo(w.y), bf_hi(w.y)}; xi[m][1] = (f32x4){bf_lo(w.z), bf_hi(w.z), bf_lo(w.w), bf_hi(w.w)}; }
                    else {
#pragma unroll
                        for (int n = 0; n < 2; ++n) xi[m][n] = *(const PG8_LAS f32x4*)(lds + rr * 512 + (((wc * 8 + fq * 2 + n) ^ (rr & 31)) << 4)); } }
#pragma unroll
                for (int m = 0; m < 4; ++m) {
                    const int row = u.pm * BM + ai * HALF + wr * 64 + m * 16 + fr; const size_t off = (size_t)row * 1024 + col0 + bj * HALF; float s = 0.f;
                    f32x4 xo[2];
#pragma unroll
                    for (int n = 0; n < 2; ++n) { xo[n] = xi[m][n] + gt[n] * acc[ai][bj][m][n];
                        if constexpr (!ROUT_BF16) *(f32x4*)((float*)xout + off + 4 * n) = xo[n];
                        if (WRITE_A) s += (xo[n][0] * xo[n][0] + xo[n][1] * xo[n][1]) + (xo[n][2] * xo[n][2] + xo[n][3] * xo[n][3]); }
                    if constexpr (ROUT_BF16) { u32x4 w; w.x = cvt_pk_bf16(xo[0][0], xo[0][1]); w.y = cvt_pk_bf16(xo[0][2], xo[0][3]); w.z = cvt_pk_bf16(xo[1][0], xo[1][1]); w.w = cvt_pk_bf16(xo[1][2], xo[1][3]); *(u32x4*)((bf16_t*)xout + off) = w; }
                    if (WRITE_A) { const f32x4 a0 = xo[0] * gvv[0], a1 = xo[1] * gvv[1]; u32x4 w; w.x = cvt_pk_bf16(a0[0], a0[1]); w.y = cvt_pk_bf16(a0[2], a0[3]); w.z = cvt_pk_bf16(a1[0], a1[1]); w.w = cvt_pk_bf16(a1[2], a1[3]);
                        *(u32x4*)(Aout + off) = w; ss[ai][m] += s; } }
                asm volatile("" ::: "memory"); }
        }
        if (WRITE_A) {
            asm volatile("s_waitcnt lgkmcnt(0)" ::: "memory"); __builtin_amdgcn_s_barrier(); asm volatile("" ::: "memory");
            PG8_LAS float* P = (PG8_LAS float*)lds;
#pragma unroll
            for (int ai = 0; ai < 2; ++ai)
#pragma unroll
                for (int m = 0; m < 4; ++m) { float s = ss[ai][m]; s += __shfl_xor(s, 16); s += __shfl_xor(s, 32); if (fq == 0) P[(ai * HALF + wr * 64 + m * 16 + fr) * 4 + wc] = s; }
            asm volatile("s_waitcnt lgkmcnt(0)" ::: "memory"); __builtin_amdgcn_s_barrier(); asm volatile("" ::: "memory");
            const int t = wid * 64 + lane;
            if (t < 256) { const PG8_LAS float* p = P + t * 4; rss_out[(size_t)(u.pm * BM + t) * 4 + u.pn] = (p[0] + p[1]) + (p[2] + p[3]); }
        }
    }
};

template <class Epi, class Sched, bool ALIGN_EPI = false, bool SP2 = false>
__device__ __forceinline__ void gemm_phase(PG8_LAS unsigned char* lds, const Gemm g, const Sched S, const Epi E, const int wid  ) {
    const int lane = MK_LANE(), tid = wid * 64 + lane, wr = wid >> 2, wc = wid & 3, fr = lane & 15, fq = lane >> 4;
    const int K = g.K, nt = (g.KL ? g.KL : K) / BK;
    unsigned voffA[2], voffB[2];
#pragma unroll
    for (int i = 0; i < 2; ++i) { int R, C; stage_rc(tid * 16 + i * 8192, R, C); const int Rb = Epi::PERM ? ((R & ~31) + perm32(R & 31)) : R;
        voffA[i] = (unsigned)(R * K + C) * 2u; voffB[i] = (unsigned)(Rb * K + C) * 2u; }
    const size_t kstep = (size_t)(BK * 2);
    const size_t hstep = (size_t)HALF * K * 2;
    const size_t tstep = 2 * hstep;
    const unsigned ldsw = (unsigned)wid * 1024u;
    const int aoff = lds_byte(wr * 64 + fr, fq * 8), boff = lds_byte(wc * 32 + fr, fq * 8);
#define PG8_SA(b, h) (((b) * 2 + (h)) * HTB)
#define PG8_SB(b, h) ((4 + (b) * 2 + (h)) * HTB)
#define PG8_STAGE(bufoff, gbase, voff) do { _Pragma("unroll") for (int _i = 0; _i < 2; ++_i) \
        __builtin_amdgcn_global_load_lds((const unsigned*)((const char*)(gbase) + (voff)[_i]), (PG8_LAS unsigned*)(lds + (bufoff) + ldsw + _i * 8192), 16, 0, 0); } while (0)
#define PG8_LDA(dst, b, h) do { _Pragma("unroll") for (int m = 0; m < 4; ++m) _Pragma("unroll") for (int k = 0; k < 2; ++k) dst[m][k] = *(const PG8_LAS bf16x8*)(lds + PG8_SA(b, h) + aoff + m * 2048 + k * 1024); } while (0)
#define PG8_LDB(dst, b, h) do { _Pragma("unroll") for (int n = 0; n < 2; ++n) _Pragma("unroll") for (int k = 0; k < 2; ++k) dst[n][k] = *(const PG8_LAS bf16x8*)(lds + PG8_SB(b, h) + boff + n * 2048 + k * 1024); } while (0)
#define PG8_MMA(ai, bj, At, Bt) do { __builtin_amdgcn_s_setprio(1); _Pragma("unroll") for (int m = 0; m < 4; ++m) _Pragma("unroll") for (int n = 0; n < 2; ++n) _Pragma("unroll") for (int k = 0; k < 2; ++k) \
        acc[ai][bj][m][n] = __builtin_amdgcn_mfma_f32_16x16x32_bf16(Bt[n][k], At[m][k], acc[ai][bj][m][n], 0, 0, 0); __builtin_amdgcn_s_setprio(0); } while (0)
#define PG8_WAIT_V(n) asm volatile("s_waitcnt vmcnt(" #n ")" ::: "memory")
#define PG8_WAIT_L(n) asm volatile("s_waitcnt lgkmcnt(" #n ")" ::: "memory")
#define PG8_BAR __builtin_amdgcn_s_barrier()
#define PG8_SCHED __builtin_amdgcn_sched_barrier(0)
    Unit cur, nxt; int ui = 0;
    if (!S.next(0, cur)) return;
    f32x4 acc[2][2][4][2];
#pragma unroll
    for (int a = 0; a < 2; ++a)
#pragma unroll
        for (int b = 0; b < 2; ++b)
#pragma unroll
            for (int m = 0; m < 4; ++m)
#pragma unroll
                for (int n = 0; n < 2; ++n) acc[a][b][m][n] = (f32x4){0.f, 0.f, 0.f, 0.f};
    bf16x8 At[4][2], B0[2][2], B1[2][2];
    const char* cA = (const char*)g.A + (size_t)cur.pm * tstep + cur.ko; const char* cB = (const char*)g.Bt + (size_t)cur.pn * tstep + cur.ko;
    S.a_ready(cur);
    if constexpr (SP2) {
        PG8_STAGE(PG8_SB(0, 0), cB, voffB); PG8_STAGE(PG8_SB(0, 1), cB + hstep, voffB); PG8_STAGE(PG8_SA(0, 0), cA, voffA); PG8_STAGE(PG8_SA(0, 1), cA + hstep, voffA);
        if (wr == 1) PG8_BAR;
        PG8_WAIT_V(2); PG8_BAR;
        PG8_STAGE(PG8_SB(1, 0), cB + kstep, voffB); PG8_STAGE(PG8_SA(1, 0), cA + kstep, voffA); PG8_STAGE(PG8_SB(1, 1), cB + hstep + kstep, voffB);
        PG8_WAIT_V(6); PG8_BAR;
    } else {
        PG8_STAGE(PG8_SB(0, 0), cB, voffB); PG8_STAGE(PG8_SA(0, 0), cA, voffA); PG8_STAGE(PG8_SB(0, 1), cB + hstep, voffB); PG8_STAGE(PG8_SA(0, 1), cA + hstep, voffA);
        if (wr == 1) PG8_BAR;
        PG8_WAIT_V(4); PG8_BAR;
        PG8_STAGE(PG8_SB(1, 0), cB + kstep, voffB); PG8_STAGE(PG8_SA(1, 0), cA + kstep, voffA); PG8_STAGE(PG8_SB(1, 1), cB + hstep + kstep, voffB);
        PG8_WAIT_V(6); PG8_BAR;
    }
    for (;;) {
        if constexpr (Epi::PREFETCH) E.prefetch(cur, lds + STAGE_BYTES + (ui & 1) * 5120, wid, lane);
        const bool has_next = S.next(ui + 1, nxt);
        const char* nA = has_next ? (const char*)g.A + (size_t)nxt.pm * tstep + nxt.ko : cA; const char* nB = has_next ? (const char*)g.Bt + (size_t)nxt.pn * tstep + nxt.ko : cB;
        for (int t = 0; t < nt; t += 2) {
            const bool last = (t == nt - 2);
            const char* a1 = cA + (size_t)(t + 1) * kstep;
            const char* a2 = last ? nA : cA + (size_t)(t + 2) * kstep; const char* b2 = last ? nB : cB + (size_t)(t + 2) * kstep;
            const char* a3 = a2 + kstep; const char* b3 = b2 + kstep;
            if (last && has_next) S.a_ready(nxt);
            if constexpr (SP2) {
            PG8_LDB(B0, 0, 0); PG8_LDB(B1, 0, 1); PG8_SCHED; PG8_LDA(At, 0, 0); PG8_STAGE(PG8_SA(1, 1), a1 + hstep, voffA);
            PG8_WAIT_V(8); PG8_WAIT_L(0); PG8_BAR; PG8_MMA(0, 0, At, B0); PG8_MMA(0, 1, At, B1); PG8_BAR; PG8_SCHED;
            PG8_LDA(At, 0, 1); PG8_STAGE(PG8_SB(0, 0), b2, voffB); PG8_STAGE(PG8_SB(0, 1), b2 + hstep, voffB); PG8_STAGE(PG8_SA(0, 0), a2, voffA);
            PG8_WAIT_V(8); PG8_WAIT_L(0); PG8_BAR; PG8_MMA(1, 0, At, B0); PG8_MMA(1, 1, At, B1); PG8_BAR; PG8_SCHED;
            PG8_LDB(B0, 1, 0); PG8_LDB(B1, 1, 1); PG8_SCHED; PG8_LDA(At, 1, 0); PG8_STAGE(PG8_SA(0, 1), a2 + hstep, voffA);
            PG8_WAIT_V(8); PG8_WAIT_L(0); PG8_BAR; PG8_MMA(0, 0, At, B0); PG8_MMA(0, 1, At, B1); PG8_BAR; PG8_SCHED;
            PG8_LDA(At, 1, 1); PG8_STAGE(PG8_SB(1, 0), b3, voffB); PG8_STAGE(PG8_SB(1, 1), b3 + hstep, voffB); PG8_STAGE(PG8_SA(1, 0), a3, voffA);
            PG8_WAIT_V(8); PG8_WAIT_L(0); PG8_BAR; PG8_MMA(1, 0, At, B0); PG8_MMA(1, 1, At, B1); PG8_BAR; PG8_SCHED;
            } else {
            PG8_LDB(B0, 0, 0); PG8_SCHED; PG8_LDA(At, 0, 0); PG8_STAGE(PG8_SA(1, 1), a1 + hstep, voffA);
            PG8_WAIT_L(8); PG8_BAR; PG8_WAIT_L(0); PG8_MMA(0, 0, At, B0); PG8_BAR; PG8_SCHED;
            PG8_LDB(B1, 0, 1); PG8_STAGE(PG8_SB(0, 0), b2, voffB);
            PG8_BAR; PG8_WAIT_L(0); PG8_MMA(0, 1, At, B1); PG8_BAR;
            PG8_LDA(At, 0, 1); PG8_STAGE(PG8_SA(0, 0), a2, voffA);
            PG8_BAR; PG8_WAIT_L(0); PG8_MMA(1, 0, At, B0); PG8_BAR; PG8_SCHED;
            PG8_STAGE(PG8_SB(0, 1), b2 + hstep, voffB);
            PG8_WAIT_V(6); PG8_BAR; PG8_MMA(1, 1, At, B1); PG8_BAR;
            PG8_LDB(B0, 1, 0); PG8_SCHED; PG8_LDA(At, 1, 0); PG8_STAGE(PG8_SA(0, 1), a2 + hstep, voffA);
            PG8_WAIT_L(8); PG8_BAR; PG8_WAIT_L(0); PG8_MMA(0, 0, At, B0); PG8_BAR; PG8_SCHED;
            PG8_LDB(B1, 1, 1); PG8_STAGE(PG8_SB(1, 0), b3, voffB);
            PG8_BAR; PG8_WAIT_L(0); PG8_MMA(0, 1, At, B1); PG8_BAR;
            PG8_LDA(At, 1, 1); PG8_STAGE(PG8_SA(1, 0), a3, voffA);
            PG8_BAR; PG8_WAIT_L(0); PG8_MMA(1, 0, At, B0); PG8_BAR; PG8_SCHED;
            PG8_STAGE(PG8_SB(1, 1), b3 + hstep, voffB);
            PG8_WAIT_V(6); PG8_BAR; PG8_MMA(1, 1, At, B1); PG8_BAR;
            }
        }
        if constexpr (ALIGN_EPI) { if (wr == 0) PG8_BAR; }
        if constexpr (!Epi::AFTER_DRAIN) { if constexpr (Epi::PREFETCH) E(acc, cur, wr, wc, fr, fq, lds + STAGE_BYTES + (ui & 1) * 5120); else E(acc, cur, wr, wc, fr, fq); S.done(cur); }
        if (!has_next) break;
        if (!Epi::CHAIN || nxt.ko == 0) {
#pragma unroll
        for (int a = 0; a < 2; ++a)
#pragma unroll
            for (int b = 0; b < 2; ++b)
#pragma unroll
                for (int m = 0; m < 4; ++m)
#pragma unroll
                    for (int n = 0; n < 2; ++n) acc[a][b][m][n] = (f32x4){0.f, 0.f, 0.f, 0.f};
        }
        cur = nxt; cA = nA; cB = nB; ++ui;
        if constexpr (ALIGN_EPI) { if (wr == 1) PG8_BAR; }
    }
    PG8_WAIT_V(0);
    if constexpr (!ALIGN_EPI) { if (wr == 0) PG8_BAR; }
    PG8_BAR;
    if constexpr (Epi::AFTER_DRAIN) { E.fused(acc, cur, wr, wc, fr, fq, lds, wid, lane); S.done(cur); }
#undef PG8_SA
#undef PG8_SB
#undef PG8_STAGE
#undef PG8_LDA
#undef PG8_LDB
#undef PG8_MMA
#undef PG8_WAIT_V
#undef PG8_WAIT_L
#undef PG8_BAR
#undef PG8_SCHED
}
}

#ifndef PG8_SP2
#define PG8_SP2 true
#endif
#ifndef PG8_ALIGN
#define PG8_ALIGN true
#endif
namespace att {
using bf16x8 = __attribute__((ext_vector_type(8))) short;
using s16x4  = __attribute__((ext_vector_type(4))) short;
using f32x16 = __attribute__((ext_vector_type(16))) float;
using u32x4  = __attribute__((ext_vector_type(4))) unsigned;
typedef unsigned short bf16_t;
constexpr int NW = 8, QBLK = 32, KVBLK = 64;
#define ATT_SBAR() __builtin_amdgcn_sched_barrier(0)
__device__ __forceinline__ int crow(int r, int hi) { return (r & 3) + 8 * (r >> 2) + 4 * hi; }
__device__ __forceinline__ unsigned cvtpk(float lo, float hi) { unsigned r; asm volatile("v_cvt_pk_bf16_f32 %0, %1, %2" : "=v"(r) : "v"(lo), "v"(hi)); return r; }
__device__ __forceinline__ float bf2f(bf16_t h) { return __uint_as_float((unsigned)h << 16); }
__device__ __forceinline__ int v_rd_base(int lane) { return ((lane & 3) << 3) | (((lane >> 2) & 3) << 6) | (((lane >> 4) & 1) << 5) | (((lane >> 5) & 1) << 8); }
template <bool WIN> __device__ __forceinline__ void wmask(f32x16& p0, f32x16& p1, int qpos, int kbase, int hi) {
  if constexpr (WIN) {
#pragma unroll
    for (int r = 0; r < 16; ++r) { const int k0 = kbase + crow(r, hi) - qpos; if (k0 > 128 || k0 < -128) p0[r] = -INFINITY; if (k0 + 32 > 128 || k0 + 32 < -128) p1[r] = -INFINITY; }
  }
}
__device__ __forceinline__ void exp_half(f32x16& p) {
#pragma unroll
  for (int r = 0; r < 16; ++r) p[r] = __builtin_amdgcn_exp2f(p[r]);
}
constexpr int NSLOT = 3, LDS_V = 0, LDS_K = NSLOT * KVBLK * 128 * 2, LDS_WS = LDS_K + 4 * KVBLK * 64 * 2, LDS_STG = LDS_WS + NW * 64 * 4, ATT_LDS_BYTES = LDS_STG + NW * 8192;
__device__ __forceinline__ void dma16(unsigned m0v, unsigned voff, __amdgpu_buffer_rsrc_t rs, unsigned soff) {
  unsigned keep;
  asm volatile("s_nop 4\n\ts_mov_b32 %0, m0\n\ts_mov_b32 m0, %1\n\ts_nop 0\n\tbuffer_load_dwordx4 %2, %3, %4 offen lds\n\ts_mov_b32 m0, %0" : "=&s"(keep) : "s"(m0v), "v"(voff), "s"(rs), "s"(soff) : "memory");
}
__device__ __forceinline__ void dma16x2(unsigned m0a, unsigned va, unsigned sa, unsigned m0b, unsigned vb, unsigned sb, __amdgpu_buffer_rsrc_t rs) {
  unsigned keep;
  asm volatile("s_nop 4\n\ts_mov_b32 %0, m0\n\ts_mov_b32 m0, %1\n\ts_nop 0\n\tbuffer_load_dwordx4 %2, %7, %3 offen lds\n\ts_mov_b32 m0, %4\n\ts_nop 0\n\tbuffer_load_dwordx4 %5, %7, %6 offen lds\n\ts_mov_b32 m0, %0"
               : "=&s"(keep) : "s"(m0a), "v"(va), "s"(sa), "s"(m0b), "v"(vb), "s"(sb), "s"(rs) : "memory");
}
__device__ __forceinline__ void dma16x3(unsigned m0a, unsigned va, unsigned sa, unsigned m0b, unsigned vb, unsigned m0c, unsigned vc, unsigned sbc, __amdgpu_buffer_rsrc_t rs) {
  unsigned keep;
  asm volatile("s_nop 4\n\ts_mov_b32 %0, m0\n\ts_mov_b32 m0, %1\n\ts_nop 0\n\tbuffer_load_dwordx4 %2, %9, %3 offen lds\n\ts_mov_b32 m0, %4\n\ts_nop 0\n\tbuffer_load_dwordx4 %5, %9, %8 offen lds\n\ts_mov_b32 m0, %6\n\ts_nop 0\n\tbuffer_load_dwordx4 %7, %9, %8 offen lds\n\ts_mov_b32 m0, %0"
               : "=&s"(keep) : "s"(m0a), "v"(va), "s"(sa), "s"(m0b), "v"(vb), "s"(m0c), "v"(vc), "s"(sbc), "s"(rs) : "memory");
}
typedef __attribute__((address_space(3))) const char* lds_cptr;
typedef short v4i16_t __attribute__((ext_vector_type(4)));
__device__ __forceinline__ s16x4 vtr(lds_cptr p) { return __builtin_bit_cast(s16x4, __builtin_amdgcn_ds_read_tr16_b64_v4i16((__attribute__((address_space(3))) v4i16_t*)p)); }
__device__ __forceinline__ bf16x8 kld(lds_cptr p) { return *(const __attribute__((address_space(3))) bf16x8*)p; }
__device__ __forceinline__ void attn_pass_d4(__amdgpu_buffer_rsrc_t rs, unsigned Qb, unsigned ldq, unsigned Kh, unsigned ldk, unsigned Vh, unsigned ldv, int seq, float negm_s, char* lds, f32x16 (&o)[4], float& l_out, const int wid) {
  constexpr int SLOTV = KVBLK * 128 * 2, SLOTK = KVBLK * 64 * 2;
  const int lane = MK_LANE(), r32 = lane & 31, hi = lane >> 5;
  const unsigned lds0 = (unsigned)(uintptr_t)lds;
  bf16x8 qr[4];
  { const unsigned qoff = (unsigned)(wid * QBLK + r32) * ldq + hi * 16;
#pragma unroll
    for (int d0 = 0; d0 < 4; ++d0) { const u32x4 w = __builtin_amdgcn_raw_buffer_load_b128(rs, qoff + d0 * 32, Qb, 0); qr[d0] = __builtin_bit_cast(bf16x8, w); } }
  f32x16 negm; { float ns = negm_s; asm volatile("" : "+v"(ns));
#pragma unroll
  for (int r = 0; r < 16; ++r) negm[r] = ns; }
  asm volatile("" : "+v"(negm));
#pragma unroll
  for (int d = 0; d < 4; ++d) o[d] = f32x16{};
  float l_reg = 0.f;
  const unsigned kvoff = (unsigned)lane * ldk + wid * 16;
  unsigned vvoff0, vvoff1;
  { const int ob = (wid * 2 + 0) * 1024 + lane * 16, st = ob >> 9, k = (st / 4) * 8 + ((ob >> 6) & 7), c = (st % 4) * 32 + ((ob >> 4) & 3) * 8; vvoff0 = (unsigned)k * ldv + c * 2; }
  { const int ob = (wid * 2 + 1) * 1024 + lane * 16, st = ob >> 9, k = (st / 4) * 8 + ((ob >> 6) & 7), c = (st % 4) * 32 + ((ob >> 4) & 3) * 8; vvoff1 = (unsigned)k * ldv + c * 2; }
  const unsigned kdst = lds0 + LDS_K + wid * 1024, vdst = lds0 + LDS_V + wid * 2048;
  const lds_cptr kp0 = (lds_cptr)lds + LDS_K + hi * 1024 + r32 * 16;
  const lds_cptr vp0 = (lds_cptr)lds + LDS_V + v_rd_base(lane);
  const int NT = seq / KVBLK;
#define D4_PIN(x) asm volatile("" : "+v"(x))
#define D4_MFMA(a, b, c) __builtin_amdgcn_mfma_f32_32x32x16_bf16(a, b, c, 0, 0, 0)
#define D4_WAIT_BAR(N) asm volatile("s_waitcnt vmcnt(" #N ") lgkmcnt(0)\n\ts_barrier" ::: "memory")
#define D4_KSLOT(t) ((unsigned)((t) & 3) * SLOTK)
#define D4_DMA_K(t) dma16(kdst + D4_KSLOT(t), kvoff, rs, Kh + (unsigned)(t) * (KVBLK * ldk))
#define D4_DMA_V(t, sl) dma16x2(vdst + (sl), vvoff0, Vh + (unsigned)(t) * (KVBLK * ldv), vdst + (sl) + 1024, vvoff1, Vh + (unsigned)(t) * (KVBLK * ldv), rs)
#define D4_DMA_KV(tk, tv, sl) dma16x3(kdst + D4_KSLOT(tk), kvoff, Kh + (unsigned)(tk) * (KVBLK * ldk), vdst + (sl), vvoff0, vdst + (sl) + 1024, vvoff1, Vh + (unsigned)(tv) * (KVBLK * ldv), rs)
  f32x16 pA0, pA1, pB0, pB1; bf16x8 kf[4]; s16x4 vl[5], vh[5]; u32x4 pw0, pw1, pw2, pw3;
#define D4_KRD(buf, kp, j) kf[buf] = kld((kp) + ((j) >> 1) * 2048 + ((j) & 1) * 512)
#define D4_VO(f, half) (((f) & 3) * 512 + (2 * ((f) >> 2) + (half)) * 2048)
#define D4_VRD(f) do { vl[(f) % 5] = vtr(vp_ + D4_VO(f, 0)); vh[(f) % 5] = vtr(vp_ + D4_VO(f, 1)); } while (0)
#define D4_VFR(f) (bf16x8){vl[(f) % 5][0], vl[(f) % 5][1], vl[(f) % 5][2], vl[(f) % 5][3], vh[(f) % 5][0], vh[(f) % 5][1], vh[(f) % 5][2], vh[(f) % 5][3]}
#define D4_PKW(P, i) cvtpk(P[i], P[i + 1])
#define D4_PAF(k) __builtin_bit_cast(bf16x8, pw##k)
  D4_DMA_K(0); D4_DMA_V(0, 0); D4_DMA_K(1); D4_DMA_K(2); D4_DMA_KV(3, 1, SLOTV);
  D4_WAIT_BAR(3);
  { const lds_cptr kp_ = kp0;
    D4_KRD(0, kp_, 0); D4_KRD(1, kp_, 1); D4_KRD(2, kp_, 2); D4_KRD(3, kp_, 3);
    pA0 = D4_MFMA(kf[0], qr[0], negm); pA1 = D4_MFMA(kf[1], qr[0], negm); pA0 = D4_MFMA(kf[2], qr[1], pA0); pA1 = D4_MFMA(kf[3], qr[1], pA1);
    D4_KRD(0, kp_, 4); D4_KRD(1, kp_, 5); D4_KRD(2, kp_, 6); D4_KRD(3, kp_, 7);
    pA0 = D4_MFMA(kf[0], qr[2], pA0); pA1 = D4_MFMA(kf[1], qr[2], pA1); pA0 = D4_MFMA(kf[2], qr[3], pA0); pA1 = D4_MFMA(kf[3], qr[3], pA1);
    exp_half(pA0); exp_half(pA1);
    const lds_cptr kn_ = kp0 + SLOTK;
    D4_KRD(0, kn_, 0); D4_KRD(1, kn_, 1); D4_KRD(2, kn_, 2); D4_KRD(3, kn_, 3); }
  D4_WAIT_BAR(3);
  unsigned sl_prev = 0, sl_cur = SLOTV, sl_next = 2 * SLOTV;
#define D4_ROT() do { sl_prev = sl_cur; sl_cur = sl_next; sl_next = (sl_next == 2u * SLOTV) ? 0u : sl_next + SLOTV; } while (0)
#define D4_EX2(X, i) do { X[i] = __builtin_amdgcn_exp2f(X[i]); X[(i) + 1] = __builtin_amdgcn_exp2f(X[(i) + 1]); } while (0)
#define D4_GAPA(MF, LD, a0, a1, a2, a3, W0, W1, PW) do { MF; LD; sacc += a0; sacc += a1; sacc += a2; sacc += a3; W0; W1; D4_PIN(PW); D4_PIN(sacc); ATT_SBAR(); } while (0)
#define D4_GAPB(i, X, xi, LD) do { o[(i) & 3] = D4_MFMA(D4_PAFI(i), D4_VFR(i), o[(i) & 3]); LD; D4_EX2(X, xi); D4_PIN(X); ATT_SBAR(); } while (0)
#define D4_PAFI(i) (((i) >> 2) == 0 ? D4_PAF(0) : ((i) >> 2) == 1 ? D4_PAF(1) : ((i) >> 2) == 2 ? D4_PAF(2) : D4_PAF(3))
#define D4_PHA(C0, C1, P0, P1, t, VR) do { ATT_SBAR(); \
    const lds_cptr vp_ = vp0 + sl_prev; const lds_cptr kp_ = kp0 + D4_KSLOT(t); \
    float sacc = P0[0] + P0[1]; ATT_SBAR(); \
    D4_GAPA(C0 = D4_MFMA(kf[0], qr[0], negm), D4_KRD(0, kp_, 4), P0[2], P0[3], P0[4], P0[5],     pw0[0] = D4_PKW(P0, 0),  pw0[1] = D4_PKW(P0, 2),  pw0); \
    D4_GAPA(C1 = D4_MFMA(kf[1], qr[0], negm), D4_KRD(1, kp_, 5), P0[6], P0[7], P0[8], P0[9],     pw0[2] = D4_PKW(P0, 4),  pw0[3] = D4_PKW(P0, 6),  pw0); \
    D4_GAPA(C0 = D4_MFMA(kf[2], qr[1], C0),   D4_KRD(2, kp_, 6), P0[10], P0[11], P0[12], P0[13], pw1[0] = D4_PKW(P0, 8),  pw1[1] = D4_PKW(P0, 10), pw1); \
    D4_GAPA(C1 = D4_MFMA(kf[3], qr[1], C1),   D4_KRD(3, kp_, 7), P0[14], P0[15], P1[0], P1[1],   pw1[2] = D4_PKW(P0, 12), pw1[3] = D4_PKW(P0, 14), pw1); \
    D4_GAPA(C0 = D4_MFMA(kf[0], qr[2], C0),   do { if (VR) D4_VRD(0); } while (0), P1[2], P1[3], P1[4], P1[5],     pw2[0] = D4_PKW(P1, 0),  pw2[1] = D4_PKW(P1, 2),  pw2); \
    D4_GAPA(C1 = D4_MFMA(kf[1], qr[2], C1),   do { if (VR) D4_VRD(1); } while (0), P1[6], P1[7], P1[8], P1[9],     pw2[2] = D4_PKW(P1, 4),  pw2[3] = D4_PKW(P1, 6),  pw2); \
    D4_GAPA(C0 = D4_MFMA(kf[2], qr[3], C0),   do { if (VR) D4_VRD(2); } while (0), P1[10], P1[11], P1[12], P1[13], pw3[0] = D4_PKW(P1, 8),  pw3[1] = D4_PKW(P1, 10), pw3); \
    D4_GAPA(C1 = D4_MFMA(kf[3], qr[3], C1),   do { if (VR) { D4_VRD(3); D4_VRD(4); } } while (0), P1[14], P1[15], 0.f, 0.f, pw3[2] = D4_PKW(P1, 12), pw3[3] = D4_PKW(P1, 14), pw3); \
    l_reg += sacc; } while (0)
#define D4_PHB(C0, C1, t, GK, GV, GL, PRE) do { ATT_SBAR(); \
    const lds_cptr vp_ = vp0 + sl_prev; const lds_cptr kn_ = kp0 + D4_KSLOT((t) + 1); \
    if (PRE) { D4_VRD(0); D4_VRD(1); D4_VRD(2); D4_VRD(3); D4_VRD(4); ATT_SBAR(); } \
    D4_GAPB(0, C0, 0, D4_VRD(5));   D4_GAPB(1, C0, 2, D4_VRD(6));   D4_GAPB(2, C0, 4, D4_VRD(7));    D4_GAPB(3, C0, 6, D4_VRD(8)); \
    D4_GAPB(4, C0, 8, D4_VRD(9));   D4_GAPB(5, C0, 10, D4_VRD(10)); D4_GAPB(6, C0, 12, D4_VRD(11));  D4_GAPB(7, C0, 14, do { D4_VRD(12); if (GL) D4_KRD(0, kn_, 0); } while (0)); \
    D4_GAPB(8, C1, 0, do { D4_VRD(13); if ((GK) && (GV)) D4_DMA_KV((t) + 3, (t) + 1, sl_next); else if (GV) D4_DMA_V((t) + 1, sl_next); } while (0)); \
    D4_GAPB(9, C1, 2, do { D4_VRD(14); if (GL) D4_KRD(1, kn_, 1); } while (0));  D4_GAPB(10, C1, 4, do { D4_VRD(15); if (GL) D4_KRD(2, kn_, 2); } while (0));  D4_GAPB(11, C1, 6, do { if (GL) D4_KRD(3, kn_, 3); } while (0)); \
    D4_GAPB(12, C1, 8, (void)0); D4_GAPB(13, C1, 10, (void)0); D4_GAPB(14, C1, 12, (void)0); D4_GAPB(15, C1, 14, (void)0); \
    } while (0)
  if (wid < 4) {
    int t = 1;
    for (; t + 4 < NT; t += 2) {
      D4_PHA(pB0, pB1, pA0, pA1, t, true);     D4_PHB(pB0, pB1, t, true, true, true, false);     D4_WAIT_BAR(3); D4_ROT();
      D4_PHA(pA0, pA1, pB0, pB1, t + 1, true); D4_PHB(pA0, pA1, t + 1, true, true, true, false); D4_WAIT_BAR(3); D4_ROT();
    }
    D4_PHA(pB0, pB1, pA0, pA1, t, true);     D4_PHB(pB0, pB1, t, false, true, true, false);      D4_WAIT_BAR(2); D4_ROT();
    D4_PHA(pA0, pA1, pB0, pB1, t + 1, true); D4_PHB(pA0, pA1, t + 1, false, true, true, false);  D4_WAIT_BAR(0); D4_ROT();
    D4_PHA(pB0, pB1, pA0, pA1, t + 2, true); D4_PHB(pB0, pB1, t + 2, false, false, false, false);
  } else {
    D4_PHA(pB0, pB1, pA0, pA1, 1, false);
    int t = 1;
    for (; t + 4 < NT; t += 2) {
      D4_PHB(pB0, pB1, t, true, true, true, true);     D4_PHA(pA0, pA1, pB0, pB1, t + 1, false); D4_WAIT_BAR(3); D4_ROT();
      D4_PHB(pA0, pA1, t + 1, true, true, true, true); D4_PHA(pB0, pB1, pA0, pA1, t + 2, false); D4_WAIT_BAR(3); D4_ROT();
    }
    D4_PHB(pB0, pB1, t, false, true, true, true);      D4_PHA(pA0, pA1, pB0, pB1, t + 1, false); D4_WAIT_BAR(2); D4_ROT();
    D4_PHB(pA0, pA1, t + 1, false, true, true, true);  D4_PHA(pB0, pB1, pA0, pA1, t + 2, false); D4_WAIT_BAR(0); D4_ROT();
    D4_PHB(pB0, pB1, t + 2, false, false, false, true);
  }
  { float sacc = pB0[0] + pB0[1];
#pragma unroll
    for (int r = 2; r < 16; ++r) sacc += pB0[r];
#pragma unroll
    for (int r = 0; r < 16; ++r) sacc += pB1[r];
    l_reg += sacc;
    pw0 = (u32x4){D4_PKW(pB0, 0), D4_PKW(pB0, 2), D4_PKW(pB0, 4), D4_PKW(pB0, 6)}; pw1 = (u32x4){D4_PKW(pB0, 8), D4_PKW(pB0, 10), D4_PKW(pB0, 12), D4_PKW(pB0, 14)};
    pw2 = (u32x4){D4_PKW(pB1, 0), D4_PKW(pB1, 2), D4_PKW(pB1, 4), D4_PKW(pB1, 6)}; pw3 = (u32x4){D4_PKW(pB1, 8), D4_PKW(pB1, 10), D4_PKW(pB1, 12), D4_PKW(pB1, 14)};
    const lds_cptr vp_ = vp0 + sl_cur;
    D4_VRD(0); D4_VRD(1); D4_VRD(2); D4_VRD(3); D4_VRD(4);
    o[0] = D4_MFMA(D4_PAF(0), D4_VFR(0), o[0]); D4_VRD(5);
    o[1] = D4_MFMA(D4_PAF(0), D4_VFR(1), o[1]); D4_VRD(6);
    o[2] = D4_MFMA(D4_PAF(0), D4_VFR(2), o[2]); D4_VRD(7);
    o[3] = D4_MFMA(D4_PAF(0), D4_VFR(3), o[3]); D4_VRD(8);
    o[0] = D4_MFMA(D4_PAF(1), D4_VFR(4), o[0]); D4_VRD(9);
    o[1] = D4_MFMA(D4_PAF(1), D4_VFR(5), o[1]); D4_VRD(10);
    o[2] = D4_MFMA(D4_PAF(1), D4_VFR(6), o[2]); D4_VRD(11);
    o[3] = D4_MFMA(D4_PAF(1), D4_VFR(7), o[3]); D4_VRD(12);
    o[0] = D4_MFMA(D4_PAF(2), D4_VFR(8), o[0]); D4_VRD(13);
    o[1] = D4_MFMA(D4_PAF(2), D4_VFR(9), o[1]); D4_VRD(14);
    o[2] = D4_MFMA(D4_PAF(2), D4_VFR(10), o[2]); D4_VRD(15);
    o[3] = D4_MFMA(D4_PAF(2), D4_VFR(11), o[3]);
    o[0] = D4_MFMA(D4_PAF(3), D4_VFR(12), o[0]);
    o[1] = D4_MFMA(D4_PAF(3), D4_VFR(13), o[1]);
    o[2] = D4_MFMA(D4_PAF(3), D4_VFR(14), o[2]);
    o[3] = D4_MFMA(D4_PAF(3), D4_VFR(15), o[3]); }
  { auto rr = __builtin_amdgcn_permlane32_swap(__float_as_uint(l_reg), __float_as_uint(l_reg), false, false); l_out = __uint_as_float(rr[0]) + __uint_as_float(rr[1]); }
  D4_WAIT_BAR(0);
#undef D4_PIN
#undef D4_MFMA
#undef D4_WAIT_BAR
#undef D4_KSLOT
#undef D4_DMA_K
#undef D4_DMA_V
#undef D4_DMA_KV
#undef D4_KRD
#undef D4_VO
#undef D4_VRD
#undef D4_VFR
#undef D4_PKW
#undef D4_PAF
#undef D4_PAFI
#undef D4_ROT
#undef D4_EX2
#undef D4_GAPA
#undef D4_GAPB
#undef D4_PHA
#undef D4_PHB
}
__device__ __forceinline__ void row_recips(float l, float extra, float* wsf, int r32, int hi, float (&rli)[16]) {
  if (hi == 0) wsf[r32] = l + extra; asm volatile("s_waitcnt lgkmcnt(0)" ::: "memory");
#pragma unroll
  for (int r = 0; r < 16; ++r) rli[r] = __builtin_amdgcn_rcpf(wsf[crow(r, hi)]);
  asm volatile("s_waitcnt lgkmcnt(0)" ::: "memory");
}

__device__ __forceinline__ void win_unit2(__amdgpu_buffer_rsrc_t rs, const char* wsb, int b, int kvh, int qb, int pair, const bf16_t* QA, const bf16_t* KA, const bf16_t* VA, bf16_t* ACAT, const float* scal, char* lds, const int wid) {
  constexpr int S = 8192, W_K = 65536, W_WS = 131072;
  const int lane = MK_LANE(), r32 = lane & 31, hi = lane >> 5;
  const unsigned lds0 = (unsigned)(uintptr_t)lds;
  const int q0 = qb * 256, kb0 = q0 - 128; const size_t rowbase = (size_t)b * S;
  const unsigned Kb = (unsigned)((const char*)(KA + rowbase * 128 + kvh * 64) - wsb), Vb = (unsigned)((const char*)(VA + rowbase * 128 + kvh * 64) - wsb);
  { const unsigned kvoff = (unsigned)lane * 256u + wid * 16;
    const int ob = wid * 1024 + lane * 16, st = ob >> 9, k = (st / 2) * 8 + ((ob >> 6) & 7), c = (st % 2) * 32 + ((ob >> 4) & 3) * 8; const unsigned vvoff = (unsigned)k * 256u + c * 2;
#pragma unroll
    for (int j = 0; j < 8; ++j) { const int ks = kb0 + 64 * j;
      if (ks >= 0 && ks < S) dma16x2(lds0 + W_K + j * 8192 + wid * 1024, kvoff, Kb + (unsigned)ks * 256u, lds0 + j * 8192 + wid * 1024, vvoff, Vb + (unsigned)ks * 256u, rs); } }
  asm volatile("s_waitcnt vmcnt(0)\n\ts_barrier" ::: "memory");
  const lds_cptr kp0 = (lds_cptr)lds + W_K + hi * 1024 + r32 * 16;
  const lds_cptr vp0 = (lds_cptr)lds + v_rd_base(lane);
  float* wsf = (float*)(lds + W_WS) + wid * 64;
  const int qrow0 = q0 + wid * QBLK, qpos = qrow0 + r32, jlo = wid >> 1;
#pragma unroll 1
  for (int hh = 0; hh < 2; ++hh) {
    const int hq = kvh * 4 + pair * 2 + hh;
    bf16x8 qr[4];
    { const unsigned Qb = (unsigned)((const char*)(QA + (rowbase + q0) * 512 + hq * 64) - wsb), qoff = (unsigned)(wid * QBLK + r32) * 1024u + hi * 16;
#pragma unroll
      for (int d0 = 0; d0 < 4; ++d0) { const u32x4 w = __builtin_amdgcn_raw_buffer_load_b128(rs, qoff + d0 * 32, Qb, 0); qr[d0] = __builtin_bit_cast(bf16x8, w); } }
    f32x16 negm; { float ns = scal[8 + hq]; asm volatile("" : "+v"(ns));
#pragma unroll
    for (int r = 0; r < 16; ++r) negm[r] = ns; }
    f32x16 o0 = f32x16{}, o1 = f32x16{}; float l_reg = 0.f;
#pragma unroll 1
    for (int i = 0; i < 5; ++i) {
      const int j = jlo + i, ks = kb0 + 64 * j;
      if (ks < 0 || ks >= S) continue;
      const lds_cptr kp = kp0 + j * 8192; const lds_cptr vp = vp0 + j * 8192;
      f32x16 p0, p1;
#pragma unroll
      for (int d0 = 0; d0 < 4; ++d0) { const bf16x8 k0 = kld(kp + d0 * 2048), k1 = kld(kp + d0 * 2048 + 512);
        if (d0 == 0) { p0 = __builtin_amdgcn_mfma_f32_32x32x16_bf16(k0, qr[0], negm, 0, 0, 0); p1 = __builtin_amdgcn_mfma_f32_32x32x16_bf16(k1, qr[0], negm, 0, 0, 0); }
        else { p0 = __builtin_amdgcn_mfma_f32_32x32x16_bf16(k0, qr[d0], p0, 0, 0, 0); p1 = __builtin_amdgcn_mfma_f32_32x32x16_bf16(k1, qr[d0], p1, 0, 0, 0); } }
      if (!((ks >= qrow0 + QBLK - 1 - 128) && (ks + 63 <= qrow0 + 128))) wmask<true>(p0, p1, qpos, ks, hi);
      exp_half(p0); exp_half(p1);
      float ps = 0.f;
#pragma unroll
      for (int r = 0; r < 16; ++r) ps += p0[r];
#pragma unroll
      for (int r = 0; r < 16; ++r) ps += p1[r];
      l_reg += ps;
      bf16x8 pa0, pa1, pa2, pa3;
#define W2_PK4(P, BASE, OUT) do { u32x4 w = {cvtpk(P[BASE + 0], P[BASE + 1]), cvtpk(P[BASE + 2], P[BASE + 3]), cvtpk(P[BASE + 4], P[BASE + 5]), cvtpk(P[BASE + 6], P[BASE + 7])}; OUT = *reinterpret_cast<bf16x8*>(&w); } while (0)
      W2_PK4(p0, 0, pa0); W2_PK4(p0, 8, pa1); W2_PK4(p1, 0, pa2); W2_PK4(p1, 8, pa3);
#undef W2_PK4
#define W2_VF(D0, ks_) ({ const s16x4 l_ = vtr(vp + (D0) * 512 + (2 * (ks_)) * 1024), h_ = vtr(vp + (D0) * 512 + (2 * (ks_) + 1) * 1024); (bf16x8){l_[0], l_[1], l_[2], l_[3], h_[0], h_[1], h_[2], h_[3]}; })
      o0 = __builtin_amdgcn_mfma_f32_32x32x16_bf16(pa0, W2_VF(0, 0), o0, 0, 0, 0); o1 = __builtin_amdgcn_mfma_f32_32x32x16_bf16(pa0, W2_VF(1, 0), o1, 0, 0, 0);
      o0 = __builtin_amdgcn_mfma_f32_32x32x16_bf16(pa1, W2_VF(0, 1), o0, 0, 0, 0); o1 = __builtin_amdgcn_mfma_f32_32x32x16_bf16(pa1, W2_VF(1, 1), o1, 0, 0, 0);
      o0 = __builtin_amdgcn_mfma_f32_32x32x16_bf16(pa2, W2_VF(0, 2), o0, 0, 0, 0); o1 = __builtin_amdgcn_mfma_f32_32x32x16_bf16(pa2, W2_VF(1, 2), o1, 0, 0, 0);
      o0 = __builtin_amdgcn_mfma_f32_32x32x16_bf16(pa3, W2_VF(0, 3), o0, 0, 0, 0); o1 = __builtin_amdgcn_mfma_f32_32x32x16_bf16(pa3, W2_VF(1, 3), o1, 0, 0, 0);
#undef W2_VF
    }
    float l; { auto rr = __builtin_amdgcn_permlane32_swap(__float_as_uint(l_reg), __float_as_uint(l_reg), false, false); l = __uint_as_float(rr[0]) + __uint_as_float(rr[1]); }
    float rli[16];
    row_recips(l, scal[16 + hq], wsf, r32, hi, rli);
    bf16_t* stg = (bf16_t*)(lds + W_WS + 2048) + wid * 1024;
    bf16_t* Ow = ACAT + (rowbase + q0 + wid * QBLK) * 1024 + hq * 64;
#pragma unroll
    for (int g = 0; g < 2; ++g) {
#pragma unroll
      for (int rr = 0; rr < 8; ++rr) { const int r = 8 * g + rr, srow = crow(r, hi) - 16 * g;
        stg[srow * 64 + r32] = (bf16_t)(cvtpk(o0[r] * rli[r], 0.f) & 0xffffu); stg[srow * 64 + 32 + r32] = (bf16_t)(cvtpk(o1[r] * rli[r], 0.f) & 0xffffu); }
      asm volatile("s_waitcnt lgkmcnt(0)" ::: "memory");
#pragma unroll
      for (int i = 0; i < 2; ++i) { const int row = i * 8 + (lane >> 3), ch = lane & 7; const u32x4 v = *(const u32x4*)(stg + row * 64 + ch * 8); *(u32x4*)(Ow + (size_t)(16 * g + row) * 1024 + ch * 8) = v; }
      asm volatile("s_waitcnt lgkmcnt(0)" ::: "memory"); }
  }
  asm volatile("s_waitcnt lgkmcnt(0)" ::: "memory"); __syncthreads();
}

__device__ __forceinline__ void diff_unit(__amdgpu_buffer_rsrc_t rs, const char* wsb, int b, int h, int qb, const bf16_t* QB, const bf16_t* KB, const bf16_t* VB, bf16_t* ACAT, const float* scal, const float* subln, char* lds, const int wid) {
  constexpr int S = 8192;
  const size_t rowbase = (size_t)b * S; const int q0 = qb * 256;
  float* wsf = (float*)(lds + LDS_WS) + wid * 64; float rli[16];
  bf16_t* stg = (bf16_t*)(lds + LDS_STG) + wid * 4096;
#pragma unroll 1
  for (int t = 0; t < 2; ++t) {
    f32x16 o[4]; float l; const float negm_s = scal[2];
    attn_pass_d4(rs, (unsigned)((const char*)(QB + (rowbase + q0) * 512 + (2 * h + t) * 64) - wsb), 1024u, (unsigned)((const char*)(KB + rowbase * 512 + (2 * h + t) * 64) - wsb), 1024u, (unsigned)((const char*)(VB + rowbase * 512 + h * 128) - wsb), 1024u, S, negm_s, lds, o, l, wid);
    const int lane1 = MK_LANE(); int r32 = lane1 & 31, hi = lane1 >> 5, lane = lane1; asm volatile("" : "+v"(r32), "+v"(hi), "+v"(lane));
    row_recips(l, 0.f, wsf, r32, hi, rli);
    if (t == 0) {
#pragma unroll
      for (int r = 0; r < 16; ++r) { const int orow = crow(r, hi);
#pragma unroll
        for (int d0 = 0; d0 < 4; ++d0) stg[orow * 128 + d0 * 32 + r32] = (bf16_t)(cvtpk(o[d0][r] * rli[r], 0.f) & 0xffffu); }
    } else {
      const float lam = scal[0], post = 1.0f - scal[1];
      float ss[16];
#pragma unroll
      for (int r = 0; r < 16; ++r) { const int orow = crow(r, hi); float s_ = 0.f;
#pragma unroll
        for (int d0 = 0; d0 < 4; ++d0) { const float v = bf2f(stg[orow * 128 + d0 * 32 + r32]) - lam * (o[d0][r] * rli[r]); o[d0][r] = v; s_ += v * v; }
        ss[r] = s_; }
#pragma unroll
      for (int r = 0; r < 16; ++r) { float s_ = ss[r]; s_ += __shfl_xor(s_, 1); s_ += __shfl_xor(s_, 2); s_ += __shfl_xor(s_, 4); s_ += __shfl_xor(s_, 8); s_ += __shfl_xor(s_, 16); ss[r] = rsqrtf(s_ * (1.0f / 128.0f) + 1e-6f) * post; }
      float sl[4];
#pragma unroll
      for (int d0 = 0; d0 < 4; ++d0) sl[d0] = subln[d0 * 32 + r32];
#pragma unroll
      for (int r = 0; r < 16; ++r) { const int orow = crow(r, hi);
#pragma unroll
        for (int d0 = 0; d0 < 4; ++d0) stg[orow * 128 + d0 * 32 + r32] = (bf16_t)(cvtpk(o[d0][r] * ss[r] * sl[d0], 0.f) & 0xffffu); }
      asm volatile("s_waitcnt lgkmcnt(0)" ::: "memory");
      const int widl = wid;
      bf16_t* Ow = ACAT + (rowbase + q0) * 1024 + 512 + h * 128 + (unsigned)((widl * QBLK + (lane >> 4)) * 1024 + (lane & 15) * 8);
      const bf16_t* sp = stg + (lane >> 4) * 128 + (lane & 15) * 8;
#pragma unroll
      for (int i = 0; i < 8; ++i) { const u32x4 v = *(const u32x4*)(sp + i * 512); *(u32x4*)(Ow + (size_t)i * 4096) = v; }
    }
  }
  asm volatile("s_waitcnt lgkmcnt(0)" ::: "memory"); __syncthreads();
}
#undef ATT_SBAR
}
constexpr int NWAVES = 8;
#ifndef MK_N_LAUNCHES
#define MK_N_LAUNCHES 1
#endif
constexpr int PER_PHASE = 10;
constexpr int N_LAUNCHES = MK_N_LAUNCHES;

constexpr int BATCH = 2, T = 8192, D = 1024, M = BATCH * T, DFF = 2816, NFF = 2 * DFF, NIN = 4352, NMOD = 9 * D;
constexpr size_t MiB = 1u << 20;
constexpr size_t WS_CTL = 0, CTL_ZERO_BYTES = 1 * MiB;
constexpr size_t WS_MOD = 512 * 1024;
constexpr size_t WS_SCAL = 1 * MiB, WS_CB1 = WS_SCAL + 4096, WS_CBIN = WS_CB1 + 65536, WS_CB2 = WS_CBIN + 65536;
constexpr size_t WS_RSS0 = 2 * MiB, WS_RSS1 = WS_RSS0 + 256 * 1024, WS_RSS2 = WS_RSS1 + 256 * 1024;
constexpr size_t WS_COS = 3 * MiB, WS_SIN = 5 * MiB;
constexpr size_t WS_W1T = 8 * MiB, WS_W1OT = 19 * MiB, WS_WINT = 25 * MiB, WS_WBRT = 34 * MiB, WS_WOT = 38 * MiB, WS_W2T = 40 * MiB, WS_W2OT = 51 * MiB;
constexpr size_t WS_ABUF = 57 * MiB;
constexpr size_t WS_R1 = 89 * MiB;
constexpr size_t WS_QA = WS_R1, WS_KA = WS_QA + 16 * MiB, WS_VA = WS_KA + 4 * MiB, WS_QB = WS_VA + 4 * MiB, WS_KB = WS_QB + 16 * MiB, WS_VB = WS_KB + 16 * MiB;
constexpr size_t WS_MG = WS_R1;
constexpr size_t WS_GA = 177 * MiB, WS_GB = 209 * MiB, WS_END = 241 * MiB;
static_assert(WS_VB + 16 * MiB <= WS_GA && WS_R1 + (size_t)M * DFF * 2 <= WS_GA && WS_W2OT + (size_t)D * DFF * 2 <= WS_ABUF, "d_ws map");
constexpr int CW_TMO = 0, CW_CODE = 1, CW_BAR = 4096;

constexpr int RING_OFF = 0, RING_BYTES = 131072;
constexpr int LDSCTL_OFF = 149504, MISC_OFF = LDSCTL_OFF + 320;
constexpr int LDS_BYTES = 155648;
static_assert(MISC_OFF + 128 <= LDS_BYTES && att::ATT_LDS_BYTES <= LDSCTL_OFF && RING_BYTES <= LDSCTL_OFF, "LDS map");

#define GAS __attribute__((address_space(1)))
#define LAS __attribute__((address_space(3)))
typedef unsigned short bf16;
typedef unsigned v4u __attribute__((ext_vector_type(4)));
typedef float f32x4 __attribute__((ext_vector_type(4)));
typedef short bf16x8 __attribute__((ext_vector_type(8)));
typedef GAS unsigned gu32;
typedef GAS unsigned long long gu64;
#define RLX_AGENT __ATOMIC_RELAXED, __HIP_MEMORY_SCOPE_AGENT
#define LDS_WAIT() asm volatile("s_waitcnt lgkmcnt(0)" ::: "memory")
#define VM_WAIT() asm volatile("s_waitcnt vmcnt(0)" ::: "memory")
__device__ __forceinline__ unsigned long long rt() { return __builtin_amdgcn_s_memrealtime(); }
__device__ __forceinline__ unsigned f2bf(float f) { unsigned u = __builtin_bit_cast(unsigned, f); return (u + 0x7fffu + ((u >> 16) & 1u)) >> 16; }
__device__ __forceinline__ unsigned pk2(float lo, float hi) { return f2bf(lo) | (f2bf(hi) << 16); }

#define XB_TMO      128
#define XB_XCNT(j)  (256  + 64 * (j))
#define XB_XSUB(j)  (1280 + 64 * (j))
#define XB_XGEN(j)  (2304 + 64 * (j))
#define XB_TOP      3328
#define XB_TOPGEN   3392
#define XCD_BAR_WORDS 3456
#define XB_SPIN_CAP (1u << 18)

__device__ __forceinline__ unsigned xb_ld(unsigned* p)              { return __hip_atomic_load(p, __ATOMIC_RELAXED, __HIP_MEMORY_SCOPE_AGENT); }
__device__ __forceinline__ unsigned xb_add(unsigned* p, unsigned v) { return __hip_atomic_fetch_add(p, v, __ATOMIC_RELAXED, __HIP_MEMORY_SCOPE_AGENT); }
__device__ __forceinline__ unsigned xb_xcc_id() { return (unsigned)__builtin_amdgcn_s_getreg((3 << 11) | 20) & 0xFu; }
#define XB_SPIN(cond, bar) do { unsigned _sp = 0; while (cond) { __builtin_amdgcn_s_sleep(1); \
    if ((++_sp & 255u) == 0u) { if (xb_ld(&(bar)[XB_TMO])) break; if (_sp > XB_SPIN_CAP) { atomicAdd(&(bar)[XB_TMO], 1u); break; } } } } while (0)

struct XcdBarrier {
    unsigned* bar; unsigned x;
    volatile LAS unsigned* st;
};

__device__ __forceinline__ XcdBarrier xcd_barrier_post(unsigned* bar, volatile LAS unsigned* st) {
    XcdBarrier b; b.bar = bar; b.x = xb_xcc_id(); b.st = st;
    if (threadIdx.x == 0) (void)xb_add(&bar[XB_XCNT(b.x)], 1u);
    return b;
}
__device__ __forceinline__ void xcd_barrier_complete(unsigned* bar, unsigned x, unsigned& nloc, unsigned& nx) {
    const unsigned G = gridDim.x * gridDim.y * gridDim.z;
    unsigned sum, cnt, mine, sp = 0u;
    for (;;) {
        sum = 0u; cnt = 0u; mine = 0u;
#pragma unroll
        for (unsigned j = 0; j < 16; ++j) { const unsigned c = xb_ld(&bar[XB_XCNT(j)]); sum += c; cnt += (c > 0u) ? 1u : 0u; mine = (j == x) ? c : mine; }
        if (sum == G) break;
        __builtin_amdgcn_s_sleep(1);
        if ((++sp & 255u) == 0u) { if (xb_ld(&bar[XB_TMO])) break; if (sp > XB_SPIN_CAP) { atomicAdd(&bar[XB_TMO], 1u); break; } }
    }
    nloc = mine > 0u ? mine : 1u; nx = cnt > 0u ? cnt : 1u;
}

__device__ __forceinline__ void xcd_barrier(const XcdBarrier& b, const bool leader  ) {
    asm volatile("s_waitcnt vmcnt(0)" ::: "memory");
    __syncthreads();
    if (leader) {
        unsigned* bar = b.bar;
        __builtin_amdgcn_s_waitcnt(0);
        unsigned nloc = b.st[0], nx = b.st[1];
        if (nloc == 0u) { xcd_barrier_complete(bar, b.x, nloc, nx); b.st[0] = nloc; b.st[1] = nx; }
        const unsigned old = xb_add(&bar[XB_XSUB(b.x)], 1u);
        const unsigned gen = old / nloc;
        if (old + 1u == (gen + 1u) * nloc) {
            __builtin_amdgcn_fence(__ATOMIC_RELEASE, "agent");
            asm volatile("s_waitcnt vmcnt(0)" ::: "memory");
            const unsigned og = xb_add(&bar[XB_TOP], 1u);
            const unsigned tg = og / nx;
            asm volatile("buffer_inv sc1" ::: "memory");
            if (og + 1u == (tg + 1u) * nx) xb_add(&bar[XB_TOPGEN], 1u);
            else XB_SPIN(xb_ld(&bar[XB_TOPGEN]) == tg, bar);
            xb_add(&bar[XB_XGEN(b.x)], 1u);
            asm volatile("s_waitcnt vmcnt(0)" ::: "memory");
        } else {
            asm volatile("buffer_inv sc1" ::: "memory");
            XB_SPIN(xb_ld(&bar[XB_XGEN(b.x)]) == gen, bar);
            asm volatile("s_waitcnt vmcnt(0)" ::: "memory");
        }
    }
    __syncthreads();
}

struct Args { const void* in[26]; float* out; unsigned char* ws; int ph_lo, ph_hi, li, pad; };

__device__ __forceinline__ float wave_sum(float v) {
#pragma unroll
    for (int o = 1; o < 64; o <<= 1) v += __shfl_xor(v, o);
    return v;
}
__device__ __forceinline__ int rowmap(int kind, int n0) {
    if (kind == 1) { const int bj = n0 >= DFF ? 1 : 0, jj = n0 - bj * DFF; return (jj >> 7) * 256 + bj * 128 + (jj & 127); }
    if (kind == 2) { if (n0 >= 2304) return n0; const int g32 = n0 >> 5, head = g32 >> 1, bj = g32 & 1; return (head >> 2) * 256 + bj * 128 + (head & 3) * 32; }
    if (kind == 3) return (n0 >> 7) * 256 + (n0 & 127);
    if (kind == 4) return (n0 >> 7) * 256 + 128 + (n0 & 127);
    return n0;
}
struct TItem { const float* src; bf16* dst; int N; int ldk; };
__device__ __forceinline__ TItem p0_item_addr(const float* W, int N, bf16* WT, int ldk, int koff, int kind, int item, int lane) {
    const int nblk = N / 32, kb = item / nblk, nb = item % nblk, k0 = 64 * kb, n0 = 32 * nb, c0 = rowmap(kind, n0), kg = lane & 7, ng = lane >> 3;
    TItem t; t.src = W + (size_t)(k0 + 8 * kg) * N + n0 + 4 * ng; t.dst = WT + (size_t)(c0 + 4 * ng) * ldk + koff + k0 + 8 * kg; t.N = N; t.ldk = ldk; return t;
}
__device__ __forceinline__ void p0_item_load(const TItem& t, f32x4 (&v)[8]) {
#pragma unroll
    for (int j = 0; j < 8; ++j) v[j] = __builtin_nontemporal_load((const f32x4*)(t.src + (size_t)j * t.N));
}
__device__ __forceinline__ void p0_item_store(const TItem& t, const f32x4 (&v)[8]) {
#pragma unroll
    for (int i = 0; i < 4; ++i) { v4u o; o.x = pk2(v[0][i], v[1][i]); o.y = pk2(v[2][i], v[3][i]); o.z = pk2(v[4][i], v[5][i]); o.w = pk2(v[6][i], v[7][i]);
        *(GAS v4u*)(t.dst + (size_t)i * t.ldk) = o; }
}

__device__ __forceinline__ void bias_rows(const bf16* Bt, float* CB, int nrows, const float* sh0, const float* sh1, int gw, int NGW) {
    const int lane = MK_LANE();
    f32x4 s0[2][2], s1[2][2];
#pragma unroll
    for (int hh = 0; hh < 2; ++hh)
#pragma unroll
        for (int q = 0; q < 2; ++q) { s0[hh][q] = *(const f32x4*)(sh0 + hh * 512 + lane * 8 + 4 * q); s1[hh][q] = *(const f32x4*)(sh1 + hh * 512 + lane * 8 + 4 * q); }
    for (int c0 = gw; c0 < nrows; c0 += 3 * NGW) {
        v4u w[3][2];
#pragma unroll
        for (int r = 0; r < 3; ++r) { const int c = c0 + r * NGW;
            if (c < nrows) {
#pragma unroll
                for (int hh = 0; hh < 2; ++hh) w[r][hh] = *(const GAS v4u*)(Bt + (size_t)c * D + hh * 512 + lane * 8); } }
#pragma unroll
        for (int r = 0; r < 3; ++r) { const int c = c0 + r * NGW;
            if (c < nrows) { float a0 = 0.f, a1 = 0.f;
#pragma unroll
                for (int hh = 0; hh < 2; ++hh) { const v4u v = w[r][hh];
                    const float wf[8] = {__uint_as_float(v.x << 16), __uint_as_float(v.x & 0xffff0000u), __uint_as_float(v.y << 16), __uint_as_float(v.y & 0xffff0000u),
                                         __uint_as_float(v.z << 16), __uint_as_float(v.z & 0xffff0000u), __uint_as_float(v.w << 16), __uint_as_float(v.w & 0xffff0000u)};
#pragma unroll
                    for (int e = 0; e < 8; ++e) { a0 += wf[e] * s0[hh][e >> 2][e & 3]; a1 += wf[e] * s1[hh][e >> 2][e & 3]; } }
                a0 = wave_sum(a0); a1 = wave_sum(a1);
                if (lane == 0) { CB[c] = a0; CB[nrows + c] = a1; } } }
    }
}

__global__ void __launch_bounds__(NWAVES * 64, 2) layer_fwd(Args args) {
    extern __shared__ __attribute__((aligned(16))) unsigned char lds[];
    LAS unsigned char* ldsl = (LAS unsigned char*)lds;
    volatile LAS unsigned* MISC = (volatile LAS unsigned*)(ldsl + MISC_OFF);
    const int wave = __builtin_amdgcn_readfirstlane((int)threadIdx.x >> 6), lane = MK_LANE(), tid = wave * 64 + lane;
    const int G = gridDim.x; const int bx = blockIdx.x; const int vcu = (G % 8 == 0) ? (bx % 8) * (G / 8) + bx / 8 : bx;
    unsigned char* ws = args.ws;
    gu32* ctl = (gu32*)(ws + WS_CTL);
    const float* x = (const float*)args.in[0]; const float* cvec = (const float*)args.in[1]; const int* positions = (const int*)args.in[2];
    const float* w_mod = (const float*)args.in[3]; const float* b_mod = (const float*)args.in[4];
    const float* norm_ffn1 = (const float*)args.in[5]; const float* w_ffn1_in = (const float*)args.in[6]; const float* w_ffn1_out = (const float*)args.in[7];
    const float* norm_mix = (const float*)args.in[8]; const float* w_in = (const float*)args.in[9];
    const float* qn_a = (const float*)args.in[10]; const float* kn_a = (const float*)args.in[11]; const float* sink_a = (const float*)args.in[12];
    const float* qn_b = (const float*)args.in[13]; const float* kn_b = (const float*)args.in[14];
    const float* lam_q1 = (const float*)args.in[15]; const float* lam_k1 = (const float*)args.in[16]; const float* lam_q2 = (const float*)args.in[17]; const float* lam_k2 = (const float*)args.in[18];
    const float* subln_b = (const float*)args.in[19]; const float* w_branch_a = (const float*)args.in[20]; const float* w_branch_b = (const float*)args.in[21];
    const float* w_out = (const float*)args.in[22]; const float* norm_ffn2 = (const float*)args.in[23]; const float* w_ffn2_in = (const float*)args.in[24]; const float* w_ffn2_out = (const float*)args.in[25];
    float* out = args.out;
    float* MOD = (float*)(ws + WS_MOD); float* SCAL = (float*)(ws + WS_SCAL); float* CB1 = (float*)(ws + WS_CB1); float* CBIN = (float*)(ws + WS_CBIN); float* CB2 = (float*)(ws + WS_CB2);
    float* RSS0 = (float*)(ws + WS_RSS0); float* RSS1 = (float*)(ws + WS_RSS1); float* RSS2 = (float*)(ws + WS_RSS2); bf16* ROPET = (bf16*)(ws + WS_COS);
    bf16* W1T = (bf16*)(ws + WS_W1T); bf16* W1OT = (bf16*)(ws + WS_W1OT); bf16* WINT = (bf16*)(ws + WS_WINT); bf16* WBRT = (bf16*)(ws + WS_WBRT); bf16* WOT = (bf16*)(ws + WS_WOT);
    bf16* W2T = (bf16*)(ws + WS_W2T); bf16* W2OT = (bf16*)(ws + WS_W2OT);
    bf16* ABUF = (bf16*)(ws + WS_ABUF); bf16* HB = (bf16*)(ws + WS_R1); bf16* MG = (bf16*)(ws + WS_MG);
    bf16* QA = (bf16*)(ws + WS_QA); bf16* KA = (bf16*)(ws + WS_KA); bf16* VA = (bf16*)(ws + WS_VA); bf16* QB = (bf16*)(ws + WS_QB); bf16* KB = (bf16*)(ws + WS_KB); bf16* VB = (bf16*)(ws + WS_VB);
    bf16* GA = (bf16*)(ws + WS_GA); bf16* GB = (bf16*)(ws + WS_GB);
    bf16* X1B = (bf16*)out;
    bf16* X2B = (bf16*)(ws + WS_GA);

    for (int u = tid; u < (LDS_BYTES - LDSCTL_OFF) / 4; u += NWAVES * 64) ((LAS unsigned*)(ldsl + LDSCTL_OFF))[u] = 0u;
    __syncthreads();
    XcdBarrier bar; bar.bar = (unsigned*)(ctl + CW_BAR); bar.x = 0; bar.st = nullptr;
    if (N_LAUNCHES != PER_PHASE) bar = xcd_barrier_post((unsigned*)(ctl + CW_BAR), MISC + 8);
#define GRID_BAR(seam) do { if (N_LAUNCHES == PER_PHASE) { if (tid == 0) __hip_atomic_store(ctl + CW_TMO, 0xBADBA0u | (unsigned)(seam), RLX_AGENT); } else { xcd_barrier(bar, wave == 0 && MK_LANE() == 0); } } while (0)
    const int lo = args.ph_lo, hi = args.ph_hi;
#ifndef PH_MASK
#define PH_MASK 0x3ff
#endif
#define IN(k) (((PH_MASK >> (k)) & 1) && lo <= (k) && (k) < hi)
#define BOTH(k) (IN(k) && IN((k) + 1))
#ifndef REPEAT_MASK
#define REPEAT_MASK 0
#endif
#define REPS(k) for (int rep_ = 0; rep_ <= ((REPEAT_MASK >> (k)) & 1); ++rep_)
    const int gw = vcu * NWAVES + wave, NGW = G * NWAVES;
    constexpr float QSCALE = 0.125f * 1.4426950408889634f;

    if (IN(0)) {
#define MOD_GEMV(IT_BEGIN, IT_END, IT_FIRST, IT_STRIDE, TIDV, LANEV) do { \
            LAS float* ca = (LAS float*)(ldsl + RING_OFF + 73728);              \
            LAS float* red = ca + 2048;                                          \
            for (int i = (TIDV); i < 2 * D; i += NWAVES * 64) { const float v = cvec[i]; ca[i] = v / (1.f + __expf(-v)); } \
            __syncthreads(); \
            for (int it = (IT_BEGIN) + (IT_FIRST); it < (IT_END); it += (IT_STRIDE)) { \
                const int cg = it >> 1, kh = it & 1, j = cg * 64 + (LANEV), kbase = kh * 512 + wave * 64; \
                float wv[64]; \
                _Pragma("unroll") \
                for (int kk = 0; kk < 64; ++kk) wv[kk] = w_mod[(size_t)(kbase + kk) * NMOD + j]; \
                float a0 = 0.f, a1 = 0.f; \
                _Pragma("unroll") \
                for (int kk = 0; kk < 64; ++kk) { a0 += ca[kbase + kk] * wv[kk]; a1 += ca[D + kbase + kk] * wv[kk]; } \
                red[(wave * 2 + 0) * 64 + (LANEV)] = a0; red[(wave * 2 + 1) * 64 + (LANEV)] = a1; \
                __syncthreads(); \
                if ((TIDV) < 128) { const int b = (TIDV) >> 6; float s_ = (kh == 0) ? b_mod[j] : 0.f; \
                    _Pragma("unroll") \
                    for (int w = 0; w < 8; ++w) s_ += red[(w * 2 + b) * 64 + (LANEV)]; \
                    atomicAdd(MOD + b * NMOD + j, s_); } \
                __syncthreads(); \
            } } while (0)
        MOD_GEMV(0, 64, bx, G, tid, lane);
        {
            constexpr int NITEMS = (D / 64) * (NFF / 32);
            auto item_of = [&](int it) -> TItem { return p0_item_addr(w_ffn1_in, NFF, W1T, D, 0, 1, it, lane); };
            for (int it = gw; it < NITEMS; it += 2 * NGW) {
                const int it2 = it + NGW; const bool two = it2 < NITEMS;
                const TItem a = item_of(it), b2 = item_of(two ? it2 : it);
                f32x4 va[8], vb[8];
                p0_item_load(a, va); if (two) p0_item_load(b2, vb);
                p0_item_store(a, va); if (two) p0_item_store(b2, vb);
            }
        }
        if (bx == 0 && wave == 0) {
            const float a = wave_sum(lam_q1[lane] * lam_k1[lane]), b2 = wave_sum(lam_q2[lane] * lam_k2[lane]);
            float mqa = fabsf(qn_a[lane]), mka = fabsf(kn_a[lane]), mqb = fabsf(qn_b[lane]), mkb = fabsf(kn_b[lane]);
#pragma unroll
            for (int o = 1; o < 64; o <<= 1) { mqa = fmaxf(mqa, __shfl_xor(mqa, o)); mka = fmaxf(mka, __shfl_xor(mka, o)); mqb = fmaxf(mqb, __shfl_xor(mqb, o)); mkb = fmaxf(mkb, __shfl_xor(mkb, o)); }
            const float bound_a = 8.0f * mqa * mka * 1.001f, bound_b = 8.0f * mqb * mkb * 1.001f, L2E = 1.4426950408889634f;
            if (lane == 0) { const float lam_init = 0.8f - 0.6f * expf(-0.3f * 0.f); SCAL[0] = expf(a) - expf(b2) + lam_init; SCAL[1] = lam_init; SCAL[2] = -bound_b * L2E; }
            if (lane < 8) { const float sk = sink_a[lane], mh = fmaxf(bound_a, sk); SCAL[8 + lane] = -mh * L2E; SCAL[16 + lane] = exp2f((sk - mh) * L2E); }
        }
        if (BOTH(0)) GRID_BAR(0);
    }

    if (IN(1)) {
        for (int m = gw; m < M; m += NGW) {
            const int b = m >> 13; const GAS f32x4* xr = (const GAS f32x4*)(x + (size_t)m * D) + lane;
            f32x4 v[4]; float s = 0.f;
#pragma unroll
            for (int j = 0; j < 4; ++j) { v[j] = xr[64 * j]; s += (v[j].x * v[j].x + v[j].y * v[j].y) + (v[j].z * v[j].z + v[j].w * v[j].w); }
            s = wave_sum(s);
            if (lane == 0) *(f32x4*)(RSS0 + (size_t)m * 4) = (f32x4){s, 0.f, 0.f, 0.f};
            GAS unsigned long long* o8 = (GAS unsigned long long*)(ABUF + (size_t)m * D) + lane;
#pragma unroll
            for (int j = 0; j < 4; ++j) { const int c = 4 * lane + 256 * j; const f32x4 g = *(const f32x4*)(norm_ffn1 + c) * (*(const f32x4*)(MOD + b * NMOD + 1 * D + c) + 1.0f); const f32x4 a = v[j] * g;
                o8[64 * j] = (unsigned long long)pk2(a.x, a.y) | ((unsigned long long)pk2(a.z, a.w) << 32); }
        }
        bias_rows(W1T, CB1, NFF, MOD + 0 * D, MOD + NMOD + 0 * D, gw, NGW);
        if (BOTH(1)) GRID_BAR(1);
    }

    if (IN(2)) {
        pg8::Gemm g{ABUF, W1T, M, NFF, D}; pg8::StaticOrder S; S.init(M, NFF, G, bx);
        pg8::EpiSwiGLU E{HB, DFF, RSS0, CB1, NFF};
        pg8::gemm_phase<pg8::EpiSwiGLU, pg8::StaticOrder, PG8_ALIGN, PG8_SP2>(ldsl + RING_OFF, g, S, E, wave);
        { pg8::Unit ud; const int nunits = (M / 256) * (NFF / 256), nfull = nunits / G;
          if (!S.next(nfull, ud)) {
            const int nidle = G - (nunits - nfull * G), iw = (bx - (G - nidle)) * NWAVES + wave, NIW = nidle * NWAVES, lane2 = MK_LANE();
            MOD_GEMV(64, 288, bx - (G - nidle), nidle, wave * 64 + lane2, lane2);
            constexpr int I_IN = (D / 64) * (NIN / 32), I_1O = (DFF / 64) * (D / 32), NITEMS = I_IN + I_1O;
            auto item_of = [&](int it) -> TItem { return it < I_IN ? p0_item_addr(w_in, NIN, WINT, D, 0, 2, it, lane2) : p0_item_addr(w_ffn1_out, D, W1OT, DFF, 0, 0, it - I_IN, lane2); };
            for (int it = iw; it < NITEMS; it += 2 * NIW) {
                const int it2 = it + NIW; const bool two = it2 < NITEMS;
                const TItem a = item_of(it), b2 = item_of(two ? it2 : it);
                f32x4 va[8], vb[8];
                p0_item_load(a, va); if (two) p0_item_load(b2, vb);
                p0_item_store(a, va); if (two) p0_item_store(b2, vb);
            }
            { const float invf = (float)pow(10000.0, -(double)(2 * (lane2 & 31)) / 64.0);
              for (int i = iw * 64 + lane2; i < M * 32; i += NIW * 64) { const float ang = (float)positions[i >> 5] * invf; const int row = i >> 5, d = i & 31;
                  ROPET[row * 64 + d] = (bf16)f2bf(cosf(ang)); ROPET[row * 64 + 32 + d] = (bf16)f2bf(sinf(ang)); } }
          } }
        if (BOTH(2)) GRID_BAR(2);
    }
    if (IN(3)) {
        pg8::Gemm g{HB, W1OT, M, D, DFF}; pg8::StaticOrder S; S.init(M, D, G, bx);
        pg8::EpiResid<true, 1, false, true> E{x, X1B, MOD + 2 * D, ABUF, norm_mix, MOD + 4 * D, RSS1};
        pg8::gemm_phase<pg8::EpiResid<true, 1, false, true>, pg8::StaticOrder, false, PG8_SP2>(ldsl + RING_OFF, g, S, E, wave);
        bias_rows(WINT, CBIN, NIN, MOD + 3 * D, MOD + NMOD + 3 * D, gw, NGW);
        if (BOTH(3)) GRID_BAR(3);
    }
    if (IN(4)) {
        pg8::Gemm g{ABUF, WINT, M, NIN, D}; pg8::StaticOrder S; S.init(M, NIN, G, bx);
        pg8::EpiInProj E{QA, KA, VA, QB, KB, VB, GA, GB, RSS1, CBIN, ROPET, qn_a, kn_a, qn_b, kn_b, QSCALE};
        pg8::gemm_phase<pg8::EpiInProj, pg8::StaticOrder, PG8_ALIGN, PG8_SP2>(ldsl + RING_OFF, g, S, E, wave);
        { pg8::Unit ud; const int nunits = (M / 256) * (NIN / 256), nfull = nunits / G;
          if (!S.next(nfull, ud)) {
            const int nidle = G - (nunits - nfull * G), iw = (bx - (G - nidle)) * NWAVES + wave, NIW = nidle * NWAVES, lane2 = MK_LANE();
            constexpr int I_1 = (D / 64) * (NFF / 32), I_1O = (DFF / 64) * (D / 32), I_BR = (512 / 64) * (D / 32), I_O = (D / 64) * (D / 32);
            constexpr int NITEMS = 2 * I_BR + I_O + I_1 + I_1O;
            auto item_of = [&](int it) -> TItem {
                int r = it;
                if (r < I_BR) return p0_item_addr(w_branch_a, D, WBRT, D, 0, 0, r, lane2); r -= I_BR;
                if (r < I_BR) return p0_item_addr(w_branch_b, D, WBRT, D, 512, 0, r, lane2); r -= I_BR;
                if (r < I_O) return p0_item_addr(w_out, D, WOT, D, 0, 0, r, lane2); r -= I_O;
                if (r < I_1) return p0_item_addr(w_ffn2_in, NFF, W2T, D, 0, 1, r, lane2); r -= I_1;
                return p0_item_addr(w_ffn2_out, D, W2OT, DFF, 0, 0, r, lane2);
            };
            for (int it = iw; it < NITEMS; it += 2 * NIW) {
                const int it2 = it + NIW; const bool two = it2 < NITEMS;
                const TItem a = item_of(it), b2 = item_of(two ? it2 : it);
                f32x4 va[8], vb[8];
                p0_item_load(a, va); if (two) p0_item_load(b2, vb);
                p0_item_store(a, va); if (two) p0_item_store(b2, vb);
            }
          } }
        if (BOTH(4)) GRID_BAR(4);
    }
    if (IN(5)) {
        char* alds = (char*)lds + RING_OFF;
        const __amdgpu_buffer_rsrc_t wsrs = __builtin_amdgcn_make_buffer_rsrc((void*)ws, (short)0, 0x10000000, 0x00020000);
#ifndef SKIP_WIN
        for (int id = vcu; id < 256; id += G) att::win_unit2(wsrs, (const char*)ws, id >> 7, (id >> 6) & 1, id & 31, (id >> 5) & 1, QA, KA, VA, ABUF, SCAL, alds, wave);
#endif
#ifndef SKIP_DIFF
        for (int id = vcu; id < 256; id += G) att::diff_unit(wsrs, (const char*)ws, id >> 7, (id >> 5) & 3, id & 31, QB, KB, VB, ABUF, SCAL, subln_b, alds, wave);
#endif
        if (BOTH(5)) GRID_BAR(5);
    }
    if (IN(6)) {
        pg8::Gemm g{ABUF, WBRT, M, D, D, 512}; pg8::PairOrder S; S.init(M, D, G, bx, D);
        pg8::EpiBranch E{GA, GB, MG};
        pg8::gemm_phase<pg8::EpiBranch, pg8::PairOrder, false, PG8_SP2>(ldsl + RING_OFF, g, S, E, wave);
        if (BOTH(6)) GRID_BAR(6);
    }
    if (IN(7)) {
        pg8::Gemm g{MG, WOT, M, D, D}; pg8::StaticOrder S; S.init(M, D, G, bx);
        pg8::EpiResid<true, 2, true, true> E{X1B, X2B, MOD + 5 * D, ABUF, norm_ffn2, MOD + 7 * D, RSS2};
        pg8::gemm_phase<pg8::EpiResid<true, 2, true, true>, pg8::StaticOrder, false, PG8_SP2>(ldsl + RING_OFF, g, S, E, wave);
        bias_rows(W2T, CB2, NFF, MOD + 6 * D, MOD + NMOD + 6 * D, gw, NGW);
        if (BOTH(7)) GRID_BAR(7);
    }
    if (IN(8)) {
        pg8::Gemm g{ABUF, W2T, M, NFF, D}; pg8::StaticOrder S; S.init(M, NFF, G, bx);
        pg8::EpiSwiGLU E{HB, DFF, RSS2, CB2, NFF};
        pg8::gemm_phase<pg8::EpiSwiGLU, pg8::StaticOrder, PG8_ALIGN, PG8_SP2>(ldsl + RING_OFF, g, S, E, wave);
        if (BOTH(8)) GRID_BAR(8);
    }
    if (IN(9)) {
        pg8::Gemm g{HB, W2OT, M, D, DFF}; pg8::StaticOrder S; S.init(M, D, G, bx);
        pg8::EpiResid<false, 1, true, false> E{X2B, out, MOD + 8 * D, nullptr, nullptr, nullptr, nullptr};
        pg8::gemm_phase<pg8::EpiResid<false, 1, true, false>, pg8::StaticOrder, false, PG8_SP2>(ldsl + RING_OFF, g, S, E, wave);
    }
#undef IN
#undef BOTH
#undef GRID_BAR
}

extern "C" void kernel_launch(void* const* d_in, const int* in_sizes, int n_in, void* d_out, int out_size, void* d_ws, size_t ws_size, hipStream_t stream) {
    static int grid = 0;
    if (grid == 0) {
        if (n_in != 26 || in_sizes[0] != M * D || out_size != M * D || ws_size < WS_END) { fprintf(stderr, "kernel_launch: unexpected shapes: n_in %d in0 %d out %d ws %zu (need >= %zu)\n", n_in, n_in > 0 ? in_sizes[0] : -1, out_size, ws_size, (size_t)WS_END); grid = -1; return; }
        int dev = 0, cus = 0;
        if (hipGetDevice(&dev) != hipSuccess || hipDeviceGetAttribute(&cus, hipDeviceAttributeMultiprocessorCount, dev) != hipSuccess) { grid = -1; return; }
        if (hipFuncSetAttribute((const void*)layer_fwd, hipFuncAttributeMaxDynamicSharedMemorySize, LDS_BYTES) != hipSuccess) { fprintf(stderr, "kernel_launch: hipFuncSetAttribute failed\n"); grid = -1; return; }
        int per_cu = 0;
        if (hipOccupancyMaxActiveBlocksPerMultiprocessor(&per_cu, (const void*)layer_fwd, NWAVES * 64, LDS_BYTES) != hipSuccess || per_cu < 1) fprintf(stderr, "kernel_launch: occupancy query says %d\n", per_cu);
        (void)hipGetLastError();
        grid = cus;
        if (grid != 256) fprintf(stderr, "kernel_launch: %d CUs; the one-unit-per-workgroup phases need exactly 256\n", grid);
    }
    if (grid < 0) return;
    (void)hipMemsetAsync((char*)d_ws + WS_CTL, 0, CTL_ZERO_BYTES, stream);
    Args a{};
    for (int i = 0; i < 26; ++i) a.in[i] = d_in[i];
    a.out = (float*)d_out; a.ws = (unsigned char*)d_ws;
    for (int li = 0; li < N_LAUNCHES; ++li) {
        a.ph_lo = (N_LAUNCHES == PER_PHASE) ? li : 0; a.ph_hi = (N_LAUNCHES == PER_PHASE) ? li + 1 : PER_PHASE; a.li = li;
        hipLaunchKernelGGL(layer_fwd, dim3(grid), dim3(NWAVES * 64), LDS_BYTES, stream, a);
    }
}
```
